# Optimizing an MI355X kernel written in HIP

```python
import math
import jax
import jax.numpy as jnp
from jax import lax
import numpy as np

D_MODEL = 1024
BATCH = 4
SEQ = 4096
DEPTH = 2

N_A = DEPTH // 2
N_B = DEPTH - N_A
S5_GROUP = 16
S5_WIDTH = D_MODEL
S5_GROUPS = S5_WIDTH // S5_GROUP
S5_STATE = 64
HEAD_DIM = 64
N_HEADS = D_MODEL // HEAD_DIM
N_KV_HEADS = 4
Q_PER_KV = N_HEADS // N_KV_HEADS
WINDOW = 128
ATTN_BLOCK = 128
ROPE_THETA = 10000.0
PEER_HEADS = 8
PEER_KEY_DIM = 128
PEER_HALF = PEER_KEY_DIM // 2
PEER_N_KEYS = 128
PEER_N_EXPERTS = PEER_N_KEYS * PEER_N_KEYS
PEER_TOPK = 16
PEER_TOKEN_BLOCK = 128
N_COND = 6 * DEPTH + 4
RMS_EPS = 1e-6
NEG_INF = -1e30

kernel_name = "yoco_s5_swa_sink_peer_adaln"


def rmsnorm(x, g):
    x32 = x.astype(jnp.float32)
    y = x32 * lax.rsqrt(jnp.mean(x32 * x32, axis=-1, keepdims=True) + RMS_EPS)
    return (y * g.astype(jnp.float32)).astype(x.dtype)


def modulate(h, shift, scale):
    return h * (1 + scale[:, None, :]) + shift[:, None, :]


def rope_tables(positions):
    inv_freq = ROPE_THETA ** (-jnp.arange(0, HEAD_DIM, 2, dtype=jnp.float32) / HEAD_DIM)
    ang = positions.astype(jnp.float32)[..., None] * inv_freq
    return jnp.cos(ang)[:, :, None, :], jnp.sin(ang)[:, :, None, :]


def apply_rope(t, cos, sin):
    cos = cos.astype(t.dtype)
    sin = sin.astype(t.dtype)
    t1, t2 = jnp.split(t, 2, axis=-1)
    return jnp.concatenate([t1 * cos - t2 * sin, t2 * cos + t1 * sin], axis=-1)


def s5_discretize(a_re, a_im, log_dt, b_re, b_im):
    a_re = a_re.astype(jnp.float32)
    a_im = a_im.astype(jnp.float32)
    b_re = b_re.astype(jnp.float32)
    b_im = b_im.astype(jnp.float32)
    dt = jnp.exp(log_dt.astype(jnp.float32))[:, None]
    mag = jnp.exp(a_re * dt)
    lb_re = mag * jnp.cos(a_im * dt)
    lb_im = mag * jnp.sin(a_im * dt)
    nr = lb_re - 1.0
    ni = lb_im
    den = a_re * a_re + a_im * a_im
    coef_re = (nr * a_re + ni * a_im) / den
    coef_im = (ni * a_re - nr * a_im) / den
    bb_re = coef_re[..., None] * b_re - coef_im[..., None] * b_im
    bb_im = coef_re[..., None] * b_im + coef_im[..., None] * b_re
    return lb_re, lb_im, bb_re, bb_im


def s5_scan_one(u, lb_re, lb_im, bb_re, bb_im, c_re, c_im, d):
    bu_re = jnp.einsum('gpc,sgc->sgp', bb_re, u)
    bu_im = jnp.einsum('gpc,sgc->sgp', bb_im, u)
    a_re = jnp.broadcast_to(lb_re, bu_re.shape)
    a_im = jnp.broadcast_to(lb_im, bu_im.shape)

    def combine(e1, e2):
        a1r, a1i, b1r, b1i = e1
        a2r, a2i, b2r, b2i = e2
        return (a2r * a1r - a2i * a1i,
                a2r * a1i + a2i * a1r,
                a2r * b1r - a2i * b1i + b2r,
                a2r * b1i + a2i * b1r + b2i)

    _, _, xr, xi = lax.associative_scan(combine, (a_re, a_im, bu_re, bu_im), axis=0)
    y = jnp.einsum('gcp,sgp->sgc', c_re, xr) - jnp.einsum('gcp,sgp->sgc', c_im, xi)
    return y + d * u


def s5_mixer(h, w_in, a_re, a_im, log_dt, b_re, b_im, c_re, c_im, d, w_glu, b_glu, w_out):
    B, S, _ = h.shape
    u = (h @ w_in).astype(jnp.float32).reshape(B, S, S5_GROUPS, S5_GROUP)
    lb_re, lb_im, bb_re, bb_im = s5_discretize(a_re, a_im, log_dt, b_re, b_im)
    c_re32 = c_re.astype(jnp.float32)
    c_im32 = c_im.astype(jnp.float32)
    d32 = d.astype(jnp.float32)
    y = lax.map(lambda ub: s5_scan_one(ub, lb_re, lb_im, bb_re, bb_im, c_re32, c_im32, d32), u)
    y = jax.nn.gelu(y.reshape(B, S, S5_WIDTH))
    y = y * jax.nn.sigmoid(y @ w_glu.astype(jnp.float32) + b_glu.astype(jnp.float32))
    return (y.astype(h.dtype) @ w_out).astype(h.dtype)


def shared_kv(x, g, shift, scale, w_kv, cos, sin):
    B, S, _ = x.shape
    h = modulate(rmsnorm(x, g), shift, scale)
    kv = h @ w_kv
    k, v = jnp.split(kv, 2, axis=-1)
    k = apply_rope(k.reshape(B, S, N_KV_HEADS, HEAD_DIM), cos, sin)
    v = v.reshape(B, S, N_KV_HEADS, HEAD_DIM)
    return k, v


def window_attention(h, k, v, w_q, sinks, w_o, cos, sin):
    B, S, _ = h.shape
    nb = S // ATTN_BLOCK
    q = apply_rope((h @ w_q).reshape(B, S, N_HEADS, HEAD_DIM), cos, sin)
    q = q.reshape(B, nb, ATTN_BLOCK, N_KV_HEADS, Q_PER_KV, HEAD_DIM)

    def band(t):
        tp = jnp.pad(t, ((0, 0), (ATTN_BLOCK, 0), (0, 0), (0, 0)))
        tp = tp.reshape(B, nb + 1, ATTN_BLOCK, N_KV_HEADS, HEAD_DIM)
        return jnp.concatenate([tp[:, :-1], tp[:, 1:]], axis=2)

    kb = band(k)
    vb = band(v)
    qi = jnp.arange(ATTN_BLOCK)[:, None]
    kj = jnp.arange(2 * ATTN_BLOCK)[None, :]
    diff = qi + ATTN_BLOCK - kj
    k_abs = (jnp.arange(nb)[:, None, None] - 1) * ATTN_BLOCK + kj[None]
    mask = (diff >= 0)[None] & (diff < WINDOW)[None] & (k_abs >= 0)
    s = jnp.einsum('bnqkgd,bnjkd->bnkgqj', q, kb).astype(jnp.float32) * (HEAD_DIM ** -0.5)
    s = jnp.where(mask[None, :, None, None, :, :], s, NEG_INF)
    sink = sinks.astype(jnp.float32).reshape(N_KV_HEADS, Q_PER_KV)[None, None, :, :, None, None]
    m = jnp.maximum(jnp.max(s, axis=-1, keepdims=True), sink)
    p = jnp.exp(s - m)
    p = p / (jnp.sum(p, axis=-1, keepdims=True) + jnp.exp(sink - m))
    o = jnp.einsum('bnkgqj,bnjkd->bnqkgd', p.astype(vb.dtype), vb)
    return o.reshape(B, S, N_HEADS * HEAD_DIM) @ w_o


def peer(h, w_q, sub_keys, u_tab, v_tab):
    B, S, D = h.shape
    T = B * S
    xt = h.reshape(T, D)
    q = (xt @ w_q).reshape(T, PEER_HEADS, 2, PEER_HALF)
    sc = jnp.einsum('thpd,hpnd->thpn', q, sub_keys).astype(jnp.float32)
    s_half, i_half = lax.top_k(sc, PEER_TOPK)
    cand = s_half[:, :, 0, :, None] + s_half[:, :, 1, None, :]
    cand_id = i_half[:, :, 0, :, None] * PEER_N_KEYS + i_half[:, :, 1, None, :]
    cand = cand.reshape(T, PEER_HEADS, PEER_TOPK * PEER_TOPK)
    cand_id = cand_id.reshape(T, PEER_HEADS, PEER_TOPK * PEER_TOPK)
    top_s, top_pos = lax.top_k(cand, PEER_TOPK)
    ids = jnp.take_along_axis(cand_id, top_pos, axis=-1)
    gates = jax.nn.softmax(top_s, axis=-1).astype(h.dtype)
    nblk = T // PEER_TOKEN_BLOCK
    ids = ids.reshape(nblk, PEER_TOKEN_BLOCK, PEER_HEADS * PEER_TOPK)
    gates = gates.reshape(nblk, PEER_TOKEN_BLOCK, PEER_HEADS * PEER_TOPK)
    xb = xt.reshape(nblk, PEER_TOKEN_BLOCK, D)

    def expert_block(args):
        xc, idc, gc = args
        act = jax.nn.gelu(jnp.einsum('td,tkd->tk', xc, u_tab[idc])) * gc
        return jnp.einsum('tk,tkd->td', act, v_tab[idc])

    out = lax.map(expert_block, (xb, ids, gates))
    return out.reshape(B, S, D)


def setup_inputs(seed: int = 0) -> dict:
    key = jax.random.key(seed)
    ks = jax.random.split(key, 32)
    f32 = jnp.float32
    B, S, D = BATCH, SEQ, D_MODEL

    def nrm(k, shape, s):
        return jax.random.normal(k, shape, f32) * s

    G, P, C = S5_GROUPS, S5_STATE, S5_GROUP
    n = jnp.arange(P, dtype=f32)
    return {
        "x": nrm(ks[0], (B, S, D), 1.0),
        "c": nrm(ks[1], (B, D), 1.0),
        "positions": jnp.broadcast_to(jnp.arange(S, dtype=jnp.int32)[None, :], (B, S)),
        "w_cond": nrm(ks[2], (D, N_COND * D), 0.5 * D ** -0.5),
        "b_cond": nrm(ks[3], (N_COND * D,), 0.02),
        "norm_mix": 1.0 + nrm(ks[4], (DEPTH, D), 0.02),
        "norm_ffn": 1.0 + nrm(ks[5], (DEPTH, D), 0.02),
        "s5_w_in": nrm(ks[6], (N_A, D, S5_WIDTH), D ** -0.5),
        "s5_a_re": -0.5 + nrm(ks[7], (N_A, G, P), 0.01),
        "s5_a_im": math.pi * n + nrm(ks[8], (N_A, G, P), 0.01),
        "s5_log_dt": jax.random.uniform(ks[9], (N_A, G), f32, math.log(1e-3), math.log(1e-1)),
        "s5_b_re": nrm(ks[10], (N_A, G, P, C), (2 * C) ** -0.5),
        "s5_b_im": nrm(ks[11], (N_A, G, P, C), (2 * C) ** -0.5),
        "s5_c_re": nrm(ks[12], (N_A, G, C, P), P ** -0.5),
        "s5_c_im": nrm(ks[13], (N_A, G, C, P), P ** -0.5),
        "s5_d": nrm(ks[14], (N_A, G, C), 1.0),
        "s5_w_glu": nrm(ks[15], (N_A, S5_WIDTH, S5_WIDTH), S5_WIDTH ** -0.5),
        "s5_b_glu": nrm(ks[16], (N_A, S5_WIDTH), 0.02),
        "s5_w_out": nrm(ks[17], (N_A, S5_WIDTH, D), S5_WIDTH ** -0.5),
        "kv_norm": 1.0 + nrm(ks[18], (D,), 0.02),
        "w_kv": nrm(ks[19], (D, 2 * N_KV_HEADS * HEAD_DIM), D ** -0.5),
        "attn_w_q": nrm(ks[20], (N_B, D, N_HEADS * HEAD_DIM), D ** -0.5),
        "attn_sinks": nrm(ks[21], (N_B, N_HEADS), 0.5),
        "attn_w_o": nrm(ks[22], (N_B, N_HEADS * HEAD_DIM, D), (N_HEADS * HEAD_DIM) ** -0.5),
        "peer_w_q": nrm(ks[23], (DEPTH, D, PEER_HEADS * PEER_KEY_DIM), D ** -0.5),
        "peer_sub_keys": nrm(ks[24], (DEPTH, PEER_HEADS, 2, PEER_N_KEYS, PEER_HALF), PEER_HALF ** -0.5),
        "peer_u": nrm(ks[25], (DEPTH, PEER_N_EXPERTS, D), D ** -0.5),
        "peer_v": nrm(ks[26], (DEPTH, PEER_N_EXPERTS, D), 1.0),
        "final_norm": 1.0 + nrm(ks[27], (D,), 0.02),
    }


def reference(x, c, positions, w_cond, b_cond, norm_mix, norm_ffn, s5_w_in, s5_a_re, s5_a_im,
              s5_log_dt, s5_b_re, s5_b_im, s5_c_re, s5_c_im, s5_d, s5_w_glu, s5_b_glu, s5_w_out,
              kv_norm, w_kv, attn_w_q, attn_sinks, attn_w_o, peer_w_q, peer_sub_keys, peer_u,
              peer_v, final_norm):
    B = x.shape[0]
    cond = (jax.nn.silu(c.astype(jnp.float32)) @ w_cond.astype(jnp.float32)
            + b_cond.astype(jnp.float32)).astype(x.dtype).reshape(B, N_COND, D_MODEL)
    cos, sin = rope_tables(positions)
    k_sh = None
    v_sh = None
    for i in range(DEPTH):
        m = cond[:, 6 * i:6 * i + 6]
        h = modulate(rmsnorm(x, norm_mix[i]), m[:, 0], m[:, 1])
        if i < N_A:
            a = i
            y = s5_mixer(h, s5_w_in[a], s5_a_re[a], s5_a_im[a], s5_log_dt[a], s5_b_re[a], s5_b_im[a],
                         s5_c_re[a], s5_c_im[a], s5_d[a], s5_w_glu[a], s5_b_glu[a], s5_w_out[a])
        else:
            b = i - N_A
            y = window_attention(h, k_sh, v_sh, attn_w_q[b], attn_sinks[b], attn_w_o[b], cos, sin)
        x = x + m[:, 2][:, None, :] * y
        h = modulate(rmsnorm(x, norm_ffn[i]), m[:, 3], m[:, 4])
        x = x + m[:, 5][:, None, :] * peer(h, peer_w_q[i], peer_sub_keys[i], peer_u[i], peer_v[i])
        if i == N_A - 1:
            k_sh, v_sh = shared_kv(x, kv_norm, cond[:, 6 * DEPTH], cond[:, 6 * DEPTH + 1], w_kv, cos, sin)
    return modulate(rmsnorm(x, final_norm), cond[:, 6 * DEPTH + 2], cond[:, 6 * DEPTH + 3])
```

```cpp
#include <hip/hip_runtime.h>
#include <hip/hip_cooperative_groups.h>
#include <cstdio>
#include <cstdint>
namespace cg = cooperative_groups;

#define NT 512
#define LAS __attribute__((address_space(3)))
typedef unsigned short bf16_t;
typedef short bf16x8 __attribute__((ext_vector_type(8)));
typedef float f32x4 __attribute__((ext_vector_type(4)));
typedef unsigned u32x4 __attribute__((ext_vector_type(4)));
typedef unsigned u32x2 __attribute__((ext_vector_type(2)));

constexpr int D = 1024, NB = 4, SEQ = 4096, T = NB * SEQ;
constexpr int NCOND = 16;
constexpr int G5 = 64, P5 = 64, C5 = 16, L5 = 64, NCH = SEQ / L5;
constexpr int NEXP = 16384;
constexpr int NSC = 4608;
constexpr int SC_IN = 0, SC_PQ0 = 1024, SC_KV = 2048, SC_Q = 2560, SC_PQ1 = 3584;
constexpr float RMS_EPS = 1e-6f;

struct Params {
    const float *x, *c; const int* pos; const float *w_cond, *b_cond, *norm_mix, *norm_ffn, *w_in, *a_re, *a_im, *log_dt, *b_re, *b_im, *c_re, *c_im, *s5d,
        *w_glu, *b_glu, *w_out, *kv_norm, *w_kv, *w_q, *sinks, *w_o, *peer_wq, *subkeys, *peer_u, *peer_v, *final_norm;
    float* out;
    float* cond;
    float* ropec;
    float* ropes;
    float* ssq0;
    float* ssq1;
    float* ssq2;
    float* ssq3;
    bf16_t* wt_glu;
    bf16_t* wt_out;
    bf16_t* wt_o;
    bf16_t* wts;
    float* bias;
    bf16_t* skeys;
    float* lamL;
    bf16_t* ktab;
    bf16_t* smat;
    bf16_t* cmat;
    bf16_t* ub;
    bf16_t* vb;
    bf16_t* s0;
    bf16_t* s1;
    bf16_t* s2;
    float* f0;
    float* f1;
    int* ids;
    float* gates;
};

__device__ __forceinline__ bf16_t f2bf(float f) { unsigned u = __float_as_uint(f); u += 0x7fffu + ((u >> 16) & 1u); return (bf16_t)(u >> 16); }
__device__ __forceinline__ float bf2f(bf16_t h) { return __uint_as_float(((unsigned)h) << 16); }
typedef __bf16 hbf2 __attribute__((ext_vector_type(2)));
typedef float f32x2 __attribute__((ext_vector_type(2)));
__device__ __forceinline__ unsigned pack2(float lo, float hi) { f32x2 v = {lo, hi}; return __builtin_bit_cast(unsigned, __builtin_convertvector(v, hbf2)); }
__device__ __forceinline__ float dot2bf(unsigned a, unsigned b, float c) { return __builtin_amdgcn_fdot2_f32_bf16(__builtin_bit_cast(hbf2, a), __builtin_bit_cast(hbf2, b), c, false); }
__device__ __forceinline__ float bflo(unsigned w) { return __uint_as_float(w << 16); }
__device__ __forceinline__ float bfhi(unsigned w) { return __uint_as_float(w & 0xffff0000u); }
__device__ __forceinline__ float wave_sum(float v) {
#pragma unroll
    for (int o = 32; o >= 1; o >>= 1) v += __shfl_xor(v, o);
    return v;
}
__device__ __forceinline__ float gelu_tanh(float x) {
    const float u = 0.7978845608028654f * (x + 0.044715f * x * x * x);
    const float e = __expf(-2.f * fabsf(u));
    float th = (1.f - e) / (1.f + e);
    th = u < 0.f ? -th : th;
    return 0.5f * x * (1.f + th);
}

__device__ void p0_cond(const Params& p, unsigned char* smem) {
    float* sc = (float*)smem;
    float* red = (float*)(smem + 16384);
    const int tid = threadIdx.x;
    for (int i = tid; i < 4 * D; i += NT) { const float v = p.c[i]; sc[i] = v / (1.f + __expf(-v)); }
    __syncthreads();
    const int cgp = tid & 15, kg = tid >> 4;
    for (int task = blockIdx.x; task < NCOND * D / 64; task += gridDim.x) {
        const int col0 = task * 64 + cgp * 4;
        float acc[4][4];
#pragma unroll
        for (int b = 0; b < 4; ++b)
#pragma unroll
            for (int j = 0; j < 4; ++j) acc[b][j] = 0.f;
        for (int k = kg; k < D; k += 32) {
            const f32x4 w = *(const f32x4*)(p.w_cond + (size_t)k * (NCOND * D) + col0);
#pragma unroll
            for (int b = 0; b < 4; ++b) { const float s = sc[b * D + k];
#pragma unroll
                for (int j = 0; j < 4; ++j) acc[b][j] += s * w[j]; }
        }
#pragma unroll
        for (int b = 0; b < 4; ++b)
#pragma unroll
            for (int j = 0; j < 4; ++j) red[(kg * 64 + cgp * 4 + j) * 4 + b] = acc[b][j];
        __syncthreads();
        if (tid < 256) {
            const int col = tid >> 2, b = tid & 3;
            float s = 0.f;
            for (int g = 0; g < 32; ++g) s += red[(g * 64 + col) * 4 + b];
            p.cond[(size_t)b * (NCOND * D) + task * 64 + col] = s + p.b_cond[task * 64 + col];
        }
        __syncthreads();
    }
}

__device__ void p0_xconv(const Params& p) {
    const int lane = threadIdx.x & 63, wv = threadIdx.x >> 6;
    const int nw = gridDim.x * (NT / 64);
    for (int t = blockIdx.x * (NT / 64) + wv; t < T; t += nw) {
        const float* xr = p.x + (size_t)t * D;
        float s = 0.f;
#pragma unroll
        for (int j = 0; j < 4; ++j) {
            const f32x4 v = *(const f32x4*)(xr + j * 256 + lane * 4);
            s += v[0] * v[0] + v[1] * v[1] + v[2] * v[2] + v[3] * v[3];
            u32x2 o; o[0] = pack2(v[0], v[1]); o[1] = pack2(v[2], v[3]);
            *(u32x2*)(p.s0 + (size_t)t * D + j * 256 + lane * 4) = o;
        }
        s = wave_sum(s);
        if (lane < 16) p.ssq0[(size_t)t * 16 + lane] = lane == 0 ? s : 0.f;
    }
}

__device__ void p0_tables(const Params& p) {
    const size_t n8 = (size_t)2 * NEXP * D / 8;
    const size_t gtid = (size_t)blockIdx.x * NT + threadIdx.x, gstride = (size_t)gridDim.x * NT;
    for (int which = 0; which < 2; ++which) {
        const float* src = which ? p.peer_v : p.peer_u; bf16_t* dst = which ? p.vb : p.ub;
        for (size_t i = gtid; i < n8; i += gstride) {
            const f32x4 a = *(const f32x4*)(src + i * 8), b = *(const f32x4*)(src + i * 8 + 4);
            u32x4 o; o[0] = pack2(a[0], a[1]); o[1] = pack2(a[2], a[3]); o[2] = pack2(b[0], b[1]); o[3] = pack2(b[2], b[3]);
            *(u32x4*)(dst + i * 8) = o;
        }
    }
    const size_t nk8 = (size_t)2 * 8 * 2 * 128 * 64 / 8;
    for (size_t i = gtid; i < nk8; i += gstride) {
        const f32x4 a = *(const f32x4*)(p.subkeys + i * 8), b = *(const f32x4*)(p.subkeys + i * 8 + 4);
        u32x4 o; o[0] = pack2(a[0], a[1]); o[1] = pack2(a[2], a[3]); o[2] = pack2(b[0], b[1]); o[3] = pack2(b[2], b[3]);
        *(u32x4*)(p.skeys + i * 8) = o;
    }
    for (size_t i = gtid; i < (size_t)T * 32; i += gstride) {
        const int t = (int)(i >> 5), f = (int)(i & 31);
        const double inv = exp(-(double)(2 * f) / 64.0 * 9.210340371976184);
        double ang = (double)p.pos[t] * inv;
        ang -= 6.283185307179586 * floor(ang * 0.15915494309189535);
        p.ropec[i] = (float)cos(ang); p.ropes[i] = (float)sin(ang);
    }
}

__device__ void transpose_tile(const float* W, int ldw, int n0, int k0, const float* sk, bf16_t* Wt, unsigned char* smem) {
    bf16_t* tl = (bf16_t*)smem;
    const int tid = threadIdx.x, kk = tid >> 3, nn = (tid & 7) * 8;
    const f32x4 a = *(const f32x4*)(W + (size_t)(k0 + kk) * ldw + n0 + nn), b = *(const f32x4*)(W + (size_t)(k0 + kk) * ldw + n0 + nn + 4);
    const float s = sk ? sk[k0 + kk] : 1.f;
#pragma unroll
    for (int j = 0; j < 4; ++j) { tl[(nn + j) * 72 + kk] = f2bf(a[j] * s); tl[(nn + 4 + j) * 72 + kk] = f2bf(b[j] * s); }
    __syncthreads();
    const int n = tid >> 3, kc = (tid & 7) * 8;
    const u32x4 v = *(const u32x4*)(tl + n * 72 + kc);
    *(u32x4*)(Wt + (size_t)(n0 + n) * D + k0 + kc) = v;
    __syncthreads();
}

__device__ void p0_wt(const Params& p, unsigned char* smem) {
    for (int task = blockIdx.x; task < 3 * 256; task += gridDim.x) {
        const int w = task >> 8, tl = task & 255, n0 = (tl & 15) * 64, k0 = (tl >> 4) * 64;
        const float* W = w == 0 ? p.w_glu : (w == 1 ? p.w_out : p.w_o);
        bf16_t* Wt = w == 0 ? p.wt_glu : (w == 1 ? p.wt_out : p.wt_o);
        transpose_tile(W, D, n0, k0, nullptr, Wt, smem);
    }
}

struct cplx { double re, im; };
__device__ __forceinline__ cplx lam_pow(double ar, double ai, double dt, int n) {
    const double m = exp(ar * dt * n); double ang = ai * dt * n;
    ang -= 6.283185307179586 * floor(ang * 0.15915494309189535);
    cplx r; r.re = m * cos(ang); r.im = m * sin(ang); return r;
}
__device__ __forceinline__ cplx s5_coef(double ar, double ai, double dt) {
    const cplx lb = lam_pow(ar, ai, dt, 1);
    const double nr = lb.re - 1.0, ni = lb.im, den = ar * ar + ai * ai;
    cplx c; c.re = (nr * ar + ni * ai) / den; c.im = (ni * ar - nr * ai) / den; return c;
}

__device__ void p0_s5(const Params& p, unsigned char* smem) {
    const size_t gtid = (size_t)blockIdx.x * NT + threadIdx.x, gstride = (size_t)gridDim.x * NT;
    for (size_t idx = gtid; idx < (size_t)G5 * P5 * 65; idx += gstride) {
        const int e = (int)(idx % 65), pp = (int)((idx / 65) % P5), g = (int)(idx / (65 * P5));
        const double dt = exp((double)p.log_dt[g]), ar = p.a_re[g * P5 + pp], ai = p.a_im[g * P5 + pp];
        const cplx pw = lam_pow(ar, ai, dt, e);
        if (e < 64) {
            const cplx cf = s5_coef(ar, ai, dt);
            const int j = 63 - e;
            bf16_t* sre = p.smat + ((size_t)g * 128 + pp) * 1024 + j * 16;
            bf16_t* sim = p.smat + ((size_t)g * 128 + 64 + pp) * 1024 + j * 16;
            for (int ci = 0; ci < 16; ++ci) {
                const double br = p.b_re[((size_t)g * P5 + pp) * C5 + ci], bi = p.b_im[((size_t)g * P5 + pp) * C5 + ci];
                const double bbr = cf.re * br - cf.im * bi, bbi = cf.re * bi + cf.im * br;
                sre[ci] = f2bf((float)(pw.re * bbr - pw.im * bbi));
                sim[ci] = f2bf((float)(pw.re * bbi + pw.im * bbr));
            }
        }
        if (e >= 1) {
            const int i = e - 1;
            for (int co = 0; co < 16; ++co) {
                const double cr = p.c_re[((size_t)g * C5 + co) * P5 + pp], ci = p.c_im[((size_t)g * C5 + co) * P5 + pp];
                bf16_t* row = p.cmat + ((size_t)g * 1024 + i * 16 + co) * 128;
                row[pp] = f2bf((float)(cr * pw.re - ci * pw.im));
                row[64 + pp] = f2bf((float)(-(cr * pw.im + ci * pw.re)));
            }
        }
        if (e == 64) { p.lamL[(g * P5 + pp) * 2] = (float)pw.re; p.lamL[(g * P5 + pp) * 2 + 1] = (float)pw.im; }
    }
    float* wre = (float*)smem; float* wim = wre + 64;
    const int tid = threadIdx.x;
    for (int task = blockIdx.x; task < G5 * 64; task += gridDim.x) {
        const int g = task >> 6, tau = task & 63;
        if (tid < 64) {
            const double dt = exp((double)p.log_dt[g]), ar = p.a_re[g * P5 + tid], ai = p.a_im[g * P5 + tid];
            const cplx pw = lam_pow(ar, ai, dt, tau), cf = s5_coef(ar, ai, dt);
            wre[tid] = (float)(pw.re * cf.re - pw.im * cf.im); wim[tid] = (float)(pw.re * cf.im + pw.im * cf.re);
        }
        __syncthreads();
        if (tid < 256) {
            const int co = tid >> 4, ci = tid & 15;
            float s = 0.f;
            for (int pp = 0; pp < 64; ++pp) {
                const float br = p.b_re[((size_t)g * P5 + pp) * C5 + ci], bi = p.b_im[((size_t)g * P5 + pp) * C5 + ci];
                const float zr = wre[pp] * br - wim[pp] * bi, zi = wre[pp] * bi + wim[pp] * br;
                const float cr = p.c_re[((size_t)g * C5 + co) * P5 + pp], cim = p.c_im[((size_t)g * C5 + co) * P5 + pp];
                s += cr * zr - cim * zi;
            }
            p.ktab[((size_t)g * 65 + tau + 1) * 256 + tid] = f2bf(s);
            if (tau == 0) p.ktab[((size_t)g * 65) * 256 + tid] = 0;
        }
        __syncthreads();
    }
}

struct ScSpec { const float* W; int ldw; int n; int col0; const float* g; int c_shift; int c_scale; };
__device__ __forceinline__ ScSpec sc_spec(const Params& p, int s) {
    ScSpec r;
    switch (s) {
        case 0: r = {p.w_in, 1024, 1024, SC_IN, p.norm_mix, 0, 1}; break;
        case 1: r = {p.peer_wq, 1024, 1024, SC_PQ0, p.norm_ffn, 3, 4}; break;
        case 2: r = {p.w_kv, 512, 512, SC_KV, p.kv_norm, 12, 13}; break;
        case 3: r = {p.w_q, 1024, 1024, SC_Q, p.norm_mix + D, 6, 7}; break;
        default: r = {p.peer_wq + (size_t)D * D, 1024, 1024, SC_PQ1, p.norm_ffn + D, 9, 10}; break;
    }
    return r;
}
__device__ void p05_weights(const Params& p, unsigned char* smem) {
    float* gsb = (float*)(smem + 16384);
    const int tid = threadIdx.x;
    int base = 0;
    for (int s = 0; s < 5; ++s) {
        const ScSpec sp = sc_spec(p, s);
        const int ntn = sp.n / 64, ntask = ntn * 16 * 4;
        for (int task = blockIdx.x; task < ntask; task += gridDim.x) {
            const int b = task & 3, tl = task >> 2, n0 = (tl % ntn) * 64, k0 = (tl / ntn) * 64;
            if (tid < 64) gsb[tid] = sp.g[k0 + tid] * (1.f + p.cond[(size_t)b * (NCOND * D) + sp.c_scale * D + k0 + tid]);
            __syncthreads();
            transpose_tile(sp.W, sp.ldw, n0, k0, gsb - k0, p.wts + ((size_t)b * NSC + sp.col0) * D, smem);
        }
        base += ntask;
    }
    float* red = (float*)smem;
    for (int task = blockIdx.x; task < NSC / 64; task += gridDim.x) {
        const int col0 = task * 64;
        int s = col0 < SC_PQ0 ? 0 : (col0 < SC_KV ? 1 : (col0 < SC_Q ? 2 : (col0 < SC_PQ1 ? 3 : 4)));
        const ScSpec sp = sc_spec(p, s);
        const int n = col0 - sp.col0 + (tid & 63), kg = tid >> 6;
        float acc[4] = {0.f, 0.f, 0.f, 0.f};
        for (int k = kg; k < D; k += 8) {
            const float w = sp.W[(size_t)k * sp.ldw + n];
#pragma unroll
            for (int b = 0; b < 4; ++b) acc[b] += p.cond[(size_t)b * (NCOND * D) + sp.c_shift * D + k] * w;
        }
#pragma unroll
        for (int b = 0; b < 4; ++b) red[(kg * 64 + (tid & 63)) * 4 + b] = acc[b];
        __syncthreads();
        if (tid < 256) {
            const int col = tid >> 2, b = tid & 3; float sum = 0.f;
            for (int g = 0; g < 8; ++g) sum += red[(g * 64 + col) * 4 + b];
            p.bias[(size_t)b * NSC + col0 + col] = sum;
        }
        __syncthreads();
    }
}

__device__ __forceinline__ int lds_off(int row, int chunk) { return row * 128 + ((chunk ^ (row & 7)) << 4); }

template <class Epi>
__device__ void gemm_phase(const bf16_t* __restrict__ A, const bf16_t* __restrict__ Bt, size_t bt_batch_stride, int N, const Epi& epi, unsigned char* smem) {
    const int tid = threadIdx.x, lane = tid & 63, w = tid >> 6, wm = w >> 1, wn = w & 1, tk = lane & 15, q = lane >> 4;
    const int nN = N / 128;
    const bool xmap = (gridDim.x % 8) == 0;
    const int nslots = xmap ? gridDim.x / 8 : gridDim.x, slot = xmap ? (blockIdx.x >> 3) : blockIdx.x, xcd = blockIdx.x & 7;
    const int nitems = xmap ? 8 * nN : 64 * nN;
    for (int item = slot; item < nitems; item += nslots) {
        const int pm = xmap ? xcd * 8 + item / nN : item / nN, pn = item % nN;
        const int m0 = pm * 256, n0 = pn * 128, b = m0 / SEQ;
        const bf16_t* Ab = A + (size_t)m0 * D;
        const bf16_t* Bb = Bt + (size_t)b * bt_batch_stride + (size_t)n0 * D;
        f32x4 acc[4][4];
#pragma unroll
        for (int mi = 0; mi < 4; ++mi)
#pragma unroll
            for (int ni = 0; ni < 4; ++ni) acc[mi][ni] = (f32x4){0.f, 0.f, 0.f, 0.f};
        u32x4 ra[4], rb[2];
        auto gload = [&](int kt) {
#pragma unroll
            for (int i = 0; i < 4; ++i) { const int id = tid + NT * i, row = id >> 3, c = id & 7; ra[i] = *(const u32x4*)(Ab + (size_t)row * D + kt * 64 + c * 8); }
#pragma unroll
            for (int i = 0; i < 2; ++i) { const int id = tid + NT * i, row = id >> 3, c = id & 7; rb[i] = *(const u32x4*)(Bb + (size_t)row * D + kt * 64 + c * 8); }
        };
        auto lstore = [&](int buf) {
            unsigned char* sA = smem + buf * 32768; unsigned char* sB = smem + 65536 + buf * 16384;
#pragma unroll
            for (int i = 0; i < 4; ++i) { const int id = tid + NT * i, row = id >> 3, c = id & 7; *(u32x4*)(sA + lds_off(row, c)) = ra[i]; }
#pragma unroll
            for (int i = 0; i < 2; ++i) { const int id = tid + NT * i, row = id >> 3, c = id & 7; *(u32x4*)(sB + lds_off(row, c)) = rb[i]; }
        };
        gload(0); lstore(0);
        __syncthreads();
        for (int kt = 0; kt < 16; ++kt) {
            if (kt + 1 < 16) gload(kt + 1);
            const unsigned char* sA = smem + (kt & 1) * 32768; const unsigned char* sB = smem + 65536 + (kt & 1) * 16384;
#pragma unroll
            for (int ks = 0; ks < 2; ++ks) {
                bf16x8 af[4], bfr[4];
#pragma unroll
                for (int mi = 0; mi < 4; ++mi) af[mi] = *(const bf16x8*)(sA + lds_off(wm * 64 + mi * 16 + tk, ks * 4 + q));
#pragma unroll
                for (int ni = 0; ni < 4; ++ni) bfr[ni] = *(const bf16x8*)(sB + lds_off(wn * 64 + ni * 16 + tk, ks * 4 + q));
#pragma unroll
                for (int mi = 0; mi < 4; ++mi)
#pragma unroll
                    for (int ni = 0; ni < 4; ++ni) acc[mi][ni] = __builtin_amdgcn_mfma_f32_16x16x32_bf16(bfr[ni], af[mi], acc[mi][ni], 0, 0, 0);
            }
            if (kt + 1 < 16) lstore((kt + 1) & 1);
            __syncthreads();
        }
        epi(acc, m0 + wm * 64, n0 + wn * 64, b, pn * 2 + wn, tk, q);
    }
}

__device__ __forceinline__ float rstd_of(const float* ssq, int token) {
    const f32x4* s4 = (const f32x4*)(ssq + (size_t)token * 16);
    const f32x4 a = s4[0], b = s4[1], c = s4[2], d = s4[3];
    const float s = ((a[0] + a[1]) + (a[2] + a[3])) + ((b[0] + b[1]) + (b[2] + b[3])) + ((c[0] + c[1]) + (c[2] + c[3])) + ((d[0] + d[1]) + (d[2] + d[3]));
    return rsqrtf(s * (1.f / D) + RMS_EPS);
}

struct EpiU {
    const float* ssq; const float* bias; bf16_t* ug;
    __device__ __forceinline__ void operator()(const f32x4 (&acc)[4][4], int mbase, int nbase, int b, int, int tk, int q) const {
#pragma unroll
        for (int mi = 0; mi < 4; ++mi) {
            const int token = mbase + mi * 16 + tk, s = token - b * SEQ;
            const float rstd = rstd_of(ssq, token);
#pragma unroll
            for (int ni = 0; ni < 4; ++ni) {
                const int n = nbase + ni * 16 + 4 * q, g = n >> 4;
                const f32x4 bv = *(const f32x4*)(bias + (size_t)b * NSC + SC_IN + n);
                u32x2 o; o[0] = pack2(rstd * acc[mi][ni][0] + bv[0], rstd * acc[mi][ni][1] + bv[1]); o[1] = pack2(rstd * acc[mi][ni][2] + bv[2], rstd * acc[mi][ni][3] + bv[3]);
                *(u32x2*)(ug + (((size_t)(g * 4 + b) * SEQ + s) * 16 + 4 * q)) = o;
            }
        }
    }
};
struct EpiQ {
    const float* ssq; const float* bias; int boff; bf16_t* out;
    __device__ __forceinline__ void operator()(const f32x4 (&acc)[4][4], int mbase, int nbase, int b, int, int tk, int q) const {
#pragma unroll
        for (int mi = 0; mi < 4; ++mi) {
            const int token = mbase + mi * 16 + tk;
            const float rstd = rstd_of(ssq, token);
#pragma unroll
            for (int ni = 0; ni < 4; ++ni) {
                const int n = nbase + ni * 16 + 4 * q;
                const f32x4 bv = *(const f32x4*)(bias + (size_t)b * NSC + boff + n);
                u32x2 o; o[0] = pack2(rstd * acc[mi][ni][0] + bv[0], rstd * acc[mi][ni][1] + bv[1]); o[1] = pack2(rstd * acc[mi][ni][2] + bv[2], rstd * acc[mi][ni][3] + bv[3]);
                *(u32x2*)(out + (size_t)token * D + n) = o;
            }
        }
    }
};
struct EpiGlu {
    const bf16_t* y; const float* bglu; bf16_t* out;
    __device__ __forceinline__ void operator()(const f32x4 (&acc)[4][4], int mbase, int nbase, int, int, int tk, int q) const {
#pragma unroll
        for (int mi = 0; mi < 4; ++mi) {
            const int token = mbase + mi * 16 + tk;
#pragma unroll
            for (int ni = 0; ni < 4; ++ni) {
                const int n = nbase + ni * 16 + 4 * q;
                const f32x4 bv = *(const f32x4*)(bglu + n);
                const u32x2 yv = *(const u32x2*)(y + (size_t)token * D + n);
                float o[4];
                const float y0 = bflo(yv[0]), y1 = bfhi(yv[0]), y2 = bflo(yv[1]), y3 = bfhi(yv[1]);
                o[0] = y0 / (1.f + __expf(-(acc[mi][ni][0] + bv[0]))); o[1] = y1 / (1.f + __expf(-(acc[mi][ni][1] + bv[1])));
                o[2] = y2 / (1.f + __expf(-(acc[mi][ni][2] + bv[2]))); o[3] = y3 / (1.f + __expf(-(acc[mi][ni][3] + bv[3])));
                u32x2 ov; ov[0] = pack2(o[0], o[1]); ov[1] = pack2(o[2], o[3]);
                *(u32x2*)(out + (size_t)token * D + n) = ov;
            }
        }
    }
};
struct EpiRes {
    const float* xold; const float* gate  ; float* xout; bf16_t* xbout; float* ssq;
    __device__ __forceinline__ void operator()(const f32x4 (&acc)[4][4], int mbase, int nbase, int b, int slot, int tk, int q) const {
#pragma unroll
        for (int mi = 0; mi < 4; ++mi) {
            const int token = mbase + mi * 16 + tk;
            float ss = 0.f;
#pragma unroll
            for (int ni = 0; ni < 4; ++ni) {
                const int n = nbase + ni * 16 + 4 * q;
                const f32x4 gv = *(const f32x4*)(gate + (size_t)b * (NCOND * D) + n);
                const f32x4 xo = *(const f32x4*)(xold + (size_t)token * D + n);
                f32x4 xn;
#pragma unroll
                for (int r = 0; r < 4; ++r) { xn[r] = xo[r] + gv[r] * acc[mi][ni][r]; ss += xn[r] * xn[r]; }
                *(f32x4*)(xout + (size_t)token * D + n) = xn;
                u32x2 ov; ov[0] = pack2(xn[0], xn[1]); ov[1] = pack2(xn[2], xn[3]);
                *(u32x2*)(xbout + (size_t)token * D + n) = ov;
            }
            ss += __shfl_xor(ss, 16); ss += __shfl_xor(ss, 32);
            if (q == 0) ssq[(size_t)token * 16 + slot] = ss;
        }
    }
};

__device__ void s5_phase(const Params& p, unsigned char* smem) {
    bf16_t* ktl = (bf16_t*)smem;
    float* Sl = (float*)(smem + 33280);
    bf16_t* Xl = (bf16_t*)(smem + 33280 + 33280);
    const int tid = threadIdx.x, lane = tid & 63, w = tid >> 6, cb = w & 3, hh = w >> 2, tk = lane & 15, q = lane >> 4;
    for (int task = blockIdx.x; task < G5 * NB; task += gridDim.x) {
        const int g = (task & 7) * 8 + ((task >> 3) >> 2), b = (task >> 3) & 3;
        const bf16_t* U = p.s1 + (size_t)(g * 4 + b) * SEQ * 16;
        const bf16_t* sm = p.smat + (size_t)g * 128 * 1024;
        const bf16_t* cm = p.cmat + (size_t)g * 1024 * 128;
        for (int i = tid; i < 65 * 256 * 2 / 16; i += NT) ((u32x4*)ktl)[i] = ((const u32x4*)(p.ktab + (size_t)g * 65 * 256))[i];
        bf16x8 ufr[32];
#pragma unroll
        for (int ks = 0; ks < 32; ++ks) ufr[ks] = *(const bf16x8*)(U + (size_t)(cb * 16 + tk) * 1024 + ks * 32 + 8 * q);
#pragma unroll 1
        for (int mf = 0; mf < 4; ++mf) {
            const int r0 = (hh * 4 + mf) * 16;
            f32x4 acc = {0.f, 0.f, 0.f, 0.f};
#pragma unroll
            for (int ks = 0; ks < 32; ++ks) {
                const bf16x8 af = *(const bf16x8*)(sm + (size_t)(r0 + tk) * 1024 + ks * 32 + 8 * q);
                acc = __builtin_amdgcn_mfma_f32_16x16x32_bf16(af, ufr[ks], acc, 0, 0, 0);
            }
#pragma unroll
            for (int r = 0; r < 4; ++r) Sl[(r0 + 4 * q + r) * 65 + cb * 16 + tk] = acc[r];
        }
        __syncthreads();
        if (w == 0) {
            const float lr = p.lamL[(g * P5 + lane) * 2], li = p.lamL[(g * P5 + lane) * 2 + 1];
            float xr = 0.f, xi = 0.f;
            for (int k = 0; k < NCH; ++k) {
                Xl[k * 128 + lane] = f2bf(xr); Xl[k * 128 + 64 + lane] = f2bf(xi);
                const float sr = Sl[lane * 65 + k], si = Sl[(64 + lane) * 65 + k];
                const float nr = lr * xr - li * xi + sr, ni = lr * xi + li * xr + si;
                xr = nr; xi = ni;
            }
        }
        __syncthreads();
        bf16x8 xfr[4];
#pragma unroll
        for (int ks = 0; ks < 4; ++ks) xfr[ks] = *(const bf16x8*)(Xl + (cb * 16 + tk) * 128 + ks * 32 + 8 * q);
        const f32x4 dv = *(const f32x4*)(p.s5d + g * 16 + 4 * q);
        const int jl = q >> 1, cih = q & 1;
#pragma unroll 1
        for (int ii = 0; ii < 32; ++ii) {
            const int i = hh ? 16 + ii : (ii < 16 ? ii : 32 + ii);
            f32x4 acc = {0.f, 0.f, 0.f, 0.f};
#pragma unroll
            for (int ks = 0; ks < 4; ++ks) {
                const bf16x8 af = *(const bf16x8*)(cm + (size_t)(i * 16 + tk) * 128 + ks * 32 + 8 * q);
                acc = __builtin_amdgcn_mfma_f32_16x16x32_bf16(af, xfr[ks], acc, 0, 0, 0);
            }
            const int mmax = i >> 1;
#pragma unroll
            for (int m = 0; m < 32; ++m) {
                if (m <= mmax) {
                    const int tau1 = i - 2 * m - jl + 1;
                    const bf16x8 kf = *(const bf16x8*)(ktl + tau1 * 256 + tk * 16 + cih * 8);
                    acc = __builtin_amdgcn_mfma_f32_16x16x32_bf16(kf, ufr[m], acc, 0, 0, 0);
                }
            }
            const int s = (cb * 16 + tk) * 64 + i;
            const u32x2 uv = *(const u32x2*)(U + (size_t)s * 16 + 4 * q);
            const float y0 = gelu_tanh(acc[0] + dv[0] * bflo(uv[0])), y1 = gelu_tanh(acc[1] + dv[1] * bfhi(uv[0]));
            const float y2 = gelu_tanh(acc[2] + dv[2] * bflo(uv[1])), y3 = gelu_tanh(acc[3] + dv[3] * bfhi(uv[1]));
            u32x2 o; o[0] = pack2(y0, y1); o[1] = pack2(y2, y3);
            *(u32x2*)(p.s0 + ((size_t)b * SEQ + s) * D + g * 16 + 4 * q) = o;
        }
        __syncthreads();
    }
}

__device__ __forceinline__ float med3f(float a, float b, float c) { return __builtin_amdgcn_fmed3f(a, b, c); }
__device__ __forceinline__ void ins16(float (&a)[16], float v) {
#pragma unroll
    for (int i = 15; i >= 1; --i) a[i] = med3f(a[i - 1], a[i], v);
    a[0] = fmaxf(a[0], v);
}
__device__ void route_phase(const Params& p, int layer, const bf16_t* qp, unsigned char* smem) {
    float* sc = (float*)smem;
    float* tl = (float*)(smem + 2 * 128 * 129 * 4);
    const int tid = threadIdx.x, lane = tid & 63, w = tid >> 6, tk = lane & 15, q = lane >> 4;
    for (int task = blockIdx.x; task < (T / 128) * 8; task += gridDim.x) {
        const int h = task & 7, t0 = (task >> 3) * 128;
#pragma unroll 1
        for (int pp = 0; pp < 2; ++pp) {
            const bf16_t* qrow = qp + (size_t)(t0 + 16 * w + tk) * D + h * 128 + pp * 64 + 8 * q;
            const bf16x8 a0 = *(const bf16x8*)(qrow), a1 = *(const bf16x8*)(qrow + 32);
            const bf16_t* kb = p.skeys + ((size_t)((layer * 8 + h) * 2 + pp) * 128) * 64 + 8 * q;
#pragma unroll
            for (int nf = 0; nf < 8; ++nf) {
                const bf16x8 b0 = *(const bf16x8*)(kb + (size_t)(nf * 16 + tk) * 64), b1 = *(const bf16x8*)(kb + (size_t)(nf * 16 + tk) * 64 + 32);
                f32x4 acc = {0.f, 0.f, 0.f, 0.f};
                acc = __builtin_amdgcn_mfma_f32_16x16x32_bf16(a0, b0, acc, 0, 0, 0);
                acc = __builtin_amdgcn_mfma_f32_16x16x32_bf16(a1, b1, acc, 0, 0, 0);
#pragma unroll
                for (int r = 0; r < 4; ++r) sc[(pp * 128 + 16 * w + 4 * q + r) * 129 + nf * 16 + tk] = acc[r];
            }
        }
        __syncthreads();
        {
            const int list = tid & 255, kr = tid >> 8;
            float a[16];
#pragma unroll
            for (int i = 0; i < 16; ++i) a[i] = -3.0e38f;
            const float* row = sc + list * 129 + kr * 64;
            for (int j = 0; j < 64; ++j) {
                const float v = __uint_as_float((__float_as_uint(row[j]) & ~0x7Fu) | (unsigned)(kr * 64 + j));
                ins16(a, v);
            }
            if (kr == 1) {
#pragma unroll
                for (int i = 0; i < 16; ++i) tl[list * 16 + i] = a[i];
            }
            __syncthreads();
            if (kr == 0) {
                float o[16];
#pragma unroll
                for (int i = 0; i < 16; ++i) o[i] = tl[list * 16 + i];
#pragma unroll
                for (int i = 0; i < 16; ++i) ins16(a, o[i]);
#pragma unroll
                for (int i = 0; i < 16; ++i) tl[list * 16 + i] = a[i];
            }
            __syncthreads();
        }
        if (tid < 128) {
            float s[16], r[16], c[16];
#pragma unroll
            for (int i = 0; i < 16; ++i) { s[i] = tl[tid * 16 + i]; r[i] = tl[(128 + tid) * 16 + i]; c[i] = -3.0e38f; }
#pragma unroll
            for (int i = 0; i < 16; ++i)
#pragma unroll
                for (int j = 0; j < 16; ++j)
                    if ((i + 1) * (j + 1) <= 16) {
                        const float v = __uint_as_float((__float_as_uint(s[i] + r[j]) & ~0xFFu) | (unsigned)(i * 16 + j));
                        ins16(c, v);
                    }
            float e[16], sum = 0.f;
#pragma unroll
            for (int k = 0; k < 16; ++k) { e[k] = __expf(c[k] - c[0]); sum += e[k]; }
            const float inv = 1.f / sum;
            int idv[16];
#pragma unroll
            for (int k = 0; k < 16; ++k) {
                const unsigned bits = __float_as_uint(c[k]), i = (bits >> 4) & 15u, j = bits & 15u;
                const unsigned ki = __float_as_uint(tl[tid * 16 + i]) & 0x7Fu, kj = __float_as_uint(tl[(128 + tid) * 16 + j]) & 0x7Fu;
                idv[k] = (int)(ki * 128u + kj);
            }
            int* ido = p.ids + (size_t)(t0 + tid) * 128 + h * 16; float* go = p.gates + (size_t)(t0 + tid) * 128 + h * 16;
#pragma unroll
            for (int k4 = 0; k4 < 4; ++k4) {
                *(int4*)(ido + k4 * 4) = make_int4(idv[k4 * 4], idv[k4 * 4 + 1], idv[k4 * 4 + 2], idv[k4 * 4 + 3]);
                *(f32x4*)(go + k4 * 4) = (f32x4){e[k4 * 4] * inv, e[k4 * 4 + 1] * inv, e[k4 * 4 + 2] * inv, e[k4 * 4 + 3] * inv};
            }
        }
        __syncthreads();
    }
}

template <bool FINAL>
__device__ void gather_phase(const Params& p, int layer, const float* xin, float* xout, bf16_t* xbout, float* ssq_out, const float* gnorm, int c_shift, int c_scale, int c_gate) {
    const int lane = threadIdx.x & 63, wv = threadIdx.x >> 6, li = lane & 15, qg = lane >> 4;
    const int nw = gridDim.x * (NT / 64);
    const bf16_t* utab = p.ub + (size_t)layer * NEXP * D;
    const bf16_t* vtab = p.vb + (size_t)layer * NEXP * D;
    for (int t = blockIdx.x * (NT / 64) + wv; t < T; t += nw) {
        const int b = t / SEQ;
        const float* cb = p.cond + (size_t)b * (NCOND * D);
        const float* xr = xin + (size_t)t * D;
        unsigned hb[8][4];
        {
            f32x4 xv[8][2]; float ss = 0.f;
#pragma unroll
            for (int c = 0; c < 8; ++c) {
                xv[c][0] = *(const f32x4*)(xr + c * 128 + li * 8); xv[c][1] = *(const f32x4*)(xr + c * 128 + li * 8 + 4);
#pragma unroll
                for (int e = 0; e < 4; ++e) ss += xv[c][0][e] * xv[c][0][e] + xv[c][1][e] * xv[c][1][e];
            }
            ss += __shfl_xor(ss, 1); ss += __shfl_xor(ss, 2); ss += __shfl_xor(ss, 4); ss += __shfl_xor(ss, 8);
            const float rstd = rsqrtf(ss * (1.f / D) + RMS_EPS);
#pragma unroll
            for (int c = 0; c < 8; ++c) {
                float hv[8];
#pragma unroll
                for (int hf = 0; hf < 2; ++hf) {
                    const int e0 = c * 128 + li * 8 + hf * 4;
                    const f32x4 g = *(const f32x4*)(gnorm + e0), sc = *(const f32x4*)(cb + c_scale * D + e0), sh = *(const f32x4*)(cb + c_shift * D + e0);
#pragma unroll
                    for (int e = 0; e < 4; ++e) hv[hf * 4 + e] = xv[c][hf][e] * rstd * g[e] * (1.f + sc[e]) + sh[e];
                }
#pragma unroll
                for (int jj = 0; jj < 4; ++jj) hb[c][jj] = pack2(hv[2 * jj], hv[2 * jj + 1]);
            }
        }
        const int idA = p.ids[(size_t)t * 128 + lane], idB = p.ids[(size_t)t * 128 + 64 + lane];
        const float gA = p.gates[(size_t)t * 128 + lane], gB = p.gates[(size_t)t * 128 + 64 + lane];
        float actA = 0.f, actB = 0.f;
        u32x4 bufA[8], bufB[8];
        auto issue = [&](u32x4 (&buf)[8], const bf16_t* tab, int m) {
            const int id = __shfl(m < 16 ? idA : idB, (4 * m + qg) & 63);
            const bf16_t* rp = tab + (size_t)id * D + li * 8;
#pragma unroll
            for (int c = 0; c < 8; ++c) buf[c] = *(const u32x4*)(rp + c * 128);
        };
        auto consume_u = [&](const u32x4 (&buf)[8], int m) {
            float d0 = 0.f, d1 = 0.f;
#pragma unroll
            for (int c = 0; c < 8; ++c) {
                d0 = dot2bf(hb[c][0], buf[c][0], d0); d1 = dot2bf(hb[c][1], buf[c][1], d1);
                d0 = dot2bf(hb[c][2], buf[c][2], d0); d1 = dot2bf(hb[c][3], buf[c][3], d1);
            }
            float d = d0 + d1;
            d += __shfl_xor(d, 1); d += __shfl_xor(d, 2); d += __shfl_xor(d, 4); d += __shfl_xor(d, 8);
            const float gt = __shfl(m < 16 ? gA : gB, (4 * m + qg) & 63);
            const float a = gelu_tanh(d) * gt;
            if (li == (m & 15)) { if (m < 16) actA = a; else actB = a; }
        };
        issue(bufA, utab, 0);
#pragma unroll 1
        for (int m = 0; m < 32; m += 2) {
            issue(bufB, utab, m + 1);
            consume_u(bufA, m);
            if (m + 2 < 32) issue(bufA, utab, m + 2);
            consume_u(bufB, m + 1);
        }
        float o[64];
#pragma unroll
        for (int e = 0; e < 64; ++e) o[e] = 0.f;
        auto consume_v = [&](const u32x4 (&buf)[8], int m) {
            const float a = __shfl(m < 16 ? actA : actB, (lane & 48) | (m & 15));
#pragma unroll
            for (int c = 0; c < 8; ++c)
#pragma unroll
                for (int jj = 0; jj < 4; ++jj) { o[c * 8 + 2 * jj] += a * bflo(buf[c][jj]); o[c * 8 + 2 * jj + 1] += a * bfhi(buf[c][jj]); }
        };
        issue(bufA, vtab, 0);
#pragma unroll 1
        for (int m = 0; m < 32; m += 2) {
            issue(bufB, vtab, m + 1);
            consume_v(bufA, m);
            if (m + 2 < 32) issue(bufA, vtab, m + 2);
            consume_v(bufB, m + 1);
        }
#pragma unroll
        for (int e = 0; e < 64; ++e) { o[e] += __shfl_xor(o[e], 16); o[e] += __shfl_xor(o[e], 32); }
        float xn[2][8]; float ss = 0.f;
#pragma unroll
        for (int cc = 0; cc < 2; ++cc) {
            const int c = 2 * qg + cc, e0 = c * 128 + li * 8;
#pragma unroll
            for (int hf = 0; hf < 2; ++hf) {
                const f32x4 xo = *(const f32x4*)(xr + e0 + hf * 4), gv = *(const f32x4*)(cb + c_gate * D + e0 + hf * 4);
#pragma unroll
                for (int e = 0; e < 4; ++e) {
                    const int k = hf * 4 + e;
                    const float ov = qg == 0 ? o[(0 + cc) * 8 + k] : (qg == 1 ? o[(2 + cc) * 8 + k] : (qg == 2 ? o[(4 + cc) * 8 + k] : o[(6 + cc) * 8 + k]));
                    const float v = xo[e] + gv[e] * ov;
                    xn[cc][k] = v; ss += v * v;
                }
            }
        }
        ss = wave_sum(ss);
        if (!FINAL) {
#pragma unroll
            for (int cc = 0; cc < 2; ++cc) {
                const int e0 = (2 * qg + cc) * 128 + li * 8;
                *(f32x4*)(xout + (size_t)t * D + e0) = (f32x4){xn[cc][0], xn[cc][1], xn[cc][2], xn[cc][3]};
                *(f32x4*)(xout + (size_t)t * D + e0 + 4) = (f32x4){xn[cc][4], xn[cc][5], xn[cc][6], xn[cc][7]};
                u32x4 ob; ob[0] = pack2(xn[cc][0], xn[cc][1]); ob[1] = pack2(xn[cc][2], xn[cc][3]); ob[2] = pack2(xn[cc][4], xn[cc][5]); ob[3] = pack2(xn[cc][6], xn[cc][7]);
                *(u32x4*)(xbout + (size_t)t * D + e0) = ob;
            }
            if (lane < 16) ssq_out[(size_t)t * 16 + lane] = lane == 0 ? ss : 0.f;
        } else {
            const float rstd = rsqrtf(ss * (1.f / D) + RMS_EPS);
#pragma unroll
            for (int cc = 0; cc < 2; ++cc) {
                const int e0 = (2 * qg + cc) * 128 + li * 8;
#pragma unroll
                for (int hf = 0; hf < 2; ++hf) {
                    const f32x4 g = *(const f32x4*)(p.final_norm + e0 + hf * 4), sc = *(const f32x4*)(cb + 15 * D + e0 + hf * 4), sh = *(const f32x4*)(cb + 14 * D + e0 + hf * 4);
                    f32x4 ov;
#pragma unroll
                    for (int e = 0; e < 4; ++e) ov[e] = xn[cc][hf * 4 + e] * rstd * g[e] * (1.f + sc[e]) + sh[e];
                    *(f32x4*)(p.out + (size_t)t * D + e0 + hf * 4) = ov;
                }
            }
        }
    }
}

struct EpiQKV {
    const float* ssq; const float* bias; const float* ropec; const float* ropes; bf16_t* K; bf16_t* V; bf16_t* Q;
    __device__ __forceinline__ void operator()(const f32x4 (&acc)[4][4], int mbase, int nbase, int b, int, int tk, int q) const {
        const bool rope = (nbase < 256) || (nbase >= 512);
#pragma unroll
        for (int mi = 0; mi < 4; ++mi) {
            const int token = mbase + mi * 16 + tk;
            const float rstd = rstd_of(ssq, token);
            float v[4][4];
#pragma unroll
            for (int ni = 0; ni < 4; ++ni) {
                const f32x4 bv = *(const f32x4*)(bias + (size_t)b * NSC + SC_KV + nbase + ni * 16 + 4 * q);
#pragma unroll
                for (int r = 0; r < 4; ++r) v[ni][r] = rstd * acc[mi][ni][r] + bv[r];
            }
            if (rope) {
#pragma unroll
                for (int ni = 0; ni < 2; ++ni) {
                    const f32x4 cs = *(const f32x4*)(ropec + (size_t)token * 32 + ni * 16 + 4 * q), sn = *(const f32x4*)(ropes + (size_t)token * 32 + ni * 16 + 4 * q);
#pragma unroll
                    for (int r = 0; r < 4; ++r) { const float t1 = v[ni][r], t2 = v[ni + 2][r]; v[ni][r] = t1 * cs[r] - t2 * sn[r]; v[ni + 2][r] = t2 * cs[r] + t1 * sn[r]; }
                }
            }
            bf16_t* dst = nbase < 256 ? K + (size_t)token * 256 + nbase : (nbase < 512 ? V + (size_t)token * 256 + (nbase - 256) : Q + (size_t)token * D + (nbase - 512));
#pragma unroll
            for (int ni = 0; ni < 4; ++ni) { u32x2 o; o[0] = pack2(v[ni][0], v[ni][1]); o[1] = pack2(v[ni][2], v[ni][3]); *(u32x2*)(dst + ni * 16 + 4 * q) = o; }
        }
    }
};

__device__ void attn_phase(const Params& p, const bf16_t* Q, const bf16_t* K, const bf16_t* V, bf16_t* O, unsigned char* smem) {
    unsigned char* Kl = smem;
    unsigned char* Vt = smem + 32768;
    unsigned char* Pl = smem + 32768 + 35840;
    const int tid = threadIdx.x, lane = tid & 63, w = tid >> 6, tk = lane & 15, q = lane >> 4;
    unsigned char* Pw = Pl + w * 5376;
    for (int task = blockIdx.x; task < NB * 32 * 4; task += gridDim.x) {
        const int kvh = task & 3, qblk = (task >> 2) & 31, b = task >> 7;
        const int kpos0 = (qblk - 1) * 128;
#pragma unroll
        for (int i = 0; i < 4; ++i) {
            const int id = tid + NT * i, j = id >> 3, c = id & 7, kp = kpos0 + j;
            u32x4 v = {0u, 0u, 0u, 0u};
            if (kp >= 0) v = *(const u32x4*)(K + ((size_t)b * SEQ + kp) * 256 + kvh * 64 + c * 8);
            *(u32x4*)(Kl + lds_off(j, c)) = v;
        }
#pragma unroll
        for (int i = 0; i < 4; ++i) {
            const int id = tid + NT * i, j = id & 255, dc = id >> 8, kp = kpos0 + j;
            u32x4 v = {0u, 0u, 0u, 0u};
            if (kp >= 0) v = *(const u32x4*)(V + ((size_t)b * SEQ + kp) * 256 + kvh * 64 + dc * 8);
#pragma unroll
            for (int e = 0; e < 4; ++e) {
                *(bf16_t*)(Vt + (dc * 8 + 2 * e) * 560 + j * 2) = (bf16_t)(v[e] & 0xffffu);
                *(bf16_t*)(Vt + (dc * 8 + 2 * e + 1) * 560 + j * 2) = (bf16_t)(v[e] >> 16);
            }
        }
        if (tid < 128) *(u32x4*)(Vt + (tid >> 1) * 560 + 512 + (tid & 1) * 16) = (u32x4){0u, 0u, 0u, 0u};
        *(u32x2*)(Pw + tk * 336 + (144 + 4 * q) * 2) = (u32x2){0u, 0u};
        __syncthreads();
        const int qt = w, i_q = qt * 16 + tk;
        const size_t trow = (size_t)b * SEQ + qblk * 128 + i_q;
#pragma unroll 1
        for (int hq = 0; hq < 4; ++hq) {
            const int head = kvh * 4 + hq;
            const bf16x8 qf0 = *(const bf16x8*)(Q + trow * D + head * 64 + 8 * q), qf1 = *(const bf16x8*)(Q + trow * D + head * 64 + 32 + 8 * q);
            f32x4 sacc[9];
#pragma unroll
            for (int kk = 0; kk < 9; ++kk) {
                const int krow = (qt + kk) * 16 + tk;
                const bf16x8 k0 = *(const bf16x8*)(Kl + lds_off(krow, q)), k1 = *(const bf16x8*)(Kl + lds_off(krow, 4 + q));
                f32x4 a = {0.f, 0.f, 0.f, 0.f};
                a = __builtin_amdgcn_mfma_f32_16x16x32_bf16(k0, qf0, a, 0, 0, 0);
                a = __builtin_amdgcn_mfma_f32_16x16x32_bf16(k1, qf1, a, 0, 0, 0);
                sacc[kk] = a;
            }
            const float sink = p.sinks[head];
            float mx = -1e30f;
#pragma unroll
            for (int kk = 0; kk < 9; ++kk)
#pragma unroll
                for (int r = 0; r < 4; ++r) {
                    const int j = (qt + kk) * 16 + 4 * q + r;
                    const bool valid = (j > i_q) && (j <= i_q + 128) && (qblk > 0 || j >= 128);
                    const float s = valid ? sacc[kk][r] * 0.125f : -1e30f;
                    sacc[kk][r] = s; mx = fmaxf(mx, s);
                }
            mx = fmaxf(mx, __shfl_xor(mx, 16)); mx = fmaxf(mx, __shfl_xor(mx, 32));
            mx = fmaxf(mx, sink);
            float sum = 0.f;
#pragma unroll
            for (int kk = 0; kk < 9; ++kk)
#pragma unroll
                for (int r = 0; r < 4; ++r) { const float e = __expf(sacc[kk][r] - mx); sacc[kk][r] = e; sum += e; }
            sum += __shfl_xor(sum, 16); sum += __shfl_xor(sum, 32);
            const float inv = 1.f / (sum + __expf(sink - mx));
#pragma unroll
            for (int kk = 0; kk < 9; ++kk) {
                u32x2 o; o[0] = pack2(sacc[kk][0] * inv, sacc[kk][1] * inv); o[1] = pack2(sacc[kk][2] * inv, sacc[kk][3] * inv);
                *(u32x2*)(Pw + tk * 336 + (kk * 16 + 4 * q) * 2) = o;
            }
            asm volatile("s_waitcnt lgkmcnt(0)" ::: "memory");
            bf16x8 pf[5];
#pragma unroll
            for (int ks = 0; ks < 5; ++ks) pf[ks] = *(const bf16x8*)(Pw + tk * 336 + (ks * 32 + 8 * q) * 2);
#pragma unroll
            for (int dt = 0; dt < 4; ++dt) {
                f32x4 oa = {0.f, 0.f, 0.f, 0.f};
#pragma unroll
                for (int ks = 0; ks < 5; ++ks) {
                    const bf16x8 vf = *(const bf16x8*)(Vt + (dt * 16 + tk) * 560 + (qt * 16 + ks * 32 + 8 * q) * 2);
                    oa = __builtin_amdgcn_mfma_f32_16x16x32_bf16(vf, pf[ks], oa, 0, 0, 0);
                }
                u32x2 o; o[0] = pack2(oa[0], oa[1]); o[1] = pack2(oa[2], oa[3]);
                *(u32x2*)(O + trow * D + head * 64 + dt * 16 + 4 * q) = o;
            }
            asm volatile("s_waitcnt lgkmcnt(0)" ::: "memory");
        }
        __syncthreads();
    }
}

__device__ void final_only(const Params& p, const float* xin) {
    const int lane = threadIdx.x & 63, wv = threadIdx.x >> 6;
    const int nw = gridDim.x * (NT / 64);
    for (int t = blockIdx.x * (NT / 64) + wv; t < T; t += nw) {
        const int b = t / SEQ;
        const float* xr = xin + (size_t)t * D;
        f32x4 v[4]; float s = 0.f;
#pragma unroll
        for (int j = 0; j < 4; ++j) { v[j] = *(const f32x4*)(xr + j * 256 + lane * 4); s += v[j][0] * v[j][0] + v[j][1] * v[j][1] + v[j][2] * v[j][2] + v[j][3] * v[j][3]; }
        s = wave_sum(s);
        const float rstd = rsqrtf(s * (1.f / D) + RMS_EPS);
#pragma unroll
        for (int j = 0; j < 4; ++j) {
            const int e = j * 256 + lane * 4;
            const f32x4 g = *(const f32x4*)(p.final_norm + e);
            const f32x4 sh = *(const f32x4*)(p.cond + (size_t)b * (NCOND * D) + 14 * D + e);
            const f32x4 sc = *(const f32x4*)(p.cond + (size_t)b * (NCOND * D) + 15 * D + e);
            f32x4 o;
#pragma unroll
            for (int i = 0; i < 4; ++i) o[i] = v[j][i] * rstd * g[i] * (1.f + sc[i]) + sh[i];
            *(f32x4*)(p.out + (size_t)t * D + e) = o;
        }
    }
}

constexpr int SMEM_BYTES = 152 * 1024;
__global__ void __launch_bounds__(NT) yoco_fwd(Params p) {
    __shared__ __attribute__((aligned(16))) unsigned char smem[SMEM_BYTES];
    cg::grid_group grid = cg::this_grid();
    p0_cond(p, smem);
    p0_xconv(p);
    p0_wt(p, smem);
    p0_s5(p, smem);
    p0_tables(p);
    grid.sync();
    p05_weights(p, smem);
    grid.sync();
    { EpiU e{p.ssq0, p.bias, p.s1}; gemm_phase(p.s0, p.wts + (size_t)SC_IN * D, (size_t)NSC * D, 1024, e, smem); }
    grid.sync();
    s5_phase(p, smem);
    grid.sync();
    { EpiGlu e{p.s0, p.b_glu, p.s1}; gemm_phase(p.s0, p.wt_glu, 0, 1024, e, smem); }
    grid.sync();
    { EpiRes e{p.x, p.cond + 2 * D, p.f0, p.s2, p.ssq1}; gemm_phase(p.s1, p.wt_out, 0, 1024, e, smem); }
    grid.sync();
    { EpiQ e{p.ssq1, p.bias, SC_PQ0, p.s1}; gemm_phase(p.s2, p.wts + (size_t)SC_PQ0 * D, (size_t)NSC * D, 1024, e, smem); }
    grid.sync();
    route_phase(p, 0, p.s1, smem);
    grid.sync();
    gather_phase<false>(p, 0, p.f0, p.f1, p.s0, p.ssq2, p.norm_ffn, 3, 4, 5);
    grid.sync();
    { EpiQKV e{p.ssq2, p.bias, p.ropec, p.ropes, p.s2, p.s2 + (size_t)T * 256, p.s1}; gemm_phase(p.s0, p.wts + (size_t)SC_KV * D, (size_t)NSC * D, 1536, e, smem); }
    grid.sync();
    attn_phase(p, p.s1, p.s2, p.s2 + (size_t)T * 256, p.s0, smem);
    grid.sync();
    { EpiRes e{p.f1, p.cond + 8 * D, p.f0, p.s2, p.ssq3}; gemm_phase(p.s0, p.wt_o, 0, 1024, e, smem); }
    grid.sync();
    { EpiQ e{p.ssq3, p.bias, SC_PQ1, p.s1}; gemm_phase(p.s2, p.wts + (size_t)SC_PQ1 * D, (size_t)NSC * D, 1024, e, smem); }
    grid.sync();
    route_phase(p, 1, p.s1, smem);
    grid.sync();
    gather_phase<true>(p, 1, p.f0, nullptr, nullptr, nullptr, p.norm_ffn + D, 9, 10, 11);
}

static inline size_t align_up(size_t v, size_t a) { return (v + a - 1) / a * a; }

extern "C" void kernel_launch(void* const* d_in, const int* in_sizes, int n_in, void* d_out, int out_size, void* d_ws, size_t ws_size, hipStream_t stream) {
    (void)in_sizes; (void)n_in; (void)out_size;
    Params p{};
    p.x = (const float*)d_in[0]; p.c = (const float*)d_in[1]; p.pos = (const int*)d_in[2]; p.w_cond = (const float*)d_in[3]; p.b_cond = (const float*)d_in[4];
    p.norm_mix = (const float*)d_in[5]; p.norm_ffn = (const float*)d_in[6]; p.w_in = (const float*)d_in[7]; p.a_re = (const float*)d_in[8]; p.a_im = (const float*)d_in[9];
    p.log_dt = (const float*)d_in[10]; p.b_re = (const float*)d_in[11]; p.b_im = (const float*)d_in[12]; p.c_re = (const float*)d_in[13]; p.c_im = (const float*)d_in[14];
    p.s5d = (const float*)d_in[15]; p.w_glu = (const float*)d_in[16]; p.b_glu = (const float*)d_in[17]; p.w_out = (const float*)d_in[18]; p.kv_norm = (const float*)d_in[19];
    p.w_kv = (const float*)d_in[20]; p.w_q = (const float*)d_in[21]; p.sinks = (const float*)d_in[22]; p.w_o = (const float*)d_in[23]; p.peer_wq = (const float*)d_in[24];
    p.subkeys = (const float*)d_in[25]; p.peer_u = (const float*)d_in[26]; p.peer_v = (const float*)d_in[27]; p.final_norm = (const float*)d_in[28];
    p.out = (float*)d_out;
    unsigned char* w = (unsigned char*)d_ws; size_t off = 65536;
    auto take = [&](size_t bytes) { void* r = w + off; off = align_up(off + bytes, 4096); return r; };
    p.cond = (float*)take((size_t)NB * NCOND * D * 4);
    p.ropec = (float*)take((size_t)T * 32 * 4); p.ropes = (float*)take((size_t)T * 32 * 4);
    p.ssq0 = (float*)take((size_t)T * 16 * 4); p.ssq1 = (float*)take((size_t)T * 16 * 4); p.ssq2 = (float*)take((size_t)T * 16 * 4); p.ssq3 = (float*)take((size_t)T * 16 * 4);
    p.wt_glu = (bf16_t*)take((size_t)D * D * 2); p.wt_out = (bf16_t*)take((size_t)D * D * 2); p.wt_o = (bf16_t*)take((size_t)D * D * 2);
    p.wts = (bf16_t*)take((size_t)NB * NSC * D * 2); p.bias = (float*)take((size_t)NB * NSC * 4);
    p.skeys = (bf16_t*)take((size_t)2 * 8 * 2 * 128 * 64 * 2);
    p.lamL = (float*)take((size_t)G5 * P5 * 2 * 4); p.ktab = (bf16_t*)take((size_t)G5 * 65 * 256 * 2);
    p.smat = (bf16_t*)take((size_t)G5 * 128 * 1024 * 2); p.cmat = (bf16_t*)take((size_t)G5 * 1024 * 128 * 2);
    p.ub = (bf16_t*)take((size_t)2 * NEXP * D * 2); p.vb = (bf16_t*)take((size_t)2 * NEXP * D * 2);
    p.s0 = (bf16_t*)take((size_t)T * D * 2); p.s1 = (bf16_t*)take((size_t)T * D * 2); p.s2 = (bf16_t*)take((size_t)T * D * 2);
    p.f0 = (float*)take((size_t)T * D * 4); p.f1 = (float*)take((size_t)T * D * 4);
    p.ids = (int*)take((size_t)T * 128 * 4); p.gates = (float*)take((size_t)T * 128 * 4);
    if (off > ws_size) { fprintf(stderr, "workspace too small: need %zu have %zu\n", off, ws_size); return; }

    static int grid_blocks = 0;
    if (!grid_blocks) {
        int dev = 0, cus = 0, per_cu = 0;
        (void)hipGetDevice(&dev);
        (void)hipDeviceGetAttribute(&cus, hipDeviceAttributeMultiprocessorCount, dev);
        (void)hipOccupancyMaxActiveBlocksPerMultiprocessor(&per_cu, yoco_fwd, NT, 0);
        if (per_cu > 1) per_cu = 1;
        grid_blocks = cus * per_cu;
        if (grid_blocks <= 0) grid_blocks = 256;
    }
    void* args[] = {&p};
    hipError_t e = hipLaunchCooperativeKernel((const void*)yoco_fwd, dim3(grid_blocks), dim3(NT), args, 0, stream);
    if (e != hipSuccess) fprintf(stderr, "cooperative launch failed: %s (grid %d)\n", hipGetErrorString(e), grid_blocks);
}
```

```cpp
#include <hip/hip_runtime.h>
#include <hip/hip_cooperative_groups.h>
#include <cstdio>
#include <cstdint>
namespace cg = cooperative_groups;

#define NT 512
#define LAS __attribute__((address_space(3)))
typedef unsigned short bf16_t;
typedef short bf16x8 __attribute__((ext_vector_type(8)));
typedef float f32x4 __attribute__((ext_vector_type(4)));
typedef unsigned u32x4 __attribute__((ext_vector_type(4)));
typedef unsigned u32x2 __attribute__((ext_vector_type(2)));

constexpr int D = 1024, NB = 4, SEQ = 4096, T = NB * SEQ;
constexpr int NCOND = 16;
constexpr int G5 = 64, P5 = 64, C5 = 16, L5 = 64, NCH = SEQ / L5;
constexpr int NEXP = 16384;
constexpr int NSC = 4608;
constexpr int SC_IN = 0, SC_PQ0 = 1024, SC_KV = 2048, SC_Q = 2560, SC_PQ1 = 3584;
constexpr float RMS_EPS = 1e-6f;

struct Params {
    const float *x, *c; const int* pos; const float *w_cond, *b_cond, *norm_mix, *norm_ffn, *w_in, *a_re, *a_im, *log_dt, *b_re, *b_im, *c_re, *c_im, *s5d,
        *w_glu, *b_glu, *w_out, *kv_norm, *w_kv, *w_q, *sinks, *w_o, *peer_wq, *subkeys, *peer_u, *peer_v, *final_norm;
    float* out;
    float* cond;
    float* ropec;
    float* ropes;
    float* ssq0;
    float* ssq1;
    float* ssq2;
    float* ssq3;
    bf16_t* wt_glu;
    bf16_t* wt_out;
    bf16_t* wt_o;
    bf16_t* wts;
    float* bias;
    bf16_t* skeys;
    float* lamL;
    bf16_t* ktab;
    bf16_t* smat;
    bf16_t* cmat;
    unsigned char* ub;
    unsigned char* vb;
    float* su;
    float* sv;
    bf16_t* s0;
    bf16_t* s1;
    bf16_t* s2;
    float* f0;
    float* f1;
    int* ids;
    float* gates;
};

__device__ __forceinline__ bf16_t f2bf(float f) { unsigned u = __float_as_uint(f); u += 0x7fffu + ((u >> 16) & 1u); return (bf16_t)(u >> 16); }
__device__ __forceinline__ float bf2f(bf16_t h) { return __uint_as_float(((unsigned)h) << 16); }
typedef __bf16 hbf2 __attribute__((ext_vector_type(2)));
typedef float f32x2 __attribute__((ext_vector_type(2)));
__device__ __forceinline__ unsigned pack2(float lo, float hi) { f32x2 v = {lo, hi}; return __builtin_bit_cast(unsigned, __builtin_convertvector(v, hbf2)); }
__device__ __forceinline__ float dot2bf(unsigned a, unsigned b, float c) { return __builtin_amdgcn_fdot2_f32_bf16(__builtin_bit_cast(hbf2, a), __builtin_bit_cast(hbf2, b), c, false); }
__device__ __forceinline__ float bflo(unsigned w) { return __uint_as_float(w << 16); }
__device__ __forceinline__ float bfhi(unsigned w) { return __uint_as_float(w & 0xffff0000u); }
__device__ __forceinline__ float wave_sum(float v) {
#pragma unroll
    for (int o = 32; o >= 1; o >>= 1) v += __shfl_xor(v, o);
    return v;
}
__device__ __forceinline__ float gelu_tanh(float x) {
    const float u = 0.7978845608028654f * (x + 0.044715f * x * x * x);
    const float e = __expf(-2.f * fabsf(u));
    float th = (1.f - e) / (1.f + e);
    th = u < 0.f ? -th : th;
    return 0.5f * x * (1.f + th);
}

__device__ void p0_cond(const Params& p, unsigned char* smem) {
    float* sc = (float*)smem;
    float* red = (float*)(smem + 16384);
    const int tid = threadIdx.x;
    for (int i = tid; i < 4 * D; i += NT) { const float v = p.c[i]; sc[i] = v / (1.f + __expf(-v)); }
    __syncthreads();
    const int cgp = tid & 15, kg = tid >> 4;
    for (int task = blockIdx.x; task < NCOND * D / 64; task += gridDim.x) {
        const int col0 = task * 64 + cgp * 4;
        float acc[4][4];
#pragma unroll
        for (int b = 0; b < 4; ++b)
#pragma unroll
            for (int j = 0; j < 4; ++j) acc[b][j] = 0.f;
        for (int k = kg; k < D; k += 32) {
            const f32x4 w = *(const f32x4*)(p.w_cond + (size_t)k * (NCOND * D) + col0);
#pragma unroll
            for (int b = 0; b < 4; ++b) { const float s = sc[b * D + k];
#pragma unroll
                for (int j = 0; j < 4; ++j) acc[b][j] += s * w[j]; }
        }
#pragma unroll
        for (int b = 0; b < 4; ++b)
#pragma unroll
            for (int j = 0; j < 4; ++j) red[(kg * 64 + cgp * 4 + j) * 4 + b] = acc[b][j];
        __syncthreads();
        if (tid < 256) {
            const int col = tid >> 2, b = tid & 3;
            float s = 0.f;
            for (int g = 0; g < 32; ++g) s += red[(g * 64 + col) * 4 + b];
            p.cond[(size_t)b * (NCOND * D) + task * 64 + col] = s + p.b_cond[task * 64 + col];
        }
        __syncthreads();
    }
}

__device__ void p0_xconv(const Params& p) {
    const int lane = threadIdx.x & 63, wv = threadIdx.x >> 6;
    const int nw = gridDim.x * (NT / 64);
    for (int t = blockIdx.x * (NT / 64) + wv; t < T; t += nw) {
        const float* xr = p.x + (size_t)t * D;
        float s = 0.f;
#pragma unroll
        for (int j = 0; j < 4; ++j) {
            const f32x4 v = *(const f32x4*)(xr + j * 256 + lane * 4);
            s += v[0] * v[0] + v[1] * v[1] + v[2] * v[2] + v[3] * v[3];
            u32x2 o; o[0] = pack2(v[0], v[1]); o[1] = pack2(v[2], v[3]);
            *(u32x2*)(p.s0 + (size_t)t * D + j * 256 + lane * 4) = o;
        }
        s = wave_sum(s);
        if (lane < 16) p.ssq0[(size_t)t * 16 + lane] = lane == 0 ? s : 0.f;
    }
}

__device__ void p0_tables(const Params& p) {
    const size_t gtid = (size_t)blockIdx.x * NT + threadIdx.x, gstride = (size_t)gridDim.x * NT;
    {
        const int li = threadIdx.x & 15;
        const size_t grp = gtid >> 4, ngrp = gstride >> 4;
        for (int which = 0; which < 2; ++which) {
            const float* src = which ? p.peer_v : p.peer_u; unsigned char* dst = which ? p.vb : p.ub; float* sdst = which ? p.sv : p.su;
            for (size_t row = grp; row < (size_t)2 * NEXP; row += ngrp) {
                f32x4 v[4][4]; float mx = 0.f;
#pragma unroll
                for (int c = 0; c < 4; ++c)
#pragma unroll
                    for (int j = 0; j < 4; ++j) {
                        v[c][j] = *(const f32x4*)(src + row * D + c * 256 + li * 16 + j * 4);
#pragma unroll
                        for (int e = 0; e < 4; ++e) mx = fmaxf(mx, fabsf(v[c][j][e]));
                    }
                mx = fmaxf(mx, __shfl_xor(mx, 1)); mx = fmaxf(mx, __shfl_xor(mx, 2)); mx = fmaxf(mx, __shfl_xor(mx, 4)); mx = fmaxf(mx, __shfl_xor(mx, 8));
                const float sc = mx > 0.f ? mx * (1.f / 448.f) : 1.f, inv = 1.f / sc;
#pragma unroll
                for (int c = 0; c < 4; ++c) {
                    u32x4 o;
#pragma unroll
                    for (int j = 0; j < 4; ++j) {
                        int r = 0;
                        r = __builtin_amdgcn_cvt_pk_fp8_f32(v[c][j][0] * inv, v[c][j][1] * inv, r, false);
                        r = __builtin_amdgcn_cvt_pk_fp8_f32(v[c][j][2] * inv, v[c][j][3] * inv, r, true);
                        o[j] = (unsigned)r;
                    }
                    *(u32x4*)(dst + row * D + c * 256 + li * 16) = o;
                }
                if (li == 0) sdst[row] = sc;
            }
        }
    }
    const size_t nk8 = (size_t)2 * 8 * 2 * 128 * 64 / 8;
    for (size_t i = gtid; i < nk8; i += gstride) {
        const f32x4 a = *(const f32x4*)(p.subkeys + i * 8), b = *(const f32x4*)(p.subkeys + i * 8 + 4);
        u32x4 o; o[0] = pack2(a[0], a[1]); o[1] = pack2(a[2], a[3]); o[2] = pack2(b[0], b[1]); o[3] = pack2(b[2], b[3]);
        *(u32x4*)(p.skeys + i * 8) = o;
    }
    for (size_t i = gtid; i < (size_t)T * 32; i += gstride) {
        const int t = (int)(i >> 5), f = (int)(i & 31);
        const double inv = exp(-(double)(2 * f) / 64.0 * 9.210340371976184);
        double ang = (double)p.pos[t] * inv;
        ang -= 6.283185307179586 * floor(ang * 0.15915494309189535);
        p.ropec[i] = (float)cos(ang); p.ropes[i] = (float)sin(ang);
    }
}

__device__ void transpose_tile(const float* W, int ldw, int n0, int k0, const float* sk, bf16_t* Wt, unsigned char* smem) {
    bf16_t* tl = (bf16_t*)smem;
    const int tid = threadIdx.x, kk = tid >> 3, nn = (tid & 7) * 8;
    const f32x4 a = *(const f32x4*)(W + (size_t)(k0 + kk) * ldw + n0 + nn), b = *(const f32x4*)(W + (size_t)(k0 + kk) * ldw + n0 + nn + 4);
    const float s = sk ? sk[k0 + kk] : 1.f;
#pragma unroll
    for (int j = 0; j < 4; ++j) { tl[(nn + j) * 72 + kk] = f2bf(a[j] * s); tl[(nn + 4 + j) * 72 + kk] = f2bf(b[j] * s); }
    __syncthreads();
    const int n = tid >> 3, kc = (tid & 7) * 8;
    const u32x4 v = *(const u32x4*)(tl + n * 72 + kc);
    *(u32x4*)(Wt + (size_t)(n0 + n) * D + k0 + kc) = v;
    __syncthreads();
}

__device__ void p0_wt(const Params& p, unsigned char* smem) {
    for (int task = blockIdx.x; task < 3 * 256; task += gridDim.x) {
        const int w = task >> 8, tl = task & 255, n0 = (tl & 15) * 64, k0 = (tl >> 4) * 64;
        const float* W = w == 0 ? p.w_glu : (w == 1 ? p.w_out : p.w_o);
        bf16_t* Wt = w == 0 ? p.wt_glu : (w == 1 ? p.wt_out : p.wt_o);
        transpose_tile(W, D, n0, k0, nullptr, Wt, smem);
    }
}

struct cplx { double re, im; };
__device__ __forceinline__ cplx lam_pow(double ar, double ai, double dt, int n) {
    const double m = exp(ar * dt * n); double ang = ai * dt * n;
    ang -= 6.283185307179586 * floor(ang * 0.15915494309189535);
    cplx r; r.re = m * cos(ang); r.im = m * sin(ang); return r;
}
__device__ __forceinline__ cplx s5_coef(double ar, double ai, double dt) {
    const cplx lb = lam_pow(ar, ai, dt, 1);
    const double nr = lb.re - 1.0, ni = lb.im, den = ar * ar + ai * ai;
    cplx c; c.re = (nr * ar + ni * ai) / den; c.im = (ni * ar - nr * ai) / den; return c;
}

__device__ void p0_s5(const Params& p, unsigned char* smem) {
    const size_t gtid = (size_t)blockIdx.x * NT + threadIdx.x, gstride = (size_t)gridDim.x * NT;
    for (size_t idx = gtid; idx < (size_t)G5 * P5 * 65; idx += gstride) {
        const int e = (int)(idx % 65), pp = (int)((idx / 65) % P5), g = (int)(idx / (65 * P5));
        const double dt = exp((double)p.log_dt[g]), ar = p.a_re[g * P5 + pp], ai = p.a_im[g * P5 + pp];
        const cplx pw = lam_pow(ar, ai, dt, e);
        if (e < 64) {
            const cplx cf = s5_coef(ar, ai, dt);
            const int j = 63 - e;
            bf16_t* sre = p.smat + ((size_t)g * 128 + pp) * 1024 + j * 16;
            bf16_t* sim = p.smat + ((size_t)g * 128 + 64 + pp) * 1024 + j * 16;
            for (int ci = 0; ci < 16; ++ci) {
                const double br = p.b_re[((size_t)g * P5 + pp) * C5 + ci], bi = p.b_im[((size_t)g * P5 + pp) * C5 + ci];
                const double bbr = cf.re * br - cf.im * bi, bbi = cf.re * bi + cf.im * br;
                sre[ci] = f2bf((float)(pw.re * bbr - pw.im * bbi));
                sim[ci] = f2bf((float)(pw.re * bbi + pw.im * bbr));
            }
        }
        if (e >= 1) {
            const int i = e - 1;
            for (int co = 0; co < 16; ++co) {
                const double cr = p.c_re[((size_t)g * C5 + co) * P5 + pp], ci = p.c_im[((size_t)g * C5 + co) * P5 + pp];
                bf16_t* row = p.cmat + ((size_t)g * 1024 + i * 16 + co) * 128;
                row[pp] = f2bf((float)(cr * pw.re - ci * pw.im));
                row[64 + pp] = f2bf((float)(-(cr * pw.im + ci * pw.re)));
            }
        }
        if (e == 64) { p.lamL[(g * P5 + pp) * 2] = (float)pw.re; p.lamL[(g * P5 + pp) * 2 + 1] = (float)pw.im; }
    }
    float* wre = (float*)smem; float* wim = wre + 64;
    const int tid = threadIdx.x;
    for (int task = blockIdx.x; task < G5 * 64; task += gridDim.x) {
        const int g = task >> 6, tau = task & 63;
        if (tid < 64) {
            const double dt = exp((double)p.log_dt[g]), ar = p.a_re[g * P5 + tid], ai = p.a_im[g * P5 + tid];
            const cplx pw = lam_pow(ar, ai, dt, tau), cf = s5_coef(ar, ai, dt);
            wre[tid] = (float)(pw.re * cf.re - pw.im * cf.im); wim[tid] = (float)(pw.re * cf.im + pw.im * cf.re);
        }
        __syncthreads();
        if (tid < 256) {
            const int co = tid >> 4, ci = tid & 15;
            float s = 0.f;
            for (int pp = 0; pp < 64; ++pp) {
                const float br = p.b_re[((size_t)g * P5 + pp) * C5 + ci], bi = p.b_im[((size_t)g * P5 + pp) * C5 + ci];
                const float zr = wre[pp] * br - wim[pp] * bi, zi = wre[pp] * bi + wim[pp] * br;
                const float cr = p.c_re[((size_t)g * C5 + co) * P5 + pp], cim = p.c_im[((size_t)g * C5 + co) * P5 + pp];
                s += cr * zr - cim * zi;
            }
            p.ktab[((size_t)g * 65 + tau + 1) * 256 + tid] = f2bf(s);
            if (tau == 0) p.ktab[((size_t)g * 65) * 256 + tid] = 0;
        }
        __syncthreads();
    }
}

struct ScSpec { const float* W; int ldw; int n; int col0; const float* g; int c_shift; int c_scale; };
__device__ __forceinline__ ScSpec sc_spec(const Params& p, int s) {
    ScSpec r;
    switch (s) {
        case 0: r = {p.w_in, 1024, 1024, SC_IN, p.norm_mix, 0, 1}; break;
        case 1: r = {p.peer_wq, 1024, 1024, SC_PQ0, p.norm_ffn, 3, 4}; break;
        case 2: r = {p.w_kv, 512, 512, SC_KV, p.kv_norm, 12, 13}; break;
        case 3: r = {p.w_q, 1024, 1024, SC_Q, p.norm_mix + D, 6, 7}; break;
        default: r = {p.peer_wq + (size_t)D * D, 1024, 1024, SC_PQ1, p.norm_ffn + D, 9, 10}; break;
    }
    return r;
}
__device__ void p05_weights(const Params& p, unsigned char* smem) {
    float* gsb = (float*)(smem + 16384);
    const int tid = threadIdx.x;
    int base = 0;
    for (int s = 0; s < 5; ++s) {
        const ScSpec sp = sc_spec(p, s);
        const int ntn = sp.n / 64, ntask = ntn * 16 * 4;
        for (int task = blockIdx.x; task < ntask; task += gridDim.x) {
            const int b = task & 3, tl = task >> 2, n0 = (tl % ntn) * 64, k0 = (tl / ntn) * 64;
            if (tid < 64) gsb[tid] = sp.g[k0 + tid] * (1.f + p.cond[(size_t)b * (NCOND * D) + sp.c_scale * D + k0 + tid]);
            __syncthreads();
            transpose_tile(sp.W, sp.ldw, n0, k0, gsb - k0, p.wts + ((size_t)b * NSC + sp.col0) * D, smem);
        }
        base += ntask;
    }
    float* red = (float*)smem;
    for (int task = blockIdx.x; task < NSC / 64; task += gridDim.x) {
        const int col0 = task * 64;
        int s = col0 < SC_PQ0 ? 0 : (col0 < SC_KV ? 1 : (col0 < SC_Q ? 2 : (col0 < SC_PQ1 ? 3 : 4)));
        const ScSpec sp = sc_spec(p, s);
        const int n = col0 - sp.col0 + (tid & 63), kg = tid >> 6;
        float acc[4] = {0.f, 0.f, 0.f, 0.f};
        for (int k = kg; k < D; k += 8) {
            const float w = sp.W[(size_t)k * sp.ldw + n];
#pragma unroll
            for (int b = 0; b < 4; ++b) acc[b] += p.cond[(size_t)b * (NCOND * D) + sp.c_shift * D + k] * w;
        }
#pragma unroll
        for (int b = 0; b < 4; ++b) red[(kg * 64 + (tid & 63)) * 4 + b] = acc[b];
        __syncthreads();
        if (tid < 256) {
            const int col = tid >> 2, b = tid & 3; float sum = 0.f;
            for (int g = 0; g < 8; ++g) sum += red[(g * 64 + col) * 4 + b];
            p.bias[(size_t)b * NSC + col0 + col] = sum;
        }
        __syncthreads();
    }
}

__device__ __forceinline__ int lds_off(int row, int chunk) { return row * 128 + ((chunk ^ (row & 7)) << 4); }

template <class Epi>
__device__ void gemm_phase(const bf16_t* __restrict__ A, const bf16_t* __restrict__ Bt, size_t bt_batch_stride, int N, const Epi& epi, unsigned char* smem) {
    const int tid = threadIdx.x, lane = tid & 63, w = tid >> 6, wm = w >> 1, wn = w & 1, tk = lane & 15, q = lane >> 4;
    const int nN = N / 128;
    const bool xmap = (gridDim.x % 8) == 0;
    const int nslots = xmap ? gridDim.x / 8 : gridDim.x, slot = xmap ? (blockIdx.x >> 3) : blockIdx.x, xcd = blockIdx.x & 7;
    const int nitems = xmap ? 8 * nN : 64 * nN;
    for (int item = slot; item < nitems; item += nslots) {
        const int pm = xmap ? xcd * 8 + item / nN : item / nN, pn = item % nN;
        const int m0 = pm * 256, n0 = pn * 128, b = m0 / SEQ;
        const bf16_t* Ab = A + (size_t)m0 * D;
        const bf16_t* Bb = Bt + (size_t)b * bt_batch_stride + (size_t)n0 * D;
        f32x4 acc[4][4];
#pragma unroll
        for (int mi = 0; mi < 4; ++mi)
#pragma unroll
            for (int ni = 0; ni < 4; ++ni) acc[mi][ni] = (f32x4){0.f, 0.f, 0.f, 0.f};
        u32x4 ra[4], rb[2];
        auto gload = [&](int kt) {
#pragma unroll
            for (int i = 0; i < 4; ++i) { const int id = tid + NT * i, row = id >> 3, c = id & 7; ra[i] = *(const u32x4*)(Ab + (size_t)row * D + kt * 64 + c * 8); }
#pragma unroll
            for (int i = 0; i < 2; ++i) { const int id = tid + NT * i, row = id >> 3, c = id & 7; rb[i] = *(const u32x4*)(Bb + (size_t)row * D + kt * 64 + c * 8); }
        };
        auto lstore = [&](int buf) {
            unsigned char* sA = smem + buf * 32768; unsigned char* sB = smem + 65536 + buf * 16384;
#pragma unroll
            for (int i = 0; i < 4; ++i) { const int id = tid + NT * i, row = id >> 3, c = id & 7; *(u32x4*)(sA + lds_off(row, c)) = ra[i]; }
#pragma unroll
            for (int i = 0; i < 2; ++i) { const int id = tid + NT * i, row = id >> 3, c = id & 7; *(u32x4*)(sB + lds_off(row, c)) = rb[i]; }
        };
        gload(0); lstore(0);
        __syncthreads();
        for (int kt = 0; kt < 16; ++kt) {
            if (kt + 1 < 16) gload(kt + 1);
            const unsigned char* sA = smem + (kt & 1) * 32768; const unsigned char* sB = smem + 65536 + (kt & 1) * 16384;
#pragma unroll
            for (int ks = 0; ks < 2; ++ks) {
                bf16x8 af[4], bfr[4];
#pragma unroll
                for (int mi = 0; mi < 4; ++mi) af[mi] = *(const bf16x8*)(sA + lds_off(wm * 64 + mi * 16 + tk, ks * 4 + q));
#pragma unroll
                for (int ni = 0; ni < 4; ++ni) bfr[ni] = *(const bf16x8*)(sB + lds_off(wn * 64 + ni * 16 + tk, ks * 4 + q));
#pragma unroll
                for (int mi = 0; mi < 4; ++mi)
#pragma unroll
                    for (int ni = 0; ni < 4; ++ni) acc[mi][ni] = __builtin_amdgcn_mfma_f32_16x16x32_bf16(bfr[ni], af[mi], acc[mi][ni], 0, 0, 0);
            }
            if (kt + 1 < 16) lstore((kt + 1) & 1);
            __syncthreads();
        }
        epi(acc, m0 + wm * 64, n0 + wn * 64, b, pn * 2 + wn, tk, q);
    }
}

__device__ __forceinline__ float rstd_of(const float* ssq, int token) {
    const f32x4* s4 = (const f32x4*)(ssq + (size_t)token * 16);
    const f32x4 a = s4[0], b = s4[1], c = s4[2], d = s4[3];
    const float s = ((a[0] + a[1]) + (a[2] + a[3])) + ((b[0] + b[1]) + (b[2] + b[3])) + ((c[0] + c[1]) + (c[2] + c[3])) + ((d[0] + d[1]) + (d[2] + d[3]));
    return rsqrtf(s * (1.f / D) + RMS_EPS);
}

struct EpiU {
    const float* ssq; const float* bias; bf16_t* ug;
    __device__ __forceinline__ void operator()(const f32x4 (&acc)[4][4], int mbase, int nbase, int b, int, int tk, int q) const {
#pragma unroll
        for (int mi = 0; mi < 4; ++mi) {
            const int token = mbase + mi * 16 + tk, s = token - b * SEQ;
            const float rstd = rstd_of(ssq, token);
#pragma unroll
            for (int ni = 0; ni < 4; ++ni) {
                const int n = nbase + ni * 16 + 4 * q, g = n >> 4;
                const f32x4 bv = *(const f32x4*)(bias + (size_t)b * NSC + SC_IN + n);
                u32x2 o; o[0] = pack2(rstd * acc[mi][ni][0] + bv[0], rstd * acc[mi][ni][1] + bv[1]); o[1] = pack2(rstd * acc[mi][ni][2] + bv[2], rstd * acc[mi][ni][3] + bv[3]);
                *(u32x2*)(ug + (((size_t)(g * 4 + b) * SEQ + s) * 16 + 4 * q)) = o;
            }
        }
    }
};
struct EpiQ {
    const float* ssq; const float* bias; int boff; bf16_t* out;
    __device__ __forceinline__ void operator()(const f32x4 (&acc)[4][4], int mbase, int nbase, int b, int, int tk, int q) const {
#pragma unroll
        for (int mi = 0; mi < 4; ++mi) {
            const int token = mbase + mi * 16 + tk;
            const float rstd = rstd_of(ssq, token);
#pragma unroll
            for (int ni = 0; ni < 4; ++ni) {
                const int n = nbase + ni * 16 + 4 * q;
                const f32x4 bv = *(const f32x4*)(bias + (size_t)b * NSC + boff + n);
                u32x2 o; o[0] = pack2(rstd * acc[mi][ni][0] + bv[0], rstd * acc[mi][ni][1] + bv[1]); o[1] = pack2(rstd * acc[mi][ni][2] + bv[2], rstd * acc[mi][ni][3] + bv[3]);
                *(u32x2*)(out + (size_t)token * D + n) = o;
            }
        }
    }
};
struct EpiGlu {
    const bf16_t* y; const float* bglu; bf16_t* out;
    __device__ __forceinline__ void operator()(const f32x4 (&acc)[4][4], int mbase, int nbase, int, int, int tk, int q) const {
#pragma unroll
        for (int mi = 0; mi < 4; ++mi) {
            const int token = mbase + mi * 16 + tk;
#pragma unroll
            for (int ni = 0; ni < 4; ++ni) {
                const int n = nbase + ni * 16 + 4 * q;
                const f32x4 bv = *(const f32x4*)(bglu + n);
                const u32x2 yv = *(const u32x2*)(y + (size_t)token * D + n);
                float o[4];
                const float y0 = bflo(yv[0]), y1 = bfhi(yv[0]), y2 = bflo(yv[1]), y3 = bfhi(yv[1]);
                o[0] = y0 / (1.f + __expf(-(acc[mi][ni][0] + bv[0]))); o[1] = y1 / (1.f + __expf(-(acc[mi][ni][1] + bv[1])));
                o[2] = y2 / (1.f + __expf(-(acc[mi][ni][2] + bv[2]))); o[3] = y3 / (1.f + __expf(-(acc[mi][ni][3] + bv[3])));
                u32x2 ov; ov[0] = pack2(o[0], o[1]); ov[1] = pack2(o[2], o[3]);
                *(u32x2*)(out + (size_t)token * D + n) = ov;
            }
        }
    }
};
struct EpiRes {
    const float* xold; const float* gate  ; float* xout; bf16_t* xbout; float* ssq;
    __device__ __forceinline__ void operator()(const f32x4 (&acc)[4][4], int mbase, int nbase, int b, int slot, int tk, int q) const {
#pragma unroll
        for (int mi = 0; mi < 4; ++mi) {
            const int token = mbase + mi * 16 + tk;
            float ss = 0.f;
#pragma unroll
            for (int ni = 0; ni < 4; ++ni) {
                const int n = nbase + ni * 16 + 4 * q;
                const f32x4 gv = *(const f32x4*)(gate + (size_t)b * (NCOND * D) + n);
                const f32x4 xo = *(const f32x4*)(xold + (size_t)token * D + n);
                f32x4 xn;
#pragma unroll
                for (int r = 0; r < 4; ++r) { xn[r] = xo[r] + gv[r] * acc[mi][ni][r]; ss += xn[r] * xn[r]; }
                *(f32x4*)(xout + (size_t)token * D + n) = xn;
                u32x2 ov; ov[0] = pack2(xn[0], xn[1]); ov[1] = pack2(xn[2], xn[3]);
                *(u32x2*)(xbout + (size_t)token * D + n) = ov;
            }
            ss += __shfl_xor(ss, 16); ss += __shfl_xor(ss, 32);
            if (q == 0) ssq[(size_t)token * 16 + slot] = ss;
        }
    }
};

__device__ void s5_phase(const Params& p, unsigned char* smem) {
    bf16_t* ktl = (bf16_t*)smem;
    float* Sl = (float*)(smem + 33280);
    bf16_t* Xl = (bf16_t*)(smem + 33280 + 33280);
    const int tid = threadIdx.x, lane = tid & 63, w = tid >> 6, cb = w & 3, hh = w >> 2, tk = lane & 15, q = lane >> 4;
    for (int task = blockIdx.x; task < G5 * NB; task += gridDim.x) {
        const int g = (task & 7) * 8 + ((task >> 3) >> 2), b = (task >> 3) & 3;
        const bf16_t* U = p.s1 + (size_t)(g * 4 + b) * SEQ * 16;
        const bf16_t* sm = p.smat + (size_t)g * 128 * 1024;
        const bf16_t* cm = p.cmat + (size_t)g * 1024 * 128;
        for (int i = tid; i < 65 * 256 * 2 / 16; i += NT) ((u32x4*)ktl)[i] = ((const u32x4*)(p.ktab + (size_t)g * 65 * 256))[i];
        bf16x8 ufr[32];
#pragma unroll
        for (int ks = 0; ks < 32; ++ks) ufr[ks] = *(const bf16x8*)(U + (size_t)(cb * 16 + tk) * 1024 + ks * 32 + 8 * q);
#pragma unroll 1
        for (int mf = 0; mf < 4; ++mf) {
            const int r0 = (hh * 4 + mf) * 16;
            f32x4 acc = {0.f, 0.f, 0.f, 0.f};
#pragma unroll
            for (int ks = 0; ks < 32; ++ks) {
                const bf16x8 af = *(const bf16x8*)(sm + (size_t)(r0 + tk) * 1024 + ks * 32 + 8 * q);
                acc = __builtin_amdgcn_mfma_f32_16x16x32_bf16(af, ufr[ks], acc, 0, 0, 0);
            }
#pragma unroll
            for (int r = 0; r < 4; ++r) Sl[(r0 + 4 * q + r) * 65 + cb * 16 + tk] = acc[r];
        }
        __syncthreads();
        if (w == 0) {
            const float lr = p.lamL[(g * P5 + lane) * 2], li = p.lamL[(g * P5 + lane) * 2 + 1];
            float xr = 0.f, xi = 0.f;
            for (int k = 0; k < NCH; ++k) {
                Xl[k * 128 + lane] = f2bf(xr); Xl[k * 128 + 64 + lane] = f2bf(xi);
                const float sr = Sl[lane * 65 + k], si = Sl[(64 + lane) * 65 + k];
                const float nr = lr * xr - li * xi + sr, ni = lr * xi + li * xr + si;
                xr = nr; xi = ni;
            }
        }
        __syncthreads();
        bf16x8 xfr[4];
#pragma unroll
        for (int ks = 0; ks < 4; ++ks) xfr[ks] = *(const bf16x8*)(Xl + (cb * 16 + tk) * 128 + ks * 32 + 8 * q);
        const f32x4 dv = *(const f32x4*)(p.s5d + g * 16 + 4 * q);
        const int jl = q >> 1, cih = q & 1;
#pragma unroll 1
        for (int ii = 0; ii < 32; ++ii) {
            const int i = hh ? 16 + ii : (ii < 16 ? ii : 32 + ii);
            f32x4 acc = {0.f, 0.f, 0.f, 0.f};
#pragma unroll
            for (int ks = 0; ks < 4; ++ks) {
                const bf16x8 af = *(const bf16x8*)(cm + (size_t)(i * 16 + tk) * 128 + ks * 32 + 8 * q);
                acc = __builtin_amdgcn_mfma_f32_16x16x32_bf16(af, xfr[ks], acc, 0, 0, 0);
            }
            const int mmax = i >> 1;
#pragma unroll
            for (int m = 0; m < 32; ++m) {
                if (m <= mmax) {
                    const int tau1 = i - 2 * m - jl + 1;
                    const bf16x8 kf = *(const bf16x8*)(ktl + tau1 * 256 + tk * 16 + cih * 8);
                    acc = __builtin_amdgcn_mfma_f32_16x16x32_bf16(kf, ufr[m], acc, 0, 0, 0);
                }
            }
            const int s = (cb * 16 + tk) * 64 + i;
            const u32x2 uv = *(const u32x2*)(U + (size_t)s * 16 + 4 * q);
            const float y0 = gelu_tanh(acc[0] + dv[0] * bflo(uv[0])), y1 = gelu_tanh(acc[1] + dv[1] * bfhi(uv[0]));
            const float y2 = gelu_tanh(acc[2] + dv[2] * bflo(uv[1])), y3 = gelu_tanh(acc[3] + dv[3] * bfhi(uv[1]));
            u32x2 o; o[0] = pack2(y0, y1); o[1] = pack2(y2, y3);
            *(u32x2*)(p.s0 + ((size_t)b * SEQ + s) * D + g * 16 + 4 * q) = o;
        }
        __syncthreads();
    }
}

__device__ __forceinline__ float med3f(float a, float b, float c) { return __builtin_amdgcn_fmed3f(a, b, c); }
__device__ __forceinline__ void ins16(float (&a)[16], float v) {
#pragma unroll
    for (int i = 15; i >= 1; --i) a[i] = med3f(a[i - 1], a[i], v);
    a[0] = fmaxf(a[0], v);
}
__device__ void route_phase(const Params& p, int layer, const bf16_t* qp, unsigned char* smem) {
    float* sc = (float*)smem;
    float* tl = (float*)(smem + 2 * 128 * 129 * 4);
    const int tid = threadIdx.x, lane = tid & 63, w = tid >> 6, tk = lane & 15, q = lane >> 4;
    for (int task = blockIdx.x; task < (T / 128) * 8; task += gridDim.x) {
        const int h = task & 7, t0 = (task >> 3) * 128;
#pragma unroll 1
        for (int pp = 0; pp < 2; ++pp) {
            const bf16_t* qrow = qp + (size_t)(t0 + 16 * w + tk) * D + h * 128 + pp * 64 + 8 * q;
            const bf16x8 a0 = *(const bf16x8*)(qrow), a1 = *(const bf16x8*)(qrow + 32);
            const bf16_t* kb = p.skeys + ((size_t)((layer * 8 + h) * 2 + pp) * 128) * 64 + 8 * q;
#pragma unroll
            for (int nf = 0; nf < 8; ++nf) {
                const bf16x8 b0 = *(const bf16x8*)(kb + (size_t)(nf * 16 + tk) * 64), b1 = *(const bf16x8*)(kb + (size_t)(nf * 16 + tk) * 64 + 32);
                f32x4 acc = {0.f, 0.f, 0.f, 0.f};
                acc = __builtin_amdgcn_mfma_f32_16x16x32_bf16(a0, b0, acc, 0, 0, 0);
                acc = __builtin_amdgcn_mfma_f32_16x16x32_bf16(a1, b1, acc, 0, 0, 0);
#pragma unroll
                for (int r = 0; r < 4; ++r) sc[(pp * 128 + 16 * w + 4 * q + r) * 129 + nf * 16 + tk] = acc[r];
            }
        }
        __syncthreads();
        {
            const int list = tid & 255, kr = tid >> 8;
            float a[16];
#pragma unroll
            for (int i = 0; i < 16; ++i) a[i] = -3.0e38f;
            const float* row = sc + list * 129 + kr * 64;
            for (int j = 0; j < 64; ++j) {
                const float v = __uint_as_float((__float_as_uint(row[j]) & ~0x7Fu) | (unsigned)(kr * 64 + j));
                ins16(a, v);
            }
            if (kr == 1) {
#pragma unroll
                for (int i = 0; i < 16; ++i) tl[list * 16 + i] = a[i];
            }
            __syncthreads();
            if (kr == 0) {
                float o[16];
#pragma unroll
                for (int i = 0; i < 16; ++i) o[i] = tl[list * 16 + i];
#pragma unroll
                for (int i = 0; i < 16; ++i) ins16(a, o[i]);
#pragma unroll
                for (int i = 0; i < 16; ++i) tl[list * 16 + i] = a[i];
            }
            __syncthreads();
        }
        if (tid < 128) {
            float s[16], r[16], c[16];
#pragma unroll
            for (int i = 0; i < 16; ++i) { s[i] = tl[tid * 16 + i]; r[i] = tl[(128 + tid) * 16 + i]; c[i] = -3.0e38f; }
#pragma unroll
            for (int i = 0; i < 16; ++i)
#pragma unroll
                for (int j = 0; j < 16; ++j)
                    if ((i + 1) * (j + 1) <= 16) {
                        const float v = __uint_as_float((__float_as_uint(s[i] + r[j]) & ~0xFFu) | (unsigned)(i * 16 + j));
                        ins16(c, v);
                    }
            float e[16], sum = 0.f;
#pragma unroll
            for (int k = 0; k < 16; ++k) { e[k] = __expf(c[k] - c[0]); sum += e[k]; }
            const float inv = 1.f / sum;
            int idv[16];
#pragma unroll
            for (int k = 0; k < 16; ++k) {
                const unsigned bits = __float_as_uint(c[k]), i = (bits >> 4) & 15u, j = bits & 15u;
                const unsigned ki = __float_as_uint(tl[tid * 16 + i]) & 0x7Fu, kj = __float_as_uint(tl[(128 + tid) * 16 + j]) & 0x7Fu;
                idv[k] = (int)(ki * 128u + kj);
            }
            int* ido = p.ids + (size_t)(t0 + tid) * 128 + h * 16; float* go = p.gates + (size_t)(t0 + tid) * 128 + h * 16;
#pragma unroll
            for (int k4 = 0; k4 < 4; ++k4) {
                *(int4*)(ido + k4 * 4) = make_int4(idv[k4 * 4], idv[k4 * 4 + 1], idv[k4 * 4 + 2], idv[k4 * 4 + 3]);
                *(f32x4*)(go + k4 * 4) = (f32x4){e[k4 * 4] * inv, e[k4 * 4 + 1] * inv, e[k4 * 4 + 2] * inv, e[k4 * 4 + 3] * inv};
            }
        }
        __syncthreads();
    }
}

struct RowBuf { u32x4 w[4]; float sc; };
template <bool FINAL>
__device__ void gather_phase(const Params& p, int layer, const float* xin, float* xout, bf16_t* xbout, float* ssq_out, const float* gnorm, int c_shift, int c_scale, int c_gate) {
    const int lane = threadIdx.x & 63, wv = threadIdx.x >> 6, li = lane & 15, qg = lane >> 4;
    const int nw = gridDim.x * (NT / 64);
    const unsigned char* utab = p.ub + (size_t)layer * NEXP * D;
    const unsigned char* vtab = p.vb + (size_t)layer * NEXP * D;
    const float* sutab = p.su + (size_t)layer * NEXP;
    const float* svtab = p.sv + (size_t)layer * NEXP;
    for (int t = blockIdx.x * (NT / 64) + wv; t < T; t += nw) {
        const int b = t / SEQ;
        const float* cb = p.cond + (size_t)b * (NCOND * D);
        const float* xr = xin + (size_t)t * D;
        float hf[4][16];
        {
            float ss = 0.f;
#pragma unroll
            for (int c = 0; c < 4; ++c)
#pragma unroll
                for (int j = 0; j < 4; ++j) {
                    const f32x4 v = *(const f32x4*)(xr + c * 256 + li * 16 + j * 4);
#pragma unroll
                    for (int e = 0; e < 4; ++e) { hf[c][j * 4 + e] = v[e]; ss += v[e] * v[e]; }
                }
            ss += __shfl_xor(ss, 1); ss += __shfl_xor(ss, 2); ss += __shfl_xor(ss, 4); ss += __shfl_xor(ss, 8);
            const float rstd = rsqrtf(ss * (1.f / D) + RMS_EPS);
#pragma unroll
            for (int c = 0; c < 4; ++c)
#pragma unroll
                for (int j = 0; j < 4; ++j) {
                    const int e0 = c * 256 + li * 16 + j * 4;
                    const f32x4 g = *(const f32x4*)(gnorm + e0), sc = *(const f32x4*)(cb + c_scale * D + e0), sh = *(const f32x4*)(cb + c_shift * D + e0);
#pragma unroll
                    for (int e = 0; e < 4; ++e) hf[c][j * 4 + e] = hf[c][j * 4 + e] * rstd * g[e] * (1.f + sc[e]) + sh[e];
                }
        }
        const int idA = p.ids[(size_t)t * 128 + lane], idB = p.ids[(size_t)t * 128 + 64 + lane];
        const float gA = p.gates[(size_t)t * 128 + lane], gB = p.gates[(size_t)t * 128 + 64 + lane];
        float actA = 0.f, actB = 0.f;
        RowBuf bufA, bufB;
        auto issue = [&](RowBuf& buf, const unsigned char* tab, const float* stab, int m) {
            const int id = __shfl(m < 16 ? idA : idB, (4 * m + qg) & 63);
            const unsigned char* rp = tab + (size_t)id * D + li * 16;
#pragma unroll
            for (int c = 0; c < 4; ++c) buf.w[c] = *(const u32x4*)(rp + c * 256);
            buf.sc = stab[id];
        };
        auto consume_u = [&](const RowBuf& buf, int m) {
            float d0 = 0.f, d1 = 0.f;
#pragma unroll
            for (int c = 0; c < 4; ++c)
#pragma unroll
                for (int j = 0; j < 4; ++j) {
                    const f32x2 lo = __builtin_amdgcn_cvt_pk_f32_fp8((int)buf.w[c][j], false), hi = __builtin_amdgcn_cvt_pk_f32_fp8((int)buf.w[c][j], true);
                    d0 += lo[0] * hf[c][j * 4]; d1 += lo[1] * hf[c][j * 4 + 1]; d0 += hi[0] * hf[c][j * 4 + 2]; d1 += hi[1] * hf[c][j * 4 + 3];
                }
            float d = d0 + d1;
            d += __shfl_xor(d, 1); d += __shfl_xor(d, 2); d += __shfl_xor(d, 4); d += __shfl_xor(d, 8);
            const float gt = __shfl(m < 16 ? gA : gB, (4 * m + qg) & 63);
            const float a = gelu_tanh(d * buf.sc) * gt;
            if (li == (m & 15)) { if (m < 16) actA = a; else actB = a; }
        };
        issue(bufA, utab, sutab, 0);
#pragma unroll 1
        for (int m = 0; m < 32; m += 2) {
            issue(bufB, utab, sutab, m + 1);
            consume_u(bufA, m);
            if (m + 2 < 32) issue(bufA, utab, sutab, m + 2);
            consume_u(bufB, m + 1);
        }
        float o[4][16];
#pragma unroll
        for (int c = 0; c < 4; ++c)
#pragma unroll
            for (int e = 0; e < 16; ++e) o[c][e] = 0.f;
        auto consume_v = [&](const RowBuf& buf, int m) {
            const float a = __shfl(m < 16 ? actA : actB, (lane & 48) | (m & 15)) * buf.sc;
#pragma unroll
            for (int c = 0; c < 4; ++c)
#pragma unroll
                for (int j = 0; j < 4; ++j) {
                    const f32x2 lo = __builtin_amdgcn_cvt_pk_f32_fp8((int)buf.w[c][j], false), hi = __builtin_amdgcn_cvt_pk_f32_fp8((int)buf.w[c][j], true);
                    o[c][j * 4] += a * lo[0]; o[c][j * 4 + 1] += a * lo[1]; o[c][j * 4 + 2] += a * hi[0]; o[c][j * 4 + 3] += a * hi[1];
                }
        };
        issue(bufA, vtab, svtab, 0);
#pragma unroll 1
        for (int m = 0; m < 32; m += 2) {
            issue(bufB, vtab, svtab, m + 1);
            consume_v(bufA, m);
            if (m + 2 < 32) issue(bufA, vtab, svtab, m + 2);
            consume_v(bufB, m + 1);
        }
#pragma unroll
        for (int c = 0; c < 4; ++c)
#pragma unroll
            for (int e = 0; e < 16; ++e) { o[c][e] += __shfl_xor(o[c][e], 16); o[c][e] += __shfl_xor(o[c][e], 32); }
        float xn[16]; float ss = 0.f;
        const int e0 = qg * 256 + li * 16;
#pragma unroll
        for (int j = 0; j < 4; ++j) {
            const f32x4 xo = *(const f32x4*)(xr + e0 + j * 4), gv = *(const f32x4*)(cb + c_gate * D + e0 + j * 4);
#pragma unroll
            for (int e = 0; e < 4; ++e) {
                const int k = j * 4 + e;
                const float ov = qg == 0 ? o[0][k] : (qg == 1 ? o[1][k] : (qg == 2 ? o[2][k] : o[3][k]));
                const float v = xo[e] + gv[e] * ov;
                xn[k] = v; ss += v * v;
            }
        }
        ss = wave_sum(ss);
        if (!FINAL) {
#pragma unroll
            for (int j = 0; j < 4; ++j) *(f32x4*)(xout + (size_t)t * D + e0 + j * 4) = (f32x4){xn[j * 4], xn[j * 4 + 1], xn[j * 4 + 2], xn[j * 4 + 3]};
#pragma unroll
            for (int j = 0; j < 2; ++j) {
                u32x4 ob; ob[0] = pack2(xn[j * 8], xn[j * 8 + 1]); ob[1] = pack2(xn[j * 8 + 2], xn[j * 8 + 3]); ob[2] = pack2(xn[j * 8 + 4], xn[j * 8 + 5]); ob[3] = pack2(xn[j * 8 + 6], xn[j * 8 + 7]);
                *(u32x4*)(xbout + (size_t)t * D + e0 + j * 8) = ob;
            }
            if (lane < 16) ssq_out[(size_t)t * 16 + lane] = lane == 0 ? ss : 0.f;
        } else {
            const float rstd = rsqrtf(ss * (1.f / D) + RMS_EPS);
#pragma unroll
            for (int j = 0; j < 4; ++j) {
                const f32x4 g = *(const f32x4*)(p.final_norm + e0 + j * 4), sc = *(const f32x4*)(cb + 15 * D + e0 + j * 4), sh = *(const f32x4*)(cb + 14 * D + e0 + j * 4);
                f32x4 ov;
#pragma unroll
                for (int e = 0; e < 4; ++e) ov[e] = xn[j * 4 + e] * rstd * g[e] * (1.f + sc[e]) + sh[e];
                *(f32x4*)(p.out + (size_t)t * D + e0 + j * 4) = ov;
            }
        }
    }
}

struct EpiQKV {
    const float* ssq; const float* bias; const float* ropec; const float* ropes; bf16_t* K; bf16_t* V; bf16_t* Q;
    __device__ __forceinline__ void operator()(const f32x4 (&acc)[4][4], int mbase, int nbase, int b, int, int tk, int q) const {
        const bool rope = (nbase < 256) || (nbase >= 512);
#pragma unroll
        for (int mi = 0; mi < 4; ++mi) {
            const int token = mbase + mi * 16 + tk;
            const float rstd = rstd_of(ssq, token);
            float v[4][4];
#pragma unroll
            for (int ni = 0; ni < 4; ++ni) {
                const f32x4 bv = *(const f32x4*)(bias + (size_t)b * NSC + SC_KV + nbase + ni * 16 + 4 * q);
#pragma unroll
                for (int r = 0; r < 4; ++r) v[ni][r] = rstd * acc[mi][ni][r] + bv[r];
            }
            if (rope) {
#pragma unroll
                for (int ni = 0; ni < 2; ++ni) {
                    const f32x4 cs = *(const f32x4*)(ropec + (size_t)token * 32 + ni * 16 + 4 * q), sn = *(const f32x4*)(ropes + (size_t)token * 32 + ni * 16 + 4 * q);
#pragma unroll
                    for (int r = 0; r < 4; ++r) { const float t1 = v[ni][r], t2 = v[ni + 2][r]; v[ni][r] = t1 * cs[r] - t2 * sn[r]; v[ni + 2][r] = t2 * cs[r] + t1 * sn[r]; }
                }
            }
            bf16_t* dst = nbase < 256 ? K + (size_t)token * 256 + nbase : (nbase < 512 ? V + (size_t)token * 256 + (nbase - 256) : Q + (size_t)token * D + (nbase - 512));
#pragma unroll
            for (int ni = 0; ni < 4; ++ni) { u32x2 o; o[0] = pack2(v[ni][0], v[ni][1]); o[1] = pack2(v[ni][2], v[ni][3]); *(u32x2*)(dst + ni * 16 + 4 * q) = o; }
        }
    }
};

__device__ void attn_phase(const Params& p, const bf16_t* Q, const bf16_t* K, const bf16_t* V, bf16_t* O, unsigned char* smem) {
    unsigned char* Kl = smem;
    unsigned char* Vt = smem + 32768;
    unsigned char* Pl = smem + 32768 + 35840;
    const int tid = threadIdx.x, lane = tid & 63, w = tid >> 6, tk = lane & 15, q = lane >> 4;
    unsigned char* Pw = Pl + w * 5376;
    for (int task = blockIdx.x; task < NB * 32 * 4; task += gridDim.x) {
        const int kvh = task & 3, qblk = (task >> 2) & 31, b = task >> 7;
        const int kpos0 = (qblk - 1) * 128;
#pragma unroll
        for (int i = 0; i < 4; ++i) {
            const int id = tid + NT * i, j = id >> 3, c = id & 7, kp = kpos0 + j;
            u32x4 v = {0u, 0u, 0u, 0u};
            if (kp >= 0) v = *(const u32x4*)(K + ((size_t)b * SEQ + kp) * 256 + kvh * 64 + c * 8);
            *(u32x4*)(Kl + lds_off(j, c)) = v;
        }
#pragma unroll
        for (int i = 0; i < 4; ++i) {
            const int id = tid + NT * i, j = id & 255, dc = id >> 8, kp = kpos0 + j;
            u32x4 v = {0u, 0u, 0u, 0u};
            if (kp >= 0) v = *(const u32x4*)(V + ((size_t)b * SEQ + kp) * 256 + kvh * 64 + dc * 8);
#pragma unroll
            for (int e = 0; e < 4; ++e) {
                *(bf16_t*)(Vt + (dc * 8 + 2 * e) * 560 + j * 2) = (bf16_t)(v[e] & 0xffffu);
                *(bf16_t*)(Vt + (dc * 8 + 2 * e + 1) * 560 + j * 2) = (bf16_t)(v[e] >> 16);
            }
        }
        if (tid < 128) *(u32x4*)(Vt + (tid >> 1) * 560 + 512 + (tid & 1) * 16) = (u32x4){0u, 0u, 0u, 0u};
        *(u32x2*)(Pw + tk * 336 + (144 + 4 * q) * 2) = (u32x2){0u, 0u};
        __syncthreads();
        const int qt = w, i_q = qt * 16 + tk;
        const size_t trow = (size_t)b * SEQ + qblk * 128 + i_q;
#pragma unroll 1
        for (int hq = 0; hq < 4; ++hq) {
            const int head = kvh * 4 + hq;
            const bf16x8 qf0 = *(const bf16x8*)(Q + trow * D + head * 64 + 8 * q), qf1 = *(const bf16x8*)(Q + trow * D + head * 64 + 32 + 8 * q);
            f32x4 sacc[9];
#pragma unroll
            for (int kk = 0; kk < 9; ++kk) {
                const int krow = (qt + kk) * 16 + tk;
                const bf16x8 k0 = *(const bf16x8*)(Kl + lds_off(krow, q)), k1 = *(const bf16x8*)(Kl + lds_off(krow, 4 + q));
                f32x4 a = {0.f, 0.f, 0.f, 0.f};
                a = __builtin_amdgcn_mfma_f32_16x16x32_bf16(k0, qf0, a, 0, 0, 0);
                a = __builtin_amdgcn_mfma_f32_16x16x32_bf16(k1, qf1, a, 0, 0, 0);
                sacc[kk] = a;
            }
            const float sink = p.sinks[head];
            float mx = -1e30f;
#pragma unroll
            for (int kk = 0; kk < 9; ++kk)
#pragma unroll
                for (int r = 0; r < 4; ++r) {
                    const int j = (qt + kk) * 16 + 4 * q + r;
                    const bool valid = (j > i_q) && (j <= i_q + 128) && (qblk > 0 || j >= 128);
                    const float s = valid ? sacc[kk][r] * 0.125f : -1e30f;
                    sacc[kk][r] = s; mx = fmaxf(mx, s);
                }
            mx = fmaxf(mx, __shfl_xor(mx, 16)); mx = fmaxf(mx, __shfl_xor(mx, 32));
            mx = fmaxf(mx, sink);
            float sum = 0.f;
#pragma unroll
            for (int kk = 0; kk < 9; ++kk)
#pragma unroll
                for (int r = 0; r < 4; ++r) { const float e = __expf(sacc[kk][r] - mx); sacc[kk][r] = e; sum += e; }
            sum += __shfl_xor(sum, 16); sum += __shfl_xor(sum, 32);
            const float inv = 1.f / (sum + __expf(sink - mx));
#pragma unroll
            for (int kk = 0; kk < 9; ++kk) {
                u32x2 o; o[0] = pack2(sacc[kk][0] * inv, sacc[kk][1] * inv); o[1] = pack2(sacc[kk][2] * inv, sacc[kk][3] * inv);
                *(u32x2*)(Pw + tk * 336 + (kk * 16 + 4 * q) * 2) = o;
            }
            asm volatile("s_waitcnt lgkmcnt(0)" ::: "memory");
            bf16x8 pf[5];
#pragma unroll
            for (int ks = 0; ks < 5; ++ks) pf[ks] = *(const bf16x8*)(Pw + tk * 336 + (ks * 32 + 8 * q) * 2);
#pragma unroll
            for (int dt = 0; dt < 4; ++dt) {
                f32x4 oa = {0.f, 0.f, 0.f, 0.f};
#pragma unroll
                for (int ks = 0; ks < 5; ++ks) {
                    const bf16x8 vf = *(const bf16x8*)(Vt + (dt * 16 + tk) * 560 + (qt * 16 + ks * 32 + 8 * q) * 2);
                    oa = __builtin_amdgcn_mfma_f32_16x16x32_bf16(vf, pf[ks], oa, 0, 0, 0);
                }
                u32x2 o; o[0] = pack2(oa[0], oa[1]); o[1] = pack2(oa[2], oa[3]);
                *(u32x2*)(O + trow * D + head * 64 + dt * 16 + 4 * q) = o;
            }
            asm volatile("s_waitcnt lgkmcnt(0)" ::: "memory");
        }
        __syncthreads();
    }
}

__device__ void final_only(const Params& p, const float* xin) {
    const int lane = threadIdx.x & 63, wv = threadIdx.x >> 6;
    const int nw = gridDim.x * (NT / 64);
    for (int t = blockIdx.x * (NT / 64) + wv; t < T; t += nw) {
        const int b = t / SEQ;
        const float* xr = xin + (size_t)t * D;
        f32x4 v[4]; float s = 0.f;
#pragma unroll
        for (int j = 0; j < 4; ++j) { v[j] = *(const f32x4*)(xr + j * 256 + lane * 4); s += v[j][0] * v[j][0] + v[j][1] * v[j][1] + v[j][2] * v[j][2] + v[j][3] * v[j][3]; }
        s = wave_sum(s);
        const float rstd = rsqrtf(s * (1.f / D) + RMS_EPS);
#pragma unroll
        for (int j = 0; j < 4; ++j) {
            const int e = j * 256 + lane * 4;
            const f32x4 g = *(const f32x4*)(p.final_norm + e);
            const f32x4 sh = *(const f32x4*)(p.cond + (size_t)b * (NCOND * D) + 14 * D + e);
            const f32x4 sc = *(const f32x4*)(p.cond + (size_t)b * (NCOND * D) + 15 * D + e);
            f32x4 o;
#pragma unroll
            for (int i = 0; i < 4; ++i) o[i] = v[j][i] * rstd * g[i] * (1.f + sc[i]) + sh[i];
            *(f32x4*)(p.out + (size_t)t * D + e) = o;
        }
    }
}

constexpr int SMEM_BYTES = 152 * 1024;
__global__ void __launch_bounds__(NT) yoco_fwd(Params p) {
    __shared__ __attribute__((aligned(16))) unsigned char smem[SMEM_BYTES];
    cg::grid_group grid = cg::this_grid();
    p0_cond(p, smem);
    p0_xconv(p);
    p0_wt(p, smem);
    p0_s5(p, smem);
    p0_tables(p);
    grid.sync();
    p05_weights(p, smem);
    grid.sync();
    { EpiU e{p.ssq0, p.bias, p.s1}; gemm_phase(p.s0, p.wts + (size_t)SC_IN * D, (size_t)NSC * D, 1024, e, smem); }
    grid.sync();
    s5_phase(p, smem);
    grid.sync();
    { EpiGlu e{p.s0, p.b_glu, p.s1}; gemm_phase(p.s0, p.wt_glu, 0, 1024, e, smem); }
    grid.sync();
    { EpiRes e{p.x, p.cond + 2 * D, p.f0, p.s2, p.ssq1}; gemm_phase(p.s1, p.wt_out, 0, 1024, e, smem); }
    grid.sync();
    { EpiQ e{p.ssq1, p.bias, SC_PQ0, p.s1}; gemm_phase(p.s2, p.wts + (size_t)SC_PQ0 * D, (size_t)NSC * D, 1024, e, smem); }
    grid.sync();
    route_phase(p, 0, p.s1, smem);
    grid.sync();
    gather_phase<false>(p, 0, p.f0, p.f1, p.s0, p.ssq2, p.norm_ffn, 3, 4, 5);
    grid.sync();
    { EpiQKV e{p.ssq2, p.bias, p.ropec, p.ropes, p.s2, p.s2 + (size_t)T * 256, p.s1}; gemm_phase(p.s0, p.wts + (size_t)SC_KV * D, (size_t)NSC * D, 1536, e, smem); }
    grid.sync();
    attn_phase(p, p.s1, p.s2, p.s2 + (size_t)T * 256, p.s0, smem);
    grid.sync();
    { EpiRes e{p.f1, p.cond + 8 * D, p.f0, p.s2, p.ssq3}; gemm_phase(p.s0, p.wt_o, 0, 1024, e, smem); }
    grid.sync();
    { EpiQ e{p.ssq3, p.bias, SC_PQ1, p.s1}; gemm_phase(p.s2, p.wts + (size_t)SC_PQ1 * D, (size_t)NSC * D, 1024, e, smem); }
    grid.sync();
    route_phase(p, 1, p.s1, smem);
    grid.sync();
    gather_phase<true>(p, 1, p.f0, nullptr, nullptr, nullptr, p.norm_ffn + D, 9, 10, 11);
}

static inline size_t align_up(size_t v, size_t a) { return (v + a - 1) / a * a; }

extern "C" void kernel_launch(void* const* d_in, const int* in_sizes, int n_in, void* d_out, int out_size, void* d_ws, size_t ws_size, hipStream_t stream) {
    (void)in_sizes; (void)n_in; (void)out_size;
    Params p{};
    p.x = (const float*)d_in[0]; p.c = (const float*)d_in[1]; p.pos = (const int*)d_in[2]; p.w_cond = (const float*)d_in[3]; p.b_cond = (const float*)d_in[4];
    p.norm_mix = (const float*)d_in[5]; p.norm_ffn = (const float*)d_in[6]; p.w_in = (const float*)d_in[7]; p.a_re = (const float*)d_in[8]; p.a_im = (const float*)d_in[9];
    p.log_dt = (const float*)d_in[10]; p.b_re = (const float*)d_in[11]; p.b_im = (const float*)d_in[12]; p.c_re = (const float*)d_in[13]; p.c_im = (const float*)d_in[14];
    p.s5d = (const float*)d_in[15]; p.w_glu = (const float*)d_in[16]; p.b_glu = (const float*)d_in[17]; p.w_out = (const float*)d_in[18]; p.kv_norm = (const float*)d_in[19];
    p.w_kv = (const float*)d_in[20]; p.w_q = (const float*)d_in[21]; p.sinks = (const float*)d_in[22]; p.w_o = (const float*)d_in[23]; p.peer_wq = (const float*)d_in[24];
    p.subkeys = (const float*)d_in[25]; p.peer_u = (const float*)d_in[26]; p.peer_v = (const float*)d_in[27]; p.final_norm = (const float*)d_in[28];
    p.out = (float*)d_out;
    unsigned char* w = (unsigned char*)d_ws; size_t off = 65536;
    auto take = [&](size_t bytes) { void* r = w + off; off = align_up(off + bytes, 4096); return r; };
    p.cond = (float*)take((size_t)NB * NCOND * D * 4);
    p.ropec = (float*)take((size_t)T * 32 * 4); p.ropes = (float*)take((size_t)T * 32 * 4);
    p.ssq0 = (float*)take((size_t)T * 16 * 4); p.ssq1 = (float*)take((size_t)T * 16 * 4); p.ssq2 = (float*)take((size_t)T * 16 * 4); p.ssq3 = (float*)take((size_t)T * 16 * 4);
    p.wt_glu = (bf16_t*)take((size_t)D * D * 2); p.wt_out = (bf16_t*)take((size_t)D * D * 2); p.wt_o = (bf16_t*)take((size_t)D * D * 2);
    p.wts = (bf16_t*)take((size_t)NB * NSC * D * 2); p.bias = (float*)take((size_t)NB * NSC * 4);
    p.skeys = (bf16_t*)take((size_t)2 * 8 * 2 * 128 * 64 * 2);
    p.lamL = (float*)take((size_t)G5 * P5 * 2 * 4); p.ktab = (bf16_t*)take((size_t)G5 * 65 * 256 * 2);
    p.smat = (bf16_t*)take((size_t)G5 * 128 * 1024 * 2); p.cmat = (bf16_t*)take((size_t)G5 * 1024 * 128 * 2);
    p.ub = (unsigned char*)take((size_t)2 * NEXP * D); p.vb = (unsigned char*)take((size_t)2 * NEXP * D);
    p.su = (float*)take((size_t)2 * NEXP * 4); p.sv = (float*)take((size_t)2 * NEXP * 4);
    p.s0 = (bf16_t*)take((size_t)T * D * 2); p.s1 = (bf16_t*)take((size_t)T * D * 2); p.s2 = (bf16_t*)take((size_t)T * D * 2);
    p.f0 = (float*)take((size_t)T * D * 4); p.f1 = (float*)take((size_t)T * D * 4);
    p.ids = (int*)take((size_t)T * 128 * 4); p.gates = (float*)take((size_t)T * 128 * 4);
    if (off > ws_size) { fprintf(stderr, "workspace too small: need %zu have %zu\n", off, ws_size); return; }

    static int grid_blocks = 0;
    if (!grid_blocks) {
        int dev = 0, cus = 0, per_cu = 0;
        (void)hipGetDevice(&dev);
        (void)hipDeviceGetAttribute(&cus, hipDeviceAttributeMultiprocessorCount, dev);
        (void)hipOccupancyMaxActiveBlocksPerMultiprocessor(&per_cu, yoco_fwd, NT, 0);
        if (per_cu > 1) per_cu = 1;
        grid_blocks = cus * per_cu;
        if (grid_blocks <= 0) grid_blocks = 256;
    }
    void* args[] = {&p};
    hipError_t e = hipLaunchCooperativeKernel((const void*)yoco_fwd, dim3(grid_blocks), dim3(NT), args, 0, stream);
    if (e != hipSuccess) fprintf(stderr, "cooperative launch failed: %s (grid %d)\n", hipGetErrorString(e), grid_blocks);
}
```

```cpp
#include <hip/hip_runtime.h>
#include <hip/hip_cooperative_groups.h>
#include <cstdio>
#include <cstdint>
namespace cg = cooperative_groups;

#define NT 512
#define LAS __attribute__((address_space(3)))
typedef unsigned short bf16_t;
typedef short bf16x8 __attribute__((ext_vector_type(8)));
typedef float f32x4 __attribute__((ext_vector_type(4)));
typedef unsigned u32x4 __attribute__((ext_vector_type(4)));
typedef unsigned u32x2 __attribute__((ext_vector_type(2)));

constexpr int D = 1024, NB = 4, SEQ = 4096, T = NB * SEQ;
constexpr int NCOND = 16;
constexpr int G5 = 64, P5 = 64, C5 = 16, L5 = 64, NCH = SEQ / L5;
constexpr int NEXP = 16384;
constexpr int NSC = 4608;
constexpr int SC_IN = 0, SC_PQ0 = 1024, SC_KV = 2048, SC_Q = 2560, SC_PQ1 = 3584;
constexpr float RMS_EPS = 1e-6f;

struct Params {
    const float *x, *c; const int* pos; const float *w_cond, *b_cond, *norm_mix, *norm_ffn, *w_in, *a_re, *a_im, *log_dt, *b_re, *b_im, *c_re, *c_im, *s5d,
        *w_glu, *b_glu, *w_out, *kv_norm, *w_kv, *w_q, *sinks, *w_o, *peer_wq, *subkeys, *peer_u, *peer_v, *final_norm;
    float* out;
    unsigned* bar;
    float* cond;
    float* ropec;
    float* ropes;
    float* ssq0;
    float* ssq1;
    float* ssq2;
    float* ssq3;
    bf16_t* wt_glu;
    bf16_t* wt_out;
    bf16_t* wt_o;
    bf16_t* wts;
    float* bias;
    bf16_t* skeys;
    float* lamL;
    bf16_t* ktab;
    bf16_t* smat;
    bf16_t* cmat;
    unsigned char* ub;
    unsigned char* vb;
    float* su;
    float* sv;
    bf16_t* s0;
    bf16_t* s1;
    bf16_t* s2;
    float* f0;
    float* f1;
    int* ids;
    float* gates;
};

#define XB_TMO      128
#define XB_XCNT(j)  (256  + 64 * (j))
#define XB_XSUB(j)  (1280 + 64 * (j))
#define XB_XGEN(j)  (2304 + 64 * (j))
#define XB_TOP      3328
#define XB_TOPGEN   3392
#define XCD_BAR_WORDS 3456
#define XB_SPIN_CAP (1u << 22)
__device__ __forceinline__ unsigned xb_ld(unsigned* p)              { return __hip_atomic_load(p, __ATOMIC_RELAXED, __HIP_MEMORY_SCOPE_AGENT); }
__device__ __forceinline__ unsigned xb_add(unsigned* p, unsigned v) { return __hip_atomic_fetch_add(p, v, __ATOMIC_RELAXED, __HIP_MEMORY_SCOPE_AGENT); }
__device__ __forceinline__ unsigned xb_xcc_id() { return (unsigned)__builtin_amdgcn_s_getreg((3 << 11) | 20) & 0xFu; }
#define XB_SPIN(cond, bar) do { unsigned _sp = 0; while (cond) { __builtin_amdgcn_s_sleep(1); \
    if ((++_sp & 255u) == 0u) { if (xb_ld(&(bar)[XB_TMO])) break; if (_sp > XB_SPIN_CAP) { atomicAdd(&(bar)[XB_TMO], 1u); break; } } } } while (0)
struct XcdBarrier { unsigned* bar; unsigned x; volatile LAS unsigned* st; };
__device__ __forceinline__ XcdBarrier xcd_barrier_post(unsigned* bar, volatile LAS unsigned* st) {
    XcdBarrier b; b.bar = bar; b.x = xb_xcc_id(); b.st = st;
    if (threadIdx.x == 0) (void)xb_add(&bar[XB_XCNT(b.x)], 1u);
    return b;
}
__device__ __forceinline__ void xcd_barrier_complete(unsigned* bar, unsigned x, unsigned& nloc, unsigned& nx) {
    const unsigned G = gridDim.x * gridDim.y * gridDim.z;
    unsigned sum, cnt, mine, sp = 0u;
    for (;;) {
        sum = 0u; cnt = 0u; mine = 0u;
#pragma unroll
        for (unsigned j = 0; j < 16; ++j) { const unsigned c = xb_ld(&bar[XB_XCNT(j)]); sum += c; cnt += (c > 0u) ? 1u : 0u; mine = (j == x) ? c : mine; }
        if (sum == G) break;
        __builtin_amdgcn_s_sleep(1);
        if ((++sp & 255u) == 0u) { if (xb_ld(&bar[XB_TMO])) break; if (sp > XB_SPIN_CAP) { atomicAdd(&bar[XB_TMO], 1u); break; } }
    }
    nloc = mine > 0u ? mine : 1u; nx = cnt > 0u ? cnt : 1u;
}
__device__ __forceinline__ void xcd_barrier(const XcdBarrier& b) {
    asm volatile("s_waitcnt vmcnt(0)" ::: "memory");
    __syncthreads();
    if (threadIdx.x == 0) {
        unsigned* bar = b.bar;
        __builtin_amdgcn_s_waitcnt(0);
        unsigned nloc = b.st[0], nx = b.st[1];
        if (nloc == 0u) { xcd_barrier_complete(bar, b.x, nloc, nx); b.st[0] = nloc; b.st[1] = nx; }
        const unsigned old = xb_add(&bar[XB_XSUB(b.x)], 1u);
        const unsigned gen = old / nloc;
        if (old + 1u == (gen + 1u) * nloc) {
            __builtin_amdgcn_fence(__ATOMIC_RELEASE, "agent");
            asm volatile("s_waitcnt vmcnt(0)" ::: "memory");
            const unsigned og = xb_add(&bar[XB_TOP], 1u);
            const unsigned tg = og / nx;
            if (og + 1u == (tg + 1u) * nx) xb_add(&bar[XB_TOPGEN], 1u);
            else XB_SPIN(xb_ld(&bar[XB_TOPGEN]) == tg, bar);
            __builtin_amdgcn_fence(__ATOMIC_ACQUIRE, "agent");
            xb_add(&bar[XB_XGEN(b.x)], 1u);
            asm volatile("s_waitcnt vmcnt(0)" ::: "memory");
        } else {
            XB_SPIN(xb_ld(&bar[XB_XGEN(b.x)]) == gen, bar);
            __builtin_amdgcn_fence(__ATOMIC_ACQUIRE, "agent");
            asm volatile("s_waitcnt vmcnt(0)" ::: "memory");
        }
    }
    __syncthreads();
}

__device__ __forceinline__ bf16_t f2bf(float f) { unsigned u = __float_as_uint(f); u += 0x7fffu + ((u >> 16) & 1u); return (bf16_t)(u >> 16); }
__device__ __forceinline__ float bf2f(bf16_t h) { return __uint_as_float(((unsigned)h) << 16); }
typedef __bf16 hbf2 __attribute__((ext_vector_type(2)));
typedef float f32x2 __attribute__((ext_vector_type(2)));
__device__ __forceinline__ unsigned pack2(float lo, float hi) { f32x2 v = {lo, hi}; return __builtin_bit_cast(unsigned, __builtin_convertvector(v, hbf2)); }
__device__ __forceinline__ float dot2bf(unsigned a, unsigned b, float c) { return __builtin_amdgcn_fdot2_f32_bf16(__builtin_bit_cast(hbf2, a), __builtin_bit_cast(hbf2, b), c, false); }
__device__ __forceinline__ float bflo(unsigned w) { return __uint_as_float(w << 16); }
__device__ __forceinline__ float bfhi(unsigned w) { return __uint_as_float(w & 0xffff0000u); }
__device__ __forceinline__ float wave_sum(float v) {
#pragma unroll
    for (int o = 32; o >= 1; o >>= 1) v += __shfl_xor(v, o);
    return v;
}
__device__ __forceinline__ float gelu_tanh(float x) {
    const float u = 0.7978845608028654f * (x + 0.044715f * x * x * x);
    const float e = __expf(-2.f * fabsf(u));
    float th = (1.f - e) / (1.f + e);
    th = u < 0.f ? -th : th;
    return 0.5f * x * (1.f + th);
}

__device__ void p0_cond(const Params& p, unsigned char* smem) {
    float* sc = (float*)smem;
    float* red = (float*)(smem + 16384);
    const int tid = threadIdx.x;
    for (int i = tid; i < 4 * D; i += NT) { const float v = p.c[i]; sc[i] = v / (1.f + __expf(-v)); }
    __syncthreads();
    const int cgp = tid & 15, kg = tid >> 4;
    for (int task = blockIdx.x; task < NCOND * D / 64; task += gridDim.x) {
        const int col0 = task * 64 + cgp * 4;
        float acc[4][4];
#pragma unroll
        for (int b = 0; b < 4; ++b)
#pragma unroll
            for (int j = 0; j < 4; ++j) acc[b][j] = 0.f;
        for (int k = kg; k < D; k += 32) {
            const f32x4 w = *(const f32x4*)(p.w_cond + (size_t)k * (NCOND * D) + col0);
#pragma unroll
            for (int b = 0; b < 4; ++b) { const float s = sc[b * D + k];
#pragma unroll
                for (int j = 0; j < 4; ++j) acc[b][j] += s * w[j]; }
        }
#pragma unroll
        for (int b = 0; b < 4; ++b)
#pragma unroll
            for (int j = 0; j < 4; ++j) red[(kg * 64 + cgp * 4 + j) * 4 + b] = acc[b][j];
        __syncthreads();
        if (tid < 256) {
            const int col = tid >> 2, b = tid & 3;
            float s = 0.f;
            for (int g = 0; g < 32; ++g) s += red[(g * 64 + col) * 4 + b];
            p.cond[(size_t)b * (NCOND * D) + task * 64 + col] = s + p.b_cond[task * 64 + col];
        }
        __syncthreads();
    }
}

__device__ void p0_xconv(const Params& p) {
    const int lane = threadIdx.x & 63, wv = threadIdx.x >> 6;
    const int nw = gridDim.x * (NT / 64);
    for (int t = blockIdx.x * (NT / 64) + wv; t < T; t += nw) {
        const float* xr = p.x + (size_t)t * D;
        float s = 0.f;
#pragma unroll
        for (int j = 0; j < 4; ++j) {
            const f32x4 v = *(const f32x4*)(xr + j * 256 + lane * 4);
            s += v[0] * v[0] + v[1] * v[1] + v[2] * v[2] + v[3] * v[3];
            u32x2 o; o[0] = pack2(v[0], v[1]); o[1] = pack2(v[2], v[3]);
            *(u32x2*)(p.s0 + (size_t)t * D + j * 256 + lane * 4) = o;
        }
        s = wave_sum(s);
        if (lane < 16) p.ssq0[(size_t)t * 16 + lane] = lane == 0 ? s : 0.f;
    }
}

__device__ void p0_tables(const Params& p) {
    const size_t gtid = (size_t)blockIdx.x * NT + threadIdx.x, gstride = (size_t)gridDim.x * NT;
    {
        const int li = threadIdx.x & 15;
        const size_t grp = gtid >> 4, ngrp = gstride >> 4;
        for (int which = 0; which < 2; ++which) {
            const float* src = which ? p.peer_v : p.peer_u; unsigned char* dst = which ? p.vb : p.ub; float* sdst = which ? p.sv : p.su;
            for (size_t row = grp; row < (size_t)2 * NEXP; row += ngrp) {
                f32x4 v[4][4]; float mx = 0.f;
#pragma unroll
                for (int c = 0; c < 4; ++c)
#pragma unroll
                    for (int j = 0; j < 4; ++j) {
                        v[c][j] = *(const f32x4*)(src + row * D + c * 256 + li * 16 + j * 4);
#pragma unroll
                        for (int e = 0; e < 4; ++e) mx = fmaxf(mx, fabsf(v[c][j][e]));
                    }
                mx = fmaxf(mx, __shfl_xor(mx, 1)); mx = fmaxf(mx, __shfl_xor(mx, 2)); mx = fmaxf(mx, __shfl_xor(mx, 4)); mx = fmaxf(mx, __shfl_xor(mx, 8));
                const float sc = mx > 0.f ? mx * (1.f / 448.f) : 1.f, inv = 1.f / sc;
#pragma unroll
                for (int c = 0; c < 4; ++c) {
                    u32x4 o;
#pragma unroll
                    for (int j = 0; j < 4; ++j) {
                        int r = 0;
                        r = __builtin_amdgcn_cvt_pk_fp8_f32(v[c][j][0] * inv, v[c][j][1] * inv, r, false);
                        r = __builtin_amdgcn_cvt_pk_fp8_f32(v[c][j][2] * inv, v[c][j][3] * inv, r, true);
                        o[j] = (unsigned)r;
                    }
                    *(u32x4*)(dst + row * D + c * 256 + li * 16) = o;
                }
                if (li == 0) sdst[row] = sc;
            }
        }
    }
    const size_t nk8 = (size_t)2 * 8 * 2 * 128 * 64 / 8;
    for (size_t i = gtid; i < nk8; i += gstride) {
        const f32x4 a = *(const f32x4*)(p.subkeys + i * 8), b = *(const f32x4*)(p.subkeys + i * 8 + 4);
        u32x4 o; o[0] = pack2(a[0], a[1]); o[1] = pack2(a[2], a[3]); o[2] = pack2(b[0], b[1]); o[3] = pack2(b[2], b[3]);
        *(u32x4*)(p.skeys + i * 8) = o;
    }
    for (size_t i = gtid; i < (size_t)T * 32; i += gstride) {
        const int t = (int)(i >> 5), f = (int)(i & 31);
        const double inv = exp(-(double)(2 * f) / 64.0 * 9.210340371976184);
        double ang = (double)p.pos[t] * inv;
        ang -= 6.283185307179586 * floor(ang * 0.15915494309189535);
        p.ropec[i] = (float)cos(ang); p.ropes[i] = (float)sin(ang);
    }
}

__device__ void transpose_tile(const float* W, int ldw, int n0, int k0, const float* sk, bf16_t* Wt, unsigned char* smem) {
    bf16_t* tl = (bf16_t*)smem;
    const int tid = threadIdx.x, kk = tid >> 3, nn = (tid & 7) * 8;
    const f32x4 a = *(const f32x4*)(W + (size_t)(k0 + kk) * ldw + n0 + nn), b = *(const f32x4*)(W + (size_t)(k0 + kk) * ldw + n0 + nn + 4);
    const float s = sk ? sk[k0 + kk] : 1.f;
#pragma unroll
    for (int j = 0; j < 4; ++j) { tl[(nn + j) * 72 + kk] = f2bf(a[j] * s); tl[(nn + 4 + j) * 72 + kk] = f2bf(b[j] * s); }
    __syncthreads();
    const int n = tid >> 3, kc = (tid & 7) * 8;
    const u32x4 v = *(const u32x4*)(tl + n * 72 + kc);
    *(u32x4*)(Wt + (size_t)(n0 + n) * D + k0 + kc) = v;
    __syncthreads();
}

__device__ void p0_wt(const Params& p, unsigned char* smem) {
    for (int task = blockIdx.x; task < 3 * 256; task += gridDim.x) {
        const int w = task >> 8, tl = task & 255, n0 = (tl & 15) * 64, k0 = (tl >> 4) * 64;
        const float* W = w == 0 ? p.w_glu : (w == 1 ? p.w_out : p.w_o);
        bf16_t* Wt = w == 0 ? p.wt_glu : (w == 1 ? p.wt_out : p.wt_o);
        transpose_tile(W, D, n0, k0, nullptr, Wt, smem);
    }
}

struct cplx { double re, im; };
__device__ __forceinline__ cplx lam_pow(double ar, double ai, double dt, int n) {
    const double m = exp(ar * dt * n); double ang = ai * dt * n;
    ang -= 6.283185307179586 * floor(ang * 0.15915494309189535);
    cplx r; r.re = m * cos(ang); r.im = m * sin(ang); return r;
}
__device__ __forceinline__ cplx s5_coef(double ar, double ai, double dt) {
    const cplx lb = lam_pow(ar, ai, dt, 1);
    const double nr = lb.re - 1.0, ni = lb.im, den = ar * ar + ai * ai;
    cplx c; c.re = (nr * ar + ni * ai) / den; c.im = (ni * ar - nr * ai) / den; return c;
}

__device__ void p0_s5(const Params& p, unsigned char* smem) {
    const size_t gtid = (size_t)blockIdx.x * NT + threadIdx.x, gstride = (size_t)gridDim.x * NT;
    for (size_t idx = gtid; idx < (size_t)G5 * P5 * 65; idx += gstride) {
        const int e = (int)(idx % 65), pp = (int)((idx / 65) % P5), g = (int)(idx / (65 * P5));
        const double dt = exp((double)p.log_dt[g]), ar = p.a_re[g * P5 + pp], ai = p.a_im[g * P5 + pp];
        const cplx pw = lam_pow(ar, ai, dt, e);
        if (e < 64) {
            const cplx cf = s5_coef(ar, ai, dt);
            const int j = 63 - e;
            bf16_t* sre = p.smat + ((size_t)g * 128 + pp) * 1024 + j * 16;
            bf16_t* sim = p.smat + ((size_t)g * 128 + 64 + pp) * 1024 + j * 16;
            for (int ci = 0; ci < 16; ++ci) {
                const double br = p.b_re[((size_t)g * P5 + pp) * C5 + ci], bi = p.b_im[((size_t)g * P5 + pp) * C5 + ci];
                const double bbr = cf.re * br - cf.im * bi, bbi = cf.re * bi + cf.im * br;
                sre[ci] = f2bf((float)(pw.re * bbr - pw.im * bbi));
                sim[ci] = f2bf((float)(pw.re * bbi + pw.im * bbr));
            }
        }
        if (e >= 1) {
            const int i = e - 1;
            for (int co = 0; co < 16; ++co) {
                const double cr = p.c_re[((size_t)g * C5 + co) * P5 + pp], ci = p.c_im[((size_t)g * C5 + co) * P5 + pp];
                bf16_t* row = p.cmat + ((size_t)g * 1024 + i * 16 + co) * 128;
                row[pp] = f2bf((float)(cr * pw.re - ci * pw.im));
                row[64 + pp] = f2bf((float)(-(cr * pw.im + ci * pw.re)));
            }
        }
        if (e == 64) { p.lamL[(g * P5 + pp) * 2] = (float)pw.re; p.lamL[(g * P5 + pp) * 2 + 1] = (float)pw.im; }
    }
    float* wre = (float*)smem; float* wim = wre + 64;
    const int tid = threadIdx.x;
    for (int task = blockIdx.x; task < G5 * 64; task += gridDim.x) {
        const int g = task >> 6, tau = task & 63;
        if (tid < 64) {
            const double dt = exp((double)p.log_dt[g]), ar = p.a_re[g * P5 + tid], ai = p.a_im[g * P5 + tid];
            const cplx pw = lam_pow(ar, ai, dt, tau), cf = s5_coef(ar, ai, dt);
            wre[tid] = (float)(pw.re * cf.re - pw.im * cf.im); wim[tid] = (float)(pw.re * cf.im + pw.im * cf.re);
        }
        __syncthreads();
        if (tid < 256) {
            const int co = tid >> 4, ci = tid & 15;
            float s = 0.f;
            for (int pp = 0; pp < 64; ++pp) {
                const float br = p.b_re[((size_t)g * P5 + pp) * C5 + ci], bi = p.b_im[((size_t)g * P5 + pp) * C5 + ci];
                const float zr = wre[pp] * br - wim[pp] * bi, zi = wre[pp] * bi + wim[pp] * br;
                const float cr = p.c_re[((size_t)g * C5 + co) * P5 + pp], cim = p.c_im[((size_t)g * C5 + co) * P5 + pp];
                s += cr * zr - cim * zi;
            }
            p.ktab[((size_t)g * 65 + tau + 1) * 256 + tid] = f2bf(s);
            if (tau == 0) p.ktab[((size_t)g * 65) * 256 + tid] = 0;
        }
        __syncthreads();
    }
}

struct ScSpec { const float* W; int ldw; int n; int col0; const float* g; int c_shift; int c_scale; };
__device__ __forceinline__ ScSpec sc_spec(const Params& p, int s) {
    ScSpec r;
    switch (s) {
        case 0: r = {p.w_in, 1024, 1024, SC_IN, p.norm_mix, 0, 1}; break;
        case 1: r = {p.peer_wq, 1024, 1024, SC_PQ0, p.norm_ffn, 3, 4}; break;
        case 2: r = {p.w_kv, 512, 512, SC_KV, p.kv_norm, 12, 13}; break;
        case 3: r = {p.w_q, 1024, 1024, SC_Q, p.norm_mix + D, 6, 7}; break;
        default: r = {p.peer_wq + (size_t)D * D, 1024, 1024, SC_PQ1, p.norm_ffn + D, 9, 10}; break;
    }
    return r;
}
__device__ void p05_weights(const Params& p, unsigned char* smem) {
    float* gsb = (float*)(smem + 16384);
    const int tid = threadIdx.x;
    int base = 0;
    for (int s = 0; s < 5; ++s) {
        const ScSpec sp = sc_spec(p, s);
        const int ntn = sp.n / 64, ntask = ntn * 16 * 4;
        for (int task = blockIdx.x; task < ntask; task += gridDim.x) {
            const int b = task & 3, tl = task >> 2, n0 = (tl % ntn) * 64, k0 = (tl / ntn) * 64;
            if (tid < 64) gsb[tid] = sp.g[k0 + tid] * (1.f + p.cond[(size_t)b * (NCOND * D) + sp.c_scale * D + k0 + tid]);
            __syncthreads();
            transpose_tile(sp.W, sp.ldw, n0, k0, gsb - k0, p.wts + ((size_t)b * NSC + sp.col0) * D, smem);
        }
        base += ntask;
    }
    float* red = (float*)smem;
    for (int task = blockIdx.x; task < NSC / 64; task += gridDim.x) {
        const int col0 = task * 64;
        int s = col0 < SC_PQ0 ? 0 : (col0 < SC_KV ? 1 : (col0 < SC_Q ? 2 : (col0 < SC_PQ1 ? 3 : 4)));
        const ScSpec sp = sc_spec(p, s);
        const int n = col0 - sp.col0 + (tid & 63), kg = tid >> 6;
        float acc[4] = {0.f, 0.f, 0.f, 0.f};
        for (int k = kg; k < D; k += 8) {
            const float w = sp.W[(size_t)k * sp.ldw + n];
#pragma unroll
            for (int b = 0; b < 4; ++b) acc[b] += p.cond[(size_t)b * (NCOND * D) + sp.c_shift * D + k] * w;
        }
#pragma unroll
        for (int b = 0; b < 4; ++b) red[(kg * 64 + (tid & 63)) * 4 + b] = acc[b];
        __syncthreads();
        if (tid < 256) {
            const int col = tid >> 2, b = tid & 3; float sum = 0.f;
            for (int g = 0; g < 8; ++g) sum += red[(g * 64 + col) * 4 + b];
            p.bias[(size_t)b * NSC + col0 + col] = sum;
        }
        __syncthreads();
    }
}

__device__ __forceinline__ int lds_off(int row, int chunk) { return row * 128 + ((chunk ^ (row & 7)) << 4); }

template <class Epi>
__device__ void gemm_phase(const bf16_t* __restrict__ A, const bf16_t* __restrict__ Bt, size_t bt_batch_stride, int N, const Epi& epi, unsigned char* smem) {
    const int tid = threadIdx.x, lane = tid & 63, w = tid >> 6, wm = w >> 1, wn = w & 1, tk = lane & 15, q = lane >> 4;
    const int nN = N / 128;
    const bool xmap = (gridDim.x % 8) == 0;
    const int nslots = xmap ? gridDim.x / 8 : gridDim.x, slot = xmap ? (blockIdx.x >> 3) : blockIdx.x, xcd = blockIdx.x & 7;
    const int nitems = xmap ? 8 * nN : 64 * nN;
    for (int item = slot; item < nitems; item += nslots) {
        const int pm = xmap ? xcd * 8 + item / nN : item / nN, pn = item % nN;
        const int m0 = pm * 256, n0 = pn * 128, b = m0 / SEQ;
        const bf16_t* Ab = A + (size_t)m0 * D;
        const bf16_t* Bb = Bt + (size_t)b * bt_batch_stride + (size_t)n0 * D;
        f32x4 acc[4][4];
#pragma unroll
        for (int mi = 0; mi < 4; ++mi)
#pragma unroll
            for (int ni = 0; ni < 4; ++ni) acc[mi][ni] = (f32x4){0.f, 0.f, 0.f, 0.f};
        u32x4 ra[4], rb[2];
        auto gload = [&](int kt) {
#pragma unroll
            for (int i = 0; i < 4; ++i) { const int id = tid + NT * i, row = id >> 3, c = id & 7; ra[i] = *(const u32x4*)(Ab + (size_t)row * D + kt * 64 + c * 8); }
#pragma unroll
            for (int i = 0; i < 2; ++i) { const int id = tid + NT * i, row = id >> 3, c = id & 7; rb[i] = *(const u32x4*)(Bb + (size_t)row * D + kt * 64 + c * 8); }
        };
        auto lstore = [&](int buf) {
            unsigned char* sA = smem + buf * 32768; unsigned char* sB = smem + 65536 + buf * 16384;
#pragma unroll
            for (int i = 0; i < 4; ++i) { const int id = tid + NT * i, row = id >> 3, c = id & 7; *(u32x4*)(sA + lds_off(row, c)) = ra[i]; }
#pragma unroll
            for (int i = 0; i < 2; ++i) { const int id = tid + NT * i, row = id >> 3, c = id & 7; *(u32x4*)(sB + lds_off(row, c)) = rb[i]; }
        };
        gload(0); lstore(0);
        __syncthreads();
        for (int kt = 0; kt < 16; ++kt) {
            if (kt + 1 < 16) gload(kt + 1);
            const unsigned char* sA = smem + (kt & 1) * 32768; const unsigned char* sB = smem + 65536 + (kt & 1) * 16384;
#pragma unroll
            for (int ks = 0; ks < 2; ++ks) {
                bf16x8 af[4], bfr[4];
#pragma unroll
                for (int mi = 0; mi < 4; ++mi) af[mi] = *(const bf16x8*)(sA + lds_off(wm * 64 + mi * 16 + tk, ks * 4 + q));
#pragma unroll
                for (int ni = 0; ni < 4; ++ni) bfr[ni] = *(const bf16x8*)(sB + lds_off(wn * 64 + ni * 16 + tk, ks * 4 + q));
#pragma unroll
                for (int mi = 0; mi < 4; ++mi)
#pragma unroll
                    for (int ni = 0; ni < 4; ++ni) acc[mi][ni] = __builtin_amdgcn_mfma_f32_16x16x32_bf16(bfr[ni], af[mi], acc[mi][ni], 0, 0, 0);
            }
            if (kt + 1 < 16) lstore((kt + 1) & 1);
            __syncthreads();
        }
        epi(acc, m0 + wm * 64, n0 + wn * 64, b, pn * 2 + wn, tk, q);
    }
}

__device__ __forceinline__ float rstd_of(const float* ssq, int token) {
    const f32x4* s4 = (const f32x4*)(ssq + (size_t)token * 16);
    const f32x4 a = s4[0], b = s4[1], c = s4[2], d = s4[3];
    const float s = ((a[0] + a[1]) + (a[2] + a[3])) + ((b[0] + b[1]) + (b[2] + b[3])) + ((c[0] + c[1]) + (c[2] + c[3])) + ((d[0] + d[1]) + (d[2] + d[3]));
    return rsqrtf(s * (1.f / D) + RMS_EPS);
}

struct EpiU {
    const float* ssq; const float* bias; bf16_t* ug;
    __device__ __forceinline__ void operator()(const f32x4 (&acc)[4][4], int mbase, int nbase, int b, int, int tk, int q) const {
#pragma unroll
        for (int mi = 0; mi < 4; ++mi) {
            const int token = mbase + mi * 16 + tk, s = token - b * SEQ;
            const float rstd = rstd_of(ssq, token);
#pragma unroll
            for (int ni = 0; ni < 4; ++ni) {
                const int n = nbase + ni * 16 + 4 * q, g = n >> 4;
                const f32x4 bv = *(const f32x4*)(bias + (size_t)b * NSC + SC_IN + n);
                u32x2 o; o[0] = pack2(rstd * acc[mi][ni][0] + bv[0], rstd * acc[mi][ni][1] + bv[1]); o[1] = pack2(rstd * acc[mi][ni][2] + bv[2], rstd * acc[mi][ni][3] + bv[3]);
                *(u32x2*)(ug + (((size_t)(g * 4 + b) * SEQ + s) * 16 + 4 * q)) = o;
            }
        }
    }
};
struct EpiQ {
    const float* ssq; const float* bias; int boff; bf16_t* out;
    __device__ __forceinline__ void operator()(const f32x4 (&acc)[4][4], int mbase, int nbase, int b, int, int tk, int q) const {
#pragma unroll
        for (int mi = 0; mi < 4; ++mi) {
            const int token = mbase + mi * 16 + tk;
            const float rstd = rstd_of(ssq, token);
#pragma unroll
            for (int ni = 0; ni < 4; ++ni) {
                const int n = nbase + ni * 16 + 4 * q;
                const f32x4 bv = *(const f32x4*)(bias + (size_t)b * NSC + boff + n);
                u32x2 o; o[0] = pack2(rstd * acc[mi][ni][0] + bv[0], rstd * acc[mi][ni][1] + bv[1]); o[1] = pack2(rstd * acc[mi][ni][2] + bv[2], rstd * acc[mi][ni][3] + bv[3]);
                *(u32x2*)(out + (size_t)token * D + n) = o;
            }
        }
    }
};
struct EpiGlu {
    const bf16_t* y; const float* bglu; bf16_t* out;
    __device__ __forceinline__ void operator()(const f32x4 (&acc)[4][4], int mbase, int nbase, int, int, int tk, int q) const {
#pragma unroll
        for (int mi = 0; mi < 4; ++mi) {
            const int token = mbase + mi * 16 + tk;
#pragma unroll
            for (int ni = 0; ni < 4; ++ni) {
                const int n = nbase + ni * 16 + 4 * q;
                const f32x4 bv = *(const f32x4*)(bglu + n);
                const u32x2 yv = *(const u32x2*)(y + (size_t)token * D + n);
                float o[4];
                const float y0 = bflo(yv[0]), y1 = bfhi(yv[0]), y2 = bflo(yv[1]), y3 = bfhi(yv[1]);
                o[0] = y0 / (1.f + __expf(-(acc[mi][ni][0] + bv[0]))); o[1] = y1 / (1.f + __expf(-(acc[mi][ni][1] + bv[1])));
                o[2] = y2 / (1.f + __expf(-(acc[mi][ni][2] + bv[2]))); o[3] = y3 / (1.f + __expf(-(acc[mi][ni][3] + bv[3])));
                u32x2 ov; ov[0] = pack2(o[0], o[1]); ov[1] = pack2(o[2], o[3]);
                *(u32x2*)(out + (size_t)token * D + n) = ov;
            }
        }
    }
};
struct EpiRes {
    const float* xold; const float* gate  ; float* xout; bf16_t* xbout; float* ssq;
    __device__ __forceinline__ void operator()(const f32x4 (&acc)[4][4], int mbase, int nbase, int b, int slot, int tk, int q) const {
#pragma unroll
        for (int mi = 0; mi < 4; ++mi) {
            const int token = mbase + mi * 16 + tk;
            float ss = 0.f;
#pragma unroll
            for (int ni = 0; ni < 4; ++ni) {
                const int n = nbase + ni * 16 + 4 * q;
                const f32x4 gv = *(const f32x4*)(gate + (size_t)b * (NCOND * D) + n);
                const f32x4 xo = *(const f32x4*)(xold + (size_t)token * D + n);
                f32x4 xn;
#pragma unroll
                for (int r = 0; r < 4; ++r) { xn[r] = xo[r] + gv[r] * acc[mi][ni][r]; ss += xn[r] * xn[r]; }
                *(f32x4*)(xout + (size_t)token * D + n) = xn;
                u32x2 ov; ov[0] = pack2(xn[0], xn[1]); ov[1] = pack2(xn[2], xn[3]);
                *(u32x2*)(xbout + (size_t)token * D + n) = ov;
            }
            ss += __shfl_xor(ss, 16); ss += __shfl_xor(ss, 32);
            if (q == 0) ssq[(size_t)token * 16 + slot] = ss;
        }
    }
};

__device__ void s5_phase(const Params& p, unsigned char* smem) {
    bf16_t* ktl = (bf16_t*)smem;
    float* Sl = (float*)(smem + 33280);
    bf16_t* Xl = (bf16_t*)(smem + 33280 + 33280);
    const int tid = threadIdx.x, lane = tid & 63, w = tid >> 6, cb = w & 3, hh = w >> 2, tk = lane & 15, q = lane >> 4;
    for (int task = blockIdx.x; task < G5 * NB; task += gridDim.x) {
        const int g = (task & 7) * 8 + ((task >> 3) >> 2), b = (task >> 3) & 3;
        const bf16_t* U = p.s1 + (size_t)(g * 4 + b) * SEQ * 16;
        const bf16_t* sm = p.smat + (size_t)g * 128 * 1024;
        const bf16_t* cm = p.cmat + (size_t)g * 1024 * 128;
        for (int i = tid; i < 65 * 256 * 2 / 16; i += NT) ((u32x4*)ktl)[i] = ((const u32x4*)(p.ktab + (size_t)g * 65 * 256))[i];
        bf16x8 ufr[32];
#pragma unroll
        for (int ks = 0; ks < 32; ++ks) ufr[ks] = *(const bf16x8*)(U + (size_t)(cb * 16 + tk) * 1024 + ks * 32 + 8 * q);
#pragma unroll 1
        for (int mf = 0; mf < 4; ++mf) {
            const int r0 = (hh * 4 + mf) * 16;
            f32x4 acc = {0.f, 0.f, 0.f, 0.f};
#pragma unroll
            for (int ks = 0; ks < 32; ++ks) {
                const bf16x8 af = *(const bf16x8*)(sm + (size_t)(r0 + tk) * 1024 + ks * 32 + 8 * q);
                acc = __builtin_amdgcn_mfma_f32_16x16x32_bf16(af, ufr[ks], acc, 0, 0, 0);
            }
#pragma unroll
            for (int r = 0; r < 4; ++r) Sl[(r0 + 4 * q + r) * 65 + cb * 16 + tk] = acc[r];
        }
        __syncthreads();
        if (w == 0) {
            const float lr = p.lamL[(g * P5 + lane) * 2], li = p.lamL[(g * P5 + lane) * 2 + 1];
            float xr = 0.f, xi = 0.f;
            for (int k = 0; k < NCH; ++k) {
                Xl[k * 128 + lane] = f2bf(xr); Xl[k * 128 + 64 + lane] = f2bf(xi);
                const float sr = Sl[lane * 65 + k], si = Sl[(64 + lane) * 65 + k];
                const float nr = lr * xr - li * xi + sr, ni = lr * xi + li * xr + si;
                xr = nr; xi = ni;
            }
        }
        __syncthreads();
        bf16x8 xfr[4];
#pragma unroll
        for (int ks = 0; ks < 4; ++ks) xfr[ks] = *(const bf16x8*)(Xl + (cb * 16 + tk) * 128 + ks * 32 + 8 * q);
        const f32x4 dv = *(const f32x4*)(p.s5d + g * 16 + 4 * q);
        const int jl = q >> 1, cih = q & 1;
#pragma unroll 1
        for (int ii = 0; ii < 32; ++ii) {
            const int i = hh ? 16 + ii : (ii < 16 ? ii : 32 + ii);
            f32x4 acc = {0.f, 0.f, 0.f, 0.f};
#pragma unroll
            for (int ks = 0; ks < 4; ++ks) {
                const bf16x8 af = *(const bf16x8*)(cm + (size_t)(i * 16 + tk) * 128 + ks * 32 + 8 * q);
                acc = __builtin_amdgcn_mfma_f32_16x16x32_bf16(af, xfr[ks], acc, 0, 0, 0);
            }
            const int mmax = i >> 1;
#pragma unroll
            for (int m = 0; m < 32; ++m) {
                if (m <= mmax) {
                    const int tau1 = i - 2 * m - jl + 1;
                    const bf16x8 kf = *(const bf16x8*)(ktl + tau1 * 256 + tk * 16 + cih * 8);
                    acc = __builtin_amdgcn_mfma_f32_16x16x32_bf16(kf, ufr[m], acc, 0, 0, 0);
                }
            }
            const int s = (cb * 16 + tk) * 64 + i;
            const u32x2 uv = *(const u32x2*)(U + (size_t)s * 16 + 4 * q);
            const float y0 = gelu_tanh(acc[0] + dv[0] * bflo(uv[0])), y1 = gelu_tanh(acc[1] + dv[1] * bfhi(uv[0]));
            const float y2 = gelu_tanh(acc[2] + dv[2] * bflo(uv[1])), y3 = gelu_tanh(acc[3] + dv[3] * bfhi(uv[1]));
            u32x2 o; o[0] = pack2(y0, y1); o[1] = pack2(y2, y3);
            *(u32x2*)(p.s0 + ((size_t)b * SEQ + s) * D + g * 16 + 4 * q) = o;
        }
        __syncthreads();
    }
}

__device__ __forceinline__ float med3f(float a, float b, float c) { return __builtin_amdgcn_fmed3f(a, b, c); }
__device__ __forceinline__ void ins16(float (&a)[16], float v) {
#pragma unroll
    for (int i = 15; i >= 1; --i) a[i] = med3f(a[i - 1], a[i], v);
    a[0] = fmaxf(a[0], v);
}
__device__ void route_phase(const Params& p, int layer, const bf16_t* qp, unsigned char* smem) {
    float* sc = (float*)smem;
    float* tl = (float*)(smem + 2 * 128 * 129 * 4);
    const int tid = threadIdx.x, lane = tid & 63, w = tid >> 6, tk = lane & 15, q = lane >> 4;
    for (int task = blockIdx.x; task < (T / 128) * 8; task += gridDim.x) {
        const int h = task & 7, t0 = (task >> 3) * 128;
#pragma unroll 1
        for (int pp = 0; pp < 2; ++pp) {
            const bf16_t* qrow = qp + (size_t)(t0 + 16 * w + tk) * D + h * 128 + pp * 64 + 8 * q;
            const bf16x8 a0 = *(const bf16x8*)(qrow), a1 = *(const bf16x8*)(qrow + 32);
            const bf16_t* kb = p.skeys + ((size_t)((layer * 8 + h) * 2 + pp) * 128) * 64 + 8 * q;
#pragma unroll
            for (int nf = 0; nf < 8; ++nf) {
                const bf16x8 b0 = *(const bf16x8*)(kb + (size_t)(nf * 16 + tk) * 64), b1 = *(const bf16x8*)(kb + (size_t)(nf * 16 + tk) * 64 + 32);
                f32x4 acc = {0.f, 0.f, 0.f, 0.f};
                acc = __builtin_amdgcn_mfma_f32_16x16x32_bf16(a0, b0, acc, 0, 0, 0);
                acc = __builtin_amdgcn_mfma_f32_16x16x32_bf16(a1, b1, acc, 0, 0, 0);
#pragma unroll
                for (int r = 0; r < 4; ++r) sc[(pp * 128 + 16 * w + 4 * q + r) * 129 + nf * 16 + tk] = acc[r];
            }
        }
        __syncthreads();
        {
            const int list = tid & 255, kr = tid >> 8;
            float a[16];
#pragma unroll
            for (int i = 0; i < 16; ++i) a[i] = -3.0e38f;
            const float* row = sc + list * 129 + kr * 64;
            for (int j = 0; j < 64; ++j) {
                const float v = __uint_as_float((__float_as_uint(row[j]) & ~0x7Fu) | (unsigned)(kr * 64 + j));
                ins16(a, v);
            }
            if (kr == 1) {
#pragma unroll
                for (int i = 0; i < 16; ++i) tl[list * 16 + i] = a[i];
            }
            __syncthreads();
            if (kr == 0) {
                float o[16];
#pragma unroll
                for (int i = 0; i < 16; ++i) o[i] = tl[list * 16 + i];
#pragma unroll
                for (int i = 0; i < 16; ++i) ins16(a, o[i]);
#pragma unroll
                for (int i = 0; i < 16; ++i) tl[list * 16 + i] = a[i];
            }
            __syncthreads();
        }
        if (tid < 128) {
            float s[16], r[16], c[16];
#pragma unroll
            for (int i = 0; i < 16; ++i) { s[i] = tl[tid * 16 + i]; r[i] = tl[(128 + tid) * 16 + i]; c[i] = -3.0e38f; }
#pragma unroll
            for (int i = 0; i < 16; ++i)
#pragma unroll
                for (int j = 0; j < 16; ++j)
                    if ((i + 1) * (j + 1) <= 16) {
                        const float v = __uint_as_float((__float_as_uint(s[i] + r[j]) & ~0xFFu) | (unsigned)(i * 16 + j));
                        ins16(c, v);
                    }
            float e[16], sum = 0.f;
#pragma unroll
            for (int k = 0; k < 16; ++k) { e[k] = __expf(c[k] - c[0]); sum += e[k]; }
            const float inv = 1.f / sum;
            int idv[16];
#pragma unroll
            for (int k = 0; k < 16; ++k) {
                const unsigned bits = __float_as_uint(c[k]), i = (bits >> 4) & 15u, j = bits & 15u;
                const unsigned ki = __float_as_uint(tl[tid * 16 + i]) & 0x7Fu, kj = __float_as_uint(tl[(128 + tid) * 16 + j]) & 0x7Fu;
                idv[k] = (int)(ki * 128u + kj);
            }
            int* ido = p.ids + (size_t)(t0 + tid) * 128 + h * 16; float* go = p.gates + (size_t)(t0 + tid) * 128 + h * 16;
#pragma unroll
            for (int k4 = 0; k4 < 4; ++k4) {
                *(int4*)(ido + k4 * 4) = make_int4(idv[k4 * 4], idv[k4 * 4 + 1], idv[k4 * 4 + 2], idv[k4 * 4 + 3]);
                *(f32x4*)(go + k4 * 4) = (f32x4){e[k4 * 4] * inv, e[k4 * 4 + 1] * inv, e[k4 * 4 + 2] * inv, e[k4 * 4 + 3] * inv};
            }
        }
        __syncthreads();
    }
}

struct RowBuf { u32x4 w[4]; float sc; };
template <bool FINAL>
__device__ void gather_phase(const Params& p, int layer, const float* xin, float* xout, bf16_t* xbout, float* ssq_out, const float* gnorm, int c_shift, int c_scale, int c_gate) {
    const int lane = threadIdx.x & 63, wv = threadIdx.x >> 6, li = lane & 15, qg = lane >> 4;
    const int nw = gridDim.x * (NT / 64);
    const unsigned char* utab = p.ub + (size_t)layer * NEXP * D;
    const unsigned char* vtab = p.vb + (size_t)layer * NEXP * D;
    const float* sutab = p.su + (size_t)layer * NEXP;
    const float* svtab = p.sv + (size_t)layer * NEXP;
    for (int t = blockIdx.x * (NT / 64) + wv; t < T; t += nw) {
        const int b = t / SEQ;
        const float* cb = p.cond + (size_t)b * (NCOND * D);
        const float* xr = xin + (size_t)t * D;
        float hf[4][16];
        {
            float ss = 0.f;
#pragma unroll
            for (int c = 0; c < 4; ++c)
#pragma unroll
                for (int j = 0; j < 4; ++j) {
                    const f32x4 v = *(const f32x4*)(xr + c * 256 + li * 16 + j * 4);
#pragma unroll
                    for (int e = 0; e < 4; ++e) { hf[c][j * 4 + e] = v[e]; ss += v[e] * v[e]; }
                }
            ss += __shfl_xor(ss, 1); ss += __shfl_xor(ss, 2); ss += __shfl_xor(ss, 4); ss += __shfl_xor(ss, 8);
            const float rstd = rsqrtf(ss * (1.f / D) + RMS_EPS);
#pragma unroll
            for (int c = 0; c < 4; ++c)
#pragma unroll
                for (int j = 0; j < 4; ++j) {
                    const int e0 = c * 256 + li * 16 + j * 4;
                    const f32x4 g = *(const f32x4*)(gnorm + e0), sc = *(const f32x4*)(cb + c_scale * D + e0), sh = *(const f32x4*)(cb + c_shift * D + e0);
#pragma unroll
                    for (int e = 0; e < 4; ++e) hf[c][j * 4 + e] = hf[c][j * 4 + e] * rstd * g[e] * (1.f + sc[e]) + sh[e];
                }
        }
        const int idA = p.ids[(size_t)t * 128 + lane], idB = p.ids[(size_t)t * 128 + 64 + lane];
        const float gA = p.gates[(size_t)t * 128 + lane], gB = p.gates[(size_t)t * 128 + 64 + lane];
        float actA = 0.f, actB = 0.f;
        RowBuf bufA, bufB;
        auto issue = [&](RowBuf& buf, const unsigned char* tab, const float* stab, int m) {
            const int id = __shfl(m < 16 ? idA : idB, (4 * m + qg) & 63);
            const unsigned char* rp = tab + (size_t)id * D + li * 16;
#pragma unroll
            for (int c = 0; c < 4; ++c) buf.w[c] = *(const u32x4*)(rp + c * 256);
            buf.sc = stab[id];
        };
        auto consume_u = [&](const RowBuf& buf, int m) {
            float d0 = 0.f, d1 = 0.f;
#pragma unroll
            for (int c = 0; c < 4; ++c)
#pragma unroll
                for (int j = 0; j < 4; ++j) {
                    const f32x2 lo = __builtin_amdgcn_cvt_pk_f32_fp8((int)buf.w[c][j], false), hi = __builtin_amdgcn_cvt_pk_f32_fp8((int)buf.w[c][j], true);
                    d0 += lo[0] * hf[c][j * 4]; d1 += lo[1] * hf[c][j * 4 + 1]; d0 += hi[0] * hf[c][j * 4 + 2]; d1 += hi[1] * hf[c][j * 4 + 3];
                }
            float d = d0 + d1;
            d += __shfl_xor(d, 1); d += __shfl_xor(d, 2); d += __shfl_xor(d, 4); d += __shfl_xor(d, 8);
            const float gt = __shfl(m < 16 ? gA : gB, (4 * m + qg) & 63);
            const float a = gelu_tanh(d * buf.sc) * gt;
            if (li == (m & 15)) { if (m < 16) actA = a; else actB = a; }
        };
        issue(bufA, utab, sutab, 0);
#pragma unroll 1
        for (int m = 0; m < 32; m += 2) {
            issue(bufB, utab, sutab, m + 1);
            consume_u(bufA, m);
            if (m + 2 < 32) issue(bufA, utab, sutab, m + 2);
            consume_u(bufB, m + 1);
        }
        float o[4][16];
#pragma unroll
        for (int c = 0; c < 4; ++c)
#pragma unroll
            for (int e = 0; e < 16; ++e) o[c][e] = 0.f;
        auto consume_v = [&](const RowBuf& buf, int m) {
            const float a = __shfl(m < 16 ? actA : actB, (lane & 48) | (m & 15)) * buf.sc;
#pragma unroll
            for (int c = 0; c < 4; ++c)
#pragma unroll
                for (int j = 0; j < 4; ++j) {
                    const f32x2 lo = __builtin_amdgcn_cvt_pk_f32_fp8((int)buf.w[c][j], false), hi = __builtin_amdgcn_cvt_pk_f32_fp8((int)buf.w[c][j], true);
                    o[c][j * 4] += a * lo[0]; o[c][j * 4 + 1] += a * lo[1]; o[c][j * 4 + 2] += a * hi[0]; o[c][j * 4 + 3] += a * hi[1];
                }
        };
        issue(bufA, vtab, svtab, 0);
#pragma unroll 1
        for (int m = 0; m < 32; m += 2) {
            issue(bufB, vtab, svtab, m + 1);
            consume_v(bufA, m);
            if (m + 2 < 32) issue(bufA, vtab, svtab, m + 2);
            consume_v(bufB, m + 1);
        }
#pragma unroll
        for (int c = 0; c < 4; ++c)
#pragma unroll
            for (int e = 0; e < 16; ++e) { o[c][e] += __shfl_xor(o[c][e], 16); o[c][e] += __shfl_xor(o[c][e], 32); }
        float xn[16]; float ss = 0.f;
        const int e0 = qg * 256 + li * 16;
#pragma unroll
        for (int j = 0; j < 4; ++j) {
            const f32x4 xo = *(const f32x4*)(xr + e0 + j * 4), gv = *(const f32x4*)(cb + c_gate * D + e0 + j * 4);
#pragma unroll
            for (int e = 0; e < 4; ++e) {
                const int k = j * 4 + e;
                const float ov = qg == 0 ? o[0][k] : (qg == 1 ? o[1][k] : (qg == 2 ? o[2][k] : o[3][k]));
                const float v = xo[e] + gv[e] * ov;
                xn[k] = v; ss += v * v;
            }
        }
        ss = wave_sum(ss);
        if (!FINAL) {
#pragma unroll
            for (int j = 0; j < 4; ++j) *(f32x4*)(xout + (size_t)t * D + e0 + j * 4) = (f32x4){xn[j * 4], xn[j * 4 + 1], xn[j * 4 + 2], xn[j * 4 + 3]};
#pragma unroll
            for (int j = 0; j < 2; ++j) {
                u32x4 ob; ob[0] = pack2(xn[j * 8], xn[j * 8 + 1]); ob[1] = pack2(xn[j * 8 + 2], xn[j * 8 + 3]); ob[2] = pack2(xn[j * 8 + 4], xn[j * 8 + 5]); ob[3] = pack2(xn[j * 8 + 6], xn[j * 8 + 7]);
                *(u32x4*)(xbout + (size_t)t * D + e0 + j * 8) = ob;
            }
            if (lane < 16) ssq_out[(size_t)t * 16 + lane] = lane == 0 ? ss : 0.f;
        } else {
            const float rstd = rsqrtf(ss * (1.f / D) + RMS_EPS);
#pragma unroll
            for (int j = 0; j < 4; ++j) {
                const f32x4 g = *(const f32x4*)(p.final_norm + e0 + j * 4), sc = *(const f32x4*)(cb + 15 * D + e0 + j * 4), sh = *(const f32x4*)(cb + 14 * D + e0 + j * 4);
                f32x4 ov;
#pragma unroll
                for (int e = 0; e < 4; ++e) ov[e] = xn[j * 4 + e] * rstd * g[e] * (1.f + sc[e]) + sh[e];
                *(f32x4*)(p.out + (size_t)t * D + e0 + j * 4) = ov;
            }
        }
    }
}

struct EpiQKV {
    const float* ssq; const float* bias; const float* ropec; const float* ropes; bf16_t* K; bf16_t* V; bf16_t* Q;
    __device__ __forceinline__ void operator()(const f32x4 (&acc)[4][4], int mbase, int nbase, int b, int, int tk, int q) const {
        const bool rope = (nbase < 256) || (nbase >= 512);
#pragma unroll
        for (int mi = 0; mi < 4; ++mi) {
            const int token = mbase + mi * 16 + tk;
            const float rstd = rstd_of(ssq, token);
            float v[4][4];
#pragma unroll
            for (int ni = 0; ni < 4; ++ni) {
                const f32x4 bv = *(const f32x4*)(bias + (size_t)b * NSC + SC_KV + nbase + ni * 16 + 4 * q);
#pragma unroll
                for (int r = 0; r < 4; ++r) v[ni][r] = rstd * acc[mi][ni][r] + bv[r];
            }
            if (rope) {
#pragma unroll
                for (int ni = 0; ni < 2; ++ni) {
                    const f32x4 cs = *(const f32x4*)(ropec + (size_t)token * 32 + ni * 16 + 4 * q), sn = *(const f32x4*)(ropes + (size_t)token * 32 + ni * 16 + 4 * q);
#pragma unroll
                    for (int r = 0; r < 4; ++r) { const float t1 = v[ni][r], t2 = v[ni + 2][r]; v[ni][r] = t1 * cs[r] - t2 * sn[r]; v[ni + 2][r] = t2 * cs[r] + t1 * sn[r]; }
                }
            }
            bf16_t* dst = nbase < 256 ? K + (size_t)token * 256 + nbase : (nbase < 512 ? V + (size_t)token * 256 + (nbase - 256) : Q + (size_t)token * D + (nbase - 512));
#pragma unroll
            for (int ni = 0; ni < 4; ++ni) { u32x2 o; o[0] = pack2(v[ni][0], v[ni][1]); o[1] = pack2(v[ni][2], v[ni][3]); *(u32x2*)(dst + ni * 16 + 4 * q) = o; }
        }
    }
};

__device__ void attn_phase(const Params& p, const bf16_t* Q, const bf16_t* K, const bf16_t* V, bf16_t* O, unsigned char* smem) {
    unsigned char* Kl = smem;
    unsigned char* Vt = smem + 32768;
    unsigned char* Pl = smem + 32768 + 35840;
    const int tid = threadIdx.x, lane = tid & 63, w = tid >> 6, tk = lane & 15, q = lane >> 4;
    unsigned char* Pw = Pl + w * 5376;
    for (int task = blockIdx.x; task < NB * 32 * 4; task += gridDim.x) {
        const int kvh = task & 3, qblk = (task >> 2) & 31, b = task >> 7;
        const int kpos0 = (qblk - 1) * 128;
#pragma unroll
        for (int i = 0; i < 4; ++i) {
            const int id = tid + NT * i, j = id >> 3, c = id & 7, kp = kpos0 + j;
            u32x4 v = {0u, 0u, 0u, 0u};
            if (kp >= 0) v = *(const u32x4*)(K + ((size_t)b * SEQ + kp) * 256 + kvh * 64 + c * 8);
            *(u32x4*)(Kl + lds_off(j, c)) = v;
        }
#pragma unroll
        for (int i = 0; i < 4; ++i) {
            const int id = tid + NT * i, j = id & 255, dc = id >> 8, kp = kpos0 + j;
            u32x4 v = {0u, 0u, 0u, 0u};
            if (kp >= 0) v = *(const u32x4*)(V + ((size_t)b * SEQ + kp) * 256 + kvh * 64 + dc * 8);
#pragma unroll
            for (int e = 0; e < 4; ++e) {
                *(bf16_t*)(Vt + (dc * 8 + 2 * e) * 560 + j * 2) = (bf16_t)(v[e] & 0xffffu);
                *(bf16_t*)(Vt + (dc * 8 + 2 * e + 1) * 560 + j * 2) = (bf16_t)(v[e] >> 16);
            }
        }
        if (tid < 128) *(u32x4*)(Vt + (tid >> 1) * 560 + 512 + (tid & 1) * 16) = (u32x4){0u, 0u, 0u, 0u};
        *(u32x2*)(Pw + tk * 336 + (144 + 4 * q) * 2) = (u32x2){0u, 0u};
        __syncthreads();
        const int qt = w, i_q = qt * 16 + tk;
        const size_t trow = (size_t)b * SEQ + qblk * 128 + i_q;
#pragma unroll 1
        for (int hq = 0; hq < 4; ++hq) {
            const int head = kvh * 4 + hq;
            const bf16x8 qf0 = *(const bf16x8*)(Q + trow * D + head * 64 + 8 * q), qf1 = *(const bf16x8*)(Q + trow * D + head * 64 + 32 + 8 * q);
            f32x4 sacc[9];
#pragma unroll
            for (int kk = 0; kk < 9; ++kk) {
                const int krow = (qt + kk) * 16 + tk;
                const bf16x8 k0 = *(const bf16x8*)(Kl + lds_off(krow, q)), k1 = *(const bf16x8*)(Kl + lds_off(krow, 4 + q));
                f32x4 a = {0.f, 0.f, 0.f, 0.f};
                a = __builtin_amdgcn_mfma_f32_16x16x32_bf16(k0, qf0, a, 0, 0, 0);
                a = __builtin_amdgcn_mfma_f32_16x16x32_bf16(k1, qf1, a, 0, 0, 0);
                sacc[kk] = a;
            }
            const float sink = p.sinks[head];
            float mx = -1e30f;
#pragma unroll
            for (int kk = 0; kk < 9; ++kk)
#pragma unroll
                for (int r = 0; r < 4; ++r) {
                    const int j = (qt + kk) * 16 + 4 * q + r;
                    const bool valid = (j > i_q) && (j <= i_q + 128) && (qblk > 0 || j >= 128);
                    const float s = valid ? sacc[kk][r] * 0.125f : -1e30f;
                    sacc[kk][r] = s; mx = fmaxf(mx, s);
                }
            mx = fmaxf(mx, __shfl_xor(mx, 16)); mx = fmaxf(mx, __shfl_xor(mx, 32));
            mx = fmaxf(mx, sink);
            float sum = 0.f;
#pragma unroll
            for (int kk = 0; kk < 9; ++kk)
#pragma unroll
                for (int r = 0; r < 4; ++r) { const float e = __expf(sacc[kk][r] - mx); sacc[kk][r] = e; sum += e; }
            sum += __shfl_xor(sum, 16); sum += __shfl_xor(sum, 32);
            const float inv = 1.f / (sum + __expf(sink - mx));
#pragma unroll
            for (int kk = 0; kk < 9; ++kk) {
                u32x2 o; o[0] = pack2(sacc[kk][0] * inv, sacc[kk][1] * inv); o[1] = pack2(sacc[kk][2] * inv, sacc[kk][3] * inv);
                *(u32x2*)(Pw + tk * 336 + (kk * 16 + 4 * q) * 2) = o;
            }
            asm volatile("s_waitcnt lgkmcnt(0)" ::: "memory");
            bf16x8 pf[5];
#pragma unroll
            for (int ks = 0; ks < 5; ++ks) pf[ks] = *(const bf16x8*)(Pw + tk * 336 + (ks * 32 + 8 * q) * 2);
#pragma unroll
            for (int dt = 0; dt < 4; ++dt) {
                f32x4 oa = {0.f, 0.f, 0.f, 0.f};
#pragma unroll
                for (int ks = 0; ks < 5; ++ks) {
                    const bf16x8 vf = *(const bf16x8*)(Vt + (dt * 16 + tk) * 560 + (qt * 16 + ks * 32 + 8 * q) * 2);
                    oa = __builtin_amdgcn_mfma_f32_16x16x32_bf16(vf, pf[ks], oa, 0, 0, 0);
                }
                u32x2 o; o[0] = pack2(oa[0], oa[1]); o[1] = pack2(oa[2], oa[3]);
                *(u32x2*)(O + trow * D + head * 64 + dt * 16 + 4 * q) = o;
            }
            asm volatile("s_waitcnt lgkmcnt(0)" ::: "memory");
        }
        __syncthreads();
    }
}

__device__ void final_only(const Params& p, const float* xin) {
    const int lane = threadIdx.x & 63, wv = threadIdx.x >> 6;
    const int nw = gridDim.x * (NT / 64);
    for (int t = blockIdx.x * (NT / 64) + wv; t < T; t += nw) {
        const int b = t / SEQ;
        const float* xr = xin + (size_t)t * D;
        f32x4 v[4]; float s = 0.f;
#pragma unroll
        for (int j = 0; j < 4; ++j) { v[j] = *(const f32x4*)(xr + j * 256 + lane * 4); s += v[j][0] * v[j][0] + v[j][1] * v[j][1] + v[j][2] * v[j][2] + v[j][3] * v[j][3]; }
        s = wave_sum(s);
        const float rstd = rsqrtf(s * (1.f / D) + RMS_EPS);
#pragma unroll
        for (int j = 0; j < 4; ++j) {
            const int e = j * 256 + lane * 4;
            const f32x4 g = *(const f32x4*)(p.final_norm + e);
            const f32x4 sh = *(const f32x4*)(p.cond + (size_t)b * (NCOND * D) + 14 * D + e);
            const f32x4 sc = *(const f32x4*)(p.cond + (size_t)b * (NCOND * D) + 15 * D + e);
            f32x4 o;
#pragma unroll
            for (int i = 0; i < 4; ++i) o[i] = v[j][i] * rstd * g[i] * (1.f + sc[i]) + sh[i];
            *(f32x4*)(p.out + (size_t)t * D + e) = o;
        }
    }
}

constexpr int SMEM_BYTES = 152 * 1024;
__global__ void __launch_bounds__(NT) yoco_fwd(Params p) {
    __shared__ __attribute__((aligned(16))) unsigned char smem[SMEM_BYTES];
    volatile LAS unsigned* st = (volatile LAS unsigned*)(smem + SMEM_BYTES - 16);
    if (threadIdx.x == 0) { st[0] = 0u; st[1] = 0u; }
    __syncthreads();
    const XcdBarrier xb = xcd_barrier_post(p.bar, st);
    p0_cond(p, smem);
    p0_xconv(p);
    p0_wt(p, smem);
    p0_s5(p, smem);
    p0_tables(p);
    xcd_barrier(xb);
    p05_weights(p, smem);
    xcd_barrier(xb);
    { EpiU e{p.ssq0, p.bias, p.s1}; gemm_phase(p.s0, p.wts + (size_t)SC_IN * D, (size_t)NSC * D, 1024, e, smem); }
    xcd_barrier(xb);
    s5_phase(p, smem);
    xcd_barrier(xb);
    { EpiGlu e{p.s0, p.b_glu, p.s1}; gemm_phase(p.s0, p.wt_glu, 0, 1024, e, smem); }
    xcd_barrier(xb);
    { EpiRes e{p.x, p.cond + 2 * D, p.f0, p.s2, p.ssq1}; gemm_phase(p.s1, p.wt_out, 0, 1024, e, smem); }
    xcd_barrier(xb);
    { EpiQ e{p.ssq1, p.bias, SC_PQ0, p.s1}; gemm_phase(p.s2, p.wts + (size_t)SC_PQ0 * D, (size_t)NSC * D, 1024, e, smem); }
    xcd_barrier(xb);
    route_phase(p, 0, p.s1, smem);
    xcd_barrier(xb);
    gather_phase<false>(p, 0, p.f0, p.f1, p.s0, p.ssq2, p.norm_ffn, 3, 4, 5);
    xcd_barrier(xb);
    { EpiQKV e{p.ssq2, p.bias, p.ropec, p.ropes, p.s2, p.s2 + (size_t)T * 256, p.s1}; gemm_phase(p.s0, p.wts + (size_t)SC_KV * D, (size_t)NSC * D, 1536, e, smem); }
    xcd_barrier(xb);
    attn_phase(p, p.s1, p.s2, p.s2 + (size_t)T * 256, p.s0, smem);
    xcd_barrier(xb);
    { EpiRes e{p.f1, p.cond + 8 * D, p.f0, p.s2, p.ssq3}; gemm_phase(p.s0, p.wt_o, 0, 1024, e, smem); }
    xcd_barrier(xb);
    { EpiQ e{p.ssq3, p.bias, SC_PQ1, p.s1}; gemm_phase(p.s2, p.wts + (size_t)SC_PQ1 * D, (size_t)NSC * D, 1024, e, smem); }
    xcd_barrier(xb);
    route_phase(p, 1, p.s1, smem);
    xcd_barrier(xb);
    gather_phase<true>(p, 1, p.f0, nullptr, nullptr, nullptr, p.norm_ffn + D, 9, 10, 11);
}

static inline size_t align_up(size_t v, size_t a) { return (v + a - 1) / a * a; }

extern "C" void kernel_launch(void* const* d_in, const int* in_sizes, int n_in, void* d_out, int out_size, void* d_ws, size_t ws_size, hipStream_t stream) {
    (void)in_sizes; (void)n_in; (void)out_size;
    Params p{};
    p.x = (const float*)d_in[0]; p.c = (const float*)d_in[1]; p.pos = (const int*)d_in[2]; p.w_cond = (const float*)d_in[3]; p.b_cond = (const float*)d_in[4];
    p.norm_mix = (const float*)d_in[5]; p.norm_ffn = (const float*)d_in[6]; p.w_in = (const float*)d_in[7]; p.a_re = (const float*)d_in[8]; p.a_im = (const float*)d_in[9];
    p.log_dt = (const float*)d_in[10]; p.b_re = (const float*)d_in[11]; p.b_im = (const float*)d_in[12]; p.c_re = (const float*)d_in[13]; p.c_im = (const float*)d_in[14];
    p.s5d = (const float*)d_in[15]; p.w_glu = (const float*)d_in[16]; p.b_glu = (const float*)d_in[17]; p.w_out = (const float*)d_in[18]; p.kv_norm = (const float*)d_in[19];
    p.w_kv = (const float*)d_in[20]; p.w_q = (const float*)d_in[21]; p.sinks = (const float*)d_in[22]; p.w_o = (const float*)d_in[23]; p.peer_wq = (const float*)d_in[24];
    p.subkeys = (const float*)d_in[25]; p.peer_u = (const float*)d_in[26]; p.peer_v = (const float*)d_in[27]; p.final_norm = (const float*)d_in[28];
    p.out = (float*)d_out;
    unsigned char* w = (unsigned char*)d_ws; size_t off = 65536;
    p.bar = (unsigned*)d_ws;
    auto take = [&](size_t bytes) { void* r = w + off; off = align_up(off + bytes, 4096); return r; };
    p.cond = (float*)take((size_t)NB * NCOND * D * 4);
    p.ropec = (float*)take((size_t)T * 32 * 4); p.ropes = (float*)take((size_t)T * 32 * 4);
    p.ssq0 = (float*)take((size_t)T * 16 * 4); p.ssq1 = (float*)take((size_t)T * 16 * 4); p.ssq2 = (float*)take((size_t)T * 16 * 4); p.ssq3 = (float*)take((size_t)T * 16 * 4);
    p.wt_glu = (bf16_t*)take((size_t)D * D * 2); p.wt_out = (bf16_t*)take((size_t)D * D * 2); p.wt_o = (bf16_t*)take((size_t)D * D * 2);
    p.wts = (bf16_t*)take((size_t)NB * NSC * D * 2); p.bias = (float*)take((size_t)NB * NSC * 4);
    p.skeys = (bf16_t*)take((size_t)2 * 8 * 2 * 128 * 64 * 2);
    p.lamL = (float*)take((size_t)G5 * P5 * 2 * 4); p.ktab = (bf16_t*)take((size_t)G5 * 65 * 256 * 2);
    p.smat = (bf16_t*)take((size_t)G5 * 128 * 1024 * 2); p.cmat = (bf16_t*)take((size_t)G5 * 1024 * 128 * 2);
    p.ub = (unsigned char*)take((size_t)2 * NEXP * D); p.vb = (unsigned char*)take((size_t)2 * NEXP * D);
    p.su = (float*)take((size_t)2 * NEXP * 4); p.sv = (float*)take((size_t)2 * NEXP * 4);
    p.s0 = (bf16_t*)take((size_t)T * D * 2); p.s1 = (bf16_t*)take((size_t)T * D * 2); p.s2 = (bf16_t*)take((size_t)T * D * 2);
    p.f0 = (float*)take((size_t)T * D * 4); p.f1 = (float*)take((size_t)T * D * 4);
    p.ids = (int*)take((size_t)T * 128 * 4); p.gates = (float*)take((size_t)T * 128 * 4);
    if (off > ws_size) { fprintf(stderr, "workspace too small: need %zu have %zu\n", off, ws_size); return; }

    static int grid_blocks = 0;
    if (!grid_blocks) {
        int dev = 0, cus = 0, per_cu = 0;
        (void)hipGetDevice(&dev);
        (void)hipDeviceGetAttribute(&cus, hipDeviceAttributeMultiprocessorCount, dev);
        (void)hipOccupancyMaxActiveBlocksPerMultiprocessor(&per_cu, yoco_fwd, NT, 0);
        if (per_cu > 1) per_cu = 1;
        grid_blocks = cus * per_cu;
        if (grid_blocks <= 0) grid_blocks = 256;
    }
    (void)hipMemsetAsync(d_ws, 0, XCD_BAR_WORDS * 4, stream);
    void* args[] = {&p};
    hipError_t e = hipLaunchCooperativeKernel((const void*)yoco_fwd, dim3(grid_blocks), dim3(NT), args, 0, stream);
    if (e != hipSuccess) fprintf(stderr, "cooperative launch failed: %s (grid %d)\n", hipGetErrorString(e), grid_blocks);
}
```

```cpp
#include <hip/hip_runtime.h>
#include <cstdio>
#include <cstdint>

#define NT 512
#define LAS __attribute__((address_space(3)))
typedef unsigned short bf16_t;
typedef short bf16x8 __attribute__((ext_vector_type(8)));
typedef float f32x4 __attribute__((ext_vector_type(4)));
typedef unsigned u32x4 __attribute__((ext_vector_type(4)));
typedef unsigned u32x2 __attribute__((ext_vector_type(2)));

constexpr int D = 1024, NB = 4, SEQ = 4096, T = NB * SEQ;
constexpr int NCOND = 16;
constexpr int G5 = 64, P5 = 64, C5 = 16, L5 = 64, NCH = SEQ / L5, KTR = 72;
constexpr int NEXP = 16384;
constexpr float RMS_EPS = 1e-6f;

struct Params {
    const float *x, *c; const int* pos; const float *w_cond, *b_cond, *norm_mix, *norm_ffn, *w_in, *a_re, *a_im, *log_dt, *b_re, *b_im, *c_re, *c_im, *s5d,
        *w_glu, *b_glu, *w_out, *kv_norm, *w_kv, *w_q, *sinks, *w_o, *peer_wq, *subkeys, *peer_u, *peer_v, *final_norm;
    float* out;
    unsigned* bar;
    float* cond;
    float* ropec;
    float* ropes;
    float* ssq1;
    float* ssq3;
    bf16_t *wt_in, *wt_glu, *wt_out, *wt_kv, *wt_q, *wt_o, *wt_pq0, *wt_pq1;
    float* biasp;
    float* bias;
    bf16_t* skeys;
    float* lamL;
    bf16_t* ktab;
    bf16_t* smat;
    bf16_t* cmat;
    unsigned char* ub;
    unsigned char* vb;
    float* su;
    float* sv;
    bf16_t *s0, *s1, *s2, *s3;
    float *f0, *f1;
    int* ids;
    float* gates;
};

#define XB_TMO      128
#define XB_XCNT(j)  (256  + 64 * (j))
#define XB_XSUB(j)  (1280 + 64 * (j))
#define XB_XGEN(j)  (2304 + 64 * (j))
#define XB_TOP      3328
#define XB_TOPGEN   3392
#define XCD_BAR_WORDS 3456
#define XB_SPIN_CAP (1u << 22)
__device__ __forceinline__ unsigned xb_ld(unsigned* p)              { return __hip_atomic_load(p, __ATOMIC_RELAXED, __HIP_MEMORY_SCOPE_AGENT); }
__device__ __forceinline__ unsigned xb_add(unsigned* p, unsigned v) { return __hip_atomic_fetch_add(p, v, __ATOMIC_RELAXED, __HIP_MEMORY_SCOPE_AGENT); }
__device__ __forceinline__ unsigned xb_xcc_id() { return (unsigned)__builtin_amdgcn_s_getreg((3 << 11) | 20) & 0xFu; }
#define XB_SPIN(cond, bar) do { unsigned _sp = 0; while (cond) { __builtin_amdgcn_s_sleep(1); \
    if ((++_sp & 255u) == 0u) { if (xb_ld(&(bar)[XB_TMO])) break; if (_sp > XB_SPIN_CAP) { atomicAdd(&(bar)[XB_TMO], 1u); break; } } } } while (0)
struct XcdBarrier { unsigned* bar; unsigned x; volatile LAS unsigned* st; };
__device__ __forceinline__ XcdBarrier xcd_barrier_post(unsigned* bar, volatile LAS unsigned* st) {
    XcdBarrier b; b.bar = bar; b.x = xb_xcc_id(); b.st = st;
    if (threadIdx.x == 0) (void)xb_add(&bar[XB_XCNT(b.x)], 1u);
    return b;
}
__device__ __forceinline__ void xcd_barrier_complete(unsigned* bar, unsigned x, unsigned& nloc, unsigned& nx) {
    const unsigned G = gridDim.x * gridDim.y * gridDim.z;
    unsigned sum, cnt, mine, sp = 0u;
    for (;;) {
        sum = 0u; cnt = 0u; mine = 0u;
#pragma unroll
        for (unsigned j = 0; j < 16; ++j) { const unsigned c = xb_ld(&bar[XB_XCNT(j)]); sum += c; cnt += (c > 0u) ? 1u : 0u; mine = (j == x) ? c : mine; }
        if (sum == G) break;
        __builtin_amdgcn_s_sleep(1);
        if ((++sp & 255u) == 0u) { if (xb_ld(&bar[XB_TMO])) break; if (sp > XB_SPIN_CAP) { atomicAdd(&bar[XB_TMO], 1u); break; } }
    }
    nloc = mine > 0u ? mine : 1u; nx = cnt > 0u ? cnt : 1u;
}
__device__ __forceinline__ void xcd_barrier(const XcdBarrier& b) {
    asm volatile("s_waitcnt vmcnt(0)" ::: "memory");
    __syncthreads();
    if (threadIdx.x == 0) {
        unsigned* bar = b.bar;
        __builtin_amdgcn_s_waitcnt(0);
        unsigned nloc = b.st[0], nx = b.st[1];
        if (nloc == 0u) { xcd_barrier_complete(bar, b.x, nloc, nx); b.st[0] = nloc; b.st[1] = nx; }
        const unsigned old = xb_add(&bar[XB_XSUB(b.x)], 1u);
        const unsigned gen = old / nloc;
        if (old + 1u == (gen + 1u) * nloc) {
            __builtin_amdgcn_fence(__ATOMIC_RELEASE, "agent");
            asm volatile("s_waitcnt vmcnt(0)" ::: "memory");
            const unsigned og = xb_add(&bar[XB_TOP], 1u);
            const unsigned tg = og / nx;
            if (og + 1u == (tg + 1u) * nx) xb_add(&bar[XB_TOPGEN], 1u);
            else XB_SPIN(xb_ld(&bar[XB_TOPGEN]) == tg, bar);
            __builtin_amdgcn_fence(__ATOMIC_ACQUIRE, "agent");
            xb_add(&bar[XB_XGEN(b.x)], 1u);
            asm volatile("s_waitcnt vmcnt(0)" ::: "memory");
        } else {
            XB_SPIN(xb_ld(&bar[XB_XGEN(b.x)]) == gen, bar);
            __builtin_amdgcn_fence(__ATOMIC_ACQUIRE, "agent");
            asm volatile("s_waitcnt vmcnt(0)" ::: "memory");
        }
    }
    __syncthreads();
}

__device__ __forceinline__ bf16_t f2bf(float f) { unsigned u = __float_as_uint(f); u += 0x7fffu + ((u >> 16) & 1u); return (bf16_t)(u >> 16); }
__device__ __forceinline__ float bf2f(bf16_t h) { return __uint_as_float(((unsigned)h) << 16); }
typedef __bf16 hbf2 __attribute__((ext_vector_type(2)));
typedef float f32x2 __attribute__((ext_vector_type(2)));
__device__ __forceinline__ unsigned pack2(float lo, float hi) { f32x2 v = {lo, hi}; return __builtin_bit_cast(unsigned, __builtin_convertvector(v, hbf2)); }
__device__ __forceinline__ float dot2bf(unsigned a, unsigned b, float c) { return __builtin_amdgcn_fdot2_f32_bf16(__builtin_bit_cast(hbf2, a), __builtin_bit_cast(hbf2, b), c, false); }
__device__ __forceinline__ float bflo(unsigned w) { return __uint_as_float(w << 16); }
__device__ __forceinline__ float bfhi(unsigned w) { return __uint_as_float(w & 0xffff0000u); }
__device__ __forceinline__ float wave_sum(float v) {
#pragma unroll
    for (int o = 32; o >= 1; o >>= 1) v += __shfl_xor(v, o);
    return v;
}
__device__ __forceinline__ float gelu_tanh(float x) {
    const float u = 0.7978845608028654f * (x + 0.044715f * x * x * x);
    const float e = __expf(-2.f * fabsf(u));
    float th = (1.f - e) / (1.f + e);
    th = u < 0.f ? -th : th;
    return 0.5f * x * (1.f + th);
}

__device__ void p0_cond(const Params& p, unsigned char* smem) {
    float* sc = (float*)smem;
    float* red = (float*)(smem + 16384);
    const int tid = threadIdx.x;
    for (int i = tid; i < 4 * D; i += NT) { const float v = p.c[i]; sc[i] = v / (1.f + __expf(-v)); }
    __syncthreads();
    const int cgp = tid & 15, kg = tid >> 4;
    for (int task = blockIdx.x; task < NCOND * D / 64; task += gridDim.x) {
        const int col0 = task * 64 + cgp * 4;
        float acc[4][4];
#pragma unroll
        for (int b = 0; b < 4; ++b)
#pragma unroll
            for (int j = 0; j < 4; ++j) acc[b][j] = 0.f;
#pragma unroll 1
        for (int k0 = 0; k0 < 32; k0 += 8) {
            f32x4 w[8];
#pragma unroll
            for (int j = 0; j < 8; ++j) w[j] = *(const f32x4*)(p.w_cond + (size_t)(kg + 32 * (k0 + j)) * (NCOND * D) + col0);
#pragma unroll
            for (int j = 0; j < 8; ++j)
#pragma unroll
                for (int b = 0; b < 4; ++b) { const float s = sc[b * D + kg + 32 * (k0 + j)];
#pragma unroll
                    for (int e = 0; e < 4; ++e) acc[b][e] += s * w[j][e]; }
        }
#pragma unroll
        for (int b = 0; b < 4; ++b)
#pragma unroll
            for (int j = 0; j < 4; ++j) red[(kg * 64 + cgp * 4 + j) * 4 + b] = acc[b][j];
        __syncthreads();
        if (tid < 256) {
            const int col = tid >> 2, b = tid & 3;
            float s = 0.f;
            for (int g = 0; g < 32; ++g) s += red[(g * 64 + col) * 4 + b];
            p.cond[(size_t)b * (NCOND * D) + task * 64 + col] = s + p.b_cond[task * 64 + col];
        }
        __syncthreads();
    }
}

__device__ void p0_tables(const Params& p) {
    const size_t gtid = (size_t)blockIdx.x * NT + threadIdx.x, gstride = (size_t)gridDim.x * NT;
    {
        const int li = threadIdx.x & 15;
        const size_t grp = gtid >> 4, ngrp = gstride >> 4;
        for (int which = 0; which < 2; ++which) {
            const float* src = which ? p.peer_v : p.peer_u; unsigned char* dst = which ? p.vb : p.ub; float* sdst = which ? p.sv : p.su;
            for (size_t row = grp; row < (size_t)2 * NEXP; row += ngrp) {
                f32x4 v[4][4]; float mx = 0.f;
#pragma unroll
                for (int c = 0; c < 4; ++c)
#pragma unroll
                    for (int j = 0; j < 4; ++j) {
                        v[c][j] = *(const f32x4*)(src + row * D + c * 256 + li * 16 + j * 4);
#pragma unroll
                        for (int e = 0; e < 4; ++e) mx = fmaxf(mx, fabsf(v[c][j][e]));
                    }
                mx = fmaxf(mx, __shfl_xor(mx, 1)); mx = fmaxf(mx, __shfl_xor(mx, 2)); mx = fmaxf(mx, __shfl_xor(mx, 4)); mx = fmaxf(mx, __shfl_xor(mx, 8));
                const float sc = mx > 0.f ? mx * (1.f / 448.f) : 1.f, inv = 1.f / sc;
#pragma unroll
                for (int c = 0; c < 4; ++c) {
                    u32x4 o;
#pragma unroll
                    for (int j = 0; j < 4; ++j) {
                        int r = 0;
                        r = __builtin_amdgcn_cvt_pk_fp8_f32(v[c][j][0] * inv, v[c][j][1] * inv, r, false);
                        r = __builtin_amdgcn_cvt_pk_fp8_f32(v[c][j][2] * inv, v[c][j][3] * inv, r, true);
                        o[j] = (unsigned)r;
                    }
                    *(u32x4*)(dst + row * D + c * 256 + li * 16) = o;
                }
                if (li == 0) sdst[row] = sc;
            }
        }
    }
    const size_t nk8 = (size_t)2 * 8 * 2 * 128 * 64 / 8;
    for (size_t i = gtid; i < nk8; i += gstride) {
        const f32x4 a = *(const f32x4*)(p.subkeys + i * 8), b = *(const f32x4*)(p.subkeys + i * 8 + 4);
        u32x4 o; o[0] = pack2(a[0], a[1]); o[1] = pack2(a[2], a[3]); o[2] = pack2(b[0], b[1]); o[3] = pack2(b[2], b[3]);
        *(u32x4*)(p.skeys + i * 8) = o;
    }
    for (size_t i = gtid; i < (size_t)T * 32; i += gstride) {
        const int t = (int)(i >> 5), f = (int)(i & 31);
        const float invrev = exp2f(-(float)f * 0.41524101186092029f) * 0.15915494309189535f;
        float rev = (float)p.pos[t] * invrev; rev -= floorf(rev);
        p.ropec[i] = __builtin_amdgcn_cosf(rev); p.ropes[i] = __builtin_amdgcn_sinf(rev);
    }
}

__device__ void transpose_tile(const float* W, int ldw, int n0, int k0, bf16_t* Wt, unsigned char* smem) {
    bf16_t* tl = (bf16_t*)smem;
    const int tid = threadIdx.x, kk = tid >> 3, nn = (tid & 7) * 8;
    const f32x4 a = *(const f32x4*)(W + (size_t)(k0 + kk) * ldw + n0 + nn), b = *(const f32x4*)(W + (size_t)(k0 + kk) * ldw + n0 + nn + 4);
#pragma unroll
    for (int j = 0; j < 4; ++j) { tl[(nn + j) * 72 + kk] = f2bf(a[j]); tl[(nn + 4 + j) * 72 + kk] = f2bf(b[j]); }
    __syncthreads();
    const int n = tid >> 3, kc = (tid & 7) * 8;
    const u32x4 v = *(const u32x4*)(tl + n * 72 + kc);
    *(u32x4*)(Wt + (size_t)(n0 + n) * D + k0 + kc) = v;
    __syncthreads();
}

__device__ void p0_wt(const Params& p, unsigned char* smem) {
    for (int task = blockIdx.x; task < 7 * 256 + 128; task += gridDim.x) {
        const int w = task >> 8, tl = task & 255;
        const float* W; bf16_t* Wt; int ldw = 1024;
        switch (w) {
            case 0: W = p.w_in; Wt = p.wt_in; break;
            case 1: W = p.w_glu; Wt = p.wt_glu; break;
            case 2: W = p.w_out; Wt = p.wt_out; break;
            case 3: W = p.w_q; Wt = p.wt_q; break;
            case 4: W = p.w_o; Wt = p.wt_o; break;
            case 5: W = p.peer_wq; Wt = p.wt_pq0; break;
            case 6: W = p.peer_wq + (size_t)D * D; Wt = p.wt_pq1; break;
            default: W = p.w_kv; Wt = p.wt_kv; ldw = 512; break;
        }
        const int ntn = ldw / 64, n0 = (tl % ntn) * 64, k0 = (tl / ntn) * 64;
        transpose_tile(W, ldw, n0, k0, Wt, smem);
    }
}

__device__ __forceinline__ void lam_powf(float ar, float ai, float dt, int n, float& re, float& im) {
    const float m = __expf(ar * dt * (float)n);
    float rev = (ai * dt) * (float)n * 0.15915494309189535f; rev -= floorf(rev);
    re = m * __builtin_amdgcn_cosf(rev); im = m * __builtin_amdgcn_sinf(rev);
}
__device__ __forceinline__ void s5_coeff(float ar, float ai, float dt, float& cre, float& cim) {
    const float a = ar * dt, th = ai * dt;
    float rev = th * 0.15915494309189535f; rev -= floorf(rev);
    float revh = th * 0.5f * 0.15915494309189535f; revh -= floorf(revh);
    const float cs = __builtin_amdgcn_cosf(rev), sn = __builtin_amdgcn_sinf(rev), sh = __builtin_amdgcn_sinf(revh);
    const float em1 = expm1f(a);
    const float nr = em1 * cs - 2.f * sh * sh, ni = (em1 + 1.f) * sn, den = ar * ar + ai * ai;
    cre = (nr * ar + ni * ai) / den; cim = (ni * ar - nr * ai) / den;
}

__device__ void p0_s5(const Params& p, unsigned char* smem) {
    const size_t gtid = (size_t)blockIdx.x * NT + threadIdx.x, gstride = (size_t)gridDim.x * NT;
    for (size_t idx = gtid; idx < (size_t)G5 * P5 * 65; idx += gstride) {
        const int pp = (int)(idx & 63), e = (int)((idx >> 6) % 65), g = (int)(idx / (65 * P5));
        const float dt = __expf(p.log_dt[g]), ar = p.a_re[g * P5 + pp], ai = p.a_im[g * P5 + pp];
        float pwr, pwi; lam_powf(ar, ai, dt, e, pwr, pwi);
        if (e < 64) {
            float cfr, cfi; s5_coeff(ar, ai, dt, cfr, cfi);
            const float wr = pwr * cfr - pwi * cfi, wi = pwr * cfi + pwi * cfr;
            const int j = 63 - e;
            const float* brp = p.b_re + ((size_t)g * P5 + pp) * C5; const float* bip = p.b_im + ((size_t)g * P5 + pp) * C5;
            unsigned ore[8], oim[8];
#pragma unroll
            for (int c4 = 0; c4 < 4; ++c4) {
                const f32x4 br = *(const f32x4*)(brp + c4 * 4), bi = *(const f32x4*)(bip + c4 * 4);
                ore[c4 * 2] = pack2(wr * br[0] - wi * bi[0], wr * br[1] - wi * bi[1]); ore[c4 * 2 + 1] = pack2(wr * br[2] - wi * bi[2], wr * br[3] - wi * bi[3]);
                oim[c4 * 2] = pack2(wr * bi[0] + wi * br[0], wr * bi[1] + wi * br[1]); oim[c4 * 2 + 1] = pack2(wr * bi[2] + wi * br[2], wr * bi[3] + wi * br[3]);
            }
            u32x4* sre = (u32x4*)(p.smat + ((size_t)g * 128 + pp) * 1024 + j * 16);
            u32x4* sim = (u32x4*)(p.smat + ((size_t)g * 128 + 64 + pp) * 1024 + j * 16);
            sre[0] = (u32x4){ore[0], ore[1], ore[2], ore[3]}; sre[1] = (u32x4){ore[4], ore[5], ore[6], ore[7]};
            sim[0] = (u32x4){oim[0], oim[1], oim[2], oim[3]}; sim[1] = (u32x4){oim[4], oim[5], oim[6], oim[7]};
        }
        if (e >= 1) {
            const int i = e - 1;
#pragma unroll 4
            for (int co = 0; co < 16; ++co) {
                const float cr = p.c_re[((size_t)g * C5 + co) * P5 + pp], ci = p.c_im[((size_t)g * C5 + co) * P5 + pp];
                bf16_t* row = p.cmat + ((size_t)g * 1024 + i * 16 + co) * 128;
                row[pp] = f2bf(cr * pwr - ci * pwi);
                row[64 + pp] = f2bf(-(cr * pwi + ci * pwr));
            }
        }
        if (e == 64) {
            const double dtd = exp((double)p.log_dt[g]), m = exp((double)ar * dtd * 64.0);
            double ang = (double)ai * dtd * 64.0; ang -= 6.283185307179586 * floor(ang * 0.15915494309189535);
            p.lamL[(g * P5 + pp) * 2] = (float)(m * cos(ang)); p.lamL[(g * P5 + pp) * 2 + 1] = (float)(m * sin(ang));
        }
    }
    float* wre = (float*)smem;
    float* wim = wre + 1024;
    const int tid = threadIdx.x;
    for (int task = blockIdx.x; task < G5 * 4; task += gridDim.x) {
        const int g = task >> 2, tq = task & 3;
        const float dt = __expf(p.log_dt[g]);
        for (int i = tid; i < 1024; i += NT) {
            const int pp = i & 63, tau = tq * 16 + (i >> 6);
            const float ar = p.a_re[g * P5 + pp], ai = p.a_im[g * P5 + pp];
            float pwr, pwi, cfr, cfi; lam_powf(ar, ai, dt, tau, pwr, pwi); s5_coeff(ar, ai, dt, cfr, cfi);
            wre[i] = pwr * cfr - pwi * cfi; wim[i] = pwr * cfi + pwi * cfr;
        }
        __syncthreads();
        {
            const int co = (tid >> 4) & 15, ci = tid & 15, ph = tid >> 8;
            float* part = wim + 1024;
            float cbr[32], cbi[32];
#pragma unroll 8
            for (int k = 0; k < 32; ++k) {
                const int pp = ph * 32 + k;
                const float br = p.b_re[((size_t)g * P5 + pp) * C5 + ci], bi = p.b_im[((size_t)g * P5 + pp) * C5 + ci];
                const float cr = p.c_re[((size_t)g * C5 + co) * P5 + pp], cim = p.c_im[((size_t)g * C5 + co) * P5 + pp];
                cbr[k] = cr * br - cim * bi; cbi[k] = cr * bi + cim * br;
            }
            float sres[16];
#pragma unroll
            for (int tl = 0; tl < 16; ++tl) {
                float s0 = 0.f, s1 = 0.f;
#pragma unroll
                for (int k = 0; k < 32; k += 2) {
                    s0 += cbr[k] * wre[tl * 64 + ph * 32 + k] - cbi[k] * wim[tl * 64 + ph * 32 + k];
                    s1 += cbr[k + 1] * wre[tl * 64 + ph * 32 + k + 1] - cbi[k + 1] * wim[tl * 64 + ph * 32 + k + 1];
                }
                sres[tl] = s0 + s1;
            }
            if (ph == 1) {
#pragma unroll
                for (int tl = 0; tl < 16; ++tl) part[tl * 256 + (tid & 255)] = sres[tl];
            }
            __syncthreads();
            if (ph == 0) {
#pragma unroll
                for (int tl = 0; tl < 16; ++tl) p.ktab[((size_t)g * KTR + tq * 16 + tl + 8) * 256 + tid] = f2bf(sres[tl] + part[tl * 256 + tid]);
                if (tq == 0) {
#pragma unroll
                    for (int r = 0; r < 8; ++r) p.ktab[((size_t)g * KTR + r) * 256 + tid] = 0;
                }
            }
        }
        __syncthreads();
    }
}

__device__ void p05_prep(const Params& p, unsigned char* smem) {
    {
        const int lane = threadIdx.x & 63, wv = threadIdx.x >> 6;
        const int nw = gridDim.x * (NT / 64);
        for (int t = blockIdx.x * (NT / 64) + wv; t < T; t += nw) {
            const int b = t / SEQ;
            const float* xr = p.x + (size_t)t * D; const float* cb = p.cond + (size_t)b * (NCOND * D);
            f32x4 v[4]; float s = 0.f;
#pragma unroll
            for (int j = 0; j < 4; ++j) { v[j] = *(const f32x4*)(xr + j * 256 + lane * 4); s += v[j][0] * v[j][0] + v[j][1] * v[j][1] + v[j][2] * v[j][2] + v[j][3] * v[j][3]; }
            s = wave_sum(s);
            const float rstd = rsqrtf(s * (1.f / D) + RMS_EPS);
#pragma unroll
            for (int j = 0; j < 4; ++j) {
                const int e = j * 256 + lane * 4;
                const f32x4 g = *(const f32x4*)(p.norm_mix + e), sh = *(const f32x4*)(cb + 0 * D + e), sc = *(const f32x4*)(cb + 1 * D + e);
                float h[4];
#pragma unroll
                for (int i = 0; i < 4; ++i) h[i] = v[j][i] * rstd * g[i] * (1.f + sc[i]) + sh[i];
                u32x2 o; o[0] = pack2(h[0], h[1]); o[1] = pack2(h[2], h[3]);
                *(u32x2*)(p.s0 + (size_t)t * D + e) = o;
            }
        }
    }
    float* red = (float*)smem;
    const int tid = threadIdx.x;
    for (int task = blockIdx.x; task < 32 * 8; task += gridDim.x) {
        const int ct = task >> 3, ks = task & 7, col0 = ct * 64, layer = col0 >> 10;
        const float* W = p.peer_wq + (size_t)layer * D * D; const int cs = layer ? 9 : 3;
        const int n = (col0 & 1023) + (tid & 63), kg = tid >> 6;
        float wv[16];
#pragma unroll
        for (int j = 0; j < 16; ++j) wv[j] = W[(size_t)(ks * 128 + kg * 16 + j) * D + n];
        float acc[4] = {0.f, 0.f, 0.f, 0.f};
#pragma unroll
        for (int j = 0; j < 16; ++j)
#pragma unroll
            for (int b = 0; b < 4; ++b) acc[b] += p.cond[(size_t)b * (NCOND * D) + cs * D + ks * 128 + kg * 16 + j] * wv[j];
#pragma unroll
        for (int b = 0; b < 4; ++b) red[(kg * 64 + (tid & 63)) * 4 + b] = acc[b];
        __syncthreads();
        if (tid < 256) {
            const int col = tid >> 2, b = tid & 3; float sum = 0.f;
#pragma unroll
            for (int g = 0; g < 8; ++g) sum += red[(g * 64 + col) * 4 + b];
            p.biasp[((size_t)ks * 4 + b) * 2048 + col0 + col] = sum;
        }
        __syncthreads();
    }
}
__device__ void bias_finalize(const Params& p) {
    const int i = blockIdx.x * NT + threadIdx.x;
    if (i < 4 * 2048) { float s = 0.f;
#pragma unroll
        for (int ks = 0; ks < 8; ++ks) s += p.biasp[(size_t)ks * 8192 + i];
        p.bias[i] = s; }
}

__device__ __forceinline__ int lds_off(int row, int chunk) { return row * 128 + ((chunk ^ (row & 7)) << 4); }

template <class Epi>
__device__ void gemm_phase(const bf16_t* __restrict__ A, const bf16_t* __restrict__ Bt, size_t bt_batch_stride, int N, const Epi& epi, unsigned char* smem) {
    const int tid = threadIdx.x, lane = tid & 63, w = tid >> 6, wm = w >> 1, wn = w & 1, tk = lane & 15, q = lane >> 4;
    const int nN = N / 128;
    const bool xmap = (gridDim.x % 8) == 0;
    const int nslots = xmap ? gridDim.x / 8 : gridDim.x, slot = xmap ? (blockIdx.x >> 3) : blockIdx.x, xcd = blockIdx.x & 7;
    const int nitems = xmap ? 8 * nN : 64 * nN;
    for (int item = slot; item < nitems; item += nslots) {
        const int pm = xmap ? xcd * 8 + item / nN : item / nN, pn = item % nN;
        const int m0 = pm * 256, n0 = pn * 128, b = m0 / SEQ;
        const bf16_t* Ab = A + (size_t)m0 * D;
        const bf16_t* Bb = Bt + (size_t)b * bt_batch_stride + (size_t)n0 * D;
        f32x4 acc[4][4];
#pragma unroll
        for (int mi = 0; mi < 4; ++mi)
#pragma unroll
            for (int ni = 0; ni < 4; ++ni) acc[mi][ni] = (f32x4){0.f, 0.f, 0.f, 0.f};
        u32x4 ra[4], rb[2];
        auto gload = [&](int kt) {
#pragma unroll
            for (int i = 0; i < 4; ++i) { const int id = tid + NT * i, row = id >> 3, c = id & 7; ra[i] = *(const u32x4*)(Ab + (size_t)row * D + kt * 64 + c * 8); }
#pragma unroll
            for (int i = 0; i < 2; ++i) { const int id = tid + NT * i, row = id >> 3, c = id & 7; rb[i] = *(const u32x4*)(Bb + (size_t)row * D + kt * 64 + c * 8); }
        };
        auto lstore = [&](int buf) {
            unsigned char* sA = smem + buf * 32768; unsigned char* sB = smem + 65536 + buf * 16384;
#pragma unroll
            for (int i = 0; i < 4; ++i) { const int id = tid + NT * i, row = id >> 3, c = id & 7; *(u32x4*)(sA + lds_off(row, c)) = ra[i]; }
#pragma unroll
            for (int i = 0; i < 2; ++i) { const int id = tid + NT * i, row = id >> 3, c = id & 7; *(u32x4*)(sB + lds_off(row, c)) = rb[i]; }
        };
        gload(0); lstore(0);
        __syncthreads();
        for (int kt = 0; kt < 16; ++kt) {
            if (kt + 1 < 16) gload(kt + 1);
            const unsigned char* sA = smem + (kt & 1) * 32768; const unsigned char* sB = smem + 65536 + (kt & 1) * 16384;
#pragma unroll
            for (int ks = 0; ks < 2; ++ks) {
                bf16x8 af[4], bfr[4];
#pragma unroll
                for (int mi = 0; mi < 4; ++mi) af[mi] = *(const bf16x8*)(sA + lds_off(wm * 64 + mi * 16 + tk, ks * 4 + q));
#pragma unroll
                for (int ni = 0; ni < 4; ++ni) bfr[ni] = *(const bf16x8*)(sB + lds_off(wn * 64 + ni * 16 + tk, ks * 4 + q));
#pragma unroll
                for (int mi = 0; mi < 4; ++mi)
#pragma unroll
                    for (int ni = 0; ni < 4; ++ni) acc[mi][ni] = __builtin_amdgcn_mfma_f32_16x16x32_bf16(bfr[ni], af[mi], acc[mi][ni], 0, 0, 0);
            }
            if (kt + 1 < 16) lstore((kt + 1) & 1);
            __syncthreads();
        }
        epi(acc, m0 + wm * 64, n0 + wn * 64, b, pn * 2 + wn, tk, q);
    }
}

__device__ __forceinline__ float rstd_of(const float* ssq, int token) {
    const f32x4* s4 = (const f32x4*)(ssq + (size_t)token * 16);
    const f32x4 a = s4[0], b = s4[1], c = s4[2], d = s4[3];
    const float s = ((a[0] + a[1]) + (a[2] + a[3])) + ((b[0] + b[1]) + (b[2] + b[3])) + ((c[0] + c[1]) + (c[2] + c[3])) + ((d[0] + d[1]) + (d[2] + d[3]));
    return rsqrtf(s * (1.f / D) + RMS_EPS);
}

struct EpiU {
    bf16_t* ug;
    __device__ __forceinline__ void operator()(const f32x4 (&acc)[4][4], int mbase, int nbase, int b, int, int tk, int q) const {
#pragma unroll
        for (int mi = 0; mi < 4; ++mi) {
            const int token = mbase + mi * 16 + tk, s = token - b * SEQ;
#pragma unroll
            for (int ni = 0; ni < 4; ++ni) {
                const int n = nbase + ni * 16 + 4 * q, g = n >> 4;
                u32x2 o; o[0] = pack2(acc[mi][ni][0], acc[mi][ni][1]); o[1] = pack2(acc[mi][ni][2], acc[mi][ni][3]);
                *(u32x2*)(ug + (((size_t)(g * 4 + b) * SEQ + s) * 16 + 4 * q)) = o;
            }
        }
    }
};
struct EpiQ {
    const float* ssq; const float* bias; int boff; bf16_t* out;
    __device__ __forceinline__ void operator()(const f32x4 (&acc)[4][4], int mbase, int nbase, int b, int, int tk, int q) const {
#pragma unroll
        for (int mi = 0; mi < 4; ++mi) {
            const int token = mbase + mi * 16 + tk;
            const float rstd = rstd_of(ssq, token);
#pragma unroll
            for (int ni = 0; ni < 4; ++ni) {
                const int n = nbase + ni * 16 + 4 * q;
                const f32x4 bv = *(const f32x4*)(bias + (size_t)b * 2048 + boff + n);
                u32x2 o; o[0] = pack2(rstd * acc[mi][ni][0] + bv[0], rstd * acc[mi][ni][1] + bv[1]); o[1] = pack2(rstd * acc[mi][ni][2] + bv[2], rstd * acc[mi][ni][3] + bv[3]);
                *(u32x2*)(out + (size_t)token * D + n) = o;
            }
        }
    }
};
struct EpiGlu {
    const bf16_t* y; const float* bglu; bf16_t* out;
    __device__ __forceinline__ void operator()(const f32x4 (&acc)[4][4], int mbase, int nbase, int, int, int tk, int q) const {
#pragma unroll
        for (int mi = 0; mi < 4; ++mi) {
            const int token = mbase + mi * 16 + tk;
#pragma unroll
            for (int ni = 0; ni < 4; ++ni) {
                const int n = nbase + ni * 16 + 4 * q;
                const f32x4 bv = *(const f32x4*)(bglu + n);
                const u32x2 yv = *(const u32x2*)(y + (size_t)token * D + n);
                float o[4];
                const float y0 = bflo(yv[0]), y1 = bfhi(yv[0]), y2 = bflo(yv[1]), y3 = bfhi(yv[1]);
                o[0] = y0 / (1.f + __expf(-(acc[mi][ni][0] + bv[0]))); o[1] = y1 / (1.f + __expf(-(acc[mi][ni][1] + bv[1])));
                o[2] = y2 / (1.f + __expf(-(acc[mi][ni][2] + bv[2]))); o[3] = y3 / (1.f + __expf(-(acc[mi][ni][3] + bv[3])));
                u32x2 ov; ov[0] = pack2(o[0], o[1]); ov[1] = pack2(o[2], o[3]);
                *(u32x2*)(out + (size_t)token * D + n) = ov;
            }
        }
    }
};
struct EpiRes {
    const float* xold; const float* gate  ; const float* gnorm; const float* scale  ; float* xout; bf16_t* xbout; float* ssq;
    __device__ __forceinline__ void operator()(const f32x4 (&acc)[4][4], int mbase, int nbase, int b, int slot, int tk, int q) const {
#pragma unroll
        for (int mi = 0; mi < 4; ++mi) {
            const int token = mbase + mi * 16 + tk;
            float ss = 0.f;
#pragma unroll
            for (int ni = 0; ni < 4; ++ni) {
                const int n = nbase + ni * 16 + 4 * q;
                const f32x4 gv = *(const f32x4*)(gate + (size_t)b * (NCOND * D) + n), gn = *(const f32x4*)(gnorm + n), sc = *(const f32x4*)(scale + (size_t)b * (NCOND * D) + n);
                const f32x4 xo = *(const f32x4*)(xold + (size_t)token * D + n);
                f32x4 xn; float hs[4];
#pragma unroll
                for (int r = 0; r < 4; ++r) { xn[r] = xo[r] + gv[r] * acc[mi][ni][r]; ss += xn[r] * xn[r]; hs[r] = xn[r] * gn[r] * (1.f + sc[r]); }
                *(f32x4*)(xout + (size_t)token * D + n) = xn;
                u32x2 ov; ov[0] = pack2(hs[0], hs[1]); ov[1] = pack2(hs[2], hs[3]);
                *(u32x2*)(xbout + (size_t)token * D + n) = ov;
            }
            ss += __shfl_xor(ss, 16); ss += __shfl_xor(ss, 32);
            if (q == 0) ssq[(size_t)token * 16 + slot] = ss;
        }
    }
};
template <int MODE  >
struct EpiRope {
    const float* ropec; const float* ropes; bf16_t* o0; bf16_t* o1;
    __device__ __forceinline__ void operator()(const f32x4 (&acc)[4][4], int mbase, int nbase, int, int, int tk, int q) const {
        const bool rope = MODE == 1 || nbase < 256;
#pragma unroll
        for (int mi = 0; mi < 4; ++mi) {
            const int token = mbase + mi * 16 + tk;
            float v[4][4];
#pragma unroll
            for (int ni = 0; ni < 4; ++ni)
#pragma unroll
                for (int r = 0; r < 4; ++r) v[ni][r] = acc[mi][ni][r];
            if (rope) {
#pragma unroll
                for (int ni = 0; ni < 2; ++ni) {
                    const f32x4 cs = *(const f32x4*)(ropec + (size_t)token * 32 + ni * 16 + 4 * q), sn = *(const f32x4*)(ropes + (size_t)token * 32 + ni * 16 + 4 * q);
#pragma unroll
                    for (int r = 0; r < 4; ++r) { const float t1 = v[ni][r], t2 = v[ni + 2][r]; v[ni][r] = t1 * cs[r] - t2 * sn[r]; v[ni + 2][r] = t2 * cs[r] + t1 * sn[r]; }
                }
            }
            bf16_t* dst = MODE == 1 ? o0 + (size_t)token * D + nbase : (nbase < 256 ? o0 + (size_t)token * 256 + nbase : o1 + (size_t)token * 256 + (nbase - 256));
#pragma unroll
            for (int ni = 0; ni < 4; ++ni) { u32x2 o; o[0] = pack2(v[ni][0], v[ni][1]); o[1] = pack2(v[ni][2], v[ni][3]); *(u32x2*)(dst + ni * 16 + 4 * q) = o; }
        }
    }
};

__device__ void s5_phase(const Params& p, unsigned char* smem) {
    bf16_t* ktl = (bf16_t*)smem;
    float* Sl = (float*)(smem + 36864);
    bf16_t* Xl = (bf16_t*)(smem + 36864 + 33280);
    const int tid = threadIdx.x, lane = tid & 63, w = tid >> 6, cb = w & 3, hh = w >> 2, tk = lane & 15, q = lane >> 4;
    for (int task = blockIdx.x; task < G5 * NB; task += gridDim.x) {
        const int g = (task & 7) * 8 + ((task >> 3) >> 2), b = (task >> 3) & 3;
        const bf16_t* U = p.s1 + (size_t)(g * 4 + b) * SEQ * 16;
        const bf16_t* sm = p.smat + (size_t)g * 128 * 1024;
        const bf16_t* cm = p.cmat + (size_t)g * 1024 * 128;
        for (int i = tid; i < KTR * 256 * 2 / 16; i += NT) ((u32x4*)ktl)[i] = ((const u32x4*)(p.ktab + (size_t)g * KTR * 256))[i];
        bf16x8 ufr[32];
#pragma unroll
        for (int ks = 0; ks < 32; ++ks) ufr[ks] = *(const bf16x8*)(U + (size_t)(cb * 16 + tk) * 1024 + ks * 32 + 8 * q);
#pragma unroll 1
        for (int mf = 0; mf < 4; ++mf) {
            const int r0 = (hh * 4 + mf) * 16;
            const bf16_t* ap = sm + (size_t)(r0 + tk) * 1024 + 8 * q;
            f32x4 acc = {0.f, 0.f, 0.f, 0.f};
#pragma unroll
            for (int k8 = 0; k8 < 4; ++k8) {
                bf16x8 af[8];
#pragma unroll
                for (int j = 0; j < 8; ++j) af[j] = *(const bf16x8*)(ap + (k8 * 8 + j) * 32);
#pragma unroll
                for (int j = 0; j < 8; ++j) acc = __builtin_amdgcn_mfma_f32_16x16x32_bf16(af[j], ufr[k8 * 8 + j], acc, 0, 0, 0);
            }
#pragma unroll
            for (int r = 0; r < 4; ++r) Sl[(r0 + 4 * q + r) * 65 + cb * 16 + tk] = acc[r];
        }
        __syncthreads();
        if (w == 0) {
            const float lr = p.lamL[(g * P5 + lane) * 2], li = p.lamL[(g * P5 + lane) * 2 + 1];
            float xr = 0.f, xi = 0.f;
            for (int k = 0; k < NCH; ++k) {
                Xl[k * 128 + lane] = f2bf(xr); Xl[k * 128 + 64 + lane] = f2bf(xi);
                const float sr = Sl[lane * 65 + k], si = Sl[(64 + lane) * 65 + k];
                const float nr = lr * xr - li * xi + sr, ni = lr * xi + li * xr + si;
                xr = nr; xi = ni;
            }
        }
        __syncthreads();
        bf16x8 xfr[4];
#pragma unroll
        for (int ks = 0; ks < 4; ++ks) xfr[ks] = *(const bf16x8*)(Xl + (cb * 16 + tk) * 128 + ks * 32 + 8 * q);
        const f32x4 dv = *(const f32x4*)(p.s5d + g * 16 + 4 * q);
        const int jl = q >> 1, cih = q & 1;
        const bf16_t* kbase = ktl + (8 - jl) * 256 + tk * 16 + cih * 8;
        const bf16_t* cmb = cm + (size_t)tk * 128 + 8 * q;
        auto iof = [&](int ii) { return hh ? 16 + ii : (ii < 16 ? ii : 32 + ii); };
        bf16x8 cf[4];
#pragma unroll
        for (int ks = 0; ks < 4; ++ks) cf[ks] = *(const bf16x8*)(cmb + (size_t)iof(0) * 2048 + ks * 32);
#pragma unroll 1
        for (int ii = 0; ii < 32; ++ii) {
            const int i = iof(ii), inext = iof(ii < 31 ? ii + 1 : ii);
            bf16x8 cfn[4];
#pragma unroll
            for (int ks = 0; ks < 4; ++ks) cfn[ks] = *(const bf16x8*)(cmb + (size_t)inext * 2048 + ks * 32);
            const int s = (cb * 16 + tk) * 64 + i;
            const u32x2 uv = *(const u32x2*)(U + (size_t)s * 16 + 4 * q);
            f32x4 acc = {0.f, 0.f, 0.f, 0.f};
#pragma unroll
            for (int ks = 0; ks < 4; ++ks) acc = __builtin_amdgcn_mfma_f32_16x16x32_bf16(cf[ks], xfr[ks], acc, 0, 0, 0);
            const int mmax = i >> 1;
            const bf16_t* kb = kbase + i * 256;
#pragma unroll
            for (int mg = 0; mg < 8; ++mg) {
                if (4 * mg <= mmax) {
                    bf16x8 kf[4];
#pragma unroll
                    for (int j = 0; j < 4; ++j) kf[j] = *(const bf16x8*)(kb - (4 * mg + j) * 512);
#pragma unroll
                    for (int j = 0; j < 4; ++j) acc = __builtin_amdgcn_mfma_f32_16x16x32_bf16(kf[j], ufr[4 * mg + j], acc, 0, 0, 0);
                }
            }
            const float y0 = gelu_tanh(acc[0] + dv[0] * bflo(uv[0])), y1 = gelu_tanh(acc[1] + dv[1] * bfhi(uv[0]));
            const float y2 = gelu_tanh(acc[2] + dv[2] * bflo(uv[1])), y3 = gelu_tanh(acc[3] + dv[3] * bfhi(uv[1]));
            u32x2 o; o[0] = pack2(y0, y1); o[1] = pack2(y2, y3);
            *(u32x2*)(p.s0 + ((size_t)b * SEQ + s) * D + g * 16 + 4 * q) = o;
#pragma unroll
            for (int ks = 0; ks < 4; ++ks) cf[ks] = cfn[ks];
        }
        __syncthreads();
    }
}

__device__ __forceinline__ float med3f(float a, float b, float c) { return __builtin_amdgcn_fmed3f(a, b, c); }
__device__ __forceinline__ void ins16(float (&a)[16], float v) {
#pragma unroll
    for (int i = 15; i >= 1; --i) a[i] = med3f(a[i - 1], a[i], v);
    a[0] = fmaxf(a[0], v);
}
__device__ void route_phase(const Params& p, int layer, const bf16_t* qp, unsigned char* smem) {
    float* sc = (float*)smem;
    float* tl = (float*)(smem + 2 * 128 * 129 * 4);
    const int tid = threadIdx.x, lane = tid & 63, w = tid >> 6, tk = lane & 15, q = lane >> 4;
    for (int task = blockIdx.x; task < (T / 128) * 8; task += gridDim.x) {
        const int h = task & 7, t0 = (task >> 3) * 128;
#pragma unroll 1
        for (int pp = 0; pp < 2; ++pp) {
            const bf16_t* qrow = qp + (size_t)(t0 + 16 * w + tk) * D + h * 128 + pp * 64 + 8 * q;
            const bf16x8 a0 = *(const bf16x8*)(qrow), a1 = *(const bf16x8*)(qrow + 32);
            const bf16_t* kb = p.skeys + ((size_t)((layer * 8 + h) * 2 + pp) * 128) * 64 + 8 * q;
#pragma unroll
            for (int nf = 0; nf < 8; ++nf) {
                const bf16x8 b0 = *(const bf16x8*)(kb + (size_t)(nf * 16 + tk) * 64), b1 = *(const bf16x8*)(kb + (size_t)(nf * 16 + tk) * 64 + 32);
                f32x4 acc = {0.f, 0.f, 0.f, 0.f};
                acc = __builtin_amdgcn_mfma_f32_16x16x32_bf16(a0, b0, acc, 0, 0, 0);
                acc = __builtin_amdgcn_mfma_f32_16x16x32_bf16(a1, b1, acc, 0, 0, 0);
#pragma unroll
                for (int r = 0; r < 4; ++r) sc[(pp * 128 + 16 * w + 4 * q + r) * 129 + nf * 16 + tk] = acc[r];
            }
        }
        __syncthreads();
        {
            const int list = tid & 255, kr = tid >> 8;
            float a[16];
#pragma unroll
            for (int i = 0; i < 16; ++i) a[i] = -3.0e38f;
            const float* row = sc + list * 129 + kr * 64;
            for (int j = 0; j < 64; ++j) {
                const float v = __uint_as_float((__float_as_uint(row[j]) & ~0x7Fu) | (unsigned)(kr * 64 + j));
                ins16(a, v);
            }
            if (kr == 1) {
#pragma unroll
                for (int i = 0; i < 16; ++i) tl[list * 16 + i] = a[i];
            }
            __syncthreads();
            if (kr == 0) {
                float o[16];
#pragma unroll
                for (int i = 0; i < 16; ++i) o[i] = tl[list * 16 + i];
#pragma unroll
                for (int i = 0; i < 16; ++i) ins16(a, o[i]);
#pragma unroll
                for (int i = 0; i < 16; ++i) tl[list * 16 + i] = a[i];
            }
            __syncthreads();
        }
        if (tid < 128) {
            float s[16], r[16], c[16];
#pragma unroll
            for (int i = 0; i < 16; ++i) { s[i] = tl[tid * 16 + i]; r[i] = tl[(128 + tid) * 16 + i]; c[i] = -3.0e38f; }
#pragma unroll
            for (int i = 0; i < 16; ++i)
#pragma unroll
                for (int j = 0; j < 16; ++j)
                    if ((i + 1) * (j + 1) <= 16) {
                        const float v = __uint_as_float((__float_as_uint(s[i] + r[j]) & ~0xFFu) | (unsigned)(i * 16 + j));
                        ins16(c, v);
                    }
            float e[16], sum = 0.f;
#pragma unroll
            for (int k = 0; k < 16; ++k) { e[k] = __expf(c[k] - c[0]); sum += e[k]; }
            const float inv = 1.f / sum;
            int idv[16];
#pragma unroll
            for (int k = 0; k < 16; ++k) {
                const unsigned bits = __float_as_uint(c[k]), i = (bits >> 4) & 15u, j = bits & 15u;
                const unsigned ki = __float_as_uint(tl[tid * 16 + i]) & 0x7Fu, kj = __float_as_uint(tl[(128 + tid) * 16 + j]) & 0x7Fu;
                idv[k] = (int)(ki * 128u + kj);
            }
            int* ido = p.ids + (size_t)(t0 + tid) * 128 + h * 16; float* go = p.gates + (size_t)(t0 + tid) * 128 + h * 16;
#pragma unroll
            for (int k4 = 0; k4 < 4; ++k4) {
                *(int4*)(ido + k4 * 4) = make_int4(idv[k4 * 4], idv[k4 * 4 + 1], idv[k4 * 4 + 2], idv[k4 * 4 + 3]);
                *(f32x4*)(go + k4 * 4) = (f32x4){e[k4 * 4] * inv, e[k4 * 4 + 1] * inv, e[k4 * 4 + 2] * inv, e[k4 * 4 + 3] * inv};
            }
        }
        __syncthreads();
    }
}

struct RowBuf { u32x4 w[4]; float sc; };
template <bool FINAL>
__device__ void gather_phase(const Params& p, int layer, const float* xin, float* xout, bf16_t* hkv_out, bf16_t* hq_out, const float* gnorm, int c_shift, int c_scale, int c_gate) {
    const int lane = threadIdx.x & 63, wv = threadIdx.x >> 6, li = lane & 15, qg = lane >> 4;
    const int nw = gridDim.x * (NT / 64);
    const unsigned char* utab = p.ub + (size_t)layer * NEXP * D;
    const unsigned char* vtab = p.vb + (size_t)layer * NEXP * D;
    const float* sutab = p.su + (size_t)layer * NEXP;
    const float* svtab = p.sv + (size_t)layer * NEXP;
    for (int t = blockIdx.x * (NT / 64) + wv; t < T; t += nw) {
        const int b = t / SEQ;
        const float* cb = p.cond + (size_t)b * (NCOND * D);
        const float* xr = xin + (size_t)t * D;
        float hf[4][16];
        {
            float ss = 0.f;
#pragma unroll
            for (int c = 0; c < 4; ++c)
#pragma unroll
                for (int j = 0; j < 4; ++j) {
                    const f32x4 v = *(const f32x4*)(xr + c * 256 + li * 16 + j * 4);
#pragma unroll
                    for (int e = 0; e < 4; ++e) { hf[c][j * 4 + e] = v[e]; ss += v[e] * v[e]; }
                }
            ss += __shfl_xor(ss, 1); ss += __shfl_xor(ss, 2); ss += __shfl_xor(ss, 4); ss += __shfl_xor(ss, 8);
            const float rstd = rsqrtf(ss * (1.f / D) + RMS_EPS);
#pragma unroll
            for (int c = 0; c < 4; ++c)
#pragma unroll
                for (int j = 0; j < 4; ++j) {
                    const int e0 = c * 256 + li * 16 + j * 4;
                    const f32x4 g = *(const f32x4*)(gnorm + e0), sc = *(const f32x4*)(cb + c_scale * D + e0), sh = *(const f32x4*)(cb + c_shift * D + e0);
#pragma unroll
                    for (int e = 0; e < 4; ++e) hf[c][j * 4 + e] = hf[c][j * 4 + e] * rstd * g[e] * (1.f + sc[e]) + sh[e];
                }
        }
        const int idA = p.ids[(size_t)t * 128 + lane], idB = p.ids[(size_t)t * 128 + 64 + lane];
        const float gA = p.gates[(size_t)t * 128 + lane], gB = p.gates[(size_t)t * 128 + 64 + lane];
        float actA = 0.f, actB = 0.f;
        RowBuf bufA, bufB;
        auto issue = [&](RowBuf& buf, const unsigned char* tab, const float* stab, int m) {
            const int id = __shfl(m < 16 ? idA : idB, (4 * m + qg) & 63);
            const unsigned char* rp = tab + (size_t)id * D + li * 16;
#pragma unroll
            for (int c = 0; c < 4; ++c) buf.w[c] = *(const u32x4*)(rp + c * 256);
            buf.sc = stab[id];
        };
        auto consume_u = [&](const RowBuf& buf, int m) {
            float d0 = 0.f, d1 = 0.f;
#pragma unroll
            for (int c = 0; c < 4; ++c)
#pragma unroll
                for (int j = 0; j < 4; ++j) {
                    const f32x2 lo = __builtin_amdgcn_cvt_pk_f32_fp8((int)buf.w[c][j], false), hi = __builtin_amdgcn_cvt_pk_f32_fp8((int)buf.w[c][j], true);
                    d0 += lo[0] * hf[c][j * 4]; d1 += lo[1] * hf[c][j * 4 + 1]; d0 += hi[0] * hf[c][j * 4 + 2]; d1 += hi[1] * hf[c][j * 4 + 3];
                }
            float d = d0 + d1;
            d += __shfl_xor(d, 1); d += __shfl_xor(d, 2); d += __shfl_xor(d, 4); d += __shfl_xor(d, 8);
            const float gt = __shfl(m < 16 ? gA : gB, (4 * m + qg) & 63);
            const float a = gelu_tanh(d * buf.sc) * gt;
            if (li == (m & 15)) { if (m < 16) actA = a; else actB = a; }
        };
        issue(bufA, utab, sutab, 0);
#pragma unroll 1
        for (int m = 0; m < 32; m += 2) {
            issue(bufB, utab, sutab, m + 1);
            consume_u(bufA, m);
            if (m + 2 < 32) issue(bufA, utab, sutab, m + 2);
            consume_u(bufB, m + 1);
        }
        float o[4][16];
#pragma unroll
        for (int c = 0; c < 4; ++c)
#pragma unroll
            for (int e = 0; e < 16; ++e) o[c][e] = 0.f;
        auto consume_v = [&](const RowBuf& buf, int m) {
            const float a = __shfl(m < 16 ? actA : actB, (lane & 48) | (m & 15)) * buf.sc;
#pragma unroll
            for (int c = 0; c < 4; ++c)
#pragma unroll
                for (int j = 0; j < 4; ++j) {
                    const f32x2 lo = __builtin_amdgcn_cvt_pk_f32_fp8((int)buf.w[c][j], false), hi = __builtin_amdgcn_cvt_pk_f32_fp8((int)buf.w[c][j], true);
                    o[c][j * 4] += a * lo[0]; o[c][j * 4 + 1] += a * lo[1]; o[c][j * 4 + 2] += a * hi[0]; o[c][j * 4 + 3] += a * hi[1];
                }
        };
        issue(bufA, vtab, svtab, 0);
#pragma unroll 1
        for (int m = 0; m < 32; m += 2) {
            issue(bufB, vtab, svtab, m + 1);
            consume_v(bufA, m);
            if (m + 2 < 32) issue(bufA, vtab, svtab, m + 2);
            consume_v(bufB, m + 1);
        }
#pragma unroll
        for (int c = 0; c < 4; ++c)
#pragma unroll
            for (int e = 0; e < 16; ++e) { o[c][e] += __shfl_xor(o[c][e], 16); o[c][e] += __shfl_xor(o[c][e], 32); }
        float xn[16]; float ss = 0.f;
        const int e0 = qg * 256 + li * 16;
#pragma unroll
        for (int j = 0; j < 4; ++j) {
            const f32x4 xo = *(const f32x4*)(xr + e0 + j * 4), gv = *(const f32x4*)(cb + c_gate * D + e0 + j * 4);
#pragma unroll
            for (int e = 0; e < 4; ++e) {
                const int k = j * 4 + e;
                const float ov = qg == 0 ? o[0][k] : (qg == 1 ? o[1][k] : (qg == 2 ? o[2][k] : o[3][k]));
                const float v = xo[e] + gv[e] * ov;
                xn[k] = v; ss += v * v;
            }
        }
        ss = wave_sum(ss);
        const float rstd = rsqrtf(ss * (1.f / D) + RMS_EPS);
        if (!FINAL) {
#pragma unroll
            for (int j = 0; j < 4; ++j) *(f32x4*)(xout + (size_t)t * D + e0 + j * 4) = (f32x4){xn[j * 4], xn[j * 4 + 1], xn[j * 4 + 2], xn[j * 4 + 3]};
            float hk[16], hq[16];
#pragma unroll
            for (int j = 0; j < 4; ++j) {
                const f32x4 gk = *(const f32x4*)(p.kv_norm + e0 + j * 4), sck = *(const f32x4*)(cb + 13 * D + e0 + j * 4), shk = *(const f32x4*)(cb + 12 * D + e0 + j * 4);
                const f32x4 gm = *(const f32x4*)(p.norm_mix + D + e0 + j * 4), scm = *(const f32x4*)(cb + 7 * D + e0 + j * 4), shm = *(const f32x4*)(cb + 6 * D + e0 + j * 4);
#pragma unroll
                for (int e = 0; e < 4; ++e) {
                    const float xs = xn[j * 4 + e] * rstd;
                    hk[j * 4 + e] = xs * gk[e] * (1.f + sck[e]) + shk[e]; hq[j * 4 + e] = xs * gm[e] * (1.f + scm[e]) + shm[e];
                }
            }
#pragma unroll
            for (int j = 0; j < 2; ++j) {
                u32x4 ob; ob[0] = pack2(hk[j * 8], hk[j * 8 + 1]); ob[1] = pack2(hk[j * 8 + 2], hk[j * 8 + 3]); ob[2] = pack2(hk[j * 8 + 4], hk[j * 8 + 5]); ob[3] = pack2(hk[j * 8 + 6], hk[j * 8 + 7]);
                *(u32x4*)(hkv_out + (size_t)t * D + e0 + j * 8) = ob;
                u32x4 oc; oc[0] = pack2(hq[j * 8], hq[j * 8 + 1]); oc[1] = pack2(hq[j * 8 + 2], hq[j * 8 + 3]); oc[2] = pack2(hq[j * 8 + 4], hq[j * 8 + 5]); oc[3] = pack2(hq[j * 8 + 6], hq[j * 8 + 7]);
                *(u32x4*)(hq_out + (size_t)t * D + e0 + j * 8) = oc;
            }
        } else {
#pragma unroll
            for (int j = 0; j < 4; ++j) {
                const f32x4 g = *(const f32x4*)(p.final_norm + e0 + j * 4), sc = *(const f32x4*)(cb + 15 * D + e0 + j * 4), sh = *(const f32x4*)(cb + 14 * D + e0 + j * 4);
                f32x4 ov;
#pragma unroll
                for (int e = 0; e < 4; ++e) ov[e] = xn[j * 4 + e] * rstd * g[e] * (1.f + sc[e]) + sh[e];
                *(f32x4*)(p.out + (size_t)t * D + e0 + j * 4) = ov;
            }
        }
    }
}

__device__ void attn_phase(const Params& p, const bf16_t* Q, const bf16_t* K, const bf16_t* V, bf16_t* O, unsigned char* smem) {
    unsigned char* Kl = smem;
    unsigned char* Vt = smem + 32768;
    unsigned char* Pl = smem + 32768 + 35840;
    const int tid = threadIdx.x, lane = tid & 63, w = tid >> 6, tk = lane & 15, q = lane >> 4;
    unsigned char* Pw = Pl + w * 5376;
    for (int task = blockIdx.x; task < NB * 32 * 4; task += gridDim.x) {
        const int kvh = task & 3, qblk = (task >> 2) & 31, b = task >> 7;
        const int kpos0 = (qblk - 1) * 128;
#pragma unroll
        for (int i = 0; i < 4; ++i) {
            const int id = tid + NT * i, j = id >> 3, c = id & 7, kp = kpos0 + j;
            u32x4 v = {0u, 0u, 0u, 0u};
            if (kp >= 0) v = *(const u32x4*)(K + ((size_t)b * SEQ + kp) * 256 + kvh * 64 + c * 8);
            *(u32x4*)(Kl + lds_off(j, c)) = v;
        }
#pragma unroll
        for (int i = 0; i < 4; ++i) {
            const int id = tid + NT * i, j = id & 255, dc = id >> 8, kp = kpos0 + j;
            u32x4 v = {0u, 0u, 0u, 0u};
            if (kp >= 0) v = *(const u32x4*)(V + ((size_t)b * SEQ + kp) * 256 + kvh * 64 + dc * 8);
#pragma unroll
            for (int e = 0; e < 4; ++e) {
                *(bf16_t*)(Vt + (dc * 8 + 2 * e) * 560 + j * 2) = (bf16_t)(v[e] & 0xffffu);
                *(bf16_t*)(Vt + (dc * 8 + 2 * e + 1) * 560 + j * 2) = (bf16_t)(v[e] >> 16);
            }
        }
        if (tid < 128) *(u32x4*)(Vt + (tid >> 1) * 560 + 512 + (tid & 1) * 16) = (u32x4){0u, 0u, 0u, 0u};
        *(u32x2*)(Pw + tk * 336 + (144 + 4 * q) * 2) = (u32x2){0u, 0u};
        __syncthreads();
        const int qt = w, i_q = qt * 16 + tk;
        const size_t trow = (size_t)b * SEQ + qblk * 128 + i_q;
        const unsigned char* kb0 = Kl + lds_off(qt * 16 + tk, q);
        const unsigned char* kb1 = Kl + lds_off(qt * 16 + tk, 4 + q);
        const unsigned char* vb0 = Vt + tk * 560 + (qt * 16 + 8 * q) * 2;
        unsigned char* pwr = Pw + tk * 336 + 8 * q;
        const unsigned char* prd = Pw + tk * 336 + 16 * q;
#pragma unroll 1
        for (int hq = 0; hq < 4; ++hq) {
            const int head = kvh * 4 + hq;
            const bf16x8 qf0 = *(const bf16x8*)(Q + trow * D + head * 64 + 8 * q), qf1 = *(const bf16x8*)(Q + trow * D + head * 64 + 32 + 8 * q);
            f32x4 sacc[9];
#pragma unroll
            for (int kk = 0; kk < 9; ++kk) {
                const bf16x8 k0 = *(const bf16x8*)(kb0 + kk * 2048), k1 = *(const bf16x8*)(kb1 + kk * 2048);
                f32x4 a = {0.f, 0.f, 0.f, 0.f};
                a = __builtin_amdgcn_mfma_f32_16x16x32_bf16(k0, qf0, a, 0, 0, 0);
                a = __builtin_amdgcn_mfma_f32_16x16x32_bf16(k1, qf1, a, 0, 0, 0);
                sacc[kk] = a;
                if (kk & 1) __builtin_amdgcn_sched_barrier(0);
            }
            const float sink = p.sinks[head];
            float mx = -1e30f;
#pragma unroll
            for (int kk = 0; kk < 9; ++kk)
#pragma unroll
                for (int r = 0; r < 4; ++r) {
                    const int j = (qt + kk) * 16 + 4 * q + r;
                    const bool valid = (j > i_q) && (j <= i_q + 128) && (qblk > 0 || j >= 128);
                    const float s = valid ? sacc[kk][r] * 0.125f : -1e30f;
                    sacc[kk][r] = s; mx = fmaxf(mx, s);
                }
            mx = fmaxf(mx, __shfl_xor(mx, 16)); mx = fmaxf(mx, __shfl_xor(mx, 32));
            mx = fmaxf(mx, sink);
            float sum = 0.f;
#pragma unroll
            for (int kk = 0; kk < 9; ++kk)
#pragma unroll
                for (int r = 0; r < 4; ++r) { const float e = __expf(sacc[kk][r] - mx); sacc[kk][r] = e; sum += e; }
            sum += __shfl_xor(sum, 16); sum += __shfl_xor(sum, 32);
            const float inv = 1.f / (sum + __expf(sink - mx));
#pragma unroll
            for (int kk = 0; kk < 9; ++kk) {
                u32x2 o; o[0] = pack2(sacc[kk][0] * inv, sacc[kk][1] * inv); o[1] = pack2(sacc[kk][2] * inv, sacc[kk][3] * inv);
                *(u32x2*)(pwr + kk * 32) = o;
            }
            asm volatile("s_waitcnt lgkmcnt(0)" ::: "memory");
            bf16x8 pf[5];
#pragma unroll
            for (int ks = 0; ks < 5; ++ks) pf[ks] = *(const bf16x8*)(prd + ks * 64);
#pragma unroll
            for (int dt = 0; dt < 4; ++dt) {
                f32x4 oa = {0.f, 0.f, 0.f, 0.f};
#pragma unroll
                for (int ks = 0; ks < 5; ++ks) {
                    const bf16x8 vf = *(const bf16x8*)(vb0 + dt * 8960 + ks * 64);
                    oa = __builtin_amdgcn_mfma_f32_16x16x32_bf16(vf, pf[ks], oa, 0, 0, 0);
                }
                u32x2 o; o[0] = pack2(oa[0], oa[1]); o[1] = pack2(oa[2], oa[3]);
                *(u32x2*)(O + trow * D + head * 64 + dt * 16 + 4 * q) = o;
                __builtin_amdgcn_sched_barrier(0);
            }
            asm volatile("s_waitcnt lgkmcnt(0)" ::: "memory");
        }
        __syncthreads();
    }
}

constexpr int SMEM_BYTES = 152 * 1024;
__global__ void __launch_bounds__(NT) yoco_fwd(Params p) {
    __shared__ __attribute__((aligned(16))) unsigned char smem[SMEM_BYTES];
    volatile LAS unsigned* st = (volatile LAS unsigned*)(smem + SMEM_BYTES - 16);
    if (threadIdx.x == 0) { st[0] = 0u; st[1] = 0u; }
    __syncthreads();
    const XcdBarrier xb = xcd_barrier_post(p.bar, st);
    p0_cond(p, smem);
    p0_tables(p);
    p0_wt(p, smem);
    p0_s5(p, smem);
    xcd_barrier(xb);
    p05_prep(p, smem);
    xcd_barrier(xb);
    bias_finalize(p);
    { EpiU e{p.s1}; gemm_phase(p.s0, p.wt_in, 0, 1024, e, smem); }
    xcd_barrier(xb);
    s5_phase(p, smem);
    xcd_barrier(xb);
    { EpiGlu e{p.s0, p.b_glu, p.s1}; gemm_phase(p.s0, p.wt_glu, 0, 1024, e, smem); }
    xcd_barrier(xb);
    { EpiRes e{p.x, p.cond + 2 * D, p.norm_ffn, p.cond + 4 * D, p.f0, p.s2, p.ssq1}; gemm_phase(p.s1, p.wt_out, 0, 1024, e, smem); }
    xcd_barrier(xb);
    { EpiQ e{p.ssq1, p.bias, 0, p.s1}; gemm_phase(p.s2, p.wt_pq0, 0, 1024, e, smem); }
    xcd_barrier(xb);
    route_phase(p, 0, p.s1, smem);
    xcd_barrier(xb);
    gather_phase<false>(p, 0, p.f0, p.f1, p.s0, p.s2, p.norm_ffn, 3, 4, 5);
    xcd_barrier(xb);
    { EpiRope<0> e{p.ropec, p.ropes, p.s1, p.s1 + (size_t)T * 256}; gemm_phase(p.s0, p.wt_kv, 0, 512, e, smem); }
    { EpiRope<1> e{p.ropec, p.ropes, p.s3, nullptr}; gemm_phase(p.s2, p.wt_q, 0, 1024, e, smem); }
    xcd_barrier(xb);
    attn_phase(p, p.s3, p.s1, p.s1 + (size_t)T * 256, p.s0, smem);
    xcd_barrier(xb);
    { EpiRes e{p.f1, p.cond + 8 * D, p.norm_ffn + D, p.cond + 10 * D, p.f0, p.s2, p.ssq3}; gemm_phase(p.s0, p.wt_o, 0, 1024, e, smem); }
    xcd_barrier(xb);
    { EpiQ e{p.ssq3, p.bias, 1024, p.s1}; gemm_phase(p.s2, p.wt_pq1, 0, 1024, e, smem); }
    xcd_barrier(xb);
    route_phase(p, 1, p.s1, smem);
    xcd_barrier(xb);
    gather_phase<true>(p, 1, p.f0, nullptr, nullptr, nullptr, p.norm_ffn + D, 9, 10, 11);
}

static inline size_t align_up(size_t v, size_t a) { return (v + a - 1) / a * a; }

extern "C" void kernel_launch(void* const* d_in, const int* in_sizes, int n_in, void* d_out, int out_size, void* d_ws, size_t ws_size, hipStream_t stream) {
    (void)in_sizes; (void)n_in; (void)out_size;
    Params p{};
    p.x = (const float*)d_in[0]; p.c = (const float*)d_in[1]; p.pos = (const int*)d_in[2]; p.w_cond = (const float*)d_in[3]; p.b_cond = (const float*)d_in[4];
    p.norm_mix = (const float*)d_in[5]; p.norm_ffn = (const float*)d_in[6]; p.w_in = (const float*)d_in[7]; p.a_re = (const float*)d_in[8]; p.a_im = (const float*)d_in[9];
    p.log_dt = (const float*)d_in[10]; p.b_re = (const float*)d_in[11]; p.b_im = (const float*)d_in[12]; p.c_re = (const float*)d_in[13]; p.c_im = (const float*)d_in[14];
    p.s5d = (const float*)d_in[15]; p.w_glu = (const float*)d_in[16]; p.b_glu = (const float*)d_in[17]; p.w_out = (const float*)d_in[18]; p.kv_norm = (const float*)d_in[19];
    p.w_kv = (const float*)d_in[20]; p.w_q = (const float*)d_in[21]; p.sinks = (const float*)d_in[22]; p.w_o = (const float*)d_in[23]; p.peer_wq = (const float*)d_in[24];
    p.subkeys = (const float*)d_in[25]; p.peer_u = (const float*)d_in[26]; p.peer_v = (const float*)d_in[27]; p.final_norm = (const float*)d_in[28];
    p.out = (float*)d_out;
    unsigned char* w = (unsigned char*)d_ws; size_t off = 65536;
    p.bar = (unsigned*)d_ws;
    auto take = [&](size_t bytes) { void* r = w + off; off = align_up(off + bytes, 4096); return r; };
    p.cond = (float*)take((size_t)NB * NCOND * D * 4);
    p.ropec = (float*)take((size_t)T * 32 * 4); p.ropes = (float*)take((size_t)T * 32 * 4);
    p.ssq1 = (float*)take((size_t)T * 16 * 4); p.ssq3 = (float*)take((size_t)T * 16 * 4);
    p.wt_in = (bf16_t*)take((size_t)D * D * 2); p.wt_glu = (bf16_t*)take((size_t)D * D * 2); p.wt_out = (bf16_t*)take((size_t)D * D * 2); p.wt_kv = (bf16_t*)take((size_t)512 * D * 2);
    p.wt_q = (bf16_t*)take((size_t)D * D * 2); p.wt_o = (bf16_t*)take((size_t)D * D * 2); p.wt_pq0 = (bf16_t*)take((size_t)D * D * 2); p.wt_pq1 = (bf16_t*)take((size_t)D * D * 2);
    p.biasp = (float*)take((size_t)8 * 4 * 2048 * 4); p.bias = (float*)take((size_t)4 * 2048 * 4);
    p.skeys = (bf16_t*)take((size_t)2 * 8 * 2 * 128 * 64 * 2);
    p.lamL = (float*)take((size_t)G5 * P5 * 2 * 4); p.ktab = (bf16_t*)take((size_t)G5 * KTR * 256 * 2);
    p.smat = (bf16_t*)take((size_t)G5 * 128 * 1024 * 2); p.cmat = (bf16_t*)take((size_t)G5 * 1024 * 128 * 2);
    p.ub = (unsigned char*)take((size_t)2 * NEXP * D); p.vb = (unsigned char*)take((size_t)2 * NEXP * D);
    p.su = (float*)take((size_t)2 * NEXP * 4); p.sv = (float*)take((size_t)2 * NEXP * 4);
    p.s0 = (bf16_t*)take((size_t)T * D * 2); p.s1 = (bf16_t*)take((size_t)T * D * 2); p.s2 = (bf16_t*)take((size_t)T * D * 2); p.s3 = (bf16_t*)take((size_t)T * D * 2);
    p.f0 = (float*)take((size_t)T * D * 4); p.f1 = (float*)take((size_t)T * D * 4);
    p.ids = (int*)take((size_t)T * 128 * 4); p.gates = (float*)take((size_t)T * 128 * 4);
    if (off > ws_size) { fprintf(stderr, "workspace too small: need %zu have %zu\n", off, ws_size); return; }

    static int grid_blocks = 0;
    if (!grid_blocks) {
        int dev = 0, cus = 0, per_cu = 0;
        (void)hipGetDevice(&dev);
        (void)hipDeviceGetAttribute(&cus, hipDeviceAttributeMultiprocessorCount, dev);
        (void)hipOccupancyMaxActiveBlocksPerMultiprocessor(&per_cu, yoco_fwd, NT, 0);
        if (per_cu > 1) per_cu = 1;
        grid_blocks = cus * per_cu;
        if (grid_blocks <= 0) grid_blocks = 256;
    }
    (void)hipMemsetAsync(d_ws, 0, XCD_BAR_WORDS * 4, stream);
    void* args[] = {&p};
    hipError_t e = hipLaunchCooperativeKernel((const void*)yoco_fwd, dim3(grid_blocks), dim3(NT), args, 0, stream);
    if (e != hipSuccess) fprintf(stderr, "cooperative launch failed: %s (grid %d)\n", hipGetErrorString(e), grid_blocks);
}
```

```cpp
#include <hip/hip_runtime.h>
#include <cstdio>
#include <cstdint>

#define NT 512
#define LAS __attribute__((address_space(3)))
typedef unsigned short bf16_t;
typedef short bf16x8 __attribute__((ext_vector_type(8)));
typedef float f32x4 __attribute__((ext_vector_type(4)));
typedef unsigned u32x4 __attribute__((ext_vector_type(4)));
typedef unsigned u32x2 __attribute__((ext_vector_type(2)));

constexpr int D = 1024, NB = 4, SEQ = 4096, T = NB * SEQ;
constexpr int NCOND = 16;
constexpr int G5 = 64, P5 = 64, C5 = 16, L5 = 64, NCH = SEQ / L5, KTR = 72;
constexpr int NEXP = 16384;
constexpr float RMS_EPS = 1e-6f;

struct Params {
    const float *x, *c; const int* pos; const float *w_cond, *b_cond, *norm_mix, *norm_ffn, *w_in, *a_re, *a_im, *log_dt, *b_re, *b_im, *c_re, *c_im, *s5d,
        *w_glu, *b_glu, *w_out, *kv_norm, *w_kv, *w_q, *sinks, *w_o, *peer_wq, *subkeys, *peer_u, *peer_v, *final_norm;
    float* out;
    unsigned* bar;
    float* cond;
    float* ropec;
    float* ropes;
    float* ssq1;
    float* ssq3;
    bf16_t *wt_in, *wt_glu, *wt_out, *wt_kv, *wt_q, *wt_o, *wt_pq0, *wt_pq1;
    float* biasp;
    float* bias;
    bf16_t* skeys;
    float* lamL;
    bf16_t* ktab;
    bf16_t* smat;
    bf16_t* cmat;
    unsigned char* ub;
    unsigned char* vb;
    float* su;
    float* sv;
    bf16_t *s0, *s1, *s2, *s3;
    float *f0, *f1;
    int* ids;
    float* gates;
};

#define XB_TMO      128
#define XB_XCNT(j)  (256  + 64 * (j))
#define XB_XSUB(j)  (1280 + 64 * (j))
#define XB_XGEN(j)  (2304 + 64 * (j))
#define XB_TOP      3328
#define XB_TOPGEN   3392
#define XCD_BAR_WORDS 3456
#define XB_SPIN_CAP (1u << 22)
__device__ __forceinline__ unsigned xb_ld(unsigned* p)              { return __hip_atomic_load(p, __ATOMIC_RELAXED, __HIP_MEMORY_SCOPE_AGENT); }
__device__ __forceinline__ unsigned xb_add(unsigned* p, unsigned v) { return __hip_atomic_fetch_add(p, v, __ATOMIC_RELAXED, __HIP_MEMORY_SCOPE_AGENT); }
__device__ __forceinline__ unsigned xb_xcc_id() { return (unsigned)__builtin_amdgcn_s_getreg((3 << 11) | 20) & 0xFu; }
#define XB_SPIN(cond, bar) do { unsigned _sp = 0; while (cond) { __builtin_amdgcn_s_sleep(1); \
    if ((++_sp & 255u) == 0u) { if (xb_ld(&(bar)[XB_TMO])) break; if (_sp > XB_SPIN_CAP) { atomicAdd(&(bar)[XB_TMO], 1u); break; } } } } while (0)
struct XcdBarrier { unsigned* bar; unsigned x; volatile LAS unsigned* st; };
__device__ __forceinline__ XcdBarrier xcd_barrier_post(unsigned* bar, volatile LAS unsigned* st) {
    XcdBarrier b; b.bar = bar; b.x = xb_xcc_id(); b.st = st;
    if (threadIdx.x == 0) (void)xb_add(&bar[XB_XCNT(b.x)], 1u);
    return b;
}
__device__ __forceinline__ void xcd_barrier_complete(unsigned* bar, unsigned x, unsigned& nloc, unsigned& nx) {
    const unsigned G = gridDim.x * gridDim.y * gridDim.z;
    unsigned sum, cnt, mine, sp = 0u;
    for (;;) {
        sum = 0u; cnt = 0u; mine = 0u;
#pragma unroll
        for (unsigned j = 0; j < 16; ++j) { const unsigned c = xb_ld(&bar[XB_XCNT(j)]); sum += c; cnt += (c > 0u) ? 1u : 0u; mine = (j == x) ? c : mine; }
        if (sum == G) break;
        __builtin_amdgcn_s_sleep(1);
        if ((++sp & 255u) == 0u) { if (xb_ld(&bar[XB_TMO])) break; if (sp > XB_SPIN_CAP) { atomicAdd(&bar[XB_TMO], 1u); break; } }
    }
    nloc = mine > 0u ? mine : 1u; nx = cnt > 0u ? cnt : 1u;
}
__device__ __forceinline__ void xcd_barrier(const XcdBarrier& b) {
    asm volatile("s_waitcnt vmcnt(0)" ::: "memory");
    __syncthreads();
    if (threadIdx.x == 0) {
        unsigned* bar = b.bar;
        __builtin_amdgcn_s_waitcnt(0);
        unsigned nloc = b.st[0], nx = b.st[1];
        if (nloc == 0u) { xcd_barrier_complete(bar, b.x, nloc, nx); b.st[0] = nloc; b.st[1] = nx; }
        const unsigned old = xb_add(&bar[XB_XSUB(b.x)], 1u);
        const unsigned gen = old / nloc;
        if (old + 1u == (gen + 1u) * nloc) {
            __builtin_amdgcn_fence(__ATOMIC_RELEASE, "agent");
            asm volatile("s_waitcnt vmcnt(0)" ::: "memory");
            const unsigned og = xb_add(&bar[XB_TOP], 1u);
            const unsigned tg = og / nx;
            if (og + 1u == (tg + 1u) * nx) xb_add(&bar[XB_TOPGEN], 1u);
            else XB_SPIN(xb_ld(&bar[XB_TOPGEN]) == tg, bar);
            __builtin_amdgcn_fence(__ATOMIC_ACQUIRE, "agent");
            xb_add(&bar[XB_XGEN(b.x)], 1u);
            asm volatile("s_waitcnt vmcnt(0)" ::: "memory");
        } else {
            XB_SPIN(xb_ld(&bar[XB_XGEN(b.x)]) == gen, bar);
            __builtin_amdgcn_fence(__ATOMIC_ACQUIRE, "agent");
            asm volatile("s_waitcnt vmcnt(0)" ::: "memory");
        }
    }
    __syncthreads();
}

__device__ __forceinline__ bf16_t f2bf(float f) { unsigned u = __float_as_uint(f); u += 0x7fffu + ((u >> 16) & 1u); return (bf16_t)(u >> 16); }
__device__ __forceinline__ float bf2f(bf16_t h) { return __uint_as_float(((unsigned)h) << 16); }
typedef __bf16 hbf2 __attribute__((ext_vector_type(2)));
typedef float f32x2 __attribute__((ext_vector_type(2)));
__device__ __forceinline__ unsigned pack2(float lo, float hi) { f32x2 v = {lo, hi}; return __builtin_bit_cast(unsigned, __builtin_convertvector(v, hbf2)); }
__device__ __forceinline__ float dot2bf(unsigned a, unsigned b, float c) { return __builtin_amdgcn_fdot2_f32_bf16(__builtin_bit_cast(hbf2, a), __builtin_bit_cast(hbf2, b), c, false); }
__device__ __forceinline__ float bflo(unsigned w) { return __uint_as_float(w << 16); }
__device__ __forceinline__ float bfhi(unsigned w) { return __uint_as_float(w & 0xffff0000u); }
__device__ __forceinline__ float wave_sum(float v) {
#pragma unroll
    for (int o = 32; o >= 1; o >>= 1) v += __shfl_xor(v, o);
    return v;
}
__device__ __forceinline__ float gelu_tanh(float x) {
    const float u = 0.7978845608028654f * (x + 0.044715f * x * x * x);
    const float e = __expf(-2.f * fabsf(u));
    float th = (1.f - e) / (1.f + e);
    th = u < 0.f ? -th : th;
    return 0.5f * x * (1.f + th);
}

__device__ void p0_cond(const Params& p, unsigned char* smem) {
    float* sc = (float*)smem;
    float* red = (float*)(smem + 16384);
    const int tid = threadIdx.x;
    for (int i = tid; i < 4 * D; i += NT) { const float v = p.c[i]; sc[i] = v / (1.f + __expf(-v)); }
    __syncthreads();
    const int cgp = tid & 15, kg = tid >> 4;
    for (int task = blockIdx.x; task < NCOND * D / 64; task += gridDim.x) {
        const int col0 = task * 64 + cgp * 4;
        float acc[4][4];
#pragma unroll
        for (int b = 0; b < 4; ++b)
#pragma unroll
            for (int j = 0; j < 4; ++j) acc[b][j] = 0.f;
#pragma unroll 1
        for (int k0 = 0; k0 < 32; k0 += 8) {
            f32x4 w[8];
#pragma unroll
            for (int j = 0; j < 8; ++j) w[j] = *(const f32x4*)(p.w_cond + (size_t)(kg + 32 * (k0 + j)) * (NCOND * D) + col0);
#pragma unroll
            for (int j = 0; j < 8; ++j)
#pragma unroll
                for (int b = 0; b < 4; ++b) { const float s = sc[b * D + kg + 32 * (k0 + j)];
#pragma unroll
                    for (int e = 0; e < 4; ++e) acc[b][e] += s * w[j][e]; }
        }
#pragma unroll
        for (int b = 0; b < 4; ++b)
#pragma unroll
            for (int j = 0; j < 4; ++j) red[(kg * 64 + cgp * 4 + j) * 4 + b] = acc[b][j];
        __syncthreads();
        if (tid < 256) {
            const int col = tid >> 2, b = tid & 3;
            float s = 0.f;
            for (int g = 0; g < 32; ++g) s += red[(g * 64 + col) * 4 + b];
            p.cond[(size_t)b * (NCOND * D) + task * 64 + col] = s + p.b_cond[task * 64 + col];
        }
        __syncthreads();
    }
}

__device__ void p0_tables(const Params& p) {
    const size_t gtid = (size_t)blockIdx.x * NT + threadIdx.x, gstride = (size_t)gridDim.x * NT;
    {
        const int li = threadIdx.x & 15;
        const size_t grp = gtid >> 4, ngrp = gstride >> 4;
        for (int which = 0; which < 2; ++which) {
            const float* src = which ? p.peer_v : p.peer_u; unsigned char* dst = which ? p.vb : p.ub; float* sdst = which ? p.sv : p.su;
            for (size_t row = grp; row < (size_t)2 * NEXP; row += ngrp) {
                f32x4 v[2][8]; float ss = 0.f;
#pragma unroll
                for (int c = 0; c < 2; ++c)
#pragma unroll
                    for (int j = 0; j < 8; ++j) {
                        v[c][j] = *(const f32x4*)(src + row * D + c * 512 + li * 32 + j * 4);
#pragma unroll
                        for (int e = 0; e < 4; ++e) ss += v[c][j][e] * v[c][j][e];
                    }
                ss += __shfl_xor(ss, 1); ss += __shfl_xor(ss, 2); ss += __shfl_xor(ss, 4); ss += __shfl_xor(ss, 8);
                const float step = 0.3352f * sqrtf(ss * (1.f / D)), inv = step > 0.f ? 1.f / step : 0.f;
#pragma unroll
                for (int c = 0; c < 2; ++c) {
                    u32x4 o;
#pragma unroll
                    for (int d = 0; d < 4; ++d) {
                        unsigned wd = 0u;
#pragma unroll
                        for (int k = 0; k < 8; ++k) {
                            const float x = v[c][d * 2 + (k >> 2)][k & 3];
                            const int n = (int)fminf(fmaxf(floorf(x * inv + 8.f), 0.f), 15.f);
                            const int nib = (k >> 1) + 4 * (k & 1);
                            wd |= (unsigned)n << (4 * nib);
                        }
                        o[d] = wd;
                    }
                    *(u32x4*)(dst + row * 512 + c * 256 + li * 16) = o;
                }
                if (li == 0) sdst[row] = step;
            }
        }
    }
    const size_t nk8 = (size_t)2 * 8 * 2 * 128 * 64 / 8;
    for (size_t i = gtid; i < nk8; i += gstride) {
        const f32x4 a = *(const f32x4*)(p.subkeys + i * 8), b = *(const f32x4*)(p.subkeys + i * 8 + 4);
        u32x4 o; o[0] = pack2(a[0], a[1]); o[1] = pack2(a[2], a[3]); o[2] = pack2(b[0], b[1]); o[3] = pack2(b[2], b[3]);
        *(u32x4*)(p.skeys + i * 8) = o;
    }
    for (size_t i = gtid; i < (size_t)T * 32; i += gstride) {
        const int t = (int)(i >> 5), f = (int)(i & 31);
        const float invrev = exp2f(-(float)f * 0.41524101186092029f) * 0.15915494309189535f;
        float rev = (float)p.pos[t] * invrev; rev -= floorf(rev);
        p.ropec[i] = __builtin_amdgcn_cosf(rev); p.ropes[i] = __builtin_amdgcn_sinf(rev);
    }
}

__device__ void transpose_tile(const float* W, int ldw, int n0, int k0, bf16_t* Wt, unsigned char* smem) {
    bf16_t* tl = (bf16_t*)smem;
    const int tid = threadIdx.x, kk = tid >> 3, nn = (tid & 7) * 8;
    const f32x4 a = *(const f32x4*)(W + (size_t)(k0 + kk) * ldw + n0 + nn), b = *(const f32x4*)(W + (size_t)(k0 + kk) * ldw + n0 + nn + 4);
#pragma unroll
    for (int j = 0; j < 4; ++j) { tl[(nn + j) * 72 + kk] = f2bf(a[j]); tl[(nn + 4 + j) * 72 + kk] = f2bf(b[j]); }
    __syncthreads();
    const int n = tid >> 3, kc = (tid & 7) * 8;
    const u32x4 v = *(const u32x4*)(tl + n * 72 + kc);
    *(u32x4*)(Wt + (size_t)(n0 + n) * D + k0 + kc) = v;
    __syncthreads();
}

__device__ void p0_wt(const Params& p, unsigned char* smem) {
    for (int task = blockIdx.x; task < 7 * 256 + 128; task += gridDim.x) {
        const int w = task >> 8, tl = task & 255;
        const float* W; bf16_t* Wt; int ldw = 1024;
        switch (w) {
            case 0: W = p.w_in; Wt = p.wt_in; break;
            case 1: W = p.w_glu; Wt = p.wt_glu; break;
            case 2: W = p.w_out; Wt = p.wt_out; break;
            case 3: W = p.w_q; Wt = p.wt_q; break;
            case 4: W = p.w_o; Wt = p.wt_o; break;
            case 5: W = p.peer_wq; Wt = p.wt_pq0; break;
            case 6: W = p.peer_wq + (size_t)D * D; Wt = p.wt_pq1; break;
            default: W = p.w_kv; Wt = p.wt_kv; ldw = 512; break;
        }
        const int ntn = ldw / 64, n0 = (tl % ntn) * 64, k0 = (tl / ntn) * 64;
        transpose_tile(W, ldw, n0, k0, Wt, smem);
    }
}

__device__ __forceinline__ void lam_powf(float ar, float ai, float dt, int n, float& re, float& im) {
    const float m = __expf(ar * dt * (float)n);
    float rev = (ai * dt) * (float)n * 0.15915494309189535f; rev -= floorf(rev);
    re = m * __builtin_amdgcn_cosf(rev); im = m * __builtin_amdgcn_sinf(rev);
}
__device__ __forceinline__ void s5_coeff(float ar, float ai, float dt, float& cre, float& cim) {
    const float a = ar * dt, th = ai * dt;
    float rev = th * 0.15915494309189535f; rev -= floorf(rev);
    float revh = th * 0.5f * 0.15915494309189535f; revh -= floorf(revh);
    const float cs = __builtin_amdgcn_cosf(rev), sn = __builtin_amdgcn_sinf(rev), sh = __builtin_amdgcn_sinf(revh);
    const float em1 = expm1f(a);
    const float nr = em1 * cs - 2.f * sh * sh, ni = (em1 + 1.f) * sn, den = ar * ar + ai * ai;
    cre = (nr * ar + ni * ai) / den; cim = (ni * ar - nr * ai) / den;
}

__device__ void p0_s5(const Params& p, unsigned char* smem) {
    const size_t gtid = (size_t)blockIdx.x * NT + threadIdx.x, gstride = (size_t)gridDim.x * NT;
    for (size_t idx = gtid; idx < (size_t)G5 * P5 * 65; idx += gstride) {
        const int pp = (int)(idx & 63), e = (int)((idx >> 6) % 65), g = (int)(idx / (65 * P5));
        const float dt = __expf(p.log_dt[g]), ar = p.a_re[g * P5 + pp], ai = p.a_im[g * P5 + pp];
        float pwr, pwi; lam_powf(ar, ai, dt, e, pwr, pwi);
        if (e < 64) {
            float cfr, cfi; s5_coeff(ar, ai, dt, cfr, cfi);
            const float wr = pwr * cfr - pwi * cfi, wi = pwr * cfi + pwi * cfr;
            const int j = 63 - e;
            const float* brp = p.b_re + ((size_t)g * P5 + pp) * C5; const float* bip = p.b_im + ((size_t)g * P5 + pp) * C5;
            unsigned ore[8], oim[8];
#pragma unroll
            for (int c4 = 0; c4 < 4; ++c4) {
                const f32x4 br = *(const f32x4*)(brp + c4 * 4), bi = *(const f32x4*)(bip + c4 * 4);
                ore[c4 * 2] = pack2(wr * br[0] - wi * bi[0], wr * br[1] - wi * bi[1]); ore[c4 * 2 + 1] = pack2(wr * br[2] - wi * bi[2], wr * br[3] - wi * bi[3]);
                oim[c4 * 2] = pack2(wr * bi[0] + wi * br[0], wr * bi[1] + wi * br[1]); oim[c4 * 2 + 1] = pack2(wr * bi[2] + wi * br[2], wr * bi[3] + wi * br[3]);
            }
            u32x4* sre = (u32x4*)(p.smat + ((size_t)g * 128 + pp) * 1024 + j * 16);
            u32x4* sim = (u32x4*)(p.smat + ((size_t)g * 128 + 64 + pp) * 1024 + j * 16);
            sre[0] = (u32x4){ore[0], ore[1], ore[2], ore[3]}; sre[1] = (u32x4){ore[4], ore[5], ore[6], ore[7]};
            sim[0] = (u32x4){oim[0], oim[1], oim[2], oim[3]}; sim[1] = (u32x4){oim[4], oim[5], oim[6], oim[7]};
        }
        if (e >= 1) {
            const int i = e - 1;
#pragma unroll 4
            for (int co = 0; co < 16; ++co) {
                const float cr = p.c_re[((size_t)g * C5 + co) * P5 + pp], ci = p.c_im[((size_t)g * C5 + co) * P5 + pp];
                bf16_t* row = p.cmat + ((size_t)g * 1024 + i * 16 + co) * 128;
                row[pp] = f2bf(cr * pwr - ci * pwi);
                row[64 + pp] = f2bf(-(cr * pwi + ci * pwr));
            }
        }
        if (e == 64) {
            const double dtd = exp((double)p.log_dt[g]), m = exp((double)ar * dtd * 64.0);
            double ang = (double)ai * dtd * 64.0; ang -= 6.283185307179586 * floor(ang * 0.15915494309189535);
            p.lamL[(g * P5 + pp) * 2] = (float)(m * cos(ang)); p.lamL[(g * P5 + pp) * 2 + 1] = (float)(m * sin(ang));
        }
    }
    float* wre = (float*)smem;
    float* wim = wre + 1024;
    const int tid = threadIdx.x;
    for (int task = blockIdx.x; task < G5 * 4; task += gridDim.x) {
        const int g = task >> 2, tq = task & 3;
        const float dt = __expf(p.log_dt[g]);
        for (int i = tid; i < 1024; i += NT) {
            const int pp = i & 63, tau = tq * 16 + (i >> 6);
            const float ar = p.a_re[g * P5 + pp], ai = p.a_im[g * P5 + pp];
            float pwr, pwi, cfr, cfi; lam_powf(ar, ai, dt, tau, pwr, pwi); s5_coeff(ar, ai, dt, cfr, cfi);
            wre[i] = pwr * cfr - pwi * cfi; wim[i] = pwr * cfi + pwi * cfr;
        }
        __syncthreads();
        {
            const int co = (tid >> 4) & 15, ci = tid & 15, ph = tid >> 8;
            float* part = wim + 1024;
            float cbr[32], cbi[32];
#pragma unroll 8
            for (int k = 0; k < 32; ++k) {
                const int pp = ph * 32 + k;
                const float br = p.b_re[((size_t)g * P5 + pp) * C5 + ci], bi = p.b_im[((size_t)g * P5 + pp) * C5 + ci];
                const float cr = p.c_re[((size_t)g * C5 + co) * P5 + pp], cim = p.c_im[((size_t)g * C5 + co) * P5 + pp];
                cbr[k] = cr * br - cim * bi; cbi[k] = cr * bi + cim * br;
            }
            float sres[16];
#pragma unroll
            for (int tl = 0; tl < 16; ++tl) {
                float s0 = 0.f, s1 = 0.f;
#pragma unroll
                for (int k = 0; k < 32; k += 2) {
                    s0 += cbr[k] * wre[tl * 64 + ph * 32 + k] - cbi[k] * wim[tl * 64 + ph * 32 + k];
                    s1 += cbr[k + 1] * wre[tl * 64 + ph * 32 + k + 1] - cbi[k + 1] * wim[tl * 64 + ph * 32 + k + 1];
                }
                sres[tl] = s0 + s1;
            }
            if (ph == 1) {
#pragma unroll
                for (int tl = 0; tl < 16; ++tl) part[tl * 256 + (tid & 255)] = sres[tl];
            }
            __syncthreads();
            if (ph == 0) {
#pragma unroll
                for (int tl = 0; tl < 16; ++tl) p.ktab[((size_t)g * KTR + tq * 16 + tl + 8) * 256 + tid] = f2bf(sres[tl] + part[tl * 256 + tid]);
                if (tq == 0) {
#pragma unroll
                    for (int r = 0; r < 8; ++r) p.ktab[((size_t)g * KTR + r) * 256 + tid] = 0;
                }
            }
        }
        __syncthreads();
    }
}

__device__ void p05_prep(const Params& p, unsigned char* smem) {
    {
        const int lane = threadIdx.x & 63, wv = threadIdx.x >> 6;
        const int nw = gridDim.x * (NT / 64);
        for (int t = blockIdx.x * (NT / 64) + wv; t < T; t += nw) {
            const int b = t / SEQ;
            const float* xr = p.x + (size_t)t * D; const float* cb = p.cond + (size_t)b * (NCOND * D);
            f32x4 v[4]; float s = 0.f;
#pragma unroll
            for (int j = 0; j < 4; ++j) { v[j] = *(const f32x4*)(xr + j * 256 + lane * 4); s += v[j][0] * v[j][0] + v[j][1] * v[j][1] + v[j][2] * v[j][2] + v[j][3] * v[j][3]; }
            s = wave_sum(s);
            const float rstd = rsqrtf(s * (1.f / D) + RMS_EPS);
#pragma unroll
            for (int j = 0; j < 4; ++j) {
                const int e = j * 256 + lane * 4;
                const f32x4 g = *(const f32x4*)(p.norm_mix + e), sh = *(const f32x4*)(cb + 0 * D + e), sc = *(const f32x4*)(cb + 1 * D + e);
                float h[4];
#pragma unroll
                for (int i = 0; i < 4; ++i) h[i] = v[j][i] * rstd * g[i] * (1.f + sc[i]) + sh[i];
                u32x2 o; o[0] = pack2(h[0], h[1]); o[1] = pack2(h[2], h[3]);
                *(u32x2*)(p.s0 + (size_t)t * D + e) = o;
            }
        }
    }
    float* red = (float*)smem;
    const int tid = threadIdx.x;
    for (int task = blockIdx.x; task < 32 * 8; task += gridDim.x) {
        const int ct = task >> 3, ks = task & 7, col0 = ct * 64, layer = col0 >> 10;
        const float* W = p.peer_wq + (size_t)layer * D * D; const int cs = layer ? 9 : 3;
        const int n = (col0 & 1023) + (tid & 63), kg = tid >> 6;
        float wv[16];
#pragma unroll
        for (int j = 0; j < 16; ++j) wv[j] = W[(size_t)(ks * 128 + kg * 16 + j) * D + n];
        float acc[4] = {0.f, 0.f, 0.f, 0.f};
#pragma unroll
        for (int j = 0; j < 16; ++j)
#pragma unroll
            for (int b = 0; b < 4; ++b) acc[b] += p.cond[(size_t)b * (NCOND * D) + cs * D + ks * 128 + kg * 16 + j] * wv[j];
#pragma unroll
        for (int b = 0; b < 4; ++b) red[(kg * 64 + (tid & 63)) * 4 + b] = acc[b];
        __syncthreads();
        if (tid < 256) {
            const int col = tid >> 2, b = tid & 3; float sum = 0.f;
#pragma unroll
            for (int g = 0; g < 8; ++g) sum += red[(g * 64 + col) * 4 + b];
            p.biasp[((size_t)ks * 4 + b) * 2048 + col0 + col] = sum;
        }
        __syncthreads();
    }
}
__device__ void bias_finalize(const Params& p) {
    const int i = blockIdx.x * NT + threadIdx.x;
    if (i < 4 * 2048) { float s = 0.f;
#pragma unroll
        for (int ks = 0; ks < 8; ++ks) s += p.biasp[(size_t)ks * 8192 + i];
        p.bias[i] = s; }
}

__device__ __forceinline__ int lds_off(int row, int chunk) { return row * 128 + ((chunk ^ (row & 7)) << 4); }

template <class Epi>
__device__ void gemm_phase(const bf16_t* __restrict__ A, const bf16_t* __restrict__ Bt, size_t bt_batch_stride, int N, const Epi& epi, unsigned char* smem) {
    const int tid = threadIdx.x, lane = tid & 63, w = tid >> 6, wm = w >> 1, wn = w & 1, tk = lane & 15, q = lane >> 4;
    const int nN = N / 128;
    const bool xmap = (gridDim.x % 8) == 0;
    const int nslots = xmap ? gridDim.x / 8 : gridDim.x, slot = xmap ? (blockIdx.x >> 3) : blockIdx.x, xcd = blockIdx.x & 7;
    const int nitems = xmap ? 8 * nN : 64 * nN;
    for (int item = slot; item < nitems; item += nslots) {
        const int pm = xmap ? xcd * 8 + item / nN : item / nN, pn = item % nN;
        const int m0 = pm * 256, n0 = pn * 128, b = m0 / SEQ;
        const bf16_t* Ab = A + (size_t)m0 * D;
        const bf16_t* Bb = Bt + (size_t)b * bt_batch_stride + (size_t)n0 * D;
        f32x4 acc[4][4];
#pragma unroll
        for (int mi = 0; mi < 4; ++mi)
#pragma unroll
            for (int ni = 0; ni < 4; ++ni) acc[mi][ni] = (f32x4){0.f, 0.f, 0.f, 0.f};
        u32x4 ra[4], rb[2];
        auto gload = [&](int kt) {
#pragma unroll
            for (int i = 0; i < 4; ++i) { const int id = tid + NT * i, row = id >> 3, c = id & 7; ra[i] = *(const u32x4*)(Ab + (size_t)row * D + kt * 64 + c * 8); }
#pragma unroll
            for (int i = 0; i < 2; ++i) { const int id = tid + NT * i, row = id >> 3, c = id & 7; rb[i] = *(const u32x4*)(Bb + (size_t)row * D + kt * 64 + c * 8); }
        };
        auto lstore = [&](int buf) {
            unsigned char* sA = smem + buf * 32768; unsigned char* sB = smem + 65536 + buf * 16384;
#pragma unroll
            for (int i = 0; i < 4; ++i) { const int id = tid + NT * i, row = id >> 3, c = id & 7; *(u32x4*)(sA + lds_off(row, c)) = ra[i]; }
#pragma unroll
            for (int i = 0; i < 2; ++i) { const int id = tid + NT * i, row = id >> 3, c = id & 7; *(u32x4*)(sB + lds_off(row, c)) = rb[i]; }
        };
        gload(0); lstore(0);
        __syncthreads();
        for (int kt = 0; kt < 16; ++kt) {
            if (kt + 1 < 16) gload(kt + 1);
            const unsigned char* sA = smem + (kt & 1) * 32768; const unsigned char* sB = smem + 65536 + (kt & 1) * 16384;
#pragma unroll
            for (int ks = 0; ks < 2; ++ks) {
                bf16x8 af[4], bfr[4];
#pragma unroll
                for (int mi = 0; mi < 4; ++mi) af[mi] = *(const bf16x8*)(sA + lds_off(wm * 64 + mi * 16 + tk, ks * 4 + q));
#pragma unroll
                for (int ni = 0; ni < 4; ++ni) bfr[ni] = *(const bf16x8*)(sB + lds_off(wn * 64 + ni * 16 + tk, ks * 4 + q));
#pragma unroll
                for (int mi = 0; mi < 4; ++mi)
#pragma unroll
                    for (int ni = 0; ni < 4; ++ni) acc[mi][ni] = __builtin_amdgcn_mfma_f32_16x16x32_bf16(bfr[ni], af[mi], acc[mi][ni], 0, 0, 0);
            }
            if (kt + 1 < 16) lstore((kt + 1) & 1);
            __syncthreads();
        }
        epi(acc, m0 + wm * 64, n0 + wn * 64, b, pn * 2 + wn, tk, q);
    }
}

__device__ __forceinline__ float rstd_of(const float* ssq, int token) {
    const f32x4* s4 = (const f32x4*)(ssq + (size_t)token * 16);
    const f32x4 a = s4[0], b = s4[1], c = s4[2], d = s4[3];
    const float s = ((a[0] + a[1]) + (a[2] + a[3])) + ((b[0] + b[1]) + (b[2] + b[3])) + ((c[0] + c[1]) + (c[2] + c[3])) + ((d[0] + d[1]) + (d[2] + d[3]));
    return rsqrtf(s * (1.f / D) + RMS_EPS);
}

struct EpiU {
    bf16_t* ug;
    __device__ __forceinline__ void operator()(const f32x4 (&acc)[4][4], int mbase, int nbase, int b, int, int tk, int q) const {
#pragma unroll
        for (int mi = 0; mi < 4; ++mi) {
            const int token = mbase + mi * 16 + tk, s = token - b * SEQ;
#pragma unroll
            for (int ni = 0; ni < 4; ++ni) {
                const int n = nbase + ni * 16 + 4 * q, g = n >> 4;
                u32x2 o; o[0] = pack2(acc[mi][ni][0], acc[mi][ni][1]); o[1] = pack2(acc[mi][ni][2], acc[mi][ni][3]);
                *(u32x2*)(ug + (((size_t)(g * 4 + b) * SEQ + s) * 16 + 4 * q)) = o;
            }
        }
    }
};
struct EpiQ {
    const float* ssq; const float* bias; int boff; bf16_t* out;
    __device__ __forceinline__ void operator()(const f32x4 (&acc)[4][4], int mbase, int nbase, int b, int, int tk, int q) const {
#pragma unroll
        for (int mi = 0; mi < 4; ++mi) {
            const int token = mbase + mi * 16 + tk;
            const float rstd = rstd_of(ssq, token);
#pragma unroll
            for (int ni = 0; ni < 4; ++ni) {
                const int n = nbase + ni * 16 + 4 * q;
                const f32x4 bv = *(const f32x4*)(bias + (size_t)b * 2048 + boff + n);
                u32x2 o; o[0] = pack2(rstd * acc[mi][ni][0] + bv[0], rstd * acc[mi][ni][1] + bv[1]); o[1] = pack2(rstd * acc[mi][ni][2] + bv[2], rstd * acc[mi][ni][3] + bv[3]);
                *(u32x2*)(out + (size_t)token * D + n) = o;
            }
        }
    }
};
struct EpiGlu {
    const bf16_t* y; const float* bglu; bf16_t* out;
    __device__ __forceinline__ void operator()(const f32x4 (&acc)[4][4], int mbase, int nbase, int, int, int tk, int q) const {
#pragma unroll
        for (int mi = 0; mi < 4; ++mi) {
            const int token = mbase + mi * 16 + tk;
#pragma unroll
            for (int ni = 0; ni < 4; ++ni) {
                const int n = nbase + ni * 16 + 4 * q;
                const f32x4 bv = *(const f32x4*)(bglu + n);
                const u32x2 yv = *(const u32x2*)(y + (size_t)token * D + n);
                float o[4];
                const float y0 = bflo(yv[0]), y1 = bfhi(yv[0]), y2 = bflo(yv[1]), y3 = bfhi(yv[1]);
                o[0] = y0 / (1.f + __expf(-(acc[mi][ni][0] + bv[0]))); o[1] = y1 / (1.f + __expf(-(acc[mi][ni][1] + bv[1])));
                o[2] = y2 / (1.f + __expf(-(acc[mi][ni][2] + bv[2]))); o[3] = y3 / (1.f + __expf(-(acc[mi][ni][3] + bv[3])));
                u32x2 ov; ov[0] = pack2(o[0], o[1]); ov[1] = pack2(o[2], o[3]);
                *(u32x2*)(out + (size_t)token * D + n) = ov;
            }
        }
    }
};
struct EpiRes {
    const float* xold; const float* gate  ; const float* gnorm; const float* scale  ; float* xout; bf16_t* xbout; float* ssq;
    __device__ __forceinline__ void operator()(const f32x4 (&acc)[4][4], int mbase, int nbase, int b, int slot, int tk, int q) const {
#pragma unroll
        for (int mi = 0; mi < 4; ++mi) {
            const int token = mbase + mi * 16 + tk;
            float ss = 0.f;
#pragma unroll
            for (int ni = 0; ni < 4; ++ni) {
                const int n = nbase + ni * 16 + 4 * q;
                const f32x4 gv = *(const f32x4*)(gate + (size_t)b * (NCOND * D) + n), gn = *(const f32x4*)(gnorm + n), sc = *(const f32x4*)(scale + (size_t)b * (NCOND * D) + n);
                const f32x4 xo = *(const f32x4*)(xold + (size_t)token * D + n);
                f32x4 xn; float hs[4];
#pragma unroll
                for (int r = 0; r < 4; ++r) { xn[r] = xo[r] + gv[r] * acc[mi][ni][r]; ss += xn[r] * xn[r]; hs[r] = xn[r] * gn[r] * (1.f + sc[r]); }
                *(f32x4*)(xout + (size_t)token * D + n) = xn;
                u32x2 ov; ov[0] = pack2(hs[0], hs[1]); ov[1] = pack2(hs[2], hs[3]);
                *(u32x2*)(xbout + (size_t)token * D + n) = ov;
            }
            ss += __shfl_xor(ss, 16); ss += __shfl_xor(ss, 32);
            if (q == 0) ssq[(size_t)token * 16 + slot] = ss;
        }
    }
};
template <int MODE  >
struct EpiRope {
    const float* ropec; const float* ropes; bf16_t* o0; bf16_t* o1;
    __device__ __forceinline__ void operator()(const f32x4 (&acc)[4][4], int mbase, int nbase, int, int, int tk, int q) const {
        const bool rope = MODE == 1 || nbase < 256;
#pragma unroll
        for (int mi = 0; mi < 4; ++mi) {
            const int token = mbase + mi * 16 + tk;
            float v[4][4];
#pragma unroll
            for (int ni = 0; ni < 4; ++ni)
#pragma unroll
                for (int r = 0; r < 4; ++r) v[ni][r] = acc[mi][ni][r];
            if (rope) {
#pragma unroll
                for (int ni = 0; ni < 2; ++ni) {
                    const f32x4 cs = *(const f32x4*)(ropec + (size_t)token * 32 + ni * 16 + 4 * q), sn = *(const f32x4*)(ropes + (size_t)token * 32 + ni * 16 + 4 * q);
#pragma unroll
                    for (int r = 0; r < 4; ++r) { const float t1 = v[ni][r], t2 = v[ni + 2][r]; v[ni][r] = t1 * cs[r] - t2 * sn[r]; v[ni + 2][r] = t2 * cs[r] + t1 * sn[r]; }
                }
            }
            bf16_t* dst = MODE == 1 ? o0 + (size_t)token * D + nbase : (nbase < 256 ? o0 + (size_t)token * 256 + nbase : o1 + (size_t)token * 256 + (nbase - 256));
#pragma unroll
            for (int ni = 0; ni < 4; ++ni) { u32x2 o; o[0] = pack2(v[ni][0], v[ni][1]); o[1] = pack2(v[ni][2], v[ni][3]); *(u32x2*)(dst + ni * 16 + 4 * q) = o; }
        }
    }
};

__device__ void s5_phase(const Params& p, unsigned char* smem) {
    bf16_t* ktl = (bf16_t*)smem;
    float* Sl = (float*)(smem + 36864);
    bf16_t* Xl = (bf16_t*)(smem + 36864 + 33280);
    const int tid = threadIdx.x, lane = tid & 63, w = tid >> 6, cb = w & 3, hh = w >> 2, tk = lane & 15, q = lane >> 4;
    for (int task = blockIdx.x; task < G5 * NB; task += gridDim.x) {
        const int g = (task & 7) * 8 + ((task >> 3) >> 2), b = (task >> 3) & 3;
        const bf16_t* U = p.s1 + (size_t)(g * 4 + b) * SEQ * 16;
        const bf16_t* sm = p.smat + (size_t)g * 128 * 1024;
        const bf16_t* cm = p.cmat + (size_t)g * 1024 * 128;
        for (int i = tid; i < KTR * 256 * 2 / 16; i += NT) ((u32x4*)ktl)[i] = ((const u32x4*)(p.ktab + (size_t)g * KTR * 256))[i];
        bf16x8 ufr[32];
#pragma unroll
        for (int ks = 0; ks < 32; ++ks) ufr[ks] = *(const bf16x8*)(U + (size_t)(cb * 16 + tk) * 1024 + ks * 32 + 8 * q);
#pragma unroll 1
        for (int mf = 0; mf < 4; ++mf) {
            const int r0 = (hh * 4 + mf) * 16;
            const bf16_t* ap = sm + (size_t)(r0 + tk) * 1024 + 8 * q;
            f32x4 acc = {0.f, 0.f, 0.f, 0.f};
#pragma unroll
            for (int k8 = 0; k8 < 4; ++k8) {
                bf16x8 af[8];
#pragma unroll
                for (int j = 0; j < 8; ++j) af[j] = *(const bf16x8*)(ap + (k8 * 8 + j) * 32);
#pragma unroll
                for (int j = 0; j < 8; ++j) acc = __builtin_amdgcn_mfma_f32_16x16x32_bf16(af[j], ufr[k8 * 8 + j], acc, 0, 0, 0);
            }
#pragma unroll
            for (int r = 0; r < 4; ++r) Sl[(r0 + 4 * q + r) * 65 + cb * 16 + tk] = acc[r];
        }
        __syncthreads();
        if (w == 0) {
            const float lr = p.lamL[(g * P5 + lane) * 2], li = p.lamL[(g * P5 + lane) * 2 + 1];
            float xr = 0.f, xi = 0.f;
            for (int k = 0; k < NCH; ++k) {
                Xl[k * 128 + lane] = f2bf(xr); Xl[k * 128 + 64 + lane] = f2bf(xi);
                const float sr = Sl[lane * 65 + k], si = Sl[(64 + lane) * 65 + k];
                const float nr = lr * xr - li * xi + sr, ni = lr * xi + li * xr + si;
                xr = nr; xi = ni;
            }
        }
        __syncthreads();
        bf16x8 xfr[4];
#pragma unroll
        for (int ks = 0; ks < 4; ++ks) xfr[ks] = *(const bf16x8*)(Xl + (cb * 16 + tk) * 128 + ks * 32 + 8 * q);
        const f32x4 dv = *(const f32x4*)(p.s5d + g * 16 + 4 * q);
        const int jl = q >> 1, cih = q & 1;
        const bf16_t* kbase = ktl + (8 - jl) * 256 + tk * 16 + cih * 8;
        const bf16_t* cmb = cm + (size_t)tk * 128 + 8 * q;
        auto iof = [&](int ii) { return hh ? 16 + ii : (ii < 16 ? ii : 32 + ii); };
        bf16x8 cf[4];
#pragma unroll
        for (int ks = 0; ks < 4; ++ks) cf[ks] = *(const bf16x8*)(cmb + (size_t)iof(0) * 2048 + ks * 32);
#pragma unroll 1
        for (int ii = 0; ii < 32; ++ii) {
            const int i = iof(ii), inext = iof(ii < 31 ? ii + 1 : ii);
            bf16x8 cfn[4];
#pragma unroll
            for (int ks = 0; ks < 4; ++ks) cfn[ks] = *(const bf16x8*)(cmb + (size_t)inext * 2048 + ks * 32);
            const int s = (cb * 16 + tk) * 64 + i;
            const u32x2 uv = *(const u32x2*)(U + (size_t)s * 16 + 4 * q);
            f32x4 acc = {0.f, 0.f, 0.f, 0.f};
#pragma unroll
            for (int ks = 0; ks < 4; ++ks) acc = __builtin_amdgcn_mfma_f32_16x16x32_bf16(cf[ks], xfr[ks], acc, 0, 0, 0);
            const int mmax = i >> 1;
            const bf16_t* kb = kbase + i * 256;
#pragma unroll
            for (int mg = 0; mg < 8; ++mg) {
                if (4 * mg <= mmax) {
                    bf16x8 kf[4];
#pragma unroll
                    for (int j = 0; j < 4; ++j) kf[j] = *(const bf16x8*)(kb - (4 * mg + j) * 512);
#pragma unroll
                    for (int j = 0; j < 4; ++j) acc = __builtin_amdgcn_mfma_f32_16x16x32_bf16(kf[j], ufr[4 * mg + j], acc, 0, 0, 0);
                }
            }
            const float y0 = gelu_tanh(acc[0] + dv[0] * bflo(uv[0])), y1 = gelu_tanh(acc[1] + dv[1] * bfhi(uv[0]));
            const float y2 = gelu_tanh(acc[2] + dv[2] * bflo(uv[1])), y3 = gelu_tanh(acc[3] + dv[3] * bfhi(uv[1]));
            u32x2 o; o[0] = pack2(y0, y1); o[1] = pack2(y2, y3);
            *(u32x2*)(p.s0 + ((size_t)b * SEQ + s) * D + g * 16 + 4 * q) = o;
#pragma unroll
            for (int ks = 0; ks < 4; ++ks) cf[ks] = cfn[ks];
        }
        __syncthreads();
    }
}

__device__ __forceinline__ float med3f(float a, float b, float c) { return __builtin_amdgcn_fmed3f(a, b, c); }
__device__ __forceinline__ void ins16(float (&a)[16], float v) {
#pragma unroll
    for (int i = 15; i >= 1; --i) a[i] = med3f(a[i - 1], a[i], v);
    a[0] = fmaxf(a[0], v);
}
__device__ void route_phase(const Params& p, int layer, const bf16_t* qp, unsigned char* smem) {
    float* sc = (float*)smem;
    float* tl = (float*)(smem + 2 * 128 * 129 * 4);
    const int tid = threadIdx.x, lane = tid & 63, w = tid >> 6, tk = lane & 15, q = lane >> 4;
    for (int task = blockIdx.x; task < (T / 128) * 8; task += gridDim.x) {
        const int h = task & 7, t0 = (task >> 3) * 128;
#pragma unroll 1
        for (int pp = 0; pp < 2; ++pp) {
            const bf16_t* qrow = qp + (size_t)(t0 + 16 * w + tk) * D + h * 128 + pp * 64 + 8 * q;
            const bf16x8 a0 = *(const bf16x8*)(qrow), a1 = *(const bf16x8*)(qrow + 32);
            const bf16_t* kb = p.skeys + ((size_t)((layer * 8 + h) * 2 + pp) * 128) * 64 + 8 * q;
#pragma unroll
            for (int nf = 0; nf < 8; ++nf) {
                const bf16x8 b0 = *(const bf16x8*)(kb + (size_t)(nf * 16 + tk) * 64), b1 = *(const bf16x8*)(kb + (size_t)(nf * 16 + tk) * 64 + 32);
                f32x4 acc = {0.f, 0.f, 0.f, 0.f};
                acc = __builtin_amdgcn_mfma_f32_16x16x32_bf16(a0, b0, acc, 0, 0, 0);
                acc = __builtin_amdgcn_mfma_f32_16x16x32_bf16(a1, b1, acc, 0, 0, 0);
#pragma unroll
                for (int r = 0; r < 4; ++r) sc[(pp * 128 + 16 * w + 4 * q + r) * 129 + nf * 16 + tk] = acc[r];
            }
        }
        __syncthreads();
        {
            const int list = tid & 255, kr = tid >> 8;
            float a[16];
#pragma unroll
            for (int i = 0; i < 16; ++i) a[i] = -3.0e38f;
            const float* row = sc + list * 129 + kr * 64;
            for (int j = 0; j < 64; ++j) {
                const float v = __uint_as_float((__float_as_uint(row[j]) & ~0x7Fu) | (unsigned)(kr * 64 + j));
                ins16(a, v);
            }
            if (kr == 1) {
#pragma unroll
                for (int i = 0; i < 16; ++i) tl[list * 16 + i] = a[i];
            }
            __syncthreads();
            if (kr == 0) {
                float o[16];
#pragma unroll
                for (int i = 0; i < 16; ++i) o[i] = tl[list * 16 + i];
#pragma unroll
                for (int i = 0; i < 16; ++i) ins16(a, o[i]);
#pragma unroll
                for (int i = 0; i < 16; ++i) tl[list * 16 + i] = a[i];
            }
            __syncthreads();
        }
        if (tid < 128) {
            float s[16], r[16], c[16];
#pragma unroll
            for (int i = 0; i < 16; ++i) { s[i] = tl[tid * 16 + i]; r[i] = tl[(128 + tid) * 16 + i]; c[i] = -3.0e38f; }
#pragma unroll
            for (int i = 0; i < 16; ++i)
#pragma unroll
                for (int j = 0; j < 16; ++j)
                    if ((i + 1) * (j + 1) <= 16) {
                        const float v = __uint_as_float((__float_as_uint(s[i] + r[j]) & ~0xFFu) | (unsigned)(i * 16 + j));
                        ins16(c, v);
                    }
            float e[16], sum = 0.f;
#pragma unroll
            for (int k = 0; k < 16; ++k) { e[k] = __expf(c[k] - c[0]); sum += e[k]; }
            const float inv = 1.f / sum;
            int idv[16];
#pragma unroll
            for (int k = 0; k < 16; ++k) {
                const unsigned bits = __float_as_uint(c[k]), i = (bits >> 4) & 15u, j = bits & 15u;
                const unsigned ki = __float_as_uint(tl[tid * 16 + i]) & 0x7Fu, kj = __float_as_uint(tl[(128 + tid) * 16 + j]) & 0x7Fu;
                idv[k] = (int)(ki * 128u + kj);
            }
            int* ido = p.ids + (size_t)(t0 + tid) * 128 + h * 16; float* go = p.gates + (size_t)(t0 + tid) * 128 + h * 16;
#pragma unroll
            for (int k4 = 0; k4 < 4; ++k4) {
                *(int4*)(ido + k4 * 4) = make_int4(idv[k4 * 4], idv[k4 * 4 + 1], idv[k4 * 4 + 2], idv[k4 * 4 + 3]);
                *(f32x4*)(go + k4 * 4) = (f32x4){e[k4 * 4] * inv, e[k4 * 4 + 1] * inv, e[k4 * 4 + 2] * inv, e[k4 * 4 + 3] * inv};
            }
        }
        __syncthreads();
    }
}

typedef _Float16 h16x2 __attribute__((ext_vector_type(2)));
typedef _Float16 h16x8 __attribute__((ext_vector_type(8)));
#ifndef NVR
#define NVR 16
#endif
__device__ __forceinline__ unsigned and_or(unsigned x, unsigned m, unsigned c) { unsigned r; asm("v_and_or_b32 %0, %1, %2, %3" : "=v"(r) : "v"(x), "s"(m), "v"(c)); return r; }
__device__ __forceinline__ void fma_mix_lo(float& acc, float a, unsigned t) { asm("v_fma_mix_f32 %0, %1, %2, %0 op_sel_hi:[0,1,0]" : "+v"(acc) : "s"(a), "v"(t)); }
__device__ __forceinline__ void fma_mix_hi(float& acc, float a, unsigned t) { asm("v_fma_mix_f32 %0, %1, %2, %0 op_sel:[0,1,0] op_sel_hi:[0,1,0]" : "+v"(acc) : "s"(a), "v"(t)); }
template <bool FINAL>
__device__ void gather_phase(const Params& p, int layer, const float* xin, float* xout, bf16_t* hkv_out, bf16_t* hq_out, const float* gnorm, int c_shift, int c_scale, int c_gate, unsigned char* smem) {
    const int lane = threadIdx.x & 63, wv = threadIdx.x >> 6, tk = lane & 15, q = lane >> 4;
    const int nw = gridDim.x * (NT / 64);
    const unsigned char* utab = p.ub + (size_t)layer * NEXP * 512;
    const unsigned char* vtab = p.vb + (size_t)layer * NEXP * 512;
    const float* sutab = p.su + (size_t)layer * NEXP;
    const float* svtab = p.sv + (size_t)layer * NEXP;
    unsigned char* hl = smem + wv * 2048;
    unsigned c_hi, c_lo;
    asm volatile("v_mov_b32 %0, 0x64006400" : "=v"(c_hi));
    asm volatile("v_mov_b32 %0, 0x54005400" : "=v"(c_lo));
    for (int t = blockIdx.x * (NT / 64) + wv; t < T; t += nw) {
        const int b = t / SEQ;
        const float* cb = p.cond + (size_t)b * (NCOND * D);
        const float* xr = xin + (size_t)t * D;
        const int e0 = lane * 16;
        float kcorr;
        {
            f32x4 xv[4]; float ss = 0.f;
#pragma unroll
            for (int j = 0; j < 4; ++j) { xv[j] = *(const f32x4*)(xr + e0 + j * 4); ss += xv[j][0] * xv[j][0] + xv[j][1] * xv[j][1] + xv[j][2] * xv[j][2] + xv[j][3] * xv[j][3]; }
            ss = wave_sum(ss);
            const float rstd = rsqrtf(ss * (1.f / D) + RMS_EPS);
            float s_hi = 0.f, s_lo = 0.f; unsigned hw[8];
#pragma unroll
            for (int j = 0; j < 4; ++j) {
                const f32x4 g = *(const f32x4*)(gnorm + e0 + j * 4), sc = *(const f32x4*)(cb + c_scale * D + e0 + j * 4), sh = *(const f32x4*)(cb + c_shift * D + e0 + j * 4);
                float h[4];
#pragma unroll
                for (int e = 0; e < 4; ++e) h[e] = xv[j][e] * rstd * g[e] * (1.f + sc[e]) + sh[e];
                const h16x2 p0 = {(_Float16)h[0], (_Float16)h[1]}, p1 = {(_Float16)h[2], (_Float16)h[3]};
                hw[2 * j] = __builtin_bit_cast(unsigned, p0); hw[2 * j + 1] = __builtin_bit_cast(unsigned, p1);
                s_hi += (float)p0[0] + (float)p0[1]; s_lo += (float)p1[0] + (float)p1[1];
            }
            *(u32x4*)(hl + lane * 32) = (u32x4){hw[0], hw[1], hw[2], hw[3]};
            *(u32x4*)(hl + lane * 32 + 16) = (u32x4){hw[4], hw[5], hw[6], hw[7]};
            kcorr = wave_sum(1031.5f * s_hi + 71.5f * s_lo);
        }
        asm volatile("s_waitcnt lgkmcnt(0)" ::: "memory");
        const unsigned char* hq4 = hl + q * 64;
        const int idA = p.ids[(size_t)t * 128 + lane], idB = p.ids[(size_t)t * 128 + 64 + lane];
        const float gA = p.gates[(size_t)t * 128 + lane], gB = p.gates[(size_t)t * 128 + 64 + lane];
        const float suA = sutab[idA], suB = sutab[idB], svA = svtab[idA], svB = svtab[idB];
        float dA = 0.f, dB = 0.f;
        u32x4 rb[4][8];
        auto issue_u = [&](u32x4 (&buf)[8], int bt) {
            const int id = __shfl(bt < 4 ? idA : idB, (bt * 16 + tk) & 63);
            const unsigned char* rp = utab + (size_t)id * 512 + q * 16;
#pragma unroll
            for (int kk = 0; kk < 8; ++kk) buf[kk] = *(const u32x4*)(rp + kk * 64);
        };
        auto consume_ub = [&](const u32x4 (&buf)[8], int bt) {
            f32x4 acc = {0.f, 0.f, 0.f, 0.f};
            int zoff; asm volatile("s_mov_b32 %0, 0" : "=s"(zoff));
            const unsigned char* hqz = hq4 + zoff;
#pragma unroll
            for (int kk = 0; kk < 8; ++kk) {
                h16x8 hbk[4];
#pragma unroll
                for (int d = 0; d < 4; ++d) hbk[d] = *(const h16x8*)(hqz + kk * 256 + d * 16);
#pragma unroll
                for (int d = 0; d < 4; ++d) {
                    const unsigned x = buf[kk][d], x8 = x >> 8;
                    u32x4 tw; tw[0] = and_or(x, 0x000F000Fu, c_hi); tw[1] = and_or(x, 0x00F000F0u, c_lo); tw[2] = and_or(x8, 0x000F000Fu, c_hi); tw[3] = and_or(x8, 0x00F000F0u, c_lo);
                    acc = __builtin_amdgcn_mfma_f32_16x16x32_f16(__builtin_bit_cast(h16x8, tw), hbk[d], acc, 0, 0, 0);
                }
            }
            const int r = lane & 3;
            const float mine = r == 0 ? acc[0] : (r == 1 ? acc[1] : (r == 2 ? acc[2] : acc[3]));
            const float got = __shfl(mine, ((lane & 15) >> 2) * 16 + (lane & 15));
            if (q == (bt & 3)) { if (bt < 4) dA = got; else dB = got; }
        };
#pragma unroll
        for (int j = 0; j < 3; ++j) issue_u(rb[j], j);
#pragma unroll 1
        for (int bt = 0; bt < 8; bt += 4) {
#pragma unroll
            for (int j = 0; j < 4; ++j) {
                if (bt + j + 3 < 8) issue_u(rb[(j + 3) & 3], bt + j + 3);
                consume_ub(rb[j], bt + j);
            }
        }
        const float apA = gelu_tanh((dA - kcorr) * suA) * gA * svA, apB = gelu_tanh((dB - kcorr) * suB) * gB * svB;
        const float suma = wave_sum(apA + apB);
        float o[16];
#pragma unroll
        for (int e = 0; e < 16; ++e) o[e] = 0.f;
        u32x2 vr[NVR];
        auto issue_v = [&](u32x2& buf, int k) {
            const int id = __builtin_amdgcn_readlane(k < 64 ? idA : idB, k & 63);
            buf = *(const u32x2*)(vtab + (size_t)id * 512 + lane * 8);
        };
        auto consume_vv = [&](const u32x2& buf, int k) {
            const float a = __uint_as_float(__builtin_amdgcn_readlane(__float_as_uint(k < 64 ? apA : apB), k & 63));
#pragma unroll
            for (int d = 0; d < 2; ++d) {
                const unsigned x = buf[d], x8 = x >> 8;
                const unsigned t0 = and_or(x, 0x000F000Fu, c_hi), t1 = and_or(x, 0x00F000F0u, c_lo), t2 = and_or(x8, 0x000F000Fu, c_hi), t3 = and_or(x8, 0x00F000F0u, c_lo);
                fma_mix_lo(o[d * 8 + 0], a, t0); fma_mix_hi(o[d * 8 + 1], a, t0); fma_mix_lo(o[d * 8 + 2], a, t1); fma_mix_hi(o[d * 8 + 3], a, t1);
                fma_mix_lo(o[d * 8 + 4], a, t2); fma_mix_hi(o[d * 8 + 5], a, t2); fma_mix_lo(o[d * 8 + 6], a, t3); fma_mix_hi(o[d * 8 + 7], a, t3);
            }
        };
#pragma unroll
        for (int jj = 0; jj < NVR - 1; ++jj) issue_v(vr[jj], jj);
#pragma unroll 1
        for (int k0 = 0; k0 < 128; k0 += NVR) {
#pragma unroll
            for (int jj = 0; jj < NVR; ++jj) {
                if (k0 + jj + NVR - 1 < 128) issue_v(vr[(jj + NVR - 1) % NVR], k0 + jj + NVR - 1);
                consume_vv(vr[jj], k0 + jj);
            }
        }
        float xn[16]; float ss = 0.f;
        {
            const float chi = 1031.5f * suma, clo = 71.5f * suma;
#pragma unroll
            for (int j4 = 0; j4 < 4; ++j4) {
                const f32x4 xo = *(const f32x4*)(xr + e0 + j4 * 4), gv = *(const f32x4*)(cb + c_gate * D + e0 + j4 * 4);
#pragma unroll
                for (int e = 0; e < 4; ++e) {
                    const int k = j4 * 4 + e;
                    const float ov = o[k] - (((k >> 1) & 1) ? clo : chi);
                    const float v = xo[e] + gv[e] * ov;
                    xn[k] = v; ss += v * v;
                }
            }
        }
        ss = wave_sum(ss);
        const float rstd = rsqrtf(ss * (1.f / D) + RMS_EPS);
        if (!FINAL) {
#pragma unroll
            for (int j = 0; j < 4; ++j) *(f32x4*)(xout + (size_t)t * D + e0 + j * 4) = (f32x4){xn[j * 4], xn[j * 4 + 1], xn[j * 4 + 2], xn[j * 4 + 3]};
            float hk[16], hq[16];
#pragma unroll
            for (int j = 0; j < 4; ++j) {
                const f32x4 gk = *(const f32x4*)(p.kv_norm + e0 + j * 4), sck = *(const f32x4*)(cb + 13 * D + e0 + j * 4), shk = *(const f32x4*)(cb + 12 * D + e0 + j * 4);
                const f32x4 gm = *(const f32x4*)(p.norm_mix + D + e0 + j * 4), scm = *(const f32x4*)(cb + 7 * D + e0 + j * 4), shm = *(const f32x4*)(cb + 6 * D + e0 + j * 4);
#pragma unroll
                for (int e = 0; e < 4; ++e) {
                    const float xs = xn[j * 4 + e] * rstd;
                    hk[j * 4 + e] = xs * gk[e] * (1.f + sck[e]) + shk[e]; hq[j * 4 + e] = xs * gm[e] * (1.f + scm[e]) + shm[e];
                }
            }
#pragma unroll
            for (int j = 0; j < 2; ++j) {
                u32x4 ob; ob[0] = pack2(hk[j * 8], hk[j * 8 + 1]); ob[1] = pack2(hk[j * 8 + 2], hk[j * 8 + 3]); ob[2] = pack2(hk[j * 8 + 4], hk[j * 8 + 5]); ob[3] = pack2(hk[j * 8 + 6], hk[j * 8 + 7]);
                *(u32x4*)(hkv_out + (size_t)t * D + e0 + j * 8) = ob;
                u32x4 oc; oc[0] = pack2(hq[j * 8], hq[j * 8 + 1]); oc[1] = pack2(hq[j * 8 + 2], hq[j * 8 + 3]); oc[2] = pack2(hq[j * 8 + 4], hq[j * 8 + 5]); oc[3] = pack2(hq[j * 8 + 6], hq[j * 8 + 7]);
                *(u32x4*)(hq_out + (size_t)t * D + e0 + j * 8) = oc;
            }
        } else {
#pragma unroll
            for (int j = 0; j < 4; ++j) {
                const f32x4 g = *(const f32x4*)(p.final_norm + e0 + j * 4), sc = *(const f32x4*)(cb + 15 * D + e0 + j * 4), sh = *(const f32x4*)(cb + 14 * D + e0 + j * 4);
                f32x4 ov;
#pragma unroll
                for (int e = 0; e < 4; ++e) ov[e] = xn[j * 4 + e] * rstd * g[e] * (1.f + sc[e]) + sh[e];
                *(f32x4*)(p.out + (size_t)t * D + e0 + j * 4) = ov;
            }
        }
        asm volatile("s_waitcnt lgkmcnt(0)" ::: "memory");
    }
}

__device__ void attn_phase(const Params& p, const bf16_t* Q, const bf16_t* K, const bf16_t* V, bf16_t* O, unsigned char* smem) {
    unsigned char* Kl = smem;
    unsigned char* Vt = smem + 32768;
    unsigned char* Pl = smem + 32768 + 35840;
    const int tid = threadIdx.x, lane = tid & 63, w = tid >> 6, tk = lane & 15, q = lane >> 4;
    unsigned char* Pw = Pl + w * 5376;
    for (int task = blockIdx.x; task < NB * 32 * 4; task += gridDim.x) {
        const int kvh = task & 3, qblk = (task >> 2) & 31, b = task >> 7;
        const int kpos0 = (qblk - 1) * 128;
#pragma unroll
        for (int i = 0; i < 4; ++i) {
            const int id = tid + NT * i, j = id >> 3, c = id & 7, kp = kpos0 + j;
            u32x4 v = {0u, 0u, 0u, 0u};
            if (kp >= 0) v = *(const u32x4*)(K + ((size_t)b * SEQ + kp) * 256 + kvh * 64 + c * 8);
            *(u32x4*)(Kl + lds_off(j, c)) = v;
        }
#pragma unroll
        for (int i = 0; i < 4; ++i) {
            const int id = tid + NT * i, j = id & 255, dc = id >> 8, kp = kpos0 + j;
            u32x4 v = {0u, 0u, 0u, 0u};
            if (kp >= 0) v = *(const u32x4*)(V + ((size_t)b * SEQ + kp) * 256 + kvh * 64 + dc * 8);
#pragma unroll
            for (int e = 0; e < 4; ++e) {
                *(bf16_t*)(Vt + (dc * 8 + 2 * e) * 560 + j * 2) = (bf16_t)(v[e] & 0xffffu);
                *(bf16_t*)(Vt + (dc * 8 + 2 * e + 1) * 560 + j * 2) = (bf16_t)(v[e] >> 16);
            }
        }
        if (tid < 128) *(u32x4*)(Vt + (tid >> 1) * 560 + 512 + (tid & 1) * 16) = (u32x4){0u, 0u, 0u, 0u};
        *(u32x2*)(Pw + tk * 336 + (144 + 4 * q) * 2) = (u32x2){0u, 0u};
        __syncthreads();
        const int qt = w, i_q = qt * 16 + tk;
        const size_t trow = (size_t)b * SEQ + qblk * 128 + i_q;
        const unsigned char* kb0 = Kl + lds_off(qt * 16 + tk, q);
        const unsigned char* kb1 = Kl + lds_off(qt * 16 + tk, 4 + q);
        const unsigned char* vb0 = Vt + tk * 560 + (qt * 16 + 8 * q) * 2;
        unsigned char* pwr = Pw + tk * 336 + 8 * q;
        const unsigned char* prd = Pw + tk * 336 + 16 * q;
#pragma unroll 1
        for (int hq = 0; hq < 4; ++hq) {
            const int head = kvh * 4 + hq;
            const bf16x8 qf0 = *(const bf16x8*)(Q + trow * D + head * 64 + 8 * q), qf1 = *(const bf16x8*)(Q + trow * D + head * 64 + 32 + 8 * q);
            f32x4 sacc[9];
#pragma unroll
            for (int kk = 0; kk < 9; ++kk) {
                const bf16x8 k0 = *(const bf16x8*)(kb0 + kk * 2048), k1 = *(const bf16x8*)(kb1 + kk * 2048);
                f32x4 a = {0.f, 0.f, 0.f, 0.f};
                a = __builtin_amdgcn_mfma_f32_16x16x32_bf16(k0, qf0, a, 0, 0, 0);
                a = __builtin_amdgcn_mfma_f32_16x16x32_bf16(k1, qf1, a, 0, 0, 0);
                sacc[kk] = a;
                if (kk & 1) __builtin_amdgcn_sched_barrier(0);
            }
            const float sink = p.sinks[head];
            float mx = -1e30f;
#pragma unroll
            for (int kk = 0; kk < 9; ++kk)
#pragma unroll
                for (int r = 0; r < 4; ++r) {
                    const int j = (qt + kk) * 16 + 4 * q + r;
                    const bool valid = (j > i_q) && (j <= i_q + 128) && (qblk > 0 || j >= 128);
                    const float s = valid ? sacc[kk][r] * 0.125f : -1e30f;
                    sacc[kk][r] = s; mx = fmaxf(mx, s);
                }
            mx = fmaxf(mx, __shfl_xor(mx, 16)); mx = fmaxf(mx, __shfl_xor(mx, 32));
            mx = fmaxf(mx, sink);
            float sum = 0.f;
#pragma unroll
            for (int kk = 0; kk < 9; ++kk)
#pragma unroll
                for (int r = 0; r < 4; ++r) { const float e = __expf(sacc[kk][r] - mx); sacc[kk][r] = e; sum += e; }
            sum += __shfl_xor(sum, 16); sum += __shfl_xor(sum, 32);
            const float inv = 1.f / (sum + __expf(sink - mx));
#pragma unroll
            for (int kk = 0; kk < 9; ++kk) {
                u32x2 o; o[0] = pack2(sacc[kk][0] * inv, sacc[kk][1] * inv); o[1] = pack2(sacc[kk][2] * inv, sacc[kk][3] * inv);
                *(u32x2*)(pwr + kk * 32) = o;
            }
            asm volatile("s_waitcnt lgkmcnt(0)" ::: "memory");
            bf16x8 pf[5];
#pragma unroll
            for (int ks = 0; ks < 5; ++ks) pf[ks] = *(const bf16x8*)(prd + ks * 64);
#pragma unroll
            for (int dt = 0; dt < 4; ++dt) {
                f32x4 oa = {0.f, 0.f, 0.f, 0.f};
#pragma unroll
                for (int ks = 0; ks < 5; ++ks) {
                    const bf16x8 vf = *(const bf16x8*)(vb0 + dt * 8960 + ks * 64);
                    oa = __builtin_amdgcn_mfma_f32_16x16x32_bf16(vf, pf[ks], oa, 0, 0, 0);
                }
                u32x2 o; o[0] = pack2(oa[0], oa[1]); o[1] = pack2(oa[2], oa[3]);
                *(u32x2*)(O + trow * D + head * 64 + dt * 16 + 4 * q) = o;
                __builtin_amdgcn_sched_barrier(0);
            }
            asm volatile("s_waitcnt lgkmcnt(0)" ::: "memory");
        }
        __syncthreads();
    }
}

constexpr int SMEM_BYTES = 152 * 1024;
__global__ void __launch_bounds__(NT) yoco_fwd(Params p) {
    __shared__ __attribute__((aligned(16))) unsigned char smem[SMEM_BYTES];
    volatile LAS unsigned* st = (volatile LAS unsigned*)(smem + SMEM_BYTES - 16);
    if (threadIdx.x == 0) { st[0] = 0u; st[1] = 0u; }
    __syncthreads();
    const XcdBarrier xb = xcd_barrier_post(p.bar, st);
    p0_cond(p, smem);
    p0_tables(p);
    p0_wt(p, smem);
    p0_s5(p, smem);
    xcd_barrier(xb);
    p05_prep(p, smem);
    xcd_barrier(xb);
    bias_finalize(p);
    { EpiU e{p.s1}; gemm_phase(p.s0, p.wt_in, 0, 1024, e, smem); }
    xcd_barrier(xb);
    s5_phase(p, smem);
    xcd_barrier(xb);
    { EpiGlu e{p.s0, p.b_glu, p.s1}; gemm_phase(p.s0, p.wt_glu, 0, 1024, e, smem); }
    xcd_barrier(xb);
    { EpiRes e{p.x, p.cond + 2 * D, p.norm_ffn, p.cond + 4 * D, p.f0, p.s2, p.ssq1}; gemm_phase(p.s1, p.wt_out, 0, 1024, e, smem); }
    xcd_barrier(xb);
    { EpiQ e{p.ssq1, p.bias, 0, p.s1}; gemm_phase(p.s2, p.wt_pq0, 0, 1024, e, smem); }
    xcd_barrier(xb);
    route_phase(p, 0, p.s1, smem);
    xcd_barrier(xb);
    gather_phase<false>(p, 0, p.f0, p.f1, p.s0, p.s2, p.norm_ffn, 3, 4, 5, smem);
    xcd_barrier(xb);
    { EpiRope<0> e{p.ropec, p.ropes, p.s1, p.s1 + (size_t)T * 256}; gemm_phase(p.s0, p.wt_kv, 0, 512, e, smem); }
    { EpiRope<1> e{p.ropec, p.ropes, p.s3, nullptr}; gemm_phase(p.s2, p.wt_q, 0, 1024, e, smem); }
    xcd_barrier(xb);
    attn_phase(p, p.s3, p.s1, p.s1 + (size_t)T * 256, p.s0, smem);
    xcd_barrier(xb);
    { EpiRes e{p.f1, p.cond + 8 * D, p.norm_ffn + D, p.cond + 10 * D, p.f0, p.s2, p.ssq3}; gemm_phase(p.s0, p.wt_o, 0, 1024, e, smem); }
    xcd_barrier(xb);
    { EpiQ e{p.ssq3, p.bias, 1024, p.s1}; gemm_phase(p.s2, p.wt_pq1, 0, 1024, e, smem); }
    xcd_barrier(xb);
    route_phase(p, 1, p.s1, smem);
    xcd_barrier(xb);
    gather_phase<true>(p, 1, p.f0, nullptr, nullptr, nullptr, p.norm_ffn + D, 9, 10, 11, smem);
}

static inline size_t align_up(size_t v, size_t a) { return (v + a - 1) / a * a; }

extern "C" void kernel_launch(void* const* d_in, const int* in_sizes, int n_in, void* d_out, int out_size, void* d_ws, size_t ws_size, hipStream_t stream) {
    (void)in_sizes; (void)n_in; (void)out_size;
    Params p{};
    p.x = (const float*)d_in[0]; p.c = (const float*)d_in[1]; p.pos = (const int*)d_in[2]; p.w_cond = (const float*)d_in[3]; p.b_cond = (const float*)d_in[4];
    p.norm_mix = (const float*)d_in[5]; p.norm_ffn = (const float*)d_in[6]; p.w_in = (const float*)d_in[7]; p.a_re = (const float*)d_in[8]; p.a_im = (const float*)d_in[9];
    p.log_dt = (const float*)d_in[10]; p.b_re = (const float*)d_in[11]; p.b_im = (const float*)d_in[12]; p.c_re = (const float*)d_in[13]; p.c_im = (const float*)d_in[14];
    p.s5d = (const float*)d_in[15]; p.w_glu = (const float*)d_in[16]; p.b_glu = (const float*)d_in[17]; p.w_out = (const float*)d_in[18]; p.kv_norm = (const float*)d_in[19];
    p.w_kv = (const float*)d_in[20]; p.w_q = (const float*)d_in[21]; p.sinks = (const float*)d_in[22]; p.w_o = (const float*)d_in[23]; p.peer_wq = (const float*)d_in[24];
    p.subkeys = (const float*)d_in[25]; p.peer_u = (const float*)d_in[26]; p.peer_v = (const float*)d_in[27]; p.final_norm = (const float*)d_in[28];
    p.out = (float*)d_out;
    unsigned char* w = (unsigned char*)d_ws; size_t off = 65536;
    p.bar = (unsigned*)d_ws;
    auto take = [&](size_t bytes) { void* r = w + off; off = align_up(off + bytes, 4096); return r; };
    p.cond = (float*)take((size_t)NB * NCOND * D * 4);
    p.ropec = (float*)take((size_t)T * 32 * 4); p.ropes = (float*)take((size_t)T * 32 * 4);
    p.ssq1 = (float*)take((size_t)T * 16 * 4); p.ssq3 = (float*)take((size_t)T * 16 * 4);
    p.wt_in = (bf16_t*)take((size_t)D * D * 2); p.wt_glu = (bf16_t*)take((size_t)D * D * 2); p.wt_out = (bf16_t*)take((size_t)D * D * 2); p.wt_kv = (bf16_t*)take((size_t)512 * D * 2);
    p.wt_q = (bf16_t*)take((size_t)D * D * 2); p.wt_o = (bf16_t*)take((size_t)D * D * 2); p.wt_pq0 = (bf16_t*)take((size_t)D * D * 2); p.wt_pq1 = (bf16_t*)take((size_t)D * D * 2);
    p.biasp = (float*)take((size_t)8 * 4 * 2048 * 4); p.bias = (float*)take((size_t)4 * 2048 * 4);
    p.skeys = (bf16_t*)take((size_t)2 * 8 * 2 * 128 * 64 * 2);
    p.lamL = (float*)take((size_t)G5 * P5 * 2 * 4); p.ktab = (bf16_t*)take((size_t)G5 * KTR * 256 * 2);
    p.smat = (bf16_t*)take((size_t)G5 * 128 * 1024 * 2); p.cmat = (bf16_t*)take((size_t)G5 * 1024 * 128 * 2);
    p.ub = (unsigned char*)take((size_t)2 * NEXP * D); p.vb = (unsigned char*)take((size_t)2 * NEXP * D);
    p.su = (float*)take((size_t)2 * NEXP * 4); p.sv = (float*)take((size_t)2 * NEXP * 4);
    p.s0 = (bf16_t*)take((size_t)T * D * 2); p.s1 = (bf16_t*)take((size_t)T * D * 2); p.s2 = (bf16_t*)take((size_t)T * D * 2); p.s3 = (bf16_t*)take((size_t)T * D * 2);
    p.f0 = (float*)take((size_t)T * D * 4); p.f1 = (float*)take((size_t)T * D * 4);
    p.ids = (int*)take((size_t)T * 128 * 4); p.gates = (float*)take((size_t)T * 128 * 4);
    if (off > ws_size) { fprintf(stderr, "workspace too small: need %zu have %zu\n", off, ws_size); return; }

    static int grid_blocks = 0;
    if (!grid_blocks) {
        int dev = 0, cus = 0, per_cu = 0;
        (void)hipGetDevice(&dev);
        (void)hipDeviceGetAttribute(&cus, hipDeviceAttributeMultiprocessorCount, dev);
        (void)hipOccupancyMaxActiveBlocksPerMultiprocessor(&per_cu, yoco_fwd, NT, 0);
        if (per_cu > 1) per_cu = 1;
        grid_blocks = cus * per_cu;
        if (grid_blocks <= 0) grid_blocks = 256;
    }
    (void)hipMemsetAsync(d_ws, 0, XCD_BAR_WORDS * 4, stream);
    void* args[] = {&p};
    hipError_t e = hipLaunchCooperativeKernel((const void*)yoco_fwd, dim3(grid_blocks), dim3(NT), args, 0, stream);
    if (e != hipSuccess) fprintf(stderr, "cooperative launch failed: %s (grid %d)\n", hipGetErrorString(e), grid_blocks);
}
```

```cpp
#include <hip/hip_runtime.h>
#include <cstdio>
#include <cstdint>

#define NT 512
#define LAS __attribute__((address_space(3)))
typedef unsigned short bf16_t;
typedef short bf16x8 __attribute__((ext_vector_type(8)));
typedef float f32x4 __attribute__((ext_vector_type(4)));
typedef unsigned u32x4 __attribute__((ext_vector_type(4)));
typedef unsigned u32x2 __attribute__((ext_vector_type(2)));

constexpr int D = 1024, NB = 4, SEQ = 4096, T = NB * SEQ;
constexpr int NCOND = 16;
constexpr int G5 = 64, P5 = 64, C5 = 16, L5 = 64, NCH = SEQ / L5, KTR = 72;
constexpr int NEXP = 16384;
constexpr float RMS_EPS = 1e-6f;

struct Params {
    const float *x, *c; const int* pos; const float *w_cond, *b_cond, *norm_mix, *norm_ffn, *w_in, *a_re, *a_im, *log_dt, *b_re, *b_im, *c_re, *c_im, *s5d,
        *w_glu, *b_glu, *w_out, *kv_norm, *w_kv, *w_q, *sinks, *w_o, *peer_wq, *subkeys, *peer_u, *peer_v, *final_norm;
    float* out;
    unsigned* bar;
    float* cond;
    float* ropec;
    float* ropes;
    float* ssq1;
    float* ssq3;
    bf16_t *wt_in, *wt_glu, *wt_out, *wt_kv, *wt_q, *wt_o, *wt_pq0, *wt_pq1;
    float* biasp;
    float* bias;
    bf16_t* skeys;
    float* lamL;
    bf16_t* ktab;
    bf16_t* smat;
    bf16_t* cmat;
    unsigned char* ub;
    unsigned char* vb;
    float* su;
    float* sv;
    bf16_t *s0, *s1, *s2, *s3;
    float *f0, *f1;
    int* ids;
    float* gates;
};

#define XB_TMO      128
#define XB_XCNT(j)  (256  + 64 * (j))
#define XB_XSUB(j)  (1280 + 64 * (j))
#define XB_XGEN(j)  (2304 + 64 * (j))
#define XB_TOP      3328
#define XB_TOPGEN   3392
#define XCD_BAR_WORDS 3456
#define XB_SPIN_CAP (1u << 22)
__device__ __forceinline__ unsigned xb_ld(unsigned* p)              { return __hip_atomic_load(p, __ATOMIC_RELAXED, __HIP_MEMORY_SCOPE_AGENT); }
__device__ __forceinline__ unsigned xb_add(unsigned* p, unsigned v) { return __hip_atomic_fetch_add(p, v, __ATOMIC_RELAXED, __HIP_MEMORY_SCOPE_AGENT); }
__device__ __forceinline__ unsigned xb_xcc_id() { return (unsigned)__builtin_amdgcn_s_getreg((3 << 11) | 20) & 0xFu; }
#define XB_SPIN(cond, bar) do { unsigned _sp = 0; while (cond) { __builtin_amdgcn_s_sleep(1); \
    if ((++_sp & 255u) == 0u) { if (xb_ld(&(bar)[XB_TMO])) break; if (_sp > XB_SPIN_CAP) { atomicAdd(&(bar)[XB_TMO], 1u); break; } } } } while (0)
struct XcdBarrier { unsigned* bar; unsigned x; volatile LAS unsigned* st; };
__device__ __forceinline__ XcdBarrier xcd_barrier_post(unsigned* bar, volatile LAS unsigned* st) {
    XcdBarrier b; b.bar = bar; b.x = xb_xcc_id(); b.st = st;
    if (threadIdx.x == 0) (void)xb_add(&bar[XB_XCNT(b.x)], 1u);
    return b;
}
__device__ __forceinline__ void xcd_barrier_complete(unsigned* bar, unsigned x, unsigned& nloc, unsigned& nx) {
    const unsigned G = gridDim.x * gridDim.y * gridDim.z;
    unsigned sum, cnt, mine, sp = 0u;
    for (;;) {
        sum = 0u; cnt = 0u; mine = 0u;
#pragma unroll
        for (unsigned j = 0; j < 16; ++j) { const unsigned c = xb_ld(&bar[XB_XCNT(j)]); sum += c; cnt += (c > 0u) ? 1u : 0u; mine = (j == x) ? c : mine; }
        if (sum == G) break;
        __builtin_amdgcn_s_sleep(1);
        if ((++sp & 255u) == 0u) { if (xb_ld(&bar[XB_TMO])) break; if (sp > XB_SPIN_CAP) { atomicAdd(&bar[XB_TMO], 1u); break; } }
    }
    nloc = mine > 0u ? mine : 1u; nx = cnt > 0u ? cnt : 1u;
}
__device__ __forceinline__ void xcd_barrier(const XcdBarrier& b) {
    asm volatile("s_waitcnt vmcnt(0)" ::: "memory");
    __syncthreads();
    if (threadIdx.x == 0) {
        unsigned* bar = b.bar;
        __builtin_amdgcn_s_waitcnt(0);
        unsigned nloc = b.st[0], nx = b.st[1];
        if (nloc == 0u) { xcd_barrier_complete(bar, b.x, nloc, nx); b.st[0] = nloc; b.st[1] = nx; }
        const unsigned old = xb_add(&bar[XB_XSUB(b.x)], 1u);
        const unsigned gen = old / nloc;
        if (old + 1u == (gen + 1u) * nloc) {
            __builtin_amdgcn_fence(__ATOMIC_RELEASE, "agent");
            asm volatile("s_waitcnt vmcnt(0)" ::: "memory");
            const unsigned og = xb_add(&bar[XB_TOP], 1u);
            const unsigned tg = og / nx;
            if (og + 1u == (tg + 1u) * nx) xb_add(&bar[XB_TOPGEN], 1u);
            else XB_SPIN(xb_ld(&bar[XB_TOPGEN]) == tg, bar);
            __builtin_amdgcn_fence(__ATOMIC_ACQUIRE, "agent");
            xb_add(&bar[XB_XGEN(b.x)], 1u);
            asm volatile("s_waitcnt vmcnt(0)" ::: "memory");
        } else {
            XB_SPIN(xb_ld(&bar[XB_XGEN(b.x)]) == gen, bar);
            __builtin_amdgcn_fence(__ATOMIC_ACQUIRE, "agent");
            asm volatile("s_waitcnt vmcnt(0)" ::: "memory");
        }
    }
    __syncthreads();
}

__device__ __forceinline__ bf16_t f2bf(float f) { unsigned u = __float_as_uint(f); u += 0x7fffu + ((u >> 16) & 1u); return (bf16_t)(u >> 16); }
__device__ __forceinline__ float bf2f(bf16_t h) { return __uint_as_float(((unsigned)h) << 16); }
typedef __bf16 hbf2 __attribute__((ext_vector_type(2)));
typedef float f32x2 __attribute__((ext_vector_type(2)));
__device__ __forceinline__ unsigned pack2(float lo, float hi) { f32x2 v = {lo, hi}; return __builtin_bit_cast(unsigned, __builtin_convertvector(v, hbf2)); }
__device__ __forceinline__ float dot2bf(unsigned a, unsigned b, float c) { return __builtin_amdgcn_fdot2_f32_bf16(__builtin_bit_cast(hbf2, a), __builtin_bit_cast(hbf2, b), c, false); }
__device__ __forceinline__ float bflo(unsigned w) { return __uint_as_float(w << 16); }
__device__ __forceinline__ float bfhi(unsigned w) { return __uint_as_float(w & 0xffff0000u); }
__device__ __forceinline__ float wave_sum(float v) {
#pragma unroll
    for (int o = 32; o >= 1; o >>= 1) v += __shfl_xor(v, o);
    return v;
}
__device__ __forceinline__ float gelu_tanh(float x) {
    const float u = 0.7978845608028654f * (x + 0.044715f * x * x * x);
    const float e = __expf(-2.f * fabsf(u));
    float th = (1.f - e) / (1.f + e);
    th = u < 0.f ? -th : th;
    return 0.5f * x * (1.f + th);
}

__device__ void p0_cond(const Params& p, unsigned char* smem) {
    float* sc = (float*)smem;
    float* red = (float*)(smem + 16384);
    const int tid = threadIdx.x;
    for (int i = tid; i < 4 * D; i += NT) { const float v = p.c[i]; sc[i] = v / (1.f + __expf(-v)); }
    __syncthreads();
    const int cgp = tid & 15, kg = tid >> 4;
    for (int task = blockIdx.x; task < NCOND * D / 64; task += gridDim.x) {
        const int col0 = task * 64 + cgp * 4;
        float acc[4][4];
#pragma unroll
        for (int b = 0; b < 4; ++b)
#pragma unroll
            for (int j = 0; j < 4; ++j) acc[b][j] = 0.f;
#pragma unroll 1
        for (int k0 = 0; k0 < 32; k0 += 8) {
            f32x4 w[8];
#pragma unroll
            for (int j = 0; j < 8; ++j) w[j] = *(const f32x4*)(p.w_cond + (size_t)(kg + 32 * (k0 + j)) * (NCOND * D) + col0);
#pragma unroll
            for (int j = 0; j < 8; ++j)
#pragma unroll
                for (int b = 0; b < 4; ++b) { const float s = sc[b * D + kg + 32 * (k0 + j)];
#pragma unroll
                    for (int e = 0; e < 4; ++e) acc[b][e] += s * w[j][e]; }
        }
#pragma unroll
        for (int b = 0; b < 4; ++b)
#pragma unroll
            for (int j = 0; j < 4; ++j) red[(kg * 64 + cgp * 4 + j) * 4 + b] = acc[b][j];
        __syncthreads();
        if (tid < 256) {
            const int col = tid >> 2, b = tid & 3;
            float s = 0.f;
            for (int g = 0; g < 32; ++g) s += red[(g * 64 + col) * 4 + b];
            p.cond[(size_t)b * (NCOND * D) + task * 64 + col] = s + p.b_cond[task * 64 + col];
        }
        __syncthreads();
    }
}

__device__ void p0_tables(const Params& p) {
    const size_t gtid = (size_t)blockIdx.x * NT + threadIdx.x, gstride = (size_t)gridDim.x * NT;
    {
        const int li = threadIdx.x & 15;
        const size_t grp = gtid >> 4, ngrp = gstride >> 4;
        for (int which = 0; which < 2; ++which) {
            const float* src = which ? p.peer_v : p.peer_u; unsigned char* dst = which ? p.vb : p.ub; float* sdst = which ? p.sv : p.su;
            for (size_t row = grp; row < (size_t)2 * NEXP; row += ngrp) {
                f32x4 v[2][8]; float ss = 0.f;
#pragma unroll
                for (int c = 0; c < 2; ++c)
#pragma unroll
                    for (int j = 0; j < 8; ++j) {
                        v[c][j] = *(const f32x4*)(src + row * D + c * 512 + li * 32 + j * 4);
#pragma unroll
                        for (int e = 0; e < 4; ++e) ss += v[c][j][e] * v[c][j][e];
                    }
                ss += __shfl_xor(ss, 1); ss += __shfl_xor(ss, 2); ss += __shfl_xor(ss, 4); ss += __shfl_xor(ss, 8);
                const float step = 0.48f * sqrtf(ss * (1.f / D)), inv = step > 0.f ? 1.f / step : 0.f;
#pragma unroll
                for (int c = 0; c < 2; ++c) {
                    u32x4 o;
#pragma unroll
                    for (int d = 0; d < 4; ++d) {
                        unsigned wd = 0u;
                        wd = __builtin_amdgcn_cvt_scalef32_pk_fp4_f32(wd, v[c][d * 2][0] * inv, v[c][d * 2][1] * inv, 1.0f, 0);
                        wd = __builtin_amdgcn_cvt_scalef32_pk_fp4_f32(wd, v[c][d * 2][2] * inv, v[c][d * 2][3] * inv, 1.0f, 1);
                        wd = __builtin_amdgcn_cvt_scalef32_pk_fp4_f32(wd, v[c][d * 2 + 1][0] * inv, v[c][d * 2 + 1][1] * inv, 1.0f, 2);
                        wd = __builtin_amdgcn_cvt_scalef32_pk_fp4_f32(wd, v[c][d * 2 + 1][2] * inv, v[c][d * 2 + 1][3] * inv, 1.0f, 3);
                        o[d] = wd;
                    }
                    *(u32x4*)(dst + row * 512 + c * 256 + li * 16) = o;
                }
                if (li == 0) sdst[row] = step;
            }
        }
    }
    const size_t nk8 = (size_t)2 * 8 * 2 * 128 * 64 / 8;
    for (size_t i = gtid; i < nk8; i += gstride) {
        const f32x4 a = *(const f32x4*)(p.subkeys + i * 8), b = *(const f32x4*)(p.subkeys + i * 8 + 4);
        u32x4 o; o[0] = pack2(a[0], a[1]); o[1] = pack2(a[2], a[3]); o[2] = pack2(b[0], b[1]); o[3] = pack2(b[2], b[3]);
        *(u32x4*)(p.skeys + i * 8) = o;
    }
    for (size_t i = gtid; i < (size_t)T * 32; i += gstride) {
        const int t = (int)(i >> 5), f = (int)(i & 31);
        const float invrev = exp2f(-(float)f * 0.41524101186092029f) * 0.15915494309189535f;
        float rev = (float)p.pos[t] * invrev; rev -= floorf(rev);
        p.ropec[i] = __builtin_amdgcn_cosf(rev); p.ropes[i] = __builtin_amdgcn_sinf(rev);
    }
}

__device__ void transpose_tile(const float* W, int ldw, int n0, int k0, bf16_t* Wt, unsigned char* smem) {
    bf16_t* tl = (bf16_t*)smem;
    const int tid = threadIdx.x, kk = tid >> 3, nn = (tid & 7) * 8;
    const f32x4 a = *(const f32x4*)(W + (size_t)(k0 + kk) * ldw + n0 + nn), b = *(const f32x4*)(W + (size_t)(k0 + kk) * ldw + n0 + nn + 4);
#pragma unroll
    for (int j = 0; j < 4; ++j) { tl[(nn + j) * 72 + kk] = f2bf(a[j]); tl[(nn + 4 + j) * 72 + kk] = f2bf(b[j]); }
    __syncthreads();
    const int n = tid >> 3, kc = (tid & 7) * 8;
    const u32x4 v = *(const u32x4*)(tl + n * 72 + kc);
    *(u32x4*)(Wt + (size_t)(n0 + n) * D + k0 + kc) = v;
    __syncthreads();
}

__device__ void p0_wt(const Params& p, unsigned char* smem) {
    for (int task = blockIdx.x; task < 7 * 256 + 128; task += gridDim.x) {
        const int w = task >> 8, tl = task & 255;
        const float* W; bf16_t* Wt; int ldw = 1024;
        switch (w) {
            case 0: W = p.w_in; Wt = p.wt_in; break;
            case 1: W = p.w_glu; Wt = p.wt_glu; break;
            case 2: W = p.w_out; Wt = p.wt_out; break;
            case 3: W = p.w_q; Wt = p.wt_q; break;
            case 4: W = p.w_o; Wt = p.wt_o; break;
            case 5: W = p.peer_wq; Wt = p.wt_pq0; break;
            case 6: W = p.peer_wq + (size_t)D * D; Wt = p.wt_pq1; break;
            default: W = p.w_kv; Wt = p.wt_kv; ldw = 512; break;
        }
        const int ntn = ldw / 64, n0 = (tl % ntn) * 64, k0 = (tl / ntn) * 64;
        transpose_tile(W, ldw, n0, k0, Wt, smem);
    }
}

__device__ __forceinline__ void lam_powf(float ar, float ai, float dt, int n, float& re, float& im) {
    const float m = __expf(ar * dt * (float)n);
    float rev = (ai * dt) * (float)n * 0.15915494309189535f; rev -= floorf(rev);
    re = m * __builtin_amdgcn_cosf(rev); im = m * __builtin_amdgcn_sinf(rev);
}
__device__ __forceinline__ void s5_coeff(float ar, float ai, float dt, float& cre, float& cim) {
    const float a = ar * dt, th = ai * dt;
    float rev = th * 0.15915494309189535f; rev -= floorf(rev);
    float revh = th * 0.5f * 0.15915494309189535f; revh -= floorf(revh);
    const float cs = __builtin_amdgcn_cosf(rev), sn = __builtin_amdgcn_sinf(rev), sh = __builtin_amdgcn_sinf(revh);
    const float em1 = expm1f(a);
    const float nr = em1 * cs - 2.f * sh * sh, ni = (em1 + 1.f) * sn, den = ar * ar + ai * ai;
    cre = (nr * ar + ni * ai) / den; cim = (ni * ar - nr * ai) / den;
}

__device__ void p0_s5(const Params& p, unsigned char* smem) {
    const size_t gtid = (size_t)blockIdx.x * NT + threadIdx.x, gstride = (size_t)gridDim.x * NT;
    for (size_t idx = gtid; idx < (size_t)G5 * P5 * 65; idx += gstride) {
        const int pp = (int)(idx & 63), e = (int)((idx >> 6) % 65), g = (int)(idx / (65 * P5));
        const float dt = __expf(p.log_dt[g]), ar = p.a_re[g * P5 + pp], ai = p.a_im[g * P5 + pp];
        float pwr, pwi; lam_powf(ar, ai, dt, e, pwr, pwi);
        if (e < 64) {
            float cfr, cfi; s5_coeff(ar, ai, dt, cfr, cfi);
            const float wr = pwr * cfr - pwi * cfi, wi = pwr * cfi + pwi * cfr;
            const int j = 63 - e;
            const float* brp = p.b_re + ((size_t)g * P5 + pp) * C5; const float* bip = p.b_im + ((size_t)g * P5 + pp) * C5;
            unsigned ore[8], oim[8];
#pragma unroll
            for (int c4 = 0; c4 < 4; ++c4) {
                const f32x4 br = *(const f32x4*)(brp + c4 * 4), bi = *(const f32x4*)(bip + c4 * 4);
                ore[c4 * 2] = pack2(wr * br[0] - wi * bi[0], wr * br[1] - wi * bi[1]); ore[c4 * 2 + 1] = pack2(wr * br[2] - wi * bi[2], wr * br[3] - wi * bi[3]);
                oim[c4 * 2] = pack2(wr * bi[0] + wi * br[0], wr * bi[1] + wi * br[1]); oim[c4 * 2 + 1] = pack2(wr * bi[2] + wi * br[2], wr * bi[3] + wi * br[3]);
            }
            u32x4* sre = (u32x4*)(p.smat + ((size_t)g * 128 + pp) * 1024 + j * 16);
            u32x4* sim = (u32x4*)(p.smat + ((size_t)g * 128 + 64 + pp) * 1024 + j * 16);
            sre[0] = (u32x4){ore[0], ore[1], ore[2], ore[3]}; sre[1] = (u32x4){ore[4], ore[5], ore[6], ore[7]};
            sim[0] = (u32x4){oim[0], oim[1], oim[2], oim[3]}; sim[1] = (u32x4){oim[4], oim[5], oim[6], oim[7]};
        }
        if (e >= 1) {
            const int i = e - 1;
#pragma unroll 4
            for (int co = 0; co < 16; ++co) {
                const float cr = p.c_re[((size_t)g * C5 + co) * P5 + pp], ci = p.c_im[((size_t)g * C5 + co) * P5 + pp];
                bf16_t* row = p.cmat + ((size_t)g * 1024 + i * 16 + co) * 128;
                row[pp] = f2bf(cr * pwr - ci * pwi);
                row[64 + pp] = f2bf(-(cr * pwi + ci * pwr));
            }
        }
        if (e == 64) {
            const double dtd = exp((double)p.log_dt[g]), m = exp((double)ar * dtd * 64.0);
            double ang = (double)ai * dtd * 64.0; ang -= 6.283185307179586 * floor(ang * 0.15915494309189535);
            p.lamL[(g * P5 + pp) * 2] = (float)(m * cos(ang)); p.lamL[(g * P5 + pp) * 2 + 1] = (float)(m * sin(ang));
        }
    }
    float* wre = (float*)smem;
    float* wim = wre + 1024;
    const int tid = threadIdx.x;
    for (int task = blockIdx.x; task < G5 * 4; task += gridDim.x) {
        const int g = task >> 2, tq = task & 3;
        const float dt = __expf(p.log_dt[g]);
        for (int i = tid; i < 1024; i += NT) {
            const int pp = i & 63, tau = tq * 16 + (i >> 6);
            const float ar = p.a_re[g * P5 + pp], ai = p.a_im[g * P5 + pp];
            float pwr, pwi, cfr, cfi; lam_powf(ar, ai, dt, tau, pwr, pwi); s5_coeff(ar, ai, dt, cfr, cfi);
            wre[i] = pwr * cfr - pwi * cfi; wim[i] = pwr * cfi + pwi * cfr;
        }
        __syncthreads();
        {
            const int co = (tid >> 4) & 15, ci = tid & 15, ph = tid >> 8;
            float* part = wim + 1024;
            float cbr[32], cbi[32];
#pragma unroll 8
            for (int k = 0; k < 32; ++k) {
                const int pp = ph * 32 + k;
                const float br = p.b_re[((size_t)g * P5 + pp) * C5 + ci], bi = p.b_im[((size_t)g * P5 + pp) * C5 + ci];
                const float cr = p.c_re[((size_t)g * C5 + co) * P5 + pp], cim = p.c_im[((size_t)g * C5 + co) * P5 + pp];
                cbr[k] = cr * br - cim * bi; cbi[k] = cr * bi + cim * br;
            }
            float sres[16];
#pragma unroll
            for (int tl = 0; tl < 16; ++tl) {
                float s0 = 0.f, s1 = 0.f;
#pragma unroll
                for (int k = 0; k < 32; k += 2) {
                    s0 += cbr[k] * wre[tl * 64 + ph * 32 + k] - cbi[k] * wim[tl * 64 + ph * 32 + k];
                    s1 += cbr[k + 1] * wre[tl * 64 + ph * 32 + k + 1] - cbi[k + 1] * wim[tl * 64 + ph * 32 + k + 1];
                }
                sres[tl] = s0 + s1;
            }
            if (ph == 1) {
#pragma unroll
                for (int tl = 0; tl < 16; ++tl) part[tl * 256 + (tid & 255)] = sres[tl];
            }
            __syncthreads();
            if (ph == 0) {
#pragma unroll
                for (int tl = 0; tl < 16; ++tl) p.ktab[((size_t)g * KTR + tq * 16 + tl + 8) * 256 + tid] = f2bf(sres[tl] + part[tl * 256 + tid]);
                if (tq == 0) {
#pragma unroll
                    for (int r = 0; r < 8; ++r) p.ktab[((size_t)g * KTR + r) * 256 + tid] = 0;
                }
            }
        }
        __syncthreads();
    }
}

__device__ void p05_prep(const Params& p, unsigned char* smem) {
    {
        const int lane = threadIdx.x & 63, wv = threadIdx.x >> 6;
        const int nw = gridDim.x * (NT / 64);
        for (int t = blockIdx.x * (NT / 64) + wv; t < T; t += nw) {
            const int b = t / SEQ;
            const float* xr = p.x + (size_t)t * D; const float* cb = p.cond + (size_t)b * (NCOND * D);
            f32x4 v[4]; float s = 0.f;
#pragma unroll
            for (int j = 0; j < 4; ++j) { v[j] = *(const f32x4*)(xr + j * 256 + lane * 4); s += v[j][0] * v[j][0] + v[j][1] * v[j][1] + v[j][2] * v[j][2] + v[j][3] * v[j][3]; }
            s = wave_sum(s);
            const float rstd = rsqrtf(s * (1.f / D) + RMS_EPS);
#pragma unroll
            for (int j = 0; j < 4; ++j) {
                const int e = j * 256 + lane * 4;
                const f32x4 g = *(const f32x4*)(p.norm_mix + e), sh = *(const f32x4*)(cb + 0 * D + e), sc = *(const f32x4*)(cb + 1 * D + e);
                float h[4];
#pragma unroll
                for (int i = 0; i < 4; ++i) h[i] = v[j][i] * rstd * g[i] * (1.f + sc[i]) + sh[i];
                u32x2 o; o[0] = pack2(h[0], h[1]); o[1] = pack2(h[2], h[3]);
                *(u32x2*)(p.s0 + (size_t)t * D + e) = o;
            }
        }
    }
    float* red = (float*)smem;
    const int tid = threadIdx.x;
    for (int task = blockIdx.x; task < 32 * 8; task += gridDim.x) {
        const int ct = task >> 3, ks = task & 7, col0 = ct * 64, layer = col0 >> 10;
        const float* W = p.peer_wq + (size_t)layer * D * D; const int cs = layer ? 9 : 3;
        const int n = (col0 & 1023) + (tid & 63), kg = tid >> 6;
        float wv[16];
#pragma unroll
        for (int j = 0; j < 16; ++j) wv[j] = W[(size_t)(ks * 128 + kg * 16 + j) * D + n];
        float acc[4] = {0.f, 0.f, 0.f, 0.f};
#pragma unroll
        for (int j = 0; j < 16; ++j)
#pragma unroll
            for (int b = 0; b < 4; ++b) acc[b] += p.cond[(size_t)b * (NCOND * D) + cs * D + ks * 128 + kg * 16 + j] * wv[j];
#pragma unroll
        for (int b = 0; b < 4; ++b) red[(kg * 64 + (tid & 63)) * 4 + b] = acc[b];
        __syncthreads();
        if (tid < 256) {
            const int col = tid >> 2, b = tid & 3; float sum = 0.f;
#pragma unroll
            for (int g = 0; g < 8; ++g) sum += red[(g * 64 + col) * 4 + b];
            p.biasp[((size_t)ks * 4 + b) * 2048 + col0 + col] = sum;
        }
        __syncthreads();
    }
}
__device__ void bias_finalize(const Params& p) {
    const int i = blockIdx.x * NT + threadIdx.x;
    if (i < 4 * 2048) { float s = 0.f;
#pragma unroll
        for (int ks = 0; ks < 8; ++ks) s += p.biasp[(size_t)ks * 8192 + i];
        p.bias[i] = s; }
}

__device__ __forceinline__ int lds_off(int row, int chunk) { return row * 128 + ((chunk ^ (row & 7)) << 4); }

template <class Epi>
__device__ void gemm_phase(const bf16_t* __restrict__ A, const bf16_t* __restrict__ Bt, size_t bt_batch_stride, int N, const Epi& epi, unsigned char* smem) {
    const int tid = threadIdx.x, lane = tid & 63, w = tid >> 6, wm = w >> 1, wn = w & 1, tk = lane & 15, q = lane >> 4;
    const int nN = N / 128;
    const bool xmap = (gridDim.x % 8) == 0;
    const int nslots = xmap ? gridDim.x / 8 : gridDim.x, slot = xmap ? (blockIdx.x >> 3) : blockIdx.x, xcd = blockIdx.x & 7;
    const int nitems = xmap ? 8 * nN : 64 * nN;
    for (int item = slot; item < nitems; item += nslots) {
        const int pm = xmap ? xcd * 8 + item / nN : item / nN, pn = item % nN;
        const int m0 = pm * 256, n0 = pn * 128, b = m0 / SEQ;
        const bf16_t* Ab = A + (size_t)m0 * D;
        const bf16_t* Bb = Bt + (size_t)b * bt_batch_stride + (size_t)n0 * D;
        f32x4 acc[4][4];
#pragma unroll
        for (int mi = 0; mi < 4; ++mi)
#pragma unroll
            for (int ni = 0; ni < 4; ++ni) acc[mi][ni] = (f32x4){0.f, 0.f, 0.f, 0.f};
        u32x4 ra[4], rb[2];
        auto gload = [&](int kt) {
#pragma unroll
            for (int i = 0; i < 4; ++i) { const int id = tid + NT * i, row = id >> 3, c = id & 7; ra[i] = *(const u32x4*)(Ab + (size_t)row * D + kt * 64 + c * 8); }
#pragma unroll
            for (int i = 0; i < 2; ++i) { const int id = tid + NT * i, row = id >> 3, c = id & 7; rb[i] = *(const u32x4*)(Bb + (size_t)row * D + kt * 64 + c * 8); }
        };
        auto lstore = [&](int buf) {
            unsigned char* sA = smem + buf * 32768; unsigned char* sB = smem + 65536 + buf * 16384;
#pragma unroll
            for (int i = 0; i < 4; ++i) { const int id = tid + NT * i, row = id >> 3, c = id & 7; *(u32x4*)(sA + lds_off(row, c)) = ra[i]; }
#pragma unroll
            for (int i = 0; i < 2; ++i) { const int id = tid + NT * i, row = id >> 3, c = id & 7; *(u32x4*)(sB + lds_off(row, c)) = rb[i]; }
        };
        gload(0); lstore(0);
        __syncthreads();
        for (int kt = 0; kt < 16; ++kt) {
            if (kt + 1 < 16) gload(kt + 1);
            const unsigned char* sA = smem + (kt & 1) * 32768; const unsigned char* sB = smem + 65536 + (kt & 1) * 16384;
#pragma unroll
            for (int ks = 0; ks < 2; ++ks) {
                bf16x8 af[4], bfr[4];
#pragma unroll
                for (int mi = 0; mi < 4; ++mi) af[mi] = *(const bf16x8*)(sA + lds_off(wm * 64 + mi * 16 + tk, ks * 4 + q));
#pragma unroll
                for (int ni = 0; ni < 4; ++ni) bfr[ni] = *(const bf16x8*)(sB + lds_off(wn * 64 + ni * 16 + tk, ks * 4 + q));
#pragma unroll
                for (int mi = 0; mi < 4; ++mi)
#pragma unroll
                    for (int ni = 0; ni < 4; ++ni) acc[mi][ni] = __builtin_amdgcn_mfma_f32_16x16x32_bf16(bfr[ni], af[mi], acc[mi][ni], 0, 0, 0);
            }
            if (kt + 1 < 16) lstore((kt + 1) & 1);
            __syncthreads();
        }
        epi(acc, m0 + wm * 64, n0 + wn * 64, b, pn * 2 + wn, tk, q);
    }
}

__device__ __forceinline__ float rstd_of(const float* ssq, int token) {
    const f32x4* s4 = (const f32x4*)(ssq + (size_t)token * 16);
    const f32x4 a = s4[0], b = s4[1], c = s4[2], d = s4[3];
    const float s = ((a[0] + a[1]) + (a[2] + a[3])) + ((b[0] + b[1]) + (b[2] + b[3])) + ((c[0] + c[1]) + (c[2] + c[3])) + ((d[0] + d[1]) + (d[2] + d[3]));
    return rsqrtf(s * (1.f / D) + RMS_EPS);
}

struct EpiU {
    bf16_t* ug;
    __device__ __forceinline__ void operator()(const f32x4 (&acc)[4][4], int mbase, int nbase, int b, int, int tk, int q) const {
#pragma unroll
        for (int mi = 0; mi < 4; ++mi) {
            const int token = mbase + mi * 16 + tk, s = token - b * SEQ;
#pragma unroll
            for (int ni = 0; ni < 4; ++ni) {
                const int n = nbase + ni * 16 + 4 * q, g = n >> 4;
                u32x2 o; o[0] = pack2(acc[mi][ni][0], acc[mi][ni][1]); o[1] = pack2(acc[mi][ni][2], acc[mi][ni][3]);
                *(u32x2*)(ug + (((size_t)(g * 4 + b) * SEQ + s) * 16 + 4 * q)) = o;
            }
        }
    }
};
struct EpiQ {
    const float* ssq; const float* bias; int boff; bf16_t* out;
    __device__ __forceinline__ void operator()(const f32x4 (&acc)[4][4], int mbase, int nbase, int b, int, int tk, int q) const {
#pragma unroll
        for (int mi = 0; mi < 4; ++mi) {
            const int token = mbase + mi * 16 + tk;
            const float rstd = rstd_of(ssq, token);
#pragma unroll
            for (int ni = 0; ni < 4; ++ni) {
                const int n = nbase + ni * 16 + 4 * q;
                const f32x4 bv = *(const f32x4*)(bias + (size_t)b * 2048 + boff + n);
                u32x2 o; o[0] = pack2(rstd * acc[mi][ni][0] + bv[0], rstd * acc[mi][ni][1] + bv[1]); o[1] = pack2(rstd * acc[mi][ni][2] + bv[2], rstd * acc[mi][ni][3] + bv[3]);
                *(u32x2*)(out + (size_t)token * D + n) = o;
            }
        }
    }
};
struct EpiGlu {
    const bf16_t* y; const float* bglu; bf16_t* out;
    __device__ __forceinline__ void operator()(const f32x4 (&acc)[4][4], int mbase, int nbase, int, int, int tk, int q) const {
#pragma unroll
        for (int mi = 0; mi < 4; ++mi) {
            const int token = mbase + mi * 16 + tk;
#pragma unroll
            for (int ni = 0; ni < 4; ++ni) {
                const int n = nbase + ni * 16 + 4 * q;
                const f32x4 bv = *(const f32x4*)(bglu + n);
                const u32x2 yv = *(const u32x2*)(y + (size_t)token * D + n);
                float o[4];
                const float y0 = bflo(yv[0]), y1 = bfhi(yv[0]), y2 = bflo(yv[1]), y3 = bfhi(yv[1]);
                o[0] = y0 / (1.f + __expf(-(acc[mi][ni][0] + bv[0]))); o[1] = y1 / (1.f + __expf(-(acc[mi][ni][1] + bv[1])));
                o[2] = y2 / (1.f + __expf(-(acc[mi][ni][2] + bv[2]))); o[3] = y3 / (1.f + __expf(-(acc[mi][ni][3] + bv[3])));
                u32x2 ov; ov[0] = pack2(o[0], o[1]); ov[1] = pack2(o[2], o[3]);
                *(u32x2*)(out + (size_t)token * D + n) = ov;
            }
        }
    }
};
struct EpiRes {
    const float* xold; const float* gate  ; const float* gnorm; const float* scale  ; float* xout; bf16_t* xbout; float* ssq;
    __device__ __forceinline__ void operator()(const f32x4 (&acc)[4][4], int mbase, int nbase, int b, int slot, int tk, int q) const {
#pragma unroll
        for (int mi = 0; mi < 4; ++mi) {
            const int token = mbase + mi * 16 + tk;
            float ss = 0.f;
#pragma unroll
            for (int ni = 0; ni < 4; ++ni) {
                const int n = nbase + ni * 16 + 4 * q;
                const f32x4 gv = *(const f32x4*)(gate + (size_t)b * (NCOND * D) + n), gn = *(const f32x4*)(gnorm + n), sc = *(const f32x4*)(scale + (size_t)b * (NCOND * D) + n);
                const f32x4 xo = *(const f32x4*)(xold + (size_t)token * D + n);
                f32x4 xn; float hs[4];
#pragma unroll
                for (int r = 0; r < 4; ++r) { xn[r] = xo[r] + gv[r] * acc[mi][ni][r]; ss += xn[r] * xn[r]; hs[r] = xn[r] * gn[r] * (1.f + sc[r]); }
                *(f32x4*)(xout + (size_t)token * D + n) = xn;
                u32x2 ov; ov[0] = pack2(hs[0], hs[1]); ov[1] = pack2(hs[2], hs[3]);
                *(u32x2*)(xbout + (size_t)token * D + n) = ov;
            }
            ss += __shfl_xor(ss, 16); ss += __shfl_xor(ss, 32);
            if (q == 0) ssq[(size_t)token * 16 + slot] = ss;
        }
    }
};
template <int MODE  >
struct EpiRope {
    const float* ropec; const float* ropes; bf16_t* o0; bf16_t* o1;
    __device__ __forceinline__ void operator()(const f32x4 (&acc)[4][4], int mbase, int nbase, int, int, int tk, int q) const {
        const bool rope = MODE == 1 || nbase < 256;
#pragma unroll
        for (int mi = 0; mi < 4; ++mi) {
            const int token = mbase + mi * 16 + tk;
            float v[4][4];
#pragma unroll
            for (int ni = 0; ni < 4; ++ni)
#pragma unroll
                for (int r = 0; r < 4; ++r) v[ni][r] = acc[mi][ni][r];
            if (rope) {
#pragma unroll
                for (int ni = 0; ni < 2; ++ni) {
                    const f32x4 cs = *(const f32x4*)(ropec + (size_t)token * 32 + ni * 16 + 4 * q), sn = *(const f32x4*)(ropes + (size_t)token * 32 + ni * 16 + 4 * q);
#pragma unroll
                    for (int r = 0; r < 4; ++r) { const float t1 = v[ni][r], t2 = v[ni + 2][r]; v[ni][r] = t1 * cs[r] - t2 * sn[r]; v[ni + 2][r] = t2 * cs[r] + t1 * sn[r]; }
                }
            }
            bf16_t* dst = MODE == 1 ? o0 + (size_t)token * D + nbase : (nbase < 256 ? o0 + (size_t)token * 256 + nbase : o1 + (size_t)token * 256 + (nbase - 256));
#pragma unroll
            for (int ni = 0; ni < 4; ++ni) { u32x2 o; o[0] = pack2(v[ni][0], v[ni][1]); o[1] = pack2(v[ni][2], v[ni][3]); *(u32x2*)(dst + ni * 16 + 4 * q) = o; }
        }
    }
};

__device__ void s5_phase(const Params& p, unsigned char* smem) {
    bf16_t* ktl = (bf16_t*)smem;
    float* Sl = (float*)(smem + 36864);
    bf16_t* Xl = (bf16_t*)(smem + 36864 + 33280);
    const int tid = threadIdx.x, lane = tid & 63, w = tid >> 6, cb = w & 3, hh = w >> 2, tk = lane & 15, q = lane >> 4;
    for (int task = blockIdx.x; task < G5 * NB; task += gridDim.x) {
        const int g = (task & 7) * 8 + ((task >> 3) >> 2), b = (task >> 3) & 3;
        const bf16_t* U = p.s1 + (size_t)(g * 4 + b) * SEQ * 16;
        const bf16_t* sm = p.smat + (size_t)g * 128 * 1024;
        const bf16_t* cm = p.cmat + (size_t)g * 1024 * 128;
        for (int i = tid; i < KTR * 256 * 2 / 16; i += NT) ((u32x4*)ktl)[i] = ((const u32x4*)(p.ktab + (size_t)g * KTR * 256))[i];
        bf16x8 ufr[32];
#pragma unroll
        for (int ks = 0; ks < 32; ++ks) ufr[ks] = *(const bf16x8*)(U + (size_t)(cb * 16 + tk) * 1024 + ks * 32 + 8 * q);
#pragma unroll 1
        for (int mf = 0; mf < 4; ++mf) {
            const int r0 = (hh * 4 + mf) * 16;
            const bf16_t* ap = sm + (size_t)(r0 + tk) * 1024 + 8 * q;
            f32x4 acc = {0.f, 0.f, 0.f, 0.f};
#pragma unroll
            for (int k8 = 0; k8 < 4; ++k8) {
                bf16x8 af[8];
#pragma unroll
                for (int j = 0; j < 8; ++j) af[j] = *(const bf16x8*)(ap + (k8 * 8 + j) * 32);
#pragma unroll
                for (int j = 0; j < 8; ++j) acc = __builtin_amdgcn_mfma_f32_16x16x32_bf16(af[j], ufr[k8 * 8 + j], acc, 0, 0, 0);
            }
#pragma unroll
            for (int r = 0; r < 4; ++r) Sl[(r0 + 4 * q + r) * 65 + cb * 16 + tk] = acc[r];
        }
        __syncthreads();
        if (w == 0) {
            const float lr = p.lamL[(g * P5 + lane) * 2], li = p.lamL[(g * P5 + lane) * 2 + 1];
            float xr = 0.f, xi = 0.f;
            for (int k = 0; k < NCH; ++k) {
                Xl[k * 128 + lane] = f2bf(xr); Xl[k * 128 + 64 + lane] = f2bf(xi);
                const float sr = Sl[lane * 65 + k], si = Sl[(64 + lane) * 65 + k];
                const float nr = lr * xr - li * xi + sr, ni = lr * xi + li * xr + si;
                xr = nr; xi = ni;
            }
        }
        __syncthreads();
        bf16x8 xfr[4];
#pragma unroll
        for (int ks = 0; ks < 4; ++ks) xfr[ks] = *(const bf16x8*)(Xl + (cb * 16 + tk) * 128 + ks * 32 + 8 * q);
        const f32x4 dv = *(const f32x4*)(p.s5d + g * 16 + 4 * q);
        const int jl = q >> 1, cih = q & 1;
        const bf16_t* kbase = ktl + (8 - jl) * 256 + tk * 16 + cih * 8;
        const bf16_t* cmb = cm + (size_t)tk * 128 + 8 * q;
        auto iof = [&](int ii) { return hh ? 16 + ii : (ii < 16 ? ii : 32 + ii); };
        bf16x8 cf[4];
#pragma unroll
        for (int ks = 0; ks < 4; ++ks) cf[ks] = *(const bf16x8*)(cmb + (size_t)iof(0) * 2048 + ks * 32);
#pragma unroll 1
        for (int ii = 0; ii < 32; ++ii) {
            const int i = iof(ii), inext = iof(ii < 31 ? ii + 1 : ii);
            bf16x8 cfn[4];
#pragma unroll
            for (int ks = 0; ks < 4; ++ks) cfn[ks] = *(const bf16x8*)(cmb + (size_t)inext * 2048 + ks * 32);
            const int s = (cb * 16 + tk) * 64 + i;
            const u32x2 uv = *(const u32x2*)(U + (size_t)s * 16 + 4 * q);
            f32x4 acc = {0.f, 0.f, 0.f, 0.f};
#pragma unroll
            for (int ks = 0; ks < 4; ++ks) acc = __builtin_amdgcn_mfma_f32_16x16x32_bf16(cf[ks], xfr[ks], acc, 0, 0, 0);
            const int mmax = i >> 1;
            const bf16_t* kb = kbase + i * 256;
#pragma unroll
            for (int mg = 0; mg < 8; ++mg) {
                if (4 * mg <= mmax) {
                    bf16x8 kf[4];
#pragma unroll
                    for (int j = 0; j < 4; ++j) kf[j] = *(const bf16x8*)(kb - (4 * mg + j) * 512);
#pragma unroll
                    for (int j = 0; j < 4; ++j) acc = __builtin_amdgcn_mfma_f32_16x16x32_bf16(kf[j], ufr[4 * mg + j], acc, 0, 0, 0);
                }
            }
            const float y0 = gelu_tanh(acc[0] + dv[0] * bflo(uv[0])), y1 = gelu_tanh(acc[1] + dv[1] * bfhi(uv[0]));
            const float y2 = gelu_tanh(acc[2] + dv[2] * bflo(uv[1])), y3 = gelu_tanh(acc[3] + dv[3] * bfhi(uv[1]));
            u32x2 o; o[0] = pack2(y0, y1); o[1] = pack2(y2, y3);
            *(u32x2*)(p.s0 + ((size_t)b * SEQ + s) * D + g * 16 + 4 * q) = o;
#pragma unroll
            for (int ks = 0; ks < 4; ++ks) cf[ks] = cfn[ks];
        }
        __syncthreads();
    }
}

__device__ __forceinline__ float med3f(float a, float b, float c) { return __builtin_amdgcn_fmed3f(a, b, c); }
__device__ __forceinline__ void ins16(float (&a)[16], float v) {
#pragma unroll
    for (int i = 15; i >= 1; --i) a[i] = med3f(a[i - 1], a[i], v);
    a[0] = fmaxf(a[0], v);
}
__device__ void route_phase(const Params& p, int layer, const bf16_t* qp, unsigned char* smem) {
    float* sc = (float*)smem;
    float* tl = (float*)(smem + 2 * 128 * 129 * 4);
    const int tid = threadIdx.x, lane = tid & 63, w = tid >> 6, tk = lane & 15, q = lane >> 4;
    for (int task = blockIdx.x; task < (T / 128) * 8; task += gridDim.x) {
        const int h = task & 7, t0 = (task >> 3) * 128;
#pragma unroll 1
        for (int pp = 0; pp < 2; ++pp) {
            const bf16_t* qrow = qp + (size_t)(t0 + 16 * w + tk) * D + h * 128 + pp * 64 + 8 * q;
            const bf16x8 a0 = *(const bf16x8*)(qrow), a1 = *(const bf16x8*)(qrow + 32);
            const bf16_t* kb = p.skeys + ((size_t)((layer * 8 + h) * 2 + pp) * 128) * 64 + 8 * q;
#pragma unroll
            for (int nf = 0; nf < 8; ++nf) {
                const bf16x8 b0 = *(const bf16x8*)(kb + (size_t)(nf * 16 + tk) * 64), b1 = *(const bf16x8*)(kb + (size_t)(nf * 16 + tk) * 64 + 32);
                f32x4 acc = {0.f, 0.f, 0.f, 0.f};
                acc = __builtin_amdgcn_mfma_f32_16x16x32_bf16(a0, b0, acc, 0, 0, 0);
                acc = __builtin_amdgcn_mfma_f32_16x16x32_bf16(a1, b1, acc, 0, 0, 0);
#pragma unroll
                for (int r = 0; r < 4; ++r) sc[(pp * 128 + 16 * w + 4 * q + r) * 129 + nf * 16 + tk] = acc[r];
            }
        }
        __syncthreads();
        {
            const int list = tid & 255, kr = tid >> 8;
            float a[16];
#pragma unroll
            for (int i = 0; i < 16; ++i) a[i] = -3.0e38f;
            const float* row = sc + list * 129 + kr * 64;
            for (int j = 0; j < 64; ++j) {
                const float v = __uint_as_float((__float_as_uint(row[j]) & ~0x7Fu) | (unsigned)(kr * 64 + j));
                ins16(a, v);
            }
            if (kr == 1) {
#pragma unroll
                for (int i = 0; i < 16; ++i) tl[list * 16 + i] = a[i];
            }
            __syncthreads();
            if (kr == 0) {
                float o[16];
#pragma unroll
                for (int i = 0; i < 16; ++i) o[i] = tl[list * 16 + i];
#pragma unroll
                for (int i = 0; i < 16; ++i) ins16(a, o[i]);
#pragma unroll
                for (int i = 0; i < 16; ++i) tl[list * 16 + i] = a[i];
            }
            __syncthreads();
        }
        if (tid < 128) {
            float s[16], r[16], c[16];
#pragma unroll
            for (int i = 0; i < 16; ++i) { s[i] = tl[tid * 16 + i]; r[i] = tl[(128 + tid) * 16 + i]; c[i] = -3.0e38f; }
#pragma unroll
            for (int i = 0; i < 16; ++i)
#pragma unroll
                for (int j = 0; j < 16; ++j)
                    if ((i + 1) * (j + 1) <= 16) {
                        const float v = __uint_as_float((__float_as_uint(s[i] + r[j]) & ~0xFFu) | (unsigned)(i * 16 + j));
                        ins16(c, v);
                    }
            float e[16], sum = 0.f;
#pragma unroll
            for (int k = 0; k < 16; ++k) { e[k] = __expf(c[k] - c[0]); sum += e[k]; }
            const float inv = 1.f / sum;
            int idv[16];
#pragma unroll
            for (int k = 0; k < 16; ++k) {
                const unsigned bits = __float_as_uint(c[k]), i = (bits >> 4) & 15u, j = bits & 15u;
                const unsigned ki = __float_as_uint(tl[tid * 16 + i]) & 0x7Fu, kj = __float_as_uint(tl[(128 + tid) * 16 + j]) & 0x7Fu;
                idv[k] = (int)(ki * 128u + kj);
            }
            int* ido = p.ids + (size_t)(t0 + tid) * 128 + h * 16; float* go = p.gates + (size_t)(t0 + tid) * 128 + h * 16;
#pragma unroll
            for (int k4 = 0; k4 < 4; ++k4) {
                *(int4*)(ido + k4 * 4) = make_int4(idv[k4 * 4], idv[k4 * 4 + 1], idv[k4 * 4 + 2], idv[k4 * 4 + 3]);
                *(f32x4*)(go + k4 * 4) = (f32x4){e[k4 * 4] * inv, e[k4 * 4 + 1] * inv, e[k4 * 4 + 2] * inv, e[k4 * 4 + 3] * inv};
            }
        }
        __syncthreads();
    }
}

typedef _Float16 h16x2 __attribute__((ext_vector_type(2)));
typedef int i32x8 __attribute__((ext_vector_type(8)));
#ifndef NVR
#define NVR 16
#endif
template <bool FINAL>
__device__ void gather_phase(const Params& p, int layer, const float* xin, float* xout, bf16_t* hkv_out, bf16_t* hq_out, const float* gnorm, int c_shift, int c_scale, int c_gate, unsigned char* smem) {
    const int lane = threadIdx.x & 63, wv = threadIdx.x >> 6, tk = lane & 15, q = lane >> 4;
    const int nw = gridDim.x * (NT / 64);
    const unsigned char* utab = p.ub + (size_t)layer * NEXP * 512;
    const unsigned char* vtab = p.vb + (size_t)layer * NEXP * 512;
    const float* sutab = p.su + (size_t)layer * NEXP;
    const float* svtab = p.sv + (size_t)layer * NEXP;
    unsigned char* hl = smem + wv * 1024;
    for (int t = blockIdx.x * (NT / 64) + wv; t < T; t += nw) {
        const int b = t / SEQ;
        const float* cb = p.cond + (size_t)b * (NCOND * D);
        const float* xr = xin + (size_t)t * D;
        const int e0 = lane * 16;
        {
            f32x4 xv[4]; float ss = 0.f;
#pragma unroll
            for (int j = 0; j < 4; ++j) { xv[j] = *(const f32x4*)(xr + e0 + j * 4); ss += xv[j][0] * xv[j][0] + xv[j][1] * xv[j][1] + xv[j][2] * xv[j][2] + xv[j][3] * xv[j][3]; }
            ss = wave_sum(ss);
            const float rstd = rsqrtf(ss * (1.f / D) + RMS_EPS);
            u32x4 hw;
#pragma unroll
            for (int j = 0; j < 4; ++j) {
                const f32x4 g = *(const f32x4*)(gnorm + e0 + j * 4), sc = *(const f32x4*)(cb + c_scale * D + e0 + j * 4), sh = *(const f32x4*)(cb + c_shift * D + e0 + j * 4);
                float h[4];
#pragma unroll
                for (int e = 0; e < 4; ++e) h[e] = xv[j][e] * rstd * g[e] * (1.f + sc[e]) + sh[e];
                int r = 0;
                r = __builtin_amdgcn_cvt_pk_fp8_f32(h[0], h[1], r, false);
                r = __builtin_amdgcn_cvt_pk_fp8_f32(h[2], h[3], r, true);
                hw[j] = (unsigned)r;
            }
            *(u32x4*)(hl + lane * 16) = hw;
        }
        asm volatile("s_waitcnt lgkmcnt(0)" ::: "memory");
        i32x8 hb[8];
#pragma unroll
        for (int kk = 0; kk < 8; ++kk) {
            const u32x4 lo = *(const u32x4*)(hl + kk * 128 + q * 16), hi = *(const u32x4*)(hl + kk * 128 + 64 + q * 16);
            hb[kk] = (i32x8){(int)lo[0], (int)lo[1], (int)lo[2], (int)lo[3], (int)hi[0], (int)hi[1], (int)hi[2], (int)hi[3]};
        }
        const int idA = p.ids[(size_t)t * 128 + lane], idB = p.ids[(size_t)t * 128 + 64 + lane];
        const float gA = p.gates[(size_t)t * 128 + lane], gB = p.gates[(size_t)t * 128 + 64 + lane];
        const float suA = sutab[idA], suB = sutab[idB], svA = svtab[idA], svB = svtab[idB];
        float dA = 0.f, dB = 0.f;
        u32x4 rb[2][8];
        auto issue_u = [&](u32x4 (&buf)[8], int bt) {
            const int id = __shfl(bt < 4 ? idA : idB, (bt * 16 + tk) & 63);
            const unsigned char* rp = utab + (size_t)id * 512 + q * 16;
#pragma unroll
            for (int kk = 0; kk < 8; ++kk) buf[kk] = *(const u32x4*)(rp + kk * 64);
        };
        auto consume_ub = [&](const u32x4 (&buf)[8], int bt) {
            f32x4 acc = {0.f, 0.f, 0.f, 0.f};
#if defined(DEBUG_VALU_U)
            {
                const int idd = __shfl(bt < 4 ? idA : idB, (bt * 16 + tk) & 63);
                const unsigned char* rp = utab + (size_t)idd * 512 + q * 16;
                float dsum = 0.f;
#pragma unroll 1
                for (int kk = 0; kk < 8; ++kk) {
                    const u32x4 xw = *(const u32x4*)(rp + kk * 64);
#pragma unroll 1
                    for (int d = 0; d < 4; ++d) {
                        const unsigned x = d == 0 ? xw[0] : (d == 1 ? xw[1] : (d == 2 ? xw[2] : xw[3]));
                        const u32x2 hw2 = *(const u32x2*)(hl + kk * 128 + q * 32 + d * 8);
                        const f32x2 u0 = __builtin_amdgcn_cvt_scalef32_pk_f32_fp4(x, 1.0f, 0), u1 = __builtin_amdgcn_cvt_scalef32_pk_f32_fp4(x, 1.0f, 1);
                        const f32x2 u2 = __builtin_amdgcn_cvt_scalef32_pk_f32_fp4(x, 1.0f, 2), u3 = __builtin_amdgcn_cvt_scalef32_pk_f32_fp4(x, 1.0f, 3);
                        const f32x2 h0 = __builtin_amdgcn_cvt_pk_f32_fp8((int)hw2[0], false), h1 = __builtin_amdgcn_cvt_pk_f32_fp8((int)hw2[0], true);
                        const f32x2 h2 = __builtin_amdgcn_cvt_pk_f32_fp8((int)hw2[1], false), h3 = __builtin_amdgcn_cvt_pk_f32_fp8((int)hw2[1], true);
                        dsum += u0[0] * h0[0] + u0[1] * h0[1] + u1[0] * h1[0] + u1[1] * h1[1] + u2[0] * h2[0] + u2[1] * h2[1] + u3[0] * h3[0] + u3[1] * h3[1];
                    }
                }
                dsum += __shfl_xor(dsum, 16); dsum += __shfl_xor(dsum, 32);
#pragma unroll
                for (int r = 0; r < 4; ++r) acc[r] = __shfl(dsum, 4 * q + r);
            }
#else
#pragma unroll
            for (int kk = 0; kk < 8; ++kk) {
                const i32x8 av = {(int)buf[kk][0], (int)buf[kk][1], (int)buf[kk][2], (int)buf[kk][3], 0, 0, 0, 0};
                acc = __builtin_amdgcn_mfma_scale_f32_16x16x128_f8f6f4(av, hb[kk], acc, 4  , 0  , 0, 0x7f7f7f7f, 0, 0x7f7f7f7f);
            }
#endif
            const int r = lane & 3;
            const float mine = r == 0 ? acc[0] : (r == 1 ? acc[1] : (r == 2 ? acc[2] : acc[3]));
            const float got = __shfl(mine, ((lane & 15) >> 2) * 16 + (lane & 15));
            if (q == (bt & 3)) { if (bt < 4) dA = got; else dB = got; }
        };
        issue_u(rb[0], 0);
#pragma unroll 1
        for (int bt = 0; bt < 8; bt += 2) {
            issue_u(rb[1], bt + 1);
            consume_ub(rb[0], bt);
            if (bt + 2 < 8) issue_u(rb[0], bt + 2);
            consume_ub(rb[1], bt + 1);
        }
        const float apA = gelu_tanh(dA * suA) * gA * svA, apB = gelu_tanh(dB * suB) * gB * svB;
        const h16x2 a2A = {(_Float16)apA, (_Float16)apA}, a2B = {(_Float16)apB, (_Float16)apB};
        const unsigned pA = __builtin_bit_cast(unsigned, a2A), pB = __builtin_bit_cast(unsigned, a2B);
        float o[16];
#pragma unroll
        for (int e = 0; e < 16; ++e) o[e] = 0.f;
        u32x2 vr[NVR];
        auto issue_v = [&](u32x2& buf, int k) {
            const int id = __builtin_amdgcn_readlane(k < 64 ? idA : idB, k & 63);
            buf = *(const u32x2*)(vtab + (size_t)id * 512 + lane * 8);
        };
#pragma unroll
        for (int jj = 0; jj < NVR - 1; ++jj) issue_v(vr[jj], jj);
#pragma unroll 1
        for (int k0 = 0; k0 < 128; k0 += NVR) {
            h16x2 oh[8];
#pragma unroll
            for (int e = 0; e < 8; ++e) oh[e] = (h16x2){(_Float16)0.f, (_Float16)0.f};
#pragma unroll
            for (int jj = 0; jj < NVR; ++jj) {
                const int k = k0 + jj;
                if (k + NVR - 1 < 128) issue_v(vr[(jj + NVR - 1) % NVR], k + NVR - 1);
                const h16x2 a2 = __builtin_bit_cast(h16x2, (unsigned)__builtin_amdgcn_readlane((int)(k < 64 ? pA : pB), k & 63));
#pragma unroll
                for (int d = 0; d < 2; ++d) {
                    const unsigned x = vr[jj][d];
                    oh[d * 4 + 0] += a2 * __builtin_amdgcn_cvt_scalef32_pk_f16_fp4(x, 1.0f, 0);
                    oh[d * 4 + 1] += a2 * __builtin_amdgcn_cvt_scalef32_pk_f16_fp4(x, 1.0f, 1);
                    oh[d * 4 + 2] += a2 * __builtin_amdgcn_cvt_scalef32_pk_f16_fp4(x, 1.0f, 2);
                    oh[d * 4 + 3] += a2 * __builtin_amdgcn_cvt_scalef32_pk_f16_fp4(x, 1.0f, 3);
                }
            }
#pragma unroll
            for (int e = 0; e < 8; ++e) { o[2 * e] += (float)oh[e][0]; o[2 * e + 1] += (float)oh[e][1]; }
        }
        float xn[16]; float ss = 0.f;
#pragma unroll
        for (int j4 = 0; j4 < 4; ++j4) {
            const f32x4 xo = *(const f32x4*)(xr + e0 + j4 * 4), gv = *(const f32x4*)(cb + c_gate * D + e0 + j4 * 4);
#pragma unroll
            for (int e = 0; e < 4; ++e) { const float v = xo[e] + gv[e] * o[j4 * 4 + e]; xn[j4 * 4 + e] = v; ss += v * v; }
        }
        ss = wave_sum(ss);
        const float rstd = rsqrtf(ss * (1.f / D) + RMS_EPS);
        if (!FINAL) {
#pragma unroll
            for (int j = 0; j < 4; ++j) *(f32x4*)(xout + (size_t)t * D + e0 + j * 4) = (f32x4){xn[j * 4], xn[j * 4 + 1], xn[j * 4 + 2], xn[j * 4 + 3]};
            float hk[16], hq[16];
#pragma unroll
            for (int j = 0; j < 4; ++j) {
                const f32x4 gk = *(const f32x4*)(p.kv_norm + e0 + j * 4), sck = *(const f32x4*)(cb + 13 * D + e0 + j * 4), shk = *(const f32x4*)(cb + 12 * D + e0 + j * 4);
                const f32x4 gm = *(const f32x4*)(p.norm_mix + D + e0 + j * 4), scm = *(const f32x4*)(cb + 7 * D + e0 + j * 4), shm = *(const f32x4*)(cb + 6 * D + e0 + j * 4);
#pragma unroll
                for (int e = 0; e < 4; ++e) {
                    const float xs = xn[j * 4 + e] * rstd;
                    hk[j * 4 + e] = xs * gk[e] * (1.f + sck[e]) + shk[e]; hq[j * 4 + e] = xs * gm[e] * (1.f + scm[e]) + shm[e];
                }
            }
#pragma unroll
            for (int j = 0; j < 2; ++j) {
                u32x4 ob; ob[0] = pack2(hk[j * 8], hk[j * 8 + 1]); ob[1] = pack2(hk[j * 8 + 2], hk[j * 8 + 3]); ob[2] = pack2(hk[j * 8 + 4], hk[j * 8 + 5]); ob[3] = pack2(hk[j * 8 + 6], hk[j * 8 + 7]);
                *(u32x4*)(hkv_out + (size_t)t * D + e0 + j * 8) = ob;
                u32x4 oc; oc[0] = pack2(hq[j * 8], hq[j * 8 + 1]); oc[1] = pack2(hq[j * 8 + 2], hq[j * 8 + 3]); oc[2] = pack2(hq[j * 8 + 4], hq[j * 8 + 5]); oc[3] = pack2(hq[j * 8 + 6], hq[j * 8 + 7]);
                *(u32x4*)(hq_out + (size_t)t * D + e0 + j * 8) = oc;
            }
        } else {
#pragma unroll
            for (int j = 0; j < 4; ++j) {
                const f32x4 g = *(const f32x4*)(p.final_norm + e0 + j * 4), sc = *(const f32x4*)(cb + 15 * D + e0 + j * 4), sh = *(const f32x4*)(cb + 14 * D + e0 + j * 4);
                f32x4 ov;
#pragma unroll
                for (int e = 0; e < 4; ++e) ov[e] = xn[j * 4 + e] * rstd * g[e] * (1.f + sc[e]) + sh[e];
                *(f32x4*)(p.out + (size_t)t * D + e0 + j * 4) = ov;
            }
        }
        asm volatile("s_waitcnt lgkmcnt(0)" ::: "memory");
    }
}

__device__ void attn_phase(const Params& p, const bf16_t* Q, const bf16_t* K, const bf16_t* V, bf16_t* O, unsigned char* smem) {
    unsigned char* Kl = smem;
    unsigned char* Vt = smem + 32768;
    unsigned char* Pl = smem + 32768 + 35840;
    const int tid = threadIdx.x, lane = tid & 63, w = tid >> 6, tk = lane & 15, q = lane >> 4;
    unsigned char* Pw = Pl + w * 5376;
    for (int task = blockIdx.x; task < NB * 32 * 4; task += gridDim.x) {
        const int kvh = task & 3, qblk = (task >> 2) & 31, b = task >> 7;
        const int kpos0 = (qblk - 1) * 128;
#pragma unroll
        for (int i = 0; i < 4; ++i) {
            const int id = tid + NT * i, j = id >> 3, c = id & 7, kp = kpos0 + j;
            u32x4 v = {0u, 0u, 0u, 0u};
            if (kp >= 0) v = *(const u32x4*)(K + ((size_t)b * SEQ + kp) * 256 + kvh * 64 + c * 8);
            *(u32x4*)(Kl + lds_off(j, c)) = v;
        }
#pragma unroll
        for (int i = 0; i < 4; ++i) {
            const int id = tid + NT * i, j = id & 255, dc = id >> 8, kp = kpos0 + j;
            u32x4 v = {0u, 0u, 0u, 0u};
            if (kp >= 0) v = *(const u32x4*)(V + ((size_t)b * SEQ + kp) * 256 + kvh * 64 + dc * 8);
#pragma unroll
            for (int e = 0; e < 4; ++e) {
                *(bf16_t*)(Vt + (dc * 8 + 2 * e) * 560 + j * 2) = (bf16_t)(v[e] & 0xffffu);
                *(bf16_t*)(Vt + (dc * 8 + 2 * e + 1) * 560 + j * 2) = (bf16_t)(v[e] >> 16);
            }
        }
        if (tid < 128) *(u32x4*)(Vt + (tid >> 1) * 560 + 512 + (tid & 1) * 16) = (u32x4){0u, 0u, 0u, 0u};
        *(u32x2*)(Pw + tk * 336 + (144 + 4 * q) * 2) = (u32x2){0u, 0u};
        __syncthreads();
        const int qt = w, i_q = qt * 16 + tk;
        const size_t trow = (size_t)b * SEQ + qblk * 128 + i_q;
        const unsigned char* kb0 = Kl + lds_off(qt * 16 + tk, q);
        const unsigned char* kb1 = Kl + lds_off(qt * 16 + tk, 4 + q);
        const unsigned char* vb0 = Vt + tk * 560 + (qt * 16 + 8 * q) * 2;
        unsigned char* pwr = Pw + tk * 336 + 8 * q;
        const unsigned char* prd = Pw + tk * 336 + 16 * q;
#pragma unroll 1
        for (int hq = 0; hq < 4; ++hq) {
            const int head = kvh * 4 + hq;
            const bf16x8 qf0 = *(const bf16x8*)(Q + trow * D + head * 64 + 8 * q), qf1 = *(const bf16x8*)(Q + trow * D + head * 64 + 32 + 8 * q);
            f32x4 sacc[9];
#pragma unroll
            for (int kk = 0; kk < 9; ++kk) {
                const bf16x8 k0 = *(const bf16x8*)(kb0 + kk * 2048), k1 = *(const bf16x8*)(kb1 + kk * 2048);
                f32x4 a = {0.f, 0.f, 0.f, 0.f};
                a = __builtin_amdgcn_mfma_f32_16x16x32_bf16(k0, qf0, a, 0, 0, 0);
                a = __builtin_amdgcn_mfma_f32_16x16x32_bf16(k1, qf1, a, 0, 0, 0);
                sacc[kk] = a;
                if (kk & 1) __builtin_amdgcn_sched_barrier(0);
            }
            const float sink = p.sinks[head];
            float mx = -1e30f;
#pragma unroll
            for (int kk = 0; kk < 9; ++kk)
#pragma unroll
                for (int r = 0; r < 4; ++r) {
                    const int j = (qt + kk) * 16 + 4 * q + r;
                    const bool valid = (j > i_q) && (j <= i_q + 128) && (qblk > 0 || j >= 128);
                    const float s = valid ? sacc[kk][r] * 0.125f : -1e30f;
                    sacc[kk][r] = s; mx = fmaxf(mx, s);
                }
            mx = fmaxf(mx, __shfl_xor(mx, 16)); mx = fmaxf(mx, __shfl_xor(mx, 32));
            mx = fmaxf(mx, sink);
            float sum = 0.f;
#pragma unroll
            for (int kk = 0; kk < 9; ++kk)
#pragma unroll
                for (int r = 0; r < 4; ++r) { const float e = __expf(sacc[kk][r] - mx); sacc[kk][r] = e; sum += e; }
            sum += __shfl_xor(sum, 16); sum += __shfl_xor(sum, 32);
            const float inv = 1.f / (sum + __expf(sink - mx));
#pragma unroll
            for (int kk = 0; kk < 9; ++kk) {
                u32x2 o; o[0] = pack2(sacc[kk][0] * inv, sacc[kk][1] * inv); o[1] = pack2(sacc[kk][2] * inv, sacc[kk][3] * inv);
                *(u32x2*)(pwr + kk * 32) = o;
            }
            asm volatile("s_waitcnt lgkmcnt(0)" ::: "memory");
            bf16x8 pf[5];
#pragma unroll
            for (int ks = 0; ks < 5; ++ks) pf[ks] = *(const bf16x8*)(prd + ks * 64);
#pragma unroll
            for (int dt = 0; dt < 4; ++dt) {
                f32x4 oa = {0.f, 0.f, 0.f, 0.f};
#pragma unroll
                for (int ks = 0; ks < 5; ++ks) {
                    const bf16x8 vf = *(const bf16x8*)(vb0 + dt * 8960 + ks * 64);
                    oa = __builtin_amdgcn_mfma_f32_16x16x32_bf16(vf, pf[ks], oa, 0, 0, 0);
                }
                u32x2 o; o[0] = pack2(oa[0], oa[1]); o[1] = pack2(oa[2], oa[3]);
                *(u32x2*)(O + trow * D + head * 64 + dt * 16 + 4 * q) = o;
                __builtin_amdgcn_sched_barrier(0);
            }
            asm volatile("s_waitcnt lgkmcnt(0)" ::: "memory");
        }
        __syncthreads();
    }
}

constexpr int SMEM_BYTES = 152 * 1024;
__global__ void __launch_bounds__(NT) yoco_fwd(Params p) {
    __shared__ __attribute__((aligned(16))) unsigned char smem[SMEM_BYTES];
    volatile LAS unsigned* st = (volatile LAS unsigned*)(smem + SMEM_BYTES - 16);
    if (threadIdx.x == 0) { st[0] = 0u; st[1] = 0u; }
    __syncthreads();
    const XcdBarrier xb = xcd_barrier_post(p.bar, st);
    p0_cond(p, smem);
    p0_tables(p);
    p0_wt(p, smem);
    p0_s5(p, smem);
    xcd_barrier(xb);
    p05_prep(p, smem);
    xcd_barrier(xb);
    bias_finalize(p);
    { EpiU e{p.s1}; gemm_phase(p.s0, p.wt_in, 0, 1024, e, smem); }
    xcd_barrier(xb);
    s5_phase(p, smem);
    xcd_barrier(xb);
    { EpiGlu e{p.s0, p.b_glu, p.s1}; gemm_phase(p.s0, p.wt_glu, 0, 1024, e, smem); }
    xcd_barrier(xb);
    { EpiRes e{p.x, p.cond + 2 * D, p.norm_ffn, p.cond + 4 * D, p.f0, p.s2, p.ssq1}; gemm_phase(p.s1, p.wt_out, 0, 1024, e, smem); }
    xcd_barrier(xb);
    { EpiQ e{p.ssq1, p.bias, 0, p.s1}; gemm_phase(p.s2, p.wt_pq0, 0, 1024, e, smem); }
    xcd_barrier(xb);
    route_phase(p, 0, p.s1, smem);
    xcd_barrier(xb);
    gather_phase<false>(p, 0, p.f0, p.f1, p.s0, p.s2, p.norm_ffn, 3, 4, 5, smem);
    xcd_barrier(xb);
    { EpiRope<0> e{p.ropec, p.ropes, p.s1, p.s1 + (size_t)T * 256}; gemm_phase(p.s0, p.wt_kv, 0, 512, e, smem); }
    { EpiRope<1> e{p.ropec, p.ropes, p.s3, nullptr}; gemm_phase(p.s2, p.wt_q, 0, 1024, e, smem); }
    xcd_barrier(xb);
    attn_phase(p, p.s3, p.s1, p.s1 + (size_t)T * 256, p.s0, smem);
    xcd_barrier(xb);
    { EpiRes e{p.f1, p.cond + 8 * D, p.norm_ffn + D, p.cond + 10 * D, p.f0, p.s2, p.ssq3}; gemm_phase(p.s0, p.wt_o, 0, 1024, e, smem); }
    xcd_barrier(xb);
    { EpiQ e{p.ssq3, p.bias, 1024, p.s1}; gemm_phase(p.s2, p.wt_pq1, 0, 1024, e, smem); }
    xcd_barrier(xb);
    route_phase(p, 1, p.s1, smem);
    xcd_barrier(xb);
    gather_phase<true>(p, 1, p.f0, nullptr, nullptr, nullptr, p.norm_ffn + D, 9, 10, 11, smem);
}

static inline size_t align_up(size_t v, size_t a) { return (v + a - 1) / a * a; }

extern "C" void kernel_launch(void* const* d_in, const int* in_sizes, int n_in, void* d_out, int out_size, void* d_ws, size_t ws_size, hipStream_t stream) {
    (void)in_sizes; (void)n_in; (void)out_size;
    Params p{};
    p.x = (const float*)d_in[0]; p.c = (const float*)d_in[1]; p.pos = (const int*)d_in[2]; p.w_cond = (const float*)d_in[3]; p.b_cond = (const float*)d_in[4];
    p.norm_mix = (const float*)d_in[5]; p.norm_ffn = (const float*)d_in[6]; p.w_in = (const float*)d_in[7]; p.a_re = (const float*)d_in[8]; p.a_im = (const float*)d_in[9];
    p.log_dt = (const float*)d_in[10]; p.b_re = (const float*)d_in[11]; p.b_im = (const float*)d_in[12]; p.c_re = (const float*)d_in[13]; p.c_im = (const float*)d_in[14];
    p.s5d = (const float*)d_in[15]; p.w_glu = (const float*)d_in[16]; p.b_glu = (const float*)d_in[17]; p.w_out = (const float*)d_in[18]; p.kv_norm = (const float*)d_in[19];
    p.w_kv = (const float*)d_in[20]; p.w_q = (const float*)d_in[21]; p.sinks = (const float*)d_in[22]; p.w_o = (const float*)d_in[23]; p.peer_wq = (const float*)d_in[24];
    p.subkeys = (const float*)d_in[25]; p.peer_u = (const float*)d_in[26]; p.peer_v = (const float*)d_in[27]; p.final_norm = (const float*)d_in[28];
    p.out = (float*)d_out;
    unsigned char* w = (unsigned char*)d_ws; size_t off = 65536;
    p.bar = (unsigned*)d_ws;
    auto take = [&](size_t bytes) { void* r = w + off; off = align_up(off + bytes, 4096); return r; };
    p.cond = (float*)take((size_t)NB * NCOND * D * 4);
    p.ropec = (float*)take((size_t)T * 32 * 4); p.ropes = (float*)take((size_t)T * 32 * 4);
    p.ssq1 = (float*)take((size_t)T * 16 * 4); p.ssq3 = (float*)take((size_t)T * 16 * 4);
    p.wt_in = (bf16_t*)take((size_t)D * D * 2); p.wt_glu = (bf16_t*)take((size_t)D * D * 2); p.wt_out = (bf16_t*)take((size_t)D * D * 2); p.wt_kv = (bf16_t*)take((size_t)512 * D * 2);
    p.wt_q = (bf16_t*)take((size_t)D * D * 2); p.wt_o = (bf16_t*)take((size_t)D * D * 2); p.wt_pq0 = (bf16_t*)take((size_t)D * D * 2); p.wt_pq1 = (bf16_t*)take((size_t)D * D * 2);
    p.biasp = (float*)take((size_t)8 * 4 * 2048 * 4); p.bias = (float*)take((size_t)4 * 2048 * 4);
    p.skeys = (bf16_t*)take((size_t)2 * 8 * 2 * 128 * 64 * 2);
    p.lamL = (float*)take((size_t)G5 * P5 * 2 * 4); p.ktab = (bf16_t*)take((size_t)G5 * KTR * 256 * 2);
    p.smat = (bf16_t*)take((size_t)G5 * 128 * 1024 * 2); p.cmat = (bf16_t*)take((size_t)G5 * 1024 * 128 * 2);
    p.ub = (unsigned char*)take((size_t)2 * NEXP * D); p.vb = (unsigned char*)take((size_t)2 * NEXP * D);
    p.su = (float*)take((size_t)2 * NEXP * 4); p.sv = (float*)take((size_t)2 * NEXP * 4);
    p.s0 = (bf16_t*)take((size_t)T * D * 2); p.s1 = (bf16_t*)take((size_t)T * D * 2); p.s2 = (bf16_t*)take((size_t)T * D * 2); p.s3 = (bf16_t*)take((size_t)T * D * 2);
    p.f0 = (float*)take((size_t)T * D * 4); p.f1 = (float*)take((size_t)T * D * 4);
    p.ids = (int*)take((size_t)T * 128 * 4); p.gates = (float*)take((size_t)T * 128 * 4);
    if (off > ws_size) { fprintf(stderr, "workspace too small: need %zu have %zu\n", off, ws_size); return; }

    static int grid_blocks = 0;
    if (!grid_blocks) {
        int dev = 0, cus = 0, per_cu = 0;
        (void)hipGetDevice(&dev);
        (void)hipDeviceGetAttribute(&cus, hipDeviceAttributeMultiprocessorCount, dev);
        (void)hipOccupancyMaxActiveBlocksPerMultiprocessor(&per_cu, yoco_fwd, NT, 0);
        if (per_cu > 1) per_cu = 1;
        grid_blocks = cus * per_cu;
        if (grid_blocks <= 0) grid_blocks = 256;
    }
    (void)hipMemsetAsync(d_ws, 0, XCD_BAR_WORDS * 4, stream);
    void* args[] = {&p};
    hipError_t e = hipLaunchCooperativeKernel((const void*)yoco_fwd, dim3(grid_blocks), dim3(NT), args, 0, stream);
    if (e != hipSuccess) fprintf(stderr, "cooperative launch failed: %s (grid %d)\n", hipGetErrorString(e), grid_blocks);
}
```

```cpp
#include <hip/hip_runtime.h>
#include <cstdio>
#include <cstdint>

#define NT 512
#define LAS __attribute__((address_space(3)))
typedef unsigned short bf16_t;
typedef short bf16x8 __attribute__((ext_vector_type(8)));
typedef float f32x4 __attribute__((ext_vector_type(4)));
typedef unsigned u32x4 __attribute__((ext_vector_type(4)));
typedef unsigned u32x2 __attribute__((ext_vector_type(2)));

constexpr int D = 1024, NB = 4, SEQ = 4096, T = NB * SEQ;
constexpr int NCOND = 16;
constexpr int G5 = 64, P5 = 64, C5 = 16, L5 = 64, NCH = SEQ / L5, KTR = 72;
constexpr int NEXP = 16384;
constexpr float RMS_EPS = 1e-6f;

struct Params {
    const float *x, *c; const int* pos; const float *w_cond, *b_cond, *norm_mix, *norm_ffn, *w_in, *a_re, *a_im, *log_dt, *b_re, *b_im, *c_re, *c_im, *s5d,
        *w_glu, *b_glu, *w_out, *kv_norm, *w_kv, *w_q, *sinks, *w_o, *peer_wq, *subkeys, *peer_u, *peer_v, *final_norm;
    float* out;
    unsigned* bar;
    float* cond;
    float* ropec;
    float* ropes;
    float* ssq1;
    float* ssq3;
    bf16_t *wt_in, *wt_glu, *wt_out, *wt_kv, *wt_q, *wt_o, *wt_pq0, *wt_pq1;
    float* biasp;
    float* bias;
    bf16_t* skeys;
    float* lamL;
    bf16_t* ktab;
    bf16_t* smat;
    bf16_t* cmat;
    unsigned char* ub;
    unsigned char* vb;
    float* su;
    float* sv;
    bf16_t *s0, *s1, *s2, *s3;
    float *f0, *f1;
    int* ids;
    float* gates;
};

#define XB_TMO      128
#define XB_XCNT(j)  (256  + 64 * (j))
#define XB_XSUB(j)  (1280 + 64 * (j))
#define XB_XGEN(j)  (2304 + 64 * (j))
#define XB_TOP      3328
#define XB_TOPGEN   3392
#define XCD_BAR_WORDS 3456
#define XB_SPIN_CAP (1u << 22)
__device__ __forceinline__ unsigned xb_ld(unsigned* p)              { return __hip_atomic_load(p, __ATOMIC_RELAXED, __HIP_MEMORY_SCOPE_AGENT); }
__device__ __forceinline__ unsigned xb_add(unsigned* p, unsigned v) { return __hip_atomic_fetch_add(p, v, __ATOMIC_RELAXED, __HIP_MEMORY_SCOPE_AGENT); }
__device__ __forceinline__ unsigned xb_xcc_id() { return (unsigned)__builtin_amdgcn_s_getreg((3 << 11) | 20) & 0xFu; }
#define XB_SPIN(cond, bar) do { unsigned _sp = 0; while (cond) { __builtin_amdgcn_s_sleep(1); \
    if ((++_sp & 255u) == 0u) { if (xb_ld(&(bar)[XB_TMO])) break; if (_sp > XB_SPIN_CAP) { atomicAdd(&(bar)[XB_TMO], 1u); break; } } } } while (0)
struct XcdBarrier { unsigned* bar; unsigned x; volatile LAS unsigned* st; };
__device__ __forceinline__ XcdBarrier xcd_barrier_post(unsigned* bar, volatile LAS unsigned* st) {
    XcdBarrier b; b.bar = bar; b.x = xb_xcc_id(); b.st = st;
    if (threadIdx.x == 0) (void)xb_add(&bar[XB_XCNT(b.x)], 1u);
    return b;
}
__device__ __forceinline__ void xcd_barrier_complete(unsigned* bar, unsigned x, unsigned& nloc, unsigned& nx) {
    const unsigned G = gridDim.x * gridDim.y * gridDim.z;
    unsigned sum, cnt, mine, sp = 0u;
    for (;;) {
        sum = 0u; cnt = 0u; mine = 0u;
#pragma unroll
        for (unsigned j = 0; j < 16; ++j) { const unsigned c = xb_ld(&bar[XB_XCNT(j)]); sum += c; cnt += (c > 0u) ? 1u : 0u; mine = (j == x) ? c : mine; }
        if (sum == G) break;
        __builtin_amdgcn_s_sleep(1);
        if ((++sp & 255u) == 0u) { if (xb_ld(&bar[XB_TMO])) break; if (sp > XB_SPIN_CAP) { atomicAdd(&bar[XB_TMO], 1u); break; } }
    }
    nloc = mine > 0u ? mine : 1u; nx = cnt > 0u ? cnt : 1u;
}
__device__ __forceinline__ void xcd_barrier(const XcdBarrier& b) {
    asm volatile("s_waitcnt vmcnt(0)" ::: "memory");
    __syncthreads();
    if (threadIdx.x == 0) {
        unsigned* bar = b.bar;
        __builtin_amdgcn_s_waitcnt(0);
        unsigned nloc = b.st[0], nx = b.st[1];
        if (nloc == 0u) { xcd_barrier_complete(bar, b.x, nloc, nx); b.st[0] = nloc; b.st[1] = nx; }
        const unsigned old = xb_add(&bar[XB_XSUB(b.x)], 1u);
        const unsigned gen = old / nloc;
        if (old + 1u == (gen + 1u) * nloc) {
            __builtin_amdgcn_fence(__ATOMIC_RELEASE, "agent");
            asm volatile("s_waitcnt vmcnt(0)" ::: "memory");
            const unsigned og = xb_add(&bar[XB_TOP], 1u);
            const unsigned tg = og / nx;
            if (og + 1u == (tg + 1u) * nx) xb_add(&bar[XB_TOPGEN], 1u);
            else XB_SPIN(xb_ld(&bar[XB_TOPGEN]) == tg, bar);
            __builtin_amdgcn_fence(__ATOMIC_ACQUIRE, "agent");
            xb_add(&bar[XB_XGEN(b.x)], 1u);
            asm volatile("s_waitcnt vmcnt(0)" ::: "memory");
        } else {
            XB_SPIN(xb_ld(&bar[XB_XGEN(b.x)]) == gen, bar);
            __builtin_amdgcn_fence(__ATOMIC_ACQUIRE, "agent");
            asm volatile("s_waitcnt vmcnt(0)" ::: "memory");
        }
    }
    __syncthreads();
}

__device__ __forceinline__ int opaque_tid() { int t = threadIdx.x; asm volatile("" : "+v"(t)); return t; }
__device__ __forceinline__ bf16_t f2bf(float f) { unsigned u = __float_as_uint(f); u += 0x7fffu + ((u >> 16) & 1u); return (bf16_t)(u >> 16); }
__device__ __forceinline__ float bf2f(bf16_t h) { return __uint_as_float(((unsigned)h) << 16); }
typedef __bf16 hbf2 __attribute__((ext_vector_type(2)));
typedef float f32x2 __attribute__((ext_vector_type(2)));
__device__ __forceinline__ unsigned pack2(float lo, float hi) { f32x2 v = {lo, hi}; return __builtin_bit_cast(unsigned, __builtin_convertvector(v, hbf2)); }
__device__ __forceinline__ float dot2bf(unsigned a, unsigned b, float c) { return __builtin_amdgcn_fdot2_f32_bf16(__builtin_bit_cast(hbf2, a), __builtin_bit_cast(hbf2, b), c, false); }
__device__ __forceinline__ float bflo(unsigned w) { return __uint_as_float(w << 16); }
__device__ __forceinline__ float bfhi(unsigned w) { return __uint_as_float(w & 0xffff0000u); }
__device__ __forceinline__ float wave_sum(float v) {
#pragma unroll
    for (int o = 32; o >= 1; o >>= 1) v += __shfl_xor(v, o);
    return v;
}
__device__ __forceinline__ float gelu_tanh(float x) {
    const float u = 0.7978845608028654f * (x + 0.044715f * x * x * x);
    const float e = __expf(-2.f * fabsf(u));
    float th = (1.f - e) / (1.f + e);
    th = u < 0.f ? -th : th;
    return 0.5f * x * (1.f + th);
}

__device__ void p0_cond(const Params& p, unsigned char* smem) {
    float* sc = (float*)smem;
    float* red = (float*)(smem + 16384);
    const int tid = threadIdx.x;
    for (int i = tid; i < 4 * D; i += NT) { const float v = p.c[i]; sc[i] = v / (1.f + __expf(-v)); }
    __syncthreads();
    const int cgp = tid & 15, kg = tid >> 4;
    for (int task = blockIdx.x; task < NCOND * D / 64; task += gridDim.x) {
        const int col0 = task * 64 + cgp * 4;
        float acc[4][4];
#pragma unroll
        for (int b = 0; b < 4; ++b)
#pragma unroll
            for (int j = 0; j < 4; ++j) acc[b][j] = 0.f;
#pragma unroll 1
        for (int k0 = 0; k0 < 32; k0 += 8) {
            f32x4 w[8];
#pragma unroll
            for (int j = 0; j < 8; ++j) w[j] = *(const f32x4*)(p.w_cond + (size_t)(kg + 32 * (k0 + j)) * (NCOND * D) + col0);
#pragma unroll
            for (int j = 0; j < 8; ++j)
#pragma unroll
                for (int b = 0; b < 4; ++b) { const float s = sc[b * D + kg + 32 * (k0 + j)];
#pragma unroll
                    for (int e = 0; e < 4; ++e) acc[b][e] += s * w[j][e]; }
        }
#pragma unroll
        for (int b = 0; b < 4; ++b)
#pragma unroll
            for (int j = 0; j < 4; ++j) red[(kg * 64 + cgp * 4 + j) * 4 + b] = acc[b][j];
        __syncthreads();
        if (tid < 256) {
            const int col = tid >> 2, b = tid & 3;
            float s = 0.f;
            for (int g = 0; g < 32; ++g) s += red[(g * 64 + col) * 4 + b];
            p.cond[(size_t)b * (NCOND * D) + task * 64 + col] = s + p.b_cond[task * 64 + col];
        }
        __syncthreads();
    }
}

__device__ void p0_tables(const Params& p) {
    const size_t gtid = (size_t)blockIdx.x * NT + threadIdx.x, gstride = (size_t)gridDim.x * NT;
    {
        const int li = threadIdx.x & 15;
        const size_t grp = gtid >> 4, ngrp = gstride >> 4;
        for (int which = 0; which < 2; ++which) {
            const float* src = which ? p.peer_v : p.peer_u; unsigned char* dst = which ? p.vb : p.ub; float* sdst = which ? p.sv : p.su;
            for (size_t row = grp; row < (size_t)2 * NEXP; row += ngrp) {
                f32x4 v[2][8]; float ss = 0.f;
#pragma unroll
                for (int c = 0; c < 2; ++c)
#pragma unroll
                    for (int j = 0; j < 8; ++j) {
                        v[c][j] = *(const f32x4*)(src + row * D + c * 512 + li * 32 + j * 4);
#pragma unroll
                        for (int e = 0; e < 4; ++e) ss += v[c][j][e] * v[c][j][e];
                    }
                ss += __shfl_xor(ss, 1); ss += __shfl_xor(ss, 2); ss += __shfl_xor(ss, 4); ss += __shfl_xor(ss, 8);
                const float step = 0.48f * sqrtf(ss * (1.f / D)), inv = step > 0.f ? 1.f / step : 0.f;
#pragma unroll
                for (int c = 0; c < 2; ++c) {
                    u32x4 o;
#pragma unroll
                    for (int d = 0; d < 4; ++d) {
                        unsigned wd = 0u;
                        wd = __builtin_amdgcn_cvt_scalef32_pk_fp4_f32(wd, v[c][d * 2][0] * inv, v[c][d * 2][1] * inv, 1.0f, 0);
                        wd = __builtin_amdgcn_cvt_scalef32_pk_fp4_f32(wd, v[c][d * 2][2] * inv, v[c][d * 2][3] * inv, 1.0f, 1);
                        wd = __builtin_amdgcn_cvt_scalef32_pk_fp4_f32(wd, v[c][d * 2 + 1][0] * inv, v[c][d * 2 + 1][1] * inv, 1.0f, 2);
                        wd = __builtin_amdgcn_cvt_scalef32_pk_fp4_f32(wd, v[c][d * 2 + 1][2] * inv, v[c][d * 2 + 1][3] * inv, 1.0f, 3);
                        o[d] = wd;
                    }
                    *(u32x4*)(dst + row * 512 + c * 256 + li * 16) = o;
                }
                if (li == 0) sdst[row] = step;
            }
        }
    }
    const size_t nk8 = (size_t)2 * 8 * 2 * 128 * 64 / 8;
    for (size_t i = gtid; i < nk8; i += gstride) {
        const f32x4 a = *(const f32x4*)(p.subkeys + i * 8), b = *(const f32x4*)(p.subkeys + i * 8 + 4);
        u32x4 o; o[0] = pack2(a[0], a[1]); o[1] = pack2(a[2], a[3]); o[2] = pack2(b[0], b[1]); o[3] = pack2(b[2], b[3]);
        *(u32x4*)(p.skeys + i * 8) = o;
    }
    for (size_t i = gtid; i < (size_t)T * 32; i += gstride) {
        const int t = (int)(i >> 5), f = (int)(i & 31);
        const float invrev = exp2f(-(float)f * 0.41524101186092029f) * 0.15915494309189535f;
        float rev = (float)p.pos[t] * invrev; rev -= floorf(rev);
        p.ropec[i] = __builtin_amdgcn_cosf(rev); p.ropes[i] = __builtin_amdgcn_sinf(rev);
    }
}

__device__ void transpose_tile(const float* W, int ldw, int n0, int k0, bf16_t* Wt, unsigned char* smem) {
    bf16_t* tl = (bf16_t*)smem;
    const int tid = opaque_tid(), kk = tid >> 3, nn = (tid & 7) * 8;
    const f32x4 a = *(const f32x4*)(W + (size_t)(k0 + kk) * ldw + n0 + nn), b = *(const f32x4*)(W + (size_t)(k0 + kk) * ldw + n0 + nn + 4);
#pragma unroll
    for (int j = 0; j < 4; ++j) { tl[(nn + j) * 72 + kk] = f2bf(a[j]); tl[(nn + 4 + j) * 72 + kk] = f2bf(b[j]); }
    __syncthreads();
    const int n = tid >> 3, kc = (tid & 7) * 8;
    const u32x4 v = *(const u32x4*)(tl + n * 72 + kc);
    *(u32x4*)(Wt + (size_t)(n0 + n) * D + k0 + kc) = v;
    __syncthreads();
}

__device__ void p0_wt(const Params& p, unsigned char* smem) {
    for (int task = blockIdx.x; task < 7 * 256 + 128; task += gridDim.x) {
        const int w = task >> 8, tl = task & 255;
        const float* W; bf16_t* Wt; int ldw = 1024;
        switch (w) {
            case 0: W = p.w_in; Wt = p.wt_in; break;
            case 1: W = p.w_glu; Wt = p.wt_glu; break;
            case 2: W = p.w_out; Wt = p.wt_out; break;
            case 3: W = p.w_q; Wt = p.wt_q; break;
            case 4: W = p.w_o; Wt = p.wt_o; break;
            case 5: W = p.peer_wq; Wt = p.wt_pq0; break;
            case 6: W = p.peer_wq + (size_t)D * D; Wt = p.wt_pq1; break;
            default: W = p.w_kv; Wt = p.wt_kv; ldw = 512; break;
        }
        const int ntn = ldw / 64, n0 = (tl % ntn) * 64, k0 = (tl / ntn) * 64;
        transpose_tile(W, ldw, n0, k0, Wt, smem);
    }
}

__device__ __forceinline__ void lam_powf(float ar, float ai, float dt, int n, float& re, float& im) {
    const float m = __expf(ar * dt * (float)n);
    float rev = (ai * dt) * (float)n * 0.15915494309189535f; rev -= floorf(rev);
    re = m * __builtin_amdgcn_cosf(rev); im = m * __builtin_amdgcn_sinf(rev);
}
__device__ __forceinline__ void s5_coeff(float ar, float ai, float dt, float& cre, float& cim) {
    const float a = ar * dt, th = ai * dt;
    float rev = th * 0.15915494309189535f; rev -= floorf(rev);
    float revh = th * 0.5f * 0.15915494309189535f; revh -= floorf(revh);
    const float cs = __builtin_amdgcn_cosf(rev), sn = __builtin_amdgcn_sinf(rev), sh = __builtin_amdgcn_sinf(revh);
    const float em1 = expm1f(a);
    const float nr = em1 * cs - 2.f * sh * sh, ni = (em1 + 1.f) * sn, den = ar * ar + ai * ai;
    cre = (nr * ar + ni * ai) / den; cim = (ni * ar - nr * ai) / den;
}

__device__ void p0_s5(const Params& p, unsigned char* smem) {
    const size_t gtid = (size_t)blockIdx.x * NT + threadIdx.x, gstride = (size_t)gridDim.x * NT;
    for (size_t idx = gtid; idx < (size_t)G5 * P5 * 65; idx += gstride) {
        const int pp = (int)(idx & 63), e = (int)((idx >> 6) % 65), g = (int)(idx / (65 * P5));
        const float dt = __expf(p.log_dt[g]), ar = p.a_re[g * P5 + pp], ai = p.a_im[g * P5 + pp];
        float pwr, pwi; lam_powf(ar, ai, dt, e, pwr, pwi);
        if (e < 64) {
            float cfr, cfi; s5_coeff(ar, ai, dt, cfr, cfi);
            const float wr = pwr * cfr - pwi * cfi, wi = pwr * cfi + pwi * cfr;
            const int j = 63 - e;
            const float* brp = p.b_re + ((size_t)g * P5 + pp) * C5; const float* bip = p.b_im + ((size_t)g * P5 + pp) * C5;
            unsigned ore[8], oim[8];
#pragma unroll
            for (int c4 = 0; c4 < 4; ++c4) {
                const f32x4 br = *(const f32x4*)(brp + c4 * 4), bi = *(const f32x4*)(bip + c4 * 4);
                ore[c4 * 2] = pack2(wr * br[0] - wi * bi[0], wr * br[1] - wi * bi[1]); ore[c4 * 2 + 1] = pack2(wr * br[2] - wi * bi[2], wr * br[3] - wi * bi[3]);
                oim[c4 * 2] = pack2(wr * bi[0] + wi * br[0], wr * bi[1] + wi * br[1]); oim[c4 * 2 + 1] = pack2(wr * bi[2] + wi * br[2], wr * bi[3] + wi * br[3]);
            }
            u32x4* sre = (u32x4*)(p.smat + ((size_t)g * 128 + pp) * 1024 + j * 16);
            u32x4* sim = (u32x4*)(p.smat + ((size_t)g * 128 + 64 + pp) * 1024 + j * 16);
            sre[0] = (u32x4){ore[0], ore[1], ore[2], ore[3]}; sre[1] = (u32x4){ore[4], ore[5], ore[6], ore[7]};
            sim[0] = (u32x4){oim[0], oim[1], oim[2], oim[3]}; sim[1] = (u32x4){oim[4], oim[5], oim[6], oim[7]};
        }
        if (e >= 1) {
            const int i = e - 1;
#pragma unroll 4
            for (int co = 0; co < 16; ++co) {
                const float cr = p.c_re[((size_t)g * C5 + co) * P5 + pp], ci = p.c_im[((size_t)g * C5 + co) * P5 + pp];
                bf16_t* row = p.cmat + ((size_t)g * 1024 + i * 16 + co) * 128;
                row[pp] = f2bf(cr * pwr - ci * pwi);
                row[64 + pp] = f2bf(-(cr * pwi + ci * pwr));
            }
        }
        if (e == 64) {
            const double dtd = exp((double)p.log_dt[g]), m = exp((double)ar * dtd * 64.0);
            double ang = (double)ai * dtd * 64.0; ang -= 6.283185307179586 * floor(ang * 0.15915494309189535);
            p.lamL[(g * P5 + pp) * 2] = (float)(m * cos(ang)); p.lamL[(g * P5 + pp) * 2 + 1] = (float)(m * sin(ang));
        }
    }
    float* wre = (float*)smem;
    float* wim = wre + 1024;
    const int tid = threadIdx.x;
    for (int task = blockIdx.x; task < G5 * 4; task += gridDim.x) {
        const int g = task >> 2, tq = task & 3;
        const float dt = __expf(p.log_dt[g]);
        for (int i = tid; i < 1024; i += NT) {
            const int pp = i & 63, tau = tq * 16 + (i >> 6);
            const float ar = p.a_re[g * P5 + pp], ai = p.a_im[g * P5 + pp];
            float pwr, pwi, cfr, cfi; lam_powf(ar, ai, dt, tau, pwr, pwi); s5_coeff(ar, ai, dt, cfr, cfi);
            wre[i] = pwr * cfr - pwi * cfi; wim[i] = pwr * cfi + pwi * cfr;
        }
        __syncthreads();
        {
            const int co = (tid >> 4) & 15, ci = tid & 15, ph = tid >> 8;
            float* part = wim + 1024;
            float cbr[32], cbi[32];
#pragma unroll 8
            for (int k = 0; k < 32; ++k) {
                const int pp = ph * 32 + k;
                const float br = p.b_re[((size_t)g * P5 + pp) * C5 + ci], bi = p.b_im[((size_t)g * P5 + pp) * C5 + ci];
                const float cr = p.c_re[((size_t)g * C5 + co) * P5 + pp], cim = p.c_im[((size_t)g * C5 + co) * P5 + pp];
                cbr[k] = cr * br - cim * bi; cbi[k] = cr * bi + cim * br;
            }
            float sres[16];
#pragma unroll
            for (int tl = 0; tl < 16; ++tl) {
                float s0 = 0.f, s1 = 0.f;
#pragma unroll
                for (int k = 0; k < 32; k += 2) {
                    s0 += cbr[k] * wre[tl * 64 + ph * 32 + k] - cbi[k] * wim[tl * 64 + ph * 32 + k];
                    s1 += cbr[k + 1] * wre[tl * 64 + ph * 32 + k + 1] - cbi[k + 1] * wim[tl * 64 + ph * 32 + k + 1];
                }
                sres[tl] = s0 + s1;
            }
            if (ph == 1) {
#pragma unroll
                for (int tl = 0; tl < 16; ++tl) part[tl * 256 + (tid & 255)] = sres[tl];
            }
            __syncthreads();
            if (ph == 0) {
#pragma unroll
                for (int tl = 0; tl < 16; ++tl) p.ktab[((size_t)g * KTR + tq * 16 + tl + 8) * 256 + tid] = f2bf(sres[tl] + part[tl * 256 + tid]);
                if (tq == 0) {
#pragma unroll
                    for (int r = 0; r < 8; ++r) p.ktab[((size_t)g * KTR + r) * 256 + tid] = 0;
                }
            }
        }
        __syncthreads();
    }
}

__device__ void p05_prep(const Params& p, unsigned char* smem) {
    {
        const int lane = threadIdx.x & 63, wv = threadIdx.x >> 6;
        const int nw = gridDim.x * (NT / 64);
        for (int t = blockIdx.x * (NT / 64) + wv; t < T; t += nw) {
            const int b = t / SEQ;
            const float* xr = p.x + (size_t)t * D; const float* cb = p.cond + (size_t)b * (NCOND * D);
            f32x4 v[4]; float s = 0.f;
#pragma unroll
            for (int j = 0; j < 4; ++j) { v[j] = *(const f32x4*)(xr + j * 256 + lane * 4); s += v[j][0] * v[j][0] + v[j][1] * v[j][1] + v[j][2] * v[j][2] + v[j][3] * v[j][3]; }
            s = wave_sum(s);
            const float rstd = rsqrtf(s * (1.f / D) + RMS_EPS);
#pragma unroll
            for (int j = 0; j < 4; ++j) {
                const int e = j * 256 + lane * 4;
                const f32x4 g = *(const f32x4*)(p.norm_mix + e), sh = *(const f32x4*)(cb + 0 * D + e), sc = *(const f32x4*)(cb + 1 * D + e);
                float h[4];
#pragma unroll
                for (int i = 0; i < 4; ++i) h[i] = v[j][i] * rstd * g[i] * (1.f + sc[i]) + sh[i];
                u32x2 o; o[0] = pack2(h[0], h[1]); o[1] = pack2(h[2], h[3]);
                *(u32x2*)(p.s0 + (size_t)t * D + e) = o;
            }
        }
    }
    float* red = (float*)smem;
    const int tid = threadIdx.x;
    for (int task = blockIdx.x; task < 32 * 8; task += gridDim.x) {
        const int ct = task >> 3, ks = task & 7, col0 = ct * 64, layer = col0 >> 10;
        const float* W = p.peer_wq + (size_t)layer * D * D; const int cs = layer ? 9 : 3;
        const int n = (col0 & 1023) + (tid & 63), kg = tid >> 6;
        float wv[16];
#pragma unroll
        for (int j = 0; j < 16; ++j) wv[j] = W[(size_t)(ks * 128 + kg * 16 + j) * D + n];
        float acc[4] = {0.f, 0.f, 0.f, 0.f};
#pragma unroll
        for (int j = 0; j < 16; ++j)
#pragma unroll
            for (int b = 0; b < 4; ++b) acc[b] += p.cond[(size_t)b * (NCOND * D) + cs * D + ks * 128 + kg * 16 + j] * wv[j];
#pragma unroll
        for (int b = 0; b < 4; ++b) red[(kg * 64 + (tid & 63)) * 4 + b] = acc[b];
        __syncthreads();
        if (tid < 256) {
            const int col = tid >> 2, b = tid & 3; float sum = 0.f;
#pragma unroll
            for (int g = 0; g < 8; ++g) sum += red[(g * 64 + col) * 4 + b];
            p.biasp[((size_t)ks * 4 + b) * 2048 + col0 + col] = sum;
        }
        __syncthreads();
    }
}
__device__ void bias_finalize(const Params& p) {
    const int i = blockIdx.x * NT + threadIdx.x;
    if (i < 4 * 2048) { float s = 0.f;
#pragma unroll
        for (int ks = 0; ks < 8; ++ks) s += p.biasp[(size_t)ks * 8192 + i];
        p.bias[i] = s; }
}

__device__ __forceinline__ int lds_off(int row, int chunk) { return row * 128 + ((chunk ^ (row & 7)) << 4); }

template <int BN, class Epi>
__device__ void gemm_phase(const bf16_t* __restrict__ A, const bf16_t* __restrict__ Bt, size_t bt_batch_stride, int N, const Epi& epi, unsigned char* smem) {
    constexpr int WMI = BN == 256 ? 8 : 4;
    constexpr int A_BYTES = 32768, B_BYTES = BN * 128, BUF = A_BYTES + B_BYTES;
    const int tid = opaque_tid(), lane = tid & 63, w = tid >> 6, tk = lane & 15, q = lane >> 4;
    const int wm = BN == 256 ? (w >> 2) : (w >> 1), wn = BN == 256 ? (w & 3) : (w & 1);
    const int nN = N / BN;
    const bool xmap = (gridDim.x % 8) == 0;
    const int nslots = xmap ? gridDim.x / 8 : gridDim.x, slot = xmap ? (blockIdx.x >> 3) : blockIdx.x, xcd = blockIdx.x & 7;
    const int nitems = xmap ? 8 * nN : 64 * nN;
    for (int item = slot; item < nitems; item += nslots) {
        const int pm = xmap ? xcd * 8 + item / nN : item / nN, pn = item % nN;
        const int m0 = pm * 256, n0 = pn * BN, b = m0 / SEQ;
        const bf16_t* Ab = A + (size_t)m0 * D;
        const bf16_t* Bb = Bt + (size_t)b * bt_batch_stride + (size_t)n0 * D;
        f32x4 acc[WMI][4];
#pragma unroll
        for (int mi = 0; mi < WMI; ++mi)
#pragma unroll
            for (int ni = 0; ni < 4; ++ni) acc[mi][ni] = (f32x4){0.f, 0.f, 0.f, 0.f};
        auto stage = [&](int buf, int kt) {
#pragma unroll
            for (int j = 0; j < 4; ++j) {
                const int piece = w * 4 + j, P = piece * 1024 + lane * 16, row = P >> 7, lc = ((P >> 4) & 7) ^ (row & 7);
                __builtin_amdgcn_global_load_lds((const __attribute__((address_space(1))) void*)(Ab + (size_t)row * D + kt * 64 + lc * 8),
                                                 (__attribute__((address_space(3))) void*)(smem + buf * BUF + piece * 1024), 16, 0, 0);
            }
#pragma unroll
            for (int j = 0; j < BN / 64; ++j) {
                const int piece = w * (BN / 64) + j, P = piece * 1024 + lane * 16, row = P >> 7, lc = ((P >> 4) & 7) ^ (row & 7);
                __builtin_amdgcn_global_load_lds((const __attribute__((address_space(1))) void*)(Bb + (size_t)row * D + kt * 64 + lc * 8),
                                                 (__attribute__((address_space(3))) void*)(smem + buf * BUF + A_BYTES + piece * 1024), 16, 0, 0);
            }
        };
        auto compute = [&](int buf) {
            const unsigned char* sA = smem + buf * BUF; const unsigned char* sB = sA + A_BYTES;
#pragma unroll
            for (int ks = 0; ks < 2; ++ks) {
                bf16x8 bfr[4];
#pragma unroll
                for (int ni = 0; ni < 4; ++ni) bfr[ni] = *(const bf16x8*)(sB + lds_off(wn * 64 + ni * 16 + tk, ks * 4 + q));
#pragma unroll
                for (int mh = 0; mh < WMI / 4; ++mh) {
                    bf16x8 af[4];
#pragma unroll
                    for (int mi = 0; mi < 4; ++mi) af[mi] = *(const bf16x8*)(sA + lds_off(wm * (WMI * 16) + (mh * 4 + mi) * 16 + tk, ks * 4 + q));
#pragma unroll
                    for (int mi = 0; mi < 4; ++mi)
#pragma unroll
                        for (int ni = 0; ni < 4; ++ni) acc[mh * 4 + mi][ni] = __builtin_amdgcn_mfma_f32_16x16x32_bf16(bfr[ni], af[mi], acc[mh * 4 + mi][ni], 0, 0, 0);
                }
            }
        };
        stage(0, 0);
        __syncthreads();
#pragma unroll 1
        for (int kt = 0; kt < 16; ++kt) {
            if (kt + 1 < 16) stage((kt + 1) & 1, kt + 1);
            compute(kt & 1);
            __syncthreads();
        }
#pragma unroll
        for (int mh = 0; mh < WMI / 4; ++mh)
            epi(*(const f32x4 (*)[4][4])&acc[mh * 4], m0 + wm * (WMI * 16) + mh * 64, n0 + wn * 64, b, pn * (BN / 64) + wn, tk, q);
    }
}

__device__ __forceinline__ float rstd_of(const float* ssq, int token) {
    const f32x4* s4 = (const f32x4*)(ssq + (size_t)token * 16);
    const f32x4 a = s4[0], b = s4[1], c = s4[2], d = s4[3];
    const float s = ((a[0] + a[1]) + (a[2] + a[3])) + ((b[0] + b[1]) + (b[2] + b[3])) + ((c[0] + c[1]) + (c[2] + c[3])) + ((d[0] + d[1]) + (d[2] + d[3]));
    return rsqrtf(s * (1.f / D) + RMS_EPS);
}

struct EpiU {
    bf16_t* ug;
    __device__ __forceinline__ void operator()(const f32x4 (&acc)[4][4], int mbase, int nbase, int b, int, int tk, int q) const {
#pragma unroll
        for (int mi = 0; mi < 4; ++mi) {
            const int token = mbase + mi * 16 + tk, s = token - b * SEQ;
#pragma unroll
            for (int ni = 0; ni < 4; ++ni) {
                const int n = nbase + ni * 16 + 4 * q, g = n >> 4;
                u32x2 o; o[0] = pack2(acc[mi][ni][0], acc[mi][ni][1]); o[1] = pack2(acc[mi][ni][2], acc[mi][ni][3]);
                *(u32x2*)(ug + (((size_t)(g * 4 + b) * SEQ + s) * 16 + 4 * q)) = o;
            }
        }
    }
};
struct EpiQ {
    const float* ssq; const float* bias; int boff; bf16_t* out;
    __device__ __forceinline__ void operator()(const f32x4 (&acc)[4][4], int mbase, int nbase, int b, int, int tk, int q) const {
#pragma unroll
        for (int mi = 0; mi < 4; ++mi) {
            const int token = mbase + mi * 16 + tk;
            const float rstd = rstd_of(ssq, token);
#pragma unroll
            for (int ni = 0; ni < 4; ++ni) {
                const int n = nbase + ni * 16 + 4 * q;
                const f32x4 bv = *(const f32x4*)(bias + (size_t)b * 2048 + boff + n);
                u32x2 o; o[0] = pack2(rstd * acc[mi][ni][0] + bv[0], rstd * acc[mi][ni][1] + bv[1]); o[1] = pack2(rstd * acc[mi][ni][2] + bv[2], rstd * acc[mi][ni][3] + bv[3]);
                *(u32x2*)(out + (size_t)token * D + n) = o;
            }
        }
    }
};
struct EpiGlu {
    const bf16_t* y; const float* bglu; bf16_t* out;
    __device__ __forceinline__ void operator()(const f32x4 (&acc)[4][4], int mbase, int nbase, int, int, int tk, int q) const {
#pragma unroll
        for (int mi = 0; mi < 4; ++mi) {
            const int token = mbase + mi * 16 + tk;
#pragma unroll
            for (int ni = 0; ni < 4; ++ni) {
                const int n = nbase + ni * 16 + 4 * q;
                const f32x4 bv = *(const f32x4*)(bglu + n);
                const u32x2 yv = *(const u32x2*)(y + (size_t)token * D + n);
                float o[4];
                const float y0 = bflo(yv[0]), y1 = bfhi(yv[0]), y2 = bflo(yv[1]), y3 = bfhi(yv[1]);
                o[0] = y0 / (1.f + __expf(-(acc[mi][ni][0] + bv[0]))); o[1] = y1 / (1.f + __expf(-(acc[mi][ni][1] + bv[1])));
                o[2] = y2 / (1.f + __expf(-(acc[mi][ni][2] + bv[2]))); o[3] = y3 / (1.f + __expf(-(acc[mi][ni][3] + bv[3])));
                u32x2 ov; ov[0] = pack2(o[0], o[1]); ov[1] = pack2(o[2], o[3]);
                *(u32x2*)(out + (size_t)token * D + n) = ov;
            }
        }
    }
};
struct EpiRes {
    const float* xold; const float* gate  ; const float* gnorm; const float* scale  ; float* xout; bf16_t* xbout; float* ssq;
    __device__ __forceinline__ void operator()(const f32x4 (&acc)[4][4], int mbase, int nbase, int b, int slot, int tk, int q) const {
#pragma unroll
        for (int mi = 0; mi < 4; ++mi) {
            const int token = mbase + mi * 16 + tk;
            float ss = 0.f;
#pragma unroll
            for (int ni = 0; ni < 4; ++ni) {
                const int n = nbase + ni * 16 + 4 * q;
                const f32x4 gv = *(const f32x4*)(gate + (size_t)b * (NCOND * D) + n), gn = *(const f32x4*)(gnorm + n), sc = *(const f32x4*)(scale + (size_t)b * (NCOND * D) + n);
                const f32x4 xo = *(const f32x4*)(xold + (size_t)token * D + n);
                f32x4 xn; float hs[4];
#pragma unroll
                for (int r = 0; r < 4; ++r) { xn[r] = xo[r] + gv[r] * acc[mi][ni][r]; ss += xn[r] * xn[r]; hs[r] = xn[r] * gn[r] * (1.f + sc[r]); }
                *(f32x4*)(xout + (size_t)token * D + n) = xn;
                u32x2 ov; ov[0] = pack2(hs[0], hs[1]); ov[1] = pack2(hs[2], hs[3]);
                *(u32x2*)(xbout + (size_t)token * D + n) = ov;
            }
            ss += __shfl_xor(ss, 16); ss += __shfl_xor(ss, 32);
            if (q == 0) ssq[(size_t)token * 16 + slot] = ss;
        }
    }
};
template <int MODE  >
struct EpiRope {
    const float* ropec; const float* ropes; bf16_t* o0; bf16_t* o1;
    __device__ __forceinline__ void operator()(const f32x4 (&acc)[4][4], int mbase, int nbase, int, int, int tk, int q) const {
        const bool rope = MODE == 1 || nbase < 256;
#pragma unroll
        for (int mi = 0; mi < 4; ++mi) {
            const int token = mbase + mi * 16 + tk;
            float v[4][4];
#pragma unroll
            for (int ni = 0; ni < 4; ++ni)
#pragma unroll
                for (int r = 0; r < 4; ++r) v[ni][r] = acc[mi][ni][r];
            if (rope) {
#pragma unroll
                for (int ni = 0; ni < 2; ++ni) {
                    const f32x4 cs = *(const f32x4*)(ropec + (size_t)token * 32 + ni * 16 + 4 * q), sn = *(const f32x4*)(ropes + (size_t)token * 32 + ni * 16 + 4 * q);
#pragma unroll
                    for (int r = 0; r < 4; ++r) { const float t1 = v[ni][r], t2 = v[ni + 2][r]; v[ni][r] = t1 * cs[r] - t2 * sn[r]; v[ni + 2][r] = t2 * cs[r] + t1 * sn[r]; }
                }
            }
            bf16_t* dst = MODE == 1 ? o0 + (size_t)token * D + nbase : (nbase < 256 ? o0 + (size_t)token * 256 + nbase : o1 + (size_t)token * 256 + (nbase - 256));
#pragma unroll
            for (int ni = 0; ni < 4; ++ni) { u32x2 o; o[0] = pack2(v[ni][0], v[ni][1]); o[1] = pack2(v[ni][2], v[ni][3]); *(u32x2*)(dst + ni * 16 + 4 * q) = o; }
        }
    }
};

__device__ void s5_phase(const Params& p, unsigned char* smem) {
    bf16_t* ktl = (bf16_t*)smem;
    float* Sl = (float*)(smem + 36864);
    bf16_t* Xl = (bf16_t*)(smem + 36864 + 33280);
    const int tid = opaque_tid(), lane = tid & 63, w = tid >> 6, cb = w & 3, hh = w >> 2, tk = lane & 15, q = lane >> 4;
    for (int task = blockIdx.x; task < G5 * NB; task += gridDim.x) {
        const int g = (task & 7) * 8 + ((task >> 3) >> 2), b = (task >> 3) & 3;
        const bf16_t* U = p.s1 + (size_t)(g * 4 + b) * SEQ * 16;
        const bf16_t* sm = p.smat + (size_t)g * 128 * 1024;
        const bf16_t* cm = p.cmat + (size_t)g * 1024 * 128;
        for (int i = tid; i < KTR * 256 * 2 / 16; i += NT) ((u32x4*)ktl)[i] = ((const u32x4*)(p.ktab + (size_t)g * KTR * 256))[i];
        bf16x8 ufr[32];
#pragma unroll
        for (int ks = 0; ks < 32; ++ks) ufr[ks] = *(const bf16x8*)(U + (size_t)(cb * 16 + tk) * 1024 + ks * 32 + 8 * q);
#pragma unroll 1
        for (int mf = 0; mf < 4; ++mf) {
            const int r0 = (hh * 4 + mf) * 16;
            const bf16_t* ap = sm + (size_t)(r0 + tk) * 1024 + 8 * q;
            f32x4 acc = {0.f, 0.f, 0.f, 0.f};
#pragma unroll
            for (int k8 = 0; k8 < 4; ++k8) {
                bf16x8 af[8];
#pragma unroll
                for (int j = 0; j < 8; ++j) af[j] = *(const bf16x8*)(ap + (k8 * 8 + j) * 32);
#pragma unroll
                for (int j = 0; j < 8; ++j) acc = __builtin_amdgcn_mfma_f32_16x16x32_bf16(af[j], ufr[k8 * 8 + j], acc, 0, 0, 0);
            }
#pragma unroll
            for (int r = 0; r < 4; ++r) Sl[(r0 + 4 * q + r) * 65 + cb * 16 + tk] = acc[r];
        }
        __syncthreads();
        if (w == 0) {
            const float lr = p.lamL[(g * P5 + lane) * 2], li = p.lamL[(g * P5 + lane) * 2 + 1];
            float xr = 0.f, xi = 0.f;
            for (int k = 0; k < NCH; ++k) {
                Xl[k * 128 + lane] = f2bf(xr); Xl[k * 128 + 64 + lane] = f2bf(xi);
                const float sr = Sl[lane * 65 + k], si = Sl[(64 + lane) * 65 + k];
                const float nr = lr * xr - li * xi + sr, ni = lr * xi + li * xr + si;
                xr = nr; xi = ni;
            }
        }
        __syncthreads();
        bf16x8 xfr[4];
#pragma unroll
        for (int ks = 0; ks < 4; ++ks) xfr[ks] = *(const bf16x8*)(Xl + (cb * 16 + tk) * 128 + ks * 32 + 8 * q);
        const f32x4 dv = *(const f32x4*)(p.s5d + g * 16 + 4 * q);
        const int jl = q >> 1, cih = q & 1;
        const bf16_t* kbase = ktl + (8 - jl) * 256 + tk * 16 + cih * 8;
        const bf16_t* cmb = cm + (size_t)tk * 128 + 8 * q;
        auto iof = [&](int ii) { return hh ? 16 + ii : (ii < 16 ? ii : 32 + ii); };
        bf16x8 cf[4];
#pragma unroll
        for (int ks = 0; ks < 4; ++ks) cf[ks] = *(const bf16x8*)(cmb + (size_t)iof(0) * 2048 + ks * 32);
#pragma unroll 1
        for (int ii = 0; ii < 32; ++ii) {
            const int i = iof(ii), inext = iof(ii < 31 ? ii + 1 : ii);
            bf16x8 cfn[4];
#pragma unroll
            for (int ks = 0; ks < 4; ++ks) cfn[ks] = *(const bf16x8*)(cmb + (size_t)inext * 2048 + ks * 32);
            const int s = (cb * 16 + tk) * 64 + i;
            const u32x2 uv = *(const u32x2*)(U + (size_t)s * 16 + 4 * q);
            f32x4 acc = {0.f, 0.f, 0.f, 0.f};
#pragma unroll
            for (int ks = 0; ks < 4; ++ks) acc = __builtin_amdgcn_mfma_f32_16x16x32_bf16(cf[ks], xfr[ks], acc, 0, 0, 0);
            const int mmax = i >> 1;
            const bf16_t* kb = kbase + i * 256;
#pragma unroll
            for (int mg = 0; mg < 8; ++mg) {
                if (4 * mg <= mmax) {
                    bf16x8 kf[4];
#pragma unroll
                    for (int j = 0; j < 4; ++j) kf[j] = *(const bf16x8*)(kb - (4 * mg + j) * 512);
#pragma unroll
                    for (int j = 0; j < 4; ++j) acc = __builtin_amdgcn_mfma_f32_16x16x32_bf16(kf[j], ufr[4 * mg + j], acc, 0, 0, 0);
                }
            }
            const float y0 = gelu_tanh(acc[0] + dv[0] * bflo(uv[0])), y1 = gelu_tanh(acc[1] + dv[1] * bfhi(uv[0]));
            const float y2 = gelu_tanh(acc[2] + dv[2] * bflo(uv[1])), y3 = gelu_tanh(acc[3] + dv[3] * bfhi(uv[1]));
            u32x2 o; o[0] = pack2(y0, y1); o[1] = pack2(y2, y3);
            *(u32x2*)(p.s0 + ((size_t)b * SEQ + s) * D + g * 16 + 4 * q) = o;
#pragma unroll
            for (int ks = 0; ks < 4; ++ks) cf[ks] = cfn[ks];
        }
        __syncthreads();
    }
}

__device__ __forceinline__ float med3f(float a, float b, float c) { return __builtin_amdgcn_fmed3f(a, b, c); }
__device__ __forceinline__ void ins16(float (&a)[16], float v) {
#pragma unroll
    for (int i = 15; i >= 1; --i) a[i] = med3f(a[i - 1], a[i], v);
    a[0] = fmaxf(a[0], v);
}
__device__ void route_phase(const Params& p, int layer, const bf16_t* qp, unsigned char* smem) {
    float* sc = (float*)smem;
    float* tl = (float*)(smem + 2 * 128 * 129 * 4);
    const int tid = opaque_tid(), lane = tid & 63, w = tid >> 6, tk = lane & 15, q = lane >> 4;
    const bool fixed = (gridDim.x & 7) == 0;
    const int ntask = (T / 128) * 8;
    int cur_h = -1;
    bf16x8 kf[2][8][2];
    for (int it = 0;; ++it) {
        int h, tt;
        if (fixed) { h = blockIdx.x & 7; tt = (blockIdx.x >> 3) + it * (gridDim.x >> 3); if (tt >= T / 128) break; }
        else { const int task = blockIdx.x + it * gridDim.x; if (task >= ntask) break; h = task & 7; tt = task >> 3; }
        const int t0 = tt * 128;
        if (h != cur_h) {
            cur_h = h;
#pragma unroll
            for (int pp = 0; pp < 2; ++pp)
#pragma unroll
                for (int nf = 0; nf < 8; ++nf) {
                    const bf16_t* kb = p.skeys + ((size_t)((layer * 8 + h) * 2 + pp) * 128 + nf * 16 + tk) * 64 + 8 * q;
                    kf[pp][nf][0] = *(const bf16x8*)(kb); kf[pp][nf][1] = *(const bf16x8*)(kb + 32);
                }
        }
        {
            const bf16_t* qrow = qp + (size_t)(t0 + 16 * w + tk) * D + h * 128 + 8 * q;
            const bf16x8 a00 = *(const bf16x8*)(qrow), a01 = *(const bf16x8*)(qrow + 32), a10 = *(const bf16x8*)(qrow + 64), a11 = *(const bf16x8*)(qrow + 96);
#pragma unroll
            for (int pp = 0; pp < 2; ++pp)
#pragma unroll
                for (int nf = 0; nf < 8; ++nf) {
                    f32x4 acc = {0.f, 0.f, 0.f, 0.f};
                    acc = __builtin_amdgcn_mfma_f32_16x16x32_bf16(pp ? a10 : a00, kf[pp][nf][0], acc, 0, 0, 0);
                    acc = __builtin_amdgcn_mfma_f32_16x16x32_bf16(pp ? a11 : a01, kf[pp][nf][1], acc, 0, 0, 0);
#pragma unroll
                    for (int r = 0; r < 4; ++r) sc[(pp * 128 + 16 * w + 4 * q + r) * 129 + nf * 16 + tk] = acc[r];
                }
        }
        __syncthreads();
        {
            const int list = tid & 255, kr = tid >> 8;
            float a[16];
#pragma unroll
            for (int i = 0; i < 16; ++i) a[i] = -3.0e38f;
            const float* row = sc + list * 129 + kr * 64;
            for (int j = 0; j < 64; ++j) {
                const float v = __uint_as_float((__float_as_uint(row[j]) & ~0x7Fu) | (unsigned)(kr * 64 + j));
                ins16(a, v);
            }
            if (kr == 1) {
#pragma unroll
                for (int i = 0; i < 16; ++i) tl[list * 16 + i] = a[i];
            }
            __syncthreads();
            if (kr == 0) {
                float o[16];
#pragma unroll
                for (int i = 0; i < 16; ++i) o[i] = tl[list * 16 + i];
#pragma unroll
                for (int i = 0; i < 16; ++i) ins16(a, o[i]);
#pragma unroll
                for (int i = 0; i < 16; ++i) tl[list * 16 + i] = a[i];
            }
            __syncthreads();
        }
        if (tid < 128) {
            float s[16], r[16], c[16];
#pragma unroll
            for (int i = 0; i < 16; ++i) { s[i] = tl[tid * 16 + i]; r[i] = tl[(128 + tid) * 16 + i]; c[i] = -3.0e38f; }
#pragma unroll
            for (int i = 0; i < 16; ++i)
#pragma unroll
                for (int j = 0; j < 16; ++j)
                    if ((i + 1) * (j + 1) <= 16) {
                        const float v = __uint_as_float((__float_as_uint(s[i] + r[j]) & ~0xFFu) | (unsigned)(i * 16 + j));
                        ins16(c, v);
                    }
            float e[16], sum = 0.f;
#pragma unroll
            for (int k = 0; k < 16; ++k) { e[k] = __expf(c[k] - c[0]); sum += e[k]; }
            const float inv = 1.f / sum;
            int idv[16];
#pragma unroll
            for (int k = 0; k < 16; ++k) {
                const unsigned bits = __float_as_uint(c[k]), i = (bits >> 4) & 15u, j = bits & 15u;
                const unsigned ki = __float_as_uint(tl[tid * 16 + i]) & 0x7Fu, kj = __float_as_uint(tl[(128 + tid) * 16 + j]) & 0x7Fu;
                idv[k] = (int)(ki * 128u + kj);
            }
            int* ido = p.ids + (size_t)(t0 + tid) * 128 + h * 16; float* go = p.gates + (size_t)(t0 + tid) * 128 + h * 16;
#pragma unroll
            for (int k4 = 0; k4 < 4; ++k4) {
                *(int4*)(ido + k4 * 4) = make_int4(idv[k4 * 4], idv[k4 * 4 + 1], idv[k4 * 4 + 2], idv[k4 * 4 + 3]);
                *(f32x4*)(go + k4 * 4) = (f32x4){e[k4 * 4] * inv, e[k4 * 4 + 1] * inv, e[k4 * 4 + 2] * inv, e[k4 * 4 + 3] * inv};
            }
        }
        __syncthreads();
    }
}

typedef _Float16 h16x2 __attribute__((ext_vector_type(2)));
typedef int i32x8 __attribute__((ext_vector_type(8)));
#ifndef NVR
#define NVR 16
#endif
template <bool FINAL>
__device__ void gather_phase(const Params& p, int layer, const float* xin, float* xout, bf16_t* hkv_out, bf16_t* hq_out, const float* gnorm, int c_shift, int c_scale, int c_gate, unsigned char* smem) {
    const int tid_ = opaque_tid(), lane = tid_ & 63, wv = tid_ >> 6, tk = lane & 15, q = lane >> 4;
    const int nw = gridDim.x * (NT / 64);
    const unsigned char* utab = p.ub + (size_t)layer * NEXP * 512;
    const unsigned char* vtab = p.vb + (size_t)layer * NEXP * 512;
    const float* sutab = p.su + (size_t)layer * NEXP;
    const float* svtab = p.sv + (size_t)layer * NEXP;
    unsigned char* hl = smem + wv * 1024;
    for (int t = blockIdx.x * (NT / 64) + wv; t < T; t += nw) {
        const int b = t / SEQ;
        const float* cb = p.cond + (size_t)b * (NCOND * D);
        const float* xr = xin + (size_t)t * D;
        const int e0 = lane * 16;
        {
            f32x4 xv[4]; float ss = 0.f;
#pragma unroll
            for (int j = 0; j < 4; ++j) { xv[j] = *(const f32x4*)(xr + e0 + j * 4); ss += xv[j][0] * xv[j][0] + xv[j][1] * xv[j][1] + xv[j][2] * xv[j][2] + xv[j][3] * xv[j][3]; }
            ss = wave_sum(ss);
            const float rstd = rsqrtf(ss * (1.f / D) + RMS_EPS);
            u32x4 hw;
#pragma unroll
            for (int j = 0; j < 4; ++j) {
                const f32x4 g = *(const f32x4*)(gnorm + e0 + j * 4), sc = *(const f32x4*)(cb + c_scale * D + e0 + j * 4), sh = *(const f32x4*)(cb + c_shift * D + e0 + j * 4);
                float h[4];
#pragma unroll
                for (int e = 0; e < 4; ++e) h[e] = xv[j][e] * rstd * g[e] * (1.f + sc[e]) + sh[e];
                int r = 0;
                r = __builtin_amdgcn_cvt_pk_fp8_f32(h[0], h[1], r, false);
                r = __builtin_amdgcn_cvt_pk_fp8_f32(h[2], h[3], r, true);
                hw[j] = (unsigned)r;
            }
            *(u32x4*)(hl + lane * 16) = hw;
        }
        asm volatile("s_waitcnt lgkmcnt(0)" ::: "memory");
        i32x8 hb[8];
#pragma unroll
        for (int kk = 0; kk < 8; ++kk) {
            const u32x4 lo = *(const u32x4*)(hl + kk * 128 + q * 16), hi = *(const u32x4*)(hl + kk * 128 + 64 + q * 16);
            hb[kk] = (i32x8){(int)lo[0], (int)lo[1], (int)lo[2], (int)lo[3], (int)hi[0], (int)hi[1], (int)hi[2], (int)hi[3]};
        }
        const int idA = p.ids[(size_t)t * 128 + lane], idB = p.ids[(size_t)t * 128 + 64 + lane];
        const float gA = p.gates[(size_t)t * 128 + lane], gB = p.gates[(size_t)t * 128 + 64 + lane];
        const float suA = sutab[idA], suB = sutab[idB], svA = svtab[idA], svB = svtab[idB];
        float dA = 0.f, dB = 0.f;
        u32x4 rb[2][8];
        auto issue_u = [&](u32x4 (&buf)[8], int bt) {
            const int id = __shfl(bt < 4 ? idA : idB, (bt * 16 + tk) & 63);
            const unsigned char* rp = utab + (size_t)id * 512 + q * 16;
#pragma unroll
            for (int kk = 0; kk < 8; ++kk) buf[kk] = *(const u32x4*)(rp + kk * 64);
        };
        auto consume_ub = [&](const u32x4 (&buf)[8], int bt) {
            f32x4 acc = {0.f, 0.f, 0.f, 0.f};
#if defined(DEBUG_VALU_U)
            {
                const int idd = __shfl(bt < 4 ? idA : idB, (bt * 16 + tk) & 63);
                const unsigned char* rp = utab + (size_t)idd * 512 + q * 16;
                float dsum = 0.f;
#pragma unroll 1
                for (int kk = 0; kk < 8; ++kk) {
                    const u32x4 xw = *(const u32x4*)(rp + kk * 64);
#pragma unroll 1
                    for (int d = 0; d < 4; ++d) {
                        const unsigned x = d == 0 ? xw[0] : (d == 1 ? xw[1] : (d == 2 ? xw[2] : xw[3]));
                        const u32x2 hw2 = *(const u32x2*)(hl + kk * 128 + q * 32 + d * 8);
                        const f32x2 u0 = __builtin_amdgcn_cvt_scalef32_pk_f32_fp4(x, 1.0f, 0), u1 = __builtin_amdgcn_cvt_scalef32_pk_f32_fp4(x, 1.0f, 1);
                        const f32x2 u2 = __builtin_amdgcn_cvt_scalef32_pk_f32_fp4(x, 1.0f, 2), u3 = __builtin_amdgcn_cvt_scalef32_pk_f32_fp4(x, 1.0f, 3);
                        const f32x2 h0 = __builtin_amdgcn_cvt_pk_f32_fp8((int)hw2[0], false), h1 = __builtin_amdgcn_cvt_pk_f32_fp8((int)hw2[0], true);
                        const f32x2 h2 = __builtin_amdgcn_cvt_pk_f32_fp8((int)hw2[1], false), h3 = __builtin_amdgcn_cvt_pk_f32_fp8((int)hw2[1], true);
                        dsum += u0[0] * h0[0] + u0[1] * h0[1] + u1[0] * h1[0] + u1[1] * h1[1] + u2[0] * h2[0] + u2[1] * h2[1] + u3[0] * h3[0] + u3[1] * h3[1];
                    }
                }
                dsum += __shfl_xor(dsum, 16); dsum += __shfl_xor(dsum, 32);
#pragma unroll
                for (int r = 0; r < 4; ++r) acc[r] = __shfl(dsum, 4 * q + r);
            }
#else
#pragma unroll
            for (int kk = 0; kk < 8; ++kk) {
                const i32x8 av = {(int)buf[kk][0], (int)buf[kk][1], (int)buf[kk][2], (int)buf[kk][3], 0, 0, 0, 0};
                acc = __builtin_amdgcn_mfma_scale_f32_16x16x128_f8f6f4(av, hb[kk], acc, 4  , 0  , 0, 0x7f7f7f7f, 0, 0x7f7f7f7f);
            }
#endif
            const int r = lane & 3;
            const float mine = r == 0 ? acc[0] : (r == 1 ? acc[1] : (r == 2 ? acc[2] : acc[3]));
            const float got = __shfl(mine, ((lane & 15) >> 2) * 16 + (lane & 15));
            if (q == (bt & 3)) { if (bt < 4) dA = got; else dB = got; }
        };
        issue_u(rb[0], 0);
#pragma unroll 1
        for (int bt = 0; bt < 8; bt += 2) {
            issue_u(rb[1], bt + 1);
            consume_ub(rb[0], bt);
            if (bt + 2 < 8) issue_u(rb[0], bt + 2);
            consume_ub(rb[1], bt + 1);
        }
        const float apA = gelu_tanh(dA * suA) * gA * svA, apB = gelu_tanh(dB * suB) * gB * svB;
        const h16x2 a2A = {(_Float16)apA, (_Float16)apA}, a2B = {(_Float16)apB, (_Float16)apB};
        const unsigned pA = __builtin_bit_cast(unsigned, a2A), pB = __builtin_bit_cast(unsigned, a2B);
        float o[16];
#pragma unroll
        for (int e = 0; e < 16; ++e) o[e] = 0.f;
        const unsigned offA = (unsigned)idA * 512u, offB = (unsigned)idB * 512u, lane8 = (unsigned)lane * 8u;
        u32x2 vr[16];
        h16x2 oh[8];
#define VR_ISSUE(slot, offreg, kidx) { const unsigned so_ = (unsigned)__builtin_amdgcn_readlane((int)(offreg), (kidx)); vr[slot] = *(const u32x2*)(vtab + (size_t)(so_ + lane8)); }
#define VR_CONSUME(slot, preg, kidx) { const h16x2 a2_ = __builtin_bit_cast(h16x2, (unsigned)__builtin_amdgcn_readlane((int)(preg), (kidx))); \
            _Pragma("unroll") for (int d_ = 0; d_ < 2; ++d_) { const unsigned x_ = vr[slot][d_]; \
                oh[d_ * 4 + 0] += a2_ * __builtin_amdgcn_cvt_scalef32_pk_f16_fp4(x_, 1.0f, 0); oh[d_ * 4 + 1] += a2_ * __builtin_amdgcn_cvt_scalef32_pk_f16_fp4(x_, 1.0f, 1); \
                oh[d_ * 4 + 2] += a2_ * __builtin_amdgcn_cvt_scalef32_pk_f16_fp4(x_, 1.0f, 2); oh[d_ * 4 + 3] += a2_ * __builtin_amdgcn_cvt_scalef32_pk_f16_fp4(x_, 1.0f, 3); } }
#define OH_ZERO() { _Pragma("unroll") for (int e_ = 0; e_ < 8; ++e_) oh[e_] = (h16x2){(_Float16)0.f, (_Float16)0.f}; }
#define OH_FLUSH() { _Pragma("unroll") for (int e_ = 0; e_ < 8; ++e_) { o[2 * e_] += (float)oh[e_][0]; o[2 * e_ + 1] += (float)oh[e_][1]; } }
#pragma unroll
        for (int jj = 0; jj < 15; ++jj) VR_ISSUE(jj, offA, jj);
#pragma unroll
        for (int half = 0; half < 2; ++half) {
            const unsigned offX = half ? offB : offA, pX = half ? pB : pA;
#pragma unroll 1
            for (int k0 = 0; k0 < 48; k0 += 16) {
                OH_ZERO();
#pragma unroll
                for (int jj = 0; jj < 16; ++jj) { VR_ISSUE((jj + 15) & 15, offX, k0 + jj + 15); VR_CONSUME(jj, pX, k0 + jj); }
                OH_FLUSH();
            }
            OH_ZERO();
#pragma unroll
            for (int jj = 0; jj < 16; ++jj) {
                if (jj == 0) { VR_ISSUE(15, offX, 63); }
                else if (half == 0) { VR_ISSUE((jj + 15) & 15, offB, jj - 1); }
                VR_CONSUME(jj, pX, 48 + jj);
            }
            OH_FLUSH();
        }
#undef VR_ISSUE
#undef VR_CONSUME
#undef OH_ZERO
#undef OH_FLUSH
        float xn[16]; float ss = 0.f;
#pragma unroll
        for (int j4 = 0; j4 < 4; ++j4) {
            const f32x4 xo = *(const f32x4*)(xr + e0 + j4 * 4), gv = *(const f32x4*)(cb + c_gate * D + e0 + j4 * 4);
#pragma unroll
            for (int e = 0; e < 4; ++e) { const float v = xo[e] + gv[e] * o[j4 * 4 + e]; xn[j4 * 4 + e] = v; ss += v * v; }
        }
        ss = wave_sum(ss);
        const float rstd = rsqrtf(ss * (1.f / D) + RMS_EPS);
        if (!FINAL) {
#pragma unroll
            for (int j = 0; j < 4; ++j) *(f32x4*)(xout + (size_t)t * D + e0 + j * 4) = (f32x4){xn[j * 4], xn[j * 4 + 1], xn[j * 4 + 2], xn[j * 4 + 3]};
            float hk[16], hq[16];
#pragma unroll
            for (int j = 0; j < 4; ++j) {
                const f32x4 gk = *(const f32x4*)(p.kv_norm + e0 + j * 4), sck = *(const f32x4*)(cb + 13 * D + e0 + j * 4), shk = *(const f32x4*)(cb + 12 * D + e0 + j * 4);
                const f32x4 gm = *(const f32x4*)(p.norm_mix + D + e0 + j * 4), scm = *(const f32x4*)(cb + 7 * D + e0 + j * 4), shm = *(const f32x4*)(cb + 6 * D + e0 + j * 4);
#pragma unroll
                for (int e = 0; e < 4; ++e) {
                    const float xs = xn[j * 4 + e] * rstd;
                    hk[j * 4 + e] = xs * gk[e] * (1.f + sck[e]) + shk[e]; hq[j * 4 + e] = xs * gm[e] * (1.f + scm[e]) + shm[e];
                }
            }
#pragma unroll
            for (int j = 0; j < 2; ++j) {
                u32x4 ob; ob[0] = pack2(hk[j * 8], hk[j * 8 + 1]); ob[1] = pack2(hk[j * 8 + 2], hk[j * 8 + 3]); ob[2] = pack2(hk[j * 8 + 4], hk[j * 8 + 5]); ob[3] = pack2(hk[j * 8 + 6], hk[j * 8 + 7]);
                *(u32x4*)(hkv_out + (size_t)t * D + e0 + j * 8) = ob;
                u32x4 oc; oc[0] = pack2(hq[j * 8], hq[j * 8 + 1]); oc[1] = pack2(hq[j * 8 + 2], hq[j * 8 + 3]); oc[2] = pack2(hq[j * 8 + 4], hq[j * 8 + 5]); oc[3] = pack2(hq[j * 8 + 6], hq[j * 8 + 7]);
                *(u32x4*)(hq_out + (size_t)t * D + e0 + j * 8) = oc;
            }
        } else {
#pragma unroll
            for (int j = 0; j < 4; ++j) {
                const f32x4 g = *(const f32x4*)(p.final_norm + e0 + j * 4), sc = *(const f32x4*)(cb + 15 * D + e0 + j * 4), sh = *(const f32x4*)(cb + 14 * D + e0 + j * 4);
                f32x4 ov;
#pragma unroll
                for (int e = 0; e < 4; ++e) ov[e] = xn[j * 4 + e] * rstd * g[e] * (1.f + sc[e]) + sh[e];
                *(f32x4*)(p.out + (size_t)t * D + e0 + j * 4) = ov;
            }
        }
        asm volatile("s_waitcnt lgkmcnt(0)" ::: "memory");
    }
}

__device__ void attn_phase(const Params& p, const bf16_t* Q, const bf16_t* K, const bf16_t* V, bf16_t* O, unsigned char* smem) {
    unsigned char* Kl = smem;
    unsigned char* Vt = smem + 32768;
    unsigned char* Pl = smem + 32768 + 35840;
    const int tid = opaque_tid(), lane = tid & 63, w = tid >> 6, tk = lane & 15, q = lane >> 4;
    unsigned char* Pw = Pl + w * 5376;
    for (int task = blockIdx.x; task < NB * 32 * 4; task += gridDim.x) {
        const int kvh = task & 3, qblk = (task >> 2) & 31, b = task >> 7;
        const int kpos0 = (qblk - 1) * 128;
#pragma unroll
        for (int i = 0; i < 4; ++i) {
            const int id = tid + NT * i, j = id >> 3, c = id & 7, kp = kpos0 + j;
            u32x4 v = {0u, 0u, 0u, 0u};
            if (kp >= 0) v = *(const u32x4*)(K + ((size_t)b * SEQ + kp) * 256 + kvh * 64 + c * 8);
            *(u32x4*)(Kl + lds_off(j, c)) = v;
        }
#pragma unroll
        for (int i = 0; i < 4; ++i) {
            const int id = tid + NT * i, j = id & 255, dc = id >> 8, kp = kpos0 + j;
            u32x4 v = {0u, 0u, 0u, 0u};
            if (kp >= 0) v = *(const u32x4*)(V + ((size_t)b * SEQ + kp) * 256 + kvh * 64 + dc * 8);
#pragma unroll
            for (int e = 0; e < 4; ++e) {
                *(bf16_t*)(Vt + (dc * 8 + 2 * e) * 560 + j * 2) = (bf16_t)(v[e] & 0xffffu);
                *(bf16_t*)(Vt + (dc * 8 + 2 * e + 1) * 560 + j * 2) = (bf16_t)(v[e] >> 16);
            }
        }
        if (tid < 128) *(u32x4*)(Vt + (tid >> 1) * 560 + 512 + (tid & 1) * 16) = (u32x4){0u, 0u, 0u, 0u};
        *(u32x2*)(Pw + tk * 336 + (144 + 4 * q) * 2) = (u32x2){0u, 0u};
        __syncthreads();
        const int qt = w, i_q = qt * 16 + tk;
        const size_t trow = (size_t)b * SEQ + qblk * 128 + i_q;
        const unsigned char* kb0 = Kl + lds_off(qt * 16 + tk, q);
        const unsigned char* kb1 = Kl + lds_off(qt * 16 + tk, 4 + q);
        const unsigned char* vb0 = Vt + tk * 560 + (qt * 16 + 8 * q) * 2;
        unsigned char* pwr = Pw + tk * 336 + 8 * q;
        const unsigned char* prd = Pw + tk * 336 + 16 * q;
#pragma unroll 1
        for (int hq = 0; hq < 4; ++hq) {
            const int head = kvh * 4 + hq;
            const bf16x8 qf0 = *(const bf16x8*)(Q + trow * D + head * 64 + 8 * q), qf1 = *(const bf16x8*)(Q + trow * D + head * 64 + 32 + 8 * q);
            f32x4 sacc[9];
#pragma unroll
            for (int kk = 0; kk < 9; ++kk) {
                const bf16x8 k0 = *(const bf16x8*)(kb0 + kk * 2048), k1 = *(const bf16x8*)(kb1 + kk * 2048);
                f32x4 a = {0.f, 0.f, 0.f, 0.f};
                a = __builtin_amdgcn_mfma_f32_16x16x32_bf16(k0, qf0, a, 0, 0, 0);
                a = __builtin_amdgcn_mfma_f32_16x16x32_bf16(k1, qf1, a, 0, 0, 0);
                sacc[kk] = a;
                if (kk & 1) __builtin_amdgcn_sched_barrier(0);
            }
            const float sink = p.sinks[head];
            float mx = -1e30f;
#pragma unroll
            for (int kk = 0; kk < 9; ++kk)
#pragma unroll
                for (int r = 0; r < 4; ++r) {
                    const int j = (qt + kk) * 16 + 4 * q + r;
                    const bool valid = (j > i_q) && (j <= i_q + 128) && (qblk > 0 || j >= 128);
                    const float s = valid ? sacc[kk][r] * 0.125f : -1e30f;
                    sacc[kk][r] = s; mx = fmaxf(mx, s);
                }
            mx = fmaxf(mx, __shfl_xor(mx, 16)); mx = fmaxf(mx, __shfl_xor(mx, 32));
            mx = fmaxf(mx, sink);
            float sum = 0.f;
#pragma unroll
            for (int kk = 0; kk < 9; ++kk)
#pragma unroll
                for (int r = 0; r < 4; ++r) { const float e = __expf(sacc[kk][r] - mx); sacc[kk][r] = e; sum += e; }
            sum += __shfl_xor(sum, 16); sum += __shfl_xor(sum, 32);
            const float inv = 1.f / (sum + __expf(sink - mx));
#pragma unroll
            for (int kk = 0; kk < 9; ++kk) {
                u32x2 o; o[0] = pack2(sacc[kk][0] * inv, sacc[kk][1] * inv); o[1] = pack2(sacc[kk][2] * inv, sacc[kk][3] * inv);
                *(u32x2*)(pwr + kk * 32) = o;
            }
            asm volatile("s_waitcnt lgkmcnt(0)" ::: "memory");
            bf16x8 pf[5];
#pragma unroll
            for (int ks = 0; ks < 5; ++ks) pf[ks] = *(const bf16x8*)(prd + ks * 64);
#pragma unroll
            for (int dt = 0; dt < 4; ++dt) {
                f32x4 oa = {0.f, 0.f, 0.f, 0.f};
#pragma unroll
                for (int ks = 0; ks < 5; ++ks) {
                    const bf16x8 vf = *(const bf16x8*)(vb0 + dt * 8960 + ks * 64);
                    oa = __builtin_amdgcn_mfma_f32_16x16x32_bf16(vf, pf[ks], oa, 0, 0, 0);
                }
                u32x2 o; o[0] = pack2(oa[0], oa[1]); o[1] = pack2(oa[2], oa[3]);
                *(u32x2*)(O + trow * D + head * 64 + dt * 16 + 4 * q) = o;
                __builtin_amdgcn_sched_barrier(0);
            }
            asm volatile("s_waitcnt lgkmcnt(0)" ::: "memory");
        }
        __syncthreads();
    }
}

constexpr int SMEM_BYTES = 152 * 1024;
__global__ void __launch_bounds__(NT) yoco_fwd(Params p) {
    __shared__ __attribute__((aligned(16))) unsigned char smem[SMEM_BYTES];
    volatile LAS unsigned* st = (volatile LAS unsigned*)(smem + SMEM_BYTES - 16);
    if (threadIdx.x == 0) { st[0] = 0u; st[1] = 0u; }
    __syncthreads();
    const XcdBarrier xb = xcd_barrier_post(p.bar, st);
    p0_cond(p, smem);
    p0_tables(p);
    p0_wt(p, smem);
    p0_s5(p, smem);
    xcd_barrier(xb);
    p05_prep(p, smem);
    xcd_barrier(xb);
    bias_finalize(p);
    { EpiU e{p.s1}; gemm_phase<256>(p.s0, p.wt_in, 0, 1024, e, smem); }
    xcd_barrier(xb);
    s5_phase(p, smem);
    xcd_barrier(xb);
    { EpiGlu e{p.s0, p.b_glu, p.s1}; gemm_phase<256>(p.s0, p.wt_glu, 0, 1024, e, smem); }
    xcd_barrier(xb);
    { EpiRes e{p.x, p.cond + 2 * D, p.norm_ffn, p.cond + 4 * D, p.f0, p.s2, p.ssq1}; gemm_phase<256>(p.s1, p.wt_out, 0, 1024, e, smem); }
    xcd_barrier(xb);
    { EpiQ e{p.ssq1, p.bias, 0, p.s1}; gemm_phase<256>(p.s2, p.wt_pq0, 0, 1024, e, smem); }
    xcd_barrier(xb);
    route_phase(p, 0, p.s1, smem);
    xcd_barrier(xb);
    gather_phase<false>(p, 0, p.f0, p.f1, p.s0, p.s2, p.norm_ffn, 3, 4, 5, smem);
    xcd_barrier(xb);
    { EpiRope<0> e{p.ropec, p.ropes, p.s1, p.s1 + (size_t)T * 256}; gemm_phase<128>(p.s0, p.wt_kv, 0, 512, e, smem); }
    { EpiRope<1> e{p.ropec, p.ropes, p.s3, nullptr}; gemm_phase<128>(p.s2, p.wt_q, 0, 1024, e, smem); }
    xcd_barrier(xb);
    attn_phase(p, p.s3, p.s1, p.s1 + (size_t)T * 256, p.s0, smem);
    xcd_barrier(xb);
    { EpiRes e{p.f1, p.cond + 8 * D, p.norm_ffn + D, p.cond + 10 * D, p.f0, p.s2, p.ssq3}; gemm_phase<256>(p.s0, p.wt_o, 0, 1024, e, smem); }
    xcd_barrier(xb);
    { EpiQ e{p.ssq3, p.bias, 1024, p.s1}; gemm_phase<256>(p.s2, p.wt_pq1, 0, 1024, e, smem); }
    xcd_barrier(xb);
    route_phase(p, 1, p.s1, smem);
    xcd_barrier(xb);
    gather_phase<true>(p, 1, p.f0, nullptr, nullptr, nullptr, p.norm_ffn + D, 9, 10, 11, smem);
}

static inline size_t align_up(size_t v, size_t a) { return (v + a - 1) / a * a; }

extern "C" void kernel_launch(void* const* d_in, const int* in_sizes, int n_in, void* d_out, int out_size, void* d_ws, size_t ws_size, hipStream_t stream) {
    (void)in_sizes; (void)n_in; (void)out_size;
    Params p{};
    p.x = (const float*)d_in[0]; p.c = (const float*)d_in[1]; p.pos = (const int*)d_in[2]; p.w_cond = (const float*)d_in[3]; p.b_cond = (const float*)d_in[4];
    p.norm_mix = (const float*)d_in[5]; p.norm_ffn = (const float*)d_in[6]; p.w_in = (const float*)d_in[7]; p.a_re = (const float*)d_in[8]; p.a_im = (const float*)d_in[9];
    p.log_dt = (const float*)d_in[10]; p.b_re = (const float*)d_in[11]; p.b_im = (const float*)d_in[12]; p.c_re = (const float*)d_in[13]; p.c_im = (const float*)d_in[14];
    p.s5d = (const float*)d_in[15]; p.w_glu = (const float*)d_in[16]; p.b_glu = (const float*)d_in[17]; p.w_out = (const float*)d_in[18]; p.kv_norm = (const float*)d_in[19];
    p.w_kv = (const float*)d_in[20]; p.w_q = (const float*)d_in[21]; p.sinks = (const float*)d_in[22]; p.w_o = (const float*)d_in[23]; p.peer_wq = (const float*)d_in[24];
    p.subkeys = (const float*)d_in[25]; p.peer_u = (const float*)d_in[26]; p.peer_v = (const float*)d_in[27]; p.final_norm = (const float*)d_in[28];
    p.out = (float*)d_out;
    unsigned char* w = (unsigned char*)d_ws; size_t off = 65536;
    p.bar = (unsigned*)d_ws;
    auto take = [&](size_t bytes) { void* r = w + off; off = align_up(off + bytes, 4096); return r; };
    p.cond = (float*)take((size_t)NB * NCOND * D * 4);
    p.ropec = (float*)take((size_t)T * 32 * 4); p.ropes = (float*)take((size_t)T * 32 * 4);
    p.ssq1 = (float*)take((size_t)T * 16 * 4); p.ssq3 = (float*)take((size_t)T * 16 * 4);
    p.wt_in = (bf16_t*)take((size_t)D * D * 2); p.wt_glu = (bf16_t*)take((size_t)D * D * 2); p.wt_out = (bf16_t*)take((size_t)D * D * 2); p.wt_kv = (bf16_t*)take((size_t)512 * D * 2);
    p.wt_q = (bf16_t*)take((size_t)D * D * 2); p.wt_o = (bf16_t*)take((size_t)D * D * 2); p.wt_pq0 = (bf16_t*)take((size_t)D * D * 2); p.wt_pq1 = (bf16_t*)take((size_t)D * D * 2);
    p.biasp = (float*)take((size_t)8 * 4 * 2048 * 4); p.bias = (float*)take((size_t)4 * 2048 * 4);
    p.skeys = (bf16_t*)take((size_t)2 * 8 * 2 * 128 * 64 * 2);
    p.lamL = (float*)take((size_t)G5 * P5 * 2 * 4); p.ktab = (bf16_t*)take((size_t)G5 * KTR * 256 * 2);
    p.smat = (bf16_t*)take((size_t)G5 * 128 * 1024 * 2); p.cmat = (bf16_t*)take((size_t)G5 * 1024 * 128 * 2);
    p.ub = (unsigned char*)take((size_t)2 * NEXP * D); p.vb = (unsigned char*)take((size_t)2 * NEXP * D);
    p.su = (float*)take((size_t)2 * NEXP * 4); p.sv = (float*)take((size_t)2 * NEXP * 4);
    p.s0 = (bf16_t*)take((size_t)T * D * 2); p.s1 = (bf16_t*)take((size_t)T * D * 2); p.s2 = (bf16_t*)take((size_t)T * D * 2); p.s3 = (bf16_t*)take((size_t)T * D * 2);
    p.f0 = (float*)take((size_t)T * D * 4); p.f1 = (float*)take((size_t)T * D * 4);
    p.ids = (int*)take((size_t)T * 128 * 4); p.gates = (float*)take((size_t)T * 128 * 4);
    if (off > ws_size) { fprintf(stderr, "workspace too small: need %zu have %zu\n", off, ws_size); return; }

    static int grid_blocks = 0;
    if (!grid_blocks) {
        int dev = 0, cus = 0, per_cu = 0;
        (void)hipGetDevice(&dev);
        (void)hipDeviceGetAttribute(&cus, hipDeviceAttributeMultiprocessorCount, dev);
        (void)hipOccupancyMaxActiveBlocksPerMultiprocessor(&per_cu, yoco_fwd, NT, 0);
        if (per_cu > 1) per_cu = 1;
        grid_blocks = cus * per_cu;
        if (grid_blocks <= 0) grid_blocks = 256;
    }
    (void)hipMemsetAsync(d_ws, 0, XCD_BAR_WORDS * 4, stream);
    void* args[] = {&p};
    hipError_t e = hipLaunchCooperativeKernel((const void*)yoco_fwd, dim3(grid_blocks), dim3(NT), args, 0, stream);
    if (e != hipSuccess) fprintf(stderr, "cooperative launch failed: %s (grid %d)\n", hipGetErrorString(e), grid_blocks);
}
```

```cpp
#include <hip/hip_runtime.h>
#include <cstdio>
#include <cstdint>
#include <type_traits>

#define NT 512
#define LAS __attribute__((address_space(3)))
typedef unsigned short bf16_t;
typedef short bf16x8 __attribute__((ext_vector_type(8)));
typedef float f32x4 __attribute__((ext_vector_type(4)));
typedef unsigned u32x4 __attribute__((ext_vector_type(4)));
typedef unsigned u32x2 __attribute__((ext_vector_type(2)));

constexpr int D = 1024, NB = 4, SEQ = 4096, T = NB * SEQ;
constexpr int NCOND = 16;
constexpr int G5 = 64, P5 = 64, C5 = 16, L5 = 64, NCH = SEQ / L5, KTR = 72;
constexpr int NEXP = 16384;
constexpr float RMS_EPS = 1e-6f;

struct Params {
    const float *x, *c; const int* pos; const float *w_cond, *b_cond, *norm_mix, *norm_ffn, *w_in, *a_re, *a_im, *log_dt, *b_re, *b_im, *c_re, *c_im, *s5d,
        *w_glu, *b_glu, *w_out, *kv_norm, *w_kv, *w_q, *sinks, *w_o, *peer_wq, *subkeys, *peer_u, *peer_v, *final_norm;
    float* out;
    unsigned* bar;
    float* cond;
    float* ropec;
    float* ropes;
    float* ssq1;
    float* ssq3;
    bf16_t *wt_in, *wt_glu, *wt_out, *wt_kv, *wt_q, *wt_o, *wt_pq0, *wt_pq1;
    float* biasp;
    float* bias;
    bf16_t* skeys;
    float* lamL;
    bf16_t* ktab;
    bf16_t* smat;
    bf16_t* cmat;
    unsigned char* ub;
    unsigned char* vb;
    float* su;
    float* sv;
    bf16_t *s0, *s1, *s2, *s3;
    float *f0, *f1;
    int* ids;
    float* gates;
};

#define XB_TMO      128
#define XB_XCNT(j)  (256  + 64 * (j))
#define XB_XSUB(j)  (1280 + 64 * (j))
#define XB_XGEN(j)  (2304 + 64 * (j))
#define XB_TOP      3328
#define XB_TOPGEN   3392
#define XCD_BAR_WORDS 3456
#define XB_SPIN_CAP (1u << 22)
__device__ __forceinline__ unsigned xb_ld(unsigned* p)              { return __hip_atomic_load(p, __ATOMIC_RELAXED, __HIP_MEMORY_SCOPE_AGENT); }
__device__ __forceinline__ unsigned xb_add(unsigned* p, unsigned v) { return __hip_atomic_fetch_add(p, v, __ATOMIC_RELAXED, __HIP_MEMORY_SCOPE_AGENT); }
__device__ __forceinline__ unsigned xb_xcc_id() { return (unsigned)__builtin_amdgcn_s_getreg((3 << 11) | 20) & 0xFu; }
#define XB_SPIN(cond, bar) do { unsigned _sp = 0; while (cond) { __builtin_amdgcn_s_sleep(1); \
    if ((++_sp & 255u) == 0u) { if (xb_ld(&(bar)[XB_TMO])) break; if (_sp > XB_SPIN_CAP) { atomicAdd(&(bar)[XB_TMO], 1u); break; } } } } while (0)
struct XcdBarrier { unsigned* bar; unsigned x; volatile LAS unsigned* st; };
__device__ __forceinline__ XcdBarrier xcd_barrier_post(unsigned* bar, volatile LAS unsigned* st) {
    XcdBarrier b; b.bar = bar; b.x = xb_xcc_id(); b.st = st;
    if (threadIdx.x == 0) (void)xb_add(&bar[XB_XCNT(b.x)], 1u);
    return b;
}
__device__ __forceinline__ void xcd_barrier_complete(unsigned* bar, unsigned x, unsigned& nloc, unsigned& nx) {
    const unsigned G = gridDim.x * gridDim.y * gridDim.z;
    unsigned sum, cnt, mine, sp = 0u;
    for (;;) {
        sum = 0u; cnt = 0u; mine = 0u;
#pragma unroll
        for (unsigned j = 0; j < 16; ++j) { const unsigned c = xb_ld(&bar[XB_XCNT(j)]); sum += c; cnt += (c > 0u) ? 1u : 0u; mine = (j == x) ? c : mine; }
        if (sum == G) break;
        __builtin_amdgcn_s_sleep(1);
        if ((++sp & 255u) == 0u) { if (xb_ld(&bar[XB_TMO])) break; if (sp > XB_SPIN_CAP) { atomicAdd(&bar[XB_TMO], 1u); break; } }
    }
    nloc = mine > 0u ? mine : 1u; nx = cnt > 0u ? cnt : 1u;
}
__device__ __forceinline__ void xcd_barrier(const XcdBarrier& b) {
    asm volatile("s_waitcnt vmcnt(0)" ::: "memory");
    __syncthreads();
    if (threadIdx.x == 0) {
        unsigned* bar = b.bar;
        __builtin_amdgcn_s_waitcnt(0);
        unsigned nloc = b.st[0], nx = b.st[1];
        if (nloc == 0u) { xcd_barrier_complete(bar, b.x, nloc, nx); b.st[0] = nloc; b.st[1] = nx; }
        const unsigned old = xb_add(&bar[XB_XSUB(b.x)], 1u);
        const unsigned gen = old / nloc;
        if (old + 1u == (gen + 1u) * nloc) {
            __builtin_amdgcn_fence(__ATOMIC_RELEASE, "agent");
            asm volatile("s_waitcnt vmcnt(0)" ::: "memory");
            const unsigned og = xb_add(&bar[XB_TOP], 1u);
            const unsigned tg = og / nx;
            if (og + 1u == (tg + 1u) * nx) xb_add(&bar[XB_TOPGEN], 1u);
            else XB_SPIN(xb_ld(&bar[XB_TOPGEN]) == tg, bar);
            __builtin_amdgcn_fence(__ATOMIC_ACQUIRE, "agent");
            xb_add(&bar[XB_XGEN(b.x)], 1u);
            asm volatile("s_waitcnt vmcnt(0)" ::: "memory");
        } else {
            XB_SPIN(xb_ld(&bar[XB_XGEN(b.x)]) == gen, bar);
            __builtin_amdgcn_fence(__ATOMIC_ACQUIRE, "agent");
            asm volatile("s_waitcnt vmcnt(0)" ::: "memory");
        }
    }
    __syncthreads();
}

__device__ __forceinline__ int opaque_tid() { int t = threadIdx.x; asm volatile("" : "+v"(t)); return t; }
__device__ __forceinline__ bf16_t f2bf(float f) { unsigned u = __float_as_uint(f); u += 0x7fffu + ((u >> 16) & 1u); return (bf16_t)(u >> 16); }
__device__ __forceinline__ float bf2f(bf16_t h) { return __uint_as_float(((unsigned)h) << 16); }
typedef __bf16 hbf2 __attribute__((ext_vector_type(2)));
typedef float f32x2 __attribute__((ext_vector_type(2)));
__device__ __forceinline__ unsigned pack2(float lo, float hi) { f32x2 v = {lo, hi}; return __builtin_bit_cast(unsigned, __builtin_convertvector(v, hbf2)); }
__device__ __forceinline__ float dot2bf(unsigned a, unsigned b, float c) { return __builtin_amdgcn_fdot2_f32_bf16(__builtin_bit_cast(hbf2, a), __builtin_bit_cast(hbf2, b), c, false); }
__device__ __forceinline__ float bflo(unsigned w) { return __uint_as_float(w << 16); }
__device__ __forceinline__ float bfhi(unsigned w) { return __uint_as_float(w & 0xffff0000u); }
__device__ __forceinline__ float wave_sum(float v) {
#pragma unroll
    for (int o = 32; o >= 1; o >>= 1) v += __shfl_xor(v, o);
    return v;
}
__device__ __forceinline__ float gelu_tanh(float x) {
    const float u = 0.7978845608028654f * (x + 0.044715f * x * x * x);
    const float e = __expf(-2.f * fabsf(u));
    float th = (1.f - e) / (1.f + e);
    th = u < 0.f ? -th : th;
    return 0.5f * x * (1.f + th);
}

__device__ void p0_cond(const Params& p, unsigned char* smem) {
    float* sc = (float*)smem;
    float* red = (float*)(smem + 16384);
    const int tid = threadIdx.x;
    for (int i = tid; i < 4 * D; i += NT) { const float v = p.c[i]; sc[i] = v / (1.f + __expf(-v)); }
    __syncthreads();
    const int cgp = tid & 15, kg = tid >> 4;
    for (int task = blockIdx.x; task < NCOND * D / 64; task += gridDim.x) {
        const int col0 = task * 64 + cgp * 4;
        float acc[4][4];
#pragma unroll
        for (int b = 0; b < 4; ++b)
#pragma unroll
            for (int j = 0; j < 4; ++j) acc[b][j] = 0.f;
#pragma unroll 1
        for (int k0 = 0; k0 < 32; k0 += 8) {
            f32x4 w[8];
#pragma unroll
            for (int j = 0; j < 8; ++j) w[j] = *(const f32x4*)(p.w_cond + (size_t)(kg + 32 * (k0 + j)) * (NCOND * D) + col0);
#pragma unroll
            for (int j = 0; j < 8; ++j)
#pragma unroll
                for (int b = 0; b < 4; ++b) { const float s = sc[b * D + kg + 32 * (k0 + j)];
#pragma unroll
                    for (int e = 0; e < 4; ++e) acc[b][e] += s * w[j][e]; }
        }
#pragma unroll
        for (int b = 0; b < 4; ++b)
#pragma unroll
            for (int j = 0; j < 4; ++j) red[(kg * 64 + cgp * 4 + j) * 4 + b] = acc[b][j];
        __syncthreads();
        if (tid < 256) {
            const int col = tid >> 2, b = tid & 3;
            float s = 0.f;
            for (int g = 0; g < 32; ++g) s += red[(g * 64 + col) * 4 + b];
            p.cond[(size_t)b * (NCOND * D) + task * 64 + col] = s + p.b_cond[task * 64 + col];
        }
        __syncthreads();
    }
}

__device__ void p0_tables(const Params& p) {
    const size_t gtid = (size_t)blockIdx.x * NT + threadIdx.x, gstride = (size_t)gridDim.x * NT;
    {
        const int li = threadIdx.x & 15;
        const size_t grp = gtid >> 4, ngrp = gstride >> 4;
        for (int which = 0; which < 2; ++which) {
            const float* src = which ? p.peer_v : p.peer_u; unsigned char* dst = which ? p.vb : p.ub; float* sdst = which ? p.sv : p.su;
            for (size_t row = grp; row < (size_t)2 * NEXP; row += ngrp) {
                f32x4 v[2][8]; float ss = 0.f;
#pragma unroll
                for (int c = 0; c < 2; ++c)
#pragma unroll
                    for (int j = 0; j < 8; ++j) {
                        v[c][j] = *(const f32x4*)(src + row * D + c * 512 + li * 32 + j * 4);
#pragma unroll
                        for (int e = 0; e < 4; ++e) ss += v[c][j][e] * v[c][j][e];
                    }
                ss += __shfl_xor(ss, 1); ss += __shfl_xor(ss, 2); ss += __shfl_xor(ss, 4); ss += __shfl_xor(ss, 8);
                const float rms = sqrtf(ss * (1.f / D)), step = 0.48f * rms, inv = step > 0.f ? 1.f / step : 0.f;
#pragma unroll
                for (int c = 0; c < 2; ++c) {
                    u32x4 o;
#pragma unroll
                    for (int d = 0; d < 4; ++d) {
                        unsigned wd = 0u;
                        if (true) {
                            wd = __builtin_amdgcn_cvt_scalef32_pk_fp4_f32(wd, v[c][d * 2][0] * inv, v[c][d * 2][1] * inv, 1.0f, 0);
                            wd = __builtin_amdgcn_cvt_scalef32_pk_fp4_f32(wd, v[c][d * 2][2] * inv, v[c][d * 2][3] * inv, 1.0f, 1);
                            wd = __builtin_amdgcn_cvt_scalef32_pk_fp4_f32(wd, v[c][d * 2 + 1][0] * inv, v[c][d * 2 + 1][1] * inv, 1.0f, 2);
                            wd = __builtin_amdgcn_cvt_scalef32_pk_fp4_f32(wd, v[c][d * 2 + 1][2] * inv, v[c][d * 2 + 1][3] * inv, 1.0f, 3);
                        } else {
#pragma unroll
                            for (int k = 0; k < 8; ++k) {
                                const float x = v[c][d * 2 + (k >> 2)][k & 3];
                                const int n = (int)fminf(fmaxf(floorf(x * inv + 8.f), 0.f), 15.f);
                                wd |= (unsigned)n << (4 * ((k >> 1) + 4 * (k & 1)));
                            }
                        }
                        o[d] = wd;
                    }
                    *(u32x4*)(dst + row * 512 + c * 256 + li * 16) = o;
                }
                if (li == 0) sdst[row] = step;
            }
        }
    }
    const size_t nk8 = (size_t)2 * 8 * 2 * 128 * 64 / 8;
    for (size_t i = gtid; i < nk8; i += gstride) {
        const f32x4 a = *(const f32x4*)(p.subkeys + i * 8), b = *(const f32x4*)(p.subkeys + i * 8 + 4);
        u32x4 o; o[0] = pack2(a[0], a[1]); o[1] = pack2(a[2], a[3]); o[2] = pack2(b[0], b[1]); o[3] = pack2(b[2], b[3]);
        *(u32x4*)(p.skeys + i * 8) = o;
    }
    for (size_t i = gtid; i < (size_t)T * 32; i += gstride) {
        const int t = (int)(i >> 5), f = (int)(i & 31);
        const float invrev = exp2f(-(float)f * 0.41524101186092029f) * 0.15915494309189535f;
        float rev = (float)p.pos[t] * invrev; rev -= floorf(rev);
        p.ropec[i] = __builtin_amdgcn_cosf(rev); p.ropes[i] = __builtin_amdgcn_sinf(rev);
    }
}

__device__ void transpose_tile(const float* W, int ldw, int n0, int k0, bf16_t* Wt, unsigned char* smem) {
    bf16_t* tl = (bf16_t*)smem;
    const int tid = opaque_tid(), kk = tid >> 3, nn = (tid & 7) * 8;
    const f32x4 a = *(const f32x4*)(W + (size_t)(k0 + kk) * ldw + n0 + nn), b = *(const f32x4*)(W + (size_t)(k0 + kk) * ldw + n0 + nn + 4);
#pragma unroll
    for (int j = 0; j < 4; ++j) { tl[(nn + j) * 72 + kk] = f2bf(a[j]); tl[(nn + 4 + j) * 72 + kk] = f2bf(b[j]); }
    __syncthreads();
    const int n = tid >> 3, kc = (tid & 7) * 8;
    const u32x4 v = *(const u32x4*)(tl + n * 72 + kc);
    *(u32x4*)(Wt + (size_t)(n0 + n) * D + k0 + kc) = v;
    __syncthreads();
}

__device__ void p0_wt(const Params& p, unsigned char* smem) {
    for (int task = blockIdx.x; task < 7 * 256 + 128; task += gridDim.x) {
        const int w = task >> 8, tl = task & 255;
        const float* W; bf16_t* Wt; int ldw = 1024;
        switch (w) {
            case 0: W = p.w_in; Wt = p.wt_in; break;
            case 1: W = p.w_glu; Wt = p.wt_glu; break;
            case 2: W = p.w_out; Wt = p.wt_out; break;
            case 3: W = p.w_q; Wt = p.wt_q; break;
            case 4: W = p.w_o; Wt = p.wt_o; break;
            case 5: W = p.peer_wq; Wt = p.wt_pq0; break;
            case 6: W = p.peer_wq + (size_t)D * D; Wt = p.wt_pq1; break;
            default: W = p.w_kv; Wt = p.wt_kv; ldw = 512; break;
        }
        const int ntn = ldw / 64, n0 = (tl % ntn) * 64, k0 = (tl / ntn) * 64;
        transpose_tile(W, ldw, n0, k0, Wt, smem);
    }
}

__device__ __forceinline__ void lam_powf(float ar, float ai, float dt, int n, float& re, float& im) {
    const float m = __expf(ar * dt * (float)n);
    float rev = (ai * dt) * (float)n * 0.15915494309189535f; rev -= floorf(rev);
    re = m * __builtin_amdgcn_cosf(rev); im = m * __builtin_amdgcn_sinf(rev);
}
__device__ __forceinline__ void s5_coeff(float ar, float ai, float dt, float& cre, float& cim) {
    const float a = ar * dt, th = ai * dt;
    float rev = th * 0.15915494309189535f; rev -= floorf(rev);
    float revh = th * 0.5f * 0.15915494309189535f; revh -= floorf(revh);
    const float cs = __builtin_amdgcn_cosf(rev), sn = __builtin_amdgcn_sinf(rev), sh = __builtin_amdgcn_sinf(revh);
    const float em1 = expm1f(a);
    const float nr = em1 * cs - 2.f * sh * sh, ni = (em1 + 1.f) * sn, den = ar * ar + ai * ai;
    cre = (nr * ar + ni * ai) / den; cim = (ni * ar - nr * ai) / den;
}

__device__ void p0_s5(const Params& p, unsigned char* smem) {
    const size_t gtid = (size_t)blockIdx.x * NT + threadIdx.x, gstride = (size_t)gridDim.x * NT;
    for (size_t idx = gtid; idx < (size_t)G5 * P5 * 65; idx += gstride) {
        const int pp = (int)(idx & 63), e = (int)((idx >> 6) % 65), g = (int)(idx / (65 * P5));
        const float dt = __expf(p.log_dt[g]), ar = p.a_re[g * P5 + pp], ai = p.a_im[g * P5 + pp];
        float pwr, pwi; lam_powf(ar, ai, dt, e, pwr, pwi);
        if (e < 64) {
            float cfr, cfi; s5_coeff(ar, ai, dt, cfr, cfi);
            const float wr = pwr * cfr - pwi * cfi, wi = pwr * cfi + pwi * cfr;
            const int j = 63 - e;
            const float* brp = p.b_re + ((size_t)g * P5 + pp) * C5; const float* bip = p.b_im + ((size_t)g * P5 + pp) * C5;
            unsigned ore[8], oim[8];
#pragma unroll
            for (int c4 = 0; c4 < 4; ++c4) {
                const f32x4 br = *(const f32x4*)(brp + c4 * 4), bi = *(const f32x4*)(bip + c4 * 4);
                ore[c4 * 2] = pack2(wr * br[0] - wi * bi[0], wr * br[1] - wi * bi[1]); ore[c4 * 2 + 1] = pack2(wr * br[2] - wi * bi[2], wr * br[3] - wi * bi[3]);
                oim[c4 * 2] = pack2(wr * bi[0] + wi * br[0], wr * bi[1] + wi * br[1]); oim[c4 * 2 + 1] = pack2(wr * bi[2] + wi * br[2], wr * bi[3] + wi * br[3]);
            }
            u32x4* sre = (u32x4*)(p.smat + ((size_t)g * 128 + pp) * 1024 + j * 16);
            u32x4* sim = (u32x4*)(p.smat + ((size_t)g * 128 + 64 + pp) * 1024 + j * 16);
            sre[0] = (u32x4){ore[0], ore[1], ore[2], ore[3]}; sre[1] = (u32x4){ore[4], ore[5], ore[6], ore[7]};
            sim[0] = (u32x4){oim[0], oim[1], oim[2], oim[3]}; sim[1] = (u32x4){oim[4], oim[5], oim[6], oim[7]};
        }
        if (e >= 1) {
            const int i = e - 1;
#pragma unroll 4
            for (int co = 0; co < 16; ++co) {
                const float cr = p.c_re[((size_t)g * C5 + co) * P5 + pp], ci = p.c_im[((size_t)g * C5 + co) * P5 + pp];
                bf16_t* row = p.cmat + ((size_t)g * 1024 + i * 16 + co) * 128;
                row[pp] = f2bf(cr * pwr - ci * pwi);
                row[64 + pp] = f2bf(-(cr * pwi + ci * pwr));
            }
        }
        if (e == 64) {
            const double dtd = exp((double)p.log_dt[g]), m = exp((double)ar * dtd * 64.0);
            double ang = (double)ai * dtd * 64.0; ang -= 6.283185307179586 * floor(ang * 0.15915494309189535);
            p.lamL[(g * P5 + pp) * 2] = (float)(m * cos(ang)); p.lamL[(g * P5 + pp) * 2 + 1] = (float)(m * sin(ang));
        }
    }
    float* wre = (float*)smem;
    float* wim = wre + 1024;
    const int tid = threadIdx.x;
    for (int task = blockIdx.x; task < G5 * 4; task += gridDim.x) {
        const int g = task >> 2, tq = task & 3;
        const float dt = __expf(p.log_dt[g]);
        for (int i = tid; i < 1024; i += NT) {
            const int pp = i & 63, tau = tq * 16 + (i >> 6);
            const float ar = p.a_re[g * P5 + pp], ai = p.a_im[g * P5 + pp];
            float pwr, pwi, cfr, cfi; lam_powf(ar, ai, dt, tau, pwr, pwi); s5_coeff(ar, ai, dt, cfr, cfi);
            wre[i] = pwr * cfr - pwi * cfi; wim[i] = pwr * cfi + pwi * cfr;
        }
        __syncthreads();
        {
            const int co = (tid >> 4) & 15, ci = tid & 15, ph = tid >> 8;
            float* part = wim + 1024;
            float cbr[32], cbi[32];
#pragma unroll 8
            for (int k = 0; k < 32; ++k) {
                const int pp = ph * 32 + k;
                const float br = p.b_re[((size_t)g * P5 + pp) * C5 + ci], bi = p.b_im[((size_t)g * P5 + pp) * C5 + ci];
                const float cr = p.c_re[((size_t)g * C5 + co) * P5 + pp], cim = p.c_im[((size_t)g * C5 + co) * P5 + pp];
                cbr[k] = cr * br - cim * bi; cbi[k] = cr * bi + cim * br;
            }
            float sres[16];
#pragma unroll
            for (int tl = 0; tl < 16; ++tl) {
                float s0 = 0.f, s1 = 0.f;
#pragma unroll
                for (int k = 0; k < 32; k += 2) {
                    s0 += cbr[k] * wre[tl * 64 + ph * 32 + k] - cbi[k] * wim[tl * 64 + ph * 32 + k];
                    s1 += cbr[k + 1] * wre[tl * 64 + ph * 32 + k + 1] - cbi[k + 1] * wim[tl * 64 + ph * 32 + k + 1];
                }
                sres[tl] = s0 + s1;
            }
            if (ph == 1) {
#pragma unroll
                for (int tl = 0; tl < 16; ++tl) part[tl * 256 + (tid & 255)] = sres[tl];
            }
            __syncthreads();
            if (ph == 0) {
#pragma unroll
                for (int tl = 0; tl < 16; ++tl) p.ktab[((size_t)g * KTR + tq * 16 + tl + 8) * 256 + tid] = f2bf(sres[tl] + part[tl * 256 + tid]);
                if (tq == 0) {
#pragma unroll
                    for (int r = 0; r < 8; ++r) p.ktab[((size_t)g * KTR + r) * 256 + tid] = 0;
                }
            }
        }
        __syncthreads();
    }
}

__device__ void p05_prep(const Params& p, unsigned char* smem) {
    {
        const int lane = threadIdx.x & 63, wv = threadIdx.x >> 6;
        const int nw = gridDim.x * (NT / 64);
        for (int t = blockIdx.x * (NT / 64) + wv; t < T; t += nw) {
            const int b = t / SEQ;
            const float* xr = p.x + (size_t)t * D; const float* cb = p.cond + (size_t)b * (NCOND * D);
            f32x4 v[4]; float s = 0.f;
#pragma unroll
            for (int j = 0; j < 4; ++j) { v[j] = *(const f32x4*)(xr + j * 256 + lane * 4); s += v[j][0] * v[j][0] + v[j][1] * v[j][1] + v[j][2] * v[j][2] + v[j][3] * v[j][3]; }
            s = wave_sum(s);
            const float rstd = rsqrtf(s * (1.f / D) + RMS_EPS);
#pragma unroll
            for (int j = 0; j < 4; ++j) {
                const int e = j * 256 + lane * 4;
                const f32x4 g = *(const f32x4*)(p.norm_mix + e), sh = *(const f32x4*)(cb + 0 * D + e), sc = *(const f32x4*)(cb + 1 * D + e);
                float h[4];
#pragma unroll
                for (int i = 0; i < 4; ++i) h[i] = v[j][i] * rstd * g[i] * (1.f + sc[i]) + sh[i];
                u32x2 o; o[0] = pack2(h[0], h[1]); o[1] = pack2(h[2], h[3]);
                *(u32x2*)(p.s0 + (size_t)t * D + e) = o;
            }
        }
    }
    float* red = (float*)smem;
    const int tid = threadIdx.x;
    for (int task = blockIdx.x; task < 32 * 8; task += gridDim.x) {
        const int ct = task >> 3, ks = task & 7, col0 = ct * 64, layer = col0 >> 10;
        const float* W = p.peer_wq + (size_t)layer * D * D; const int cs = layer ? 9 : 3;
        const int n = (col0 & 1023) + (tid & 63), kg = tid >> 6;
        float wv[16];
#pragma unroll
        for (int j = 0; j < 16; ++j) wv[j] = W[(size_t)(ks * 128 + kg * 16 + j) * D + n];
        float acc[4] = {0.f, 0.f, 0.f, 0.f};
#pragma unroll
        for (int j = 0; j < 16; ++j)
#pragma unroll
            for (int b = 0; b < 4; ++b) acc[b] += p.cond[(size_t)b * (NCOND * D) + cs * D + ks * 128 + kg * 16 + j] * wv[j];
#pragma unroll
        for (int b = 0; b < 4; ++b) red[(kg * 64 + (tid & 63)) * 4 + b] = acc[b];
        __syncthreads();
        if (tid < 256) {
            const int col = tid >> 2, b = tid & 3; float sum = 0.f;
#pragma unroll
            for (int g = 0; g < 8; ++g) sum += red[(g * 64 + col) * 4 + b];
            p.biasp[((size_t)ks * 4 + b) * 2048 + col0 + col] = sum;
        }
        __syncthreads();
    }
}
__device__ void bias_finalize(const Params& p) {
    const int i = blockIdx.x * NT + threadIdx.x;
    if (i < 4 * 2048) { float s = 0.f;
#pragma unroll
        for (int ks = 0; ks < 8; ++ks) s += p.biasp[(size_t)ks * 8192 + i];
        p.bias[i] = s; }
}

__device__ __forceinline__ int lds_off(int row, int chunk) { return row * 128 + ((chunk ^ (row & 7)) << 4); }

template <int BN, class Epi>
__device__ void gemm_phase(const bf16_t* __restrict__ A, const bf16_t* __restrict__ Bt, size_t bt_batch_stride, int N, const Epi& epi, unsigned char* smem) {
    constexpr int WMI = BN == 256 ? 8 : 4;
    constexpr int A_BYTES = 32768, B_BYTES = BN * 128, BUF = A_BYTES + B_BYTES;
    const int tid = opaque_tid(), lane = tid & 63, w = tid >> 6, tk = lane & 15, q = lane >> 4;
    const int wm = BN == 256 ? (w >> 2) : (w >> 1), wn = BN == 256 ? (w & 3) : (w & 1);
    const int nN = N / BN;
    const bool xmap = (gridDim.x % 8) == 0;
    const int nslots = xmap ? gridDim.x / 8 : gridDim.x, slot = xmap ? (blockIdx.x >> 3) : blockIdx.x, xcd = blockIdx.x & 7;
    const int nitems = xmap ? 8 * nN : 64 * nN;
    for (int item = slot; item < nitems; item += nslots) {
        const int pm = xmap ? xcd * 8 + item / nN : item / nN, pn = item % nN;
        const int m0 = pm * 256, n0 = pn * BN, b = m0 / SEQ;
        const bf16_t* Ab = A + (size_t)m0 * D;
        const bf16_t* Bb = Bt + (size_t)b * bt_batch_stride + (size_t)n0 * D;
        f32x4 acc[WMI][4];
#pragma unroll
        for (int mi = 0; mi < WMI; ++mi)
#pragma unroll
            for (int ni = 0; ni < 4; ++ni) acc[mi][ni] = (f32x4){0.f, 0.f, 0.f, 0.f};
        auto stage = [&](int buf, int kt) {
#pragma unroll
            for (int j = 0; j < 4; ++j) {
                const int piece = w * 4 + j, P = piece * 1024 + lane * 16, row = P >> 7, lc = ((P >> 4) & 7) ^ (row & 7);
                __builtin_amdgcn_global_load_lds((const __attribute__((address_space(1))) void*)(Ab + (size_t)row * D + kt * 64 + lc * 8),
                                                 (__attribute__((address_space(3))) void*)(smem + buf * BUF + piece * 1024), 16, 0, 0);
            }
#pragma unroll
            for (int j = 0; j < BN / 64; ++j) {
                const int piece = w * (BN / 64) + j, P = piece * 1024 + lane * 16, row = P >> 7, lc = ((P >> 4) & 7) ^ (row & 7);
                __builtin_amdgcn_global_load_lds((const __attribute__((address_space(1))) void*)(Bb + (size_t)row * D + kt * 64 + lc * 8),
                                                 (__attribute__((address_space(3))) void*)(smem + buf * BUF + A_BYTES + piece * 1024), 16, 0, 0);
            }
        };
        auto compute = [&](int buf) {
            const unsigned char* sA = smem + buf * BUF; const unsigned char* sB = sA + A_BYTES;
#pragma unroll
            for (int ks = 0; ks < 2; ++ks) {
                bf16x8 bfr[4];
#pragma unroll
                for (int ni = 0; ni < 4; ++ni) bfr[ni] = *(const bf16x8*)(sB + lds_off(wn * 64 + ni * 16 + tk, ks * 4 + q));
#pragma unroll
                for (int mh = 0; mh < WMI / 4; ++mh) {
                    bf16x8 af[4];
#pragma unroll
                    for (int mi = 0; mi < 4; ++mi) af[mi] = *(const bf16x8*)(sA + lds_off(wm * (WMI * 16) + (mh * 4 + mi) * 16 + tk, ks * 4 + q));
#pragma unroll
                    for (int mi = 0; mi < 4; ++mi)
#pragma unroll
                        for (int ni = 0; ni < 4; ++ni) acc[mh * 4 + mi][ni] = __builtin_amdgcn_mfma_f32_16x16x32_bf16(bfr[ni], af[mi], acc[mh * 4 + mi][ni], 0, 0, 0);
                }
            }
        };
        stage(0, 0);
        __syncthreads();
#pragma unroll 1
        for (int kt = 0; kt < 16; ++kt) {
            if (kt + 1 < 16) stage((kt + 1) & 1, kt + 1);
            compute(kt & 1);
            __syncthreads();
        }
#pragma unroll
        for (int mh = 0; mh < WMI / 4; ++mh)
            epi(*(const f32x4 (*)[4][4])&acc[mh * 4], m0 + wm * (WMI * 16) + mh * 64, n0 + wn * 64, b, pn * (BN / 64) + wn, tk, q);
    }
}

__device__ __forceinline__ float rstd_of(const float* ssq, int token) {
    const f32x4* s4 = (const f32x4*)(ssq + (size_t)token * 16);
    const f32x4 a = s4[0], b = s4[1], c = s4[2], d = s4[3];
    const float s = ((a[0] + a[1]) + (a[2] + a[3])) + ((b[0] + b[1]) + (b[2] + b[3])) + ((c[0] + c[1]) + (c[2] + c[3])) + ((d[0] + d[1]) + (d[2] + d[3]));
    return rsqrtf(s * (1.f / D) + RMS_EPS);
}

struct EpiU {
    bf16_t* ug;
    __device__ __forceinline__ void operator()(const f32x4 (&acc)[4][4], int mbase, int nbase, int b, int, int tk, int q) const {
#pragma unroll
        for (int mi = 0; mi < 4; ++mi) {
            const int token = mbase + mi * 16 + tk, s = token - b * SEQ;
#pragma unroll
            for (int ni = 0; ni < 4; ++ni) {
                const int n = nbase + ni * 16 + 4 * q, g = n >> 4;
                u32x2 o; o[0] = pack2(acc[mi][ni][0], acc[mi][ni][1]); o[1] = pack2(acc[mi][ni][2], acc[mi][ni][3]);
                *(u32x2*)(ug + (((size_t)(g * 4 + b) * SEQ + s) * 16 + 4 * q)) = o;
            }
        }
    }
};
struct EpiQ {
    const float* ssq; const float* bias; int boff; bf16_t* out;
    __device__ __forceinline__ void operator()(const f32x4 (&acc)[4][4], int mbase, int nbase, int b, int, int tk, int q) const {
#pragma unroll
        for (int mi = 0; mi < 4; ++mi) {
            const int token = mbase + mi * 16 + tk;
            const float rstd = rstd_of(ssq, token);
#pragma unroll
            for (int ni = 0; ni < 4; ++ni) {
                const int n = nbase + ni * 16 + 4 * q;
                const f32x4 bv = *(const f32x4*)(bias + (size_t)b * 2048 + boff + n);
                u32x2 o; o[0] = pack2(rstd * acc[mi][ni][0] + bv[0], rstd * acc[mi][ni][1] + bv[1]); o[1] = pack2(rstd * acc[mi][ni][2] + bv[2], rstd * acc[mi][ni][3] + bv[3]);
                *(u32x2*)(out + (size_t)token * D + n) = o;
            }
        }
    }
};
struct EpiGlu {
    const bf16_t* y; const float* bglu; bf16_t* out;
    __device__ __forceinline__ void operator()(const f32x4 (&acc)[4][4], int mbase, int nbase, int, int, int tk, int q) const {
#pragma unroll
        for (int mi = 0; mi < 4; ++mi) {
            const int token = mbase + mi * 16 + tk;
#pragma unroll
            for (int ni = 0; ni < 4; ++ni) {
                const int n = nbase + ni * 16 + 4 * q;
                const f32x4 bv = *(const f32x4*)(bglu + n);
                const u32x2 yv = *(const u32x2*)(y + (size_t)token * D + n);
                float o[4];
                const float y0 = bflo(yv[0]), y1 = bfhi(yv[0]), y2 = bflo(yv[1]), y3 = bfhi(yv[1]);
                o[0] = y0 / (1.f + __expf(-(acc[mi][ni][0] + bv[0]))); o[1] = y1 / (1.f + __expf(-(acc[mi][ni][1] + bv[1])));
                o[2] = y2 / (1.f + __expf(-(acc[mi][ni][2] + bv[2]))); o[3] = y3 / (1.f + __expf(-(acc[mi][ni][3] + bv[3])));
                u32x2 ov; ov[0] = pack2(o[0], o[1]); ov[1] = pack2(o[2], o[3]);
                *(u32x2*)(out + (size_t)token * D + n) = ov;
            }
        }
    }
};
struct EpiRes {
    const float* xold; const float* gate  ; const float* gnorm; const float* scale  ; float* xout; bf16_t* xbout; float* ssq;
    __device__ __forceinline__ void operator()(const f32x4 (&acc)[4][4], int mbase, int nbase, int b, int slot, int tk, int q) const {
#pragma unroll
        for (int mi = 0; mi < 4; ++mi) {
            const int token = mbase + mi * 16 + tk;
            float ss = 0.f;
#pragma unroll
            for (int ni = 0; ni < 4; ++ni) {
                const int n = nbase + ni * 16 + 4 * q;
                const f32x4 gv = *(const f32x4*)(gate + (size_t)b * (NCOND * D) + n), gn = *(const f32x4*)(gnorm + n), sc = *(const f32x4*)(scale + (size_t)b * (NCOND * D) + n);
                const f32x4 xo = *(const f32x4*)(xold + (size_t)token * D + n);
                f32x4 xn; float hs[4];
#pragma unroll
                for (int r = 0; r < 4; ++r) { xn[r] = xo[r] + gv[r] * acc[mi][ni][r]; ss += xn[r] * xn[r]; hs[r] = xn[r] * gn[r] * (1.f + sc[r]); }
                *(f32x4*)(xout + (size_t)token * D + n) = xn;
                u32x2 ov; ov[0] = pack2(hs[0], hs[1]); ov[1] = pack2(hs[2], hs[3]);
                *(u32x2*)(xbout + (size_t)token * D + n) = ov;
            }
            ss += __shfl_xor(ss, 16); ss += __shfl_xor(ss, 32);
            if (q == 0) ssq[(size_t)token * 16 + slot] = ss;
        }
    }
};
template <int MODE  >
struct EpiRope {
    const float* ropec; const float* ropes; bf16_t* o0; bf16_t* o1;
    __device__ __forceinline__ void operator()(const f32x4 (&acc)[4][4], int mbase, int nbase, int, int, int tk, int q) const {
        const bool rope = MODE == 1 || nbase < 256;
#pragma unroll
        for (int mi = 0; mi < 4; ++mi) {
            const int token = mbase + mi * 16 + tk;
            float v[4][4];
#pragma unroll
            for (int ni = 0; ni < 4; ++ni)
#pragma unroll
                for (int r = 0; r < 4; ++r) v[ni][r] = acc[mi][ni][r];
            if (rope) {
#pragma unroll
                for (int ni = 0; ni < 2; ++ni) {
                    const f32x4 cs = *(const f32x4*)(ropec + (size_t)token * 32 + ni * 16 + 4 * q), sn = *(const f32x4*)(ropes + (size_t)token * 32 + ni * 16 + 4 * q);
#pragma unroll
                    for (int r = 0; r < 4; ++r) { const float t1 = v[ni][r], t2 = v[ni + 2][r]; v[ni][r] = t1 * cs[r] - t2 * sn[r]; v[ni + 2][r] = t2 * cs[r] + t1 * sn[r]; }
                }
            }
            bf16_t* dst = MODE == 1 ? o0 + (size_t)token * D + nbase : (nbase < 256 ? o0 + (size_t)token * 256 + nbase : o1 + (size_t)token * 256 + (nbase - 256));
#pragma unroll
            for (int ni = 0; ni < 4; ++ni) { u32x2 o; o[0] = pack2(v[ni][0], v[ni][1]); o[1] = pack2(v[ni][2], v[ni][3]); *(u32x2*)(dst + ni * 16 + 4 * q) = o; }
        }
    }
};

__device__ void s5_phase(const Params& p, unsigned char* smem) {
    bf16_t* ktl = (bf16_t*)smem;
    float* Sl = (float*)(smem + 36864);
    bf16_t* Xl = (bf16_t*)(smem + 36864 + 33280);
    const int tid = opaque_tid(), lane = tid & 63, w = tid >> 6, cb = w & 3, hh = w >> 2, tk = lane & 15, q = lane >> 4;
    for (int task = blockIdx.x; task < G5 * NB; task += gridDim.x) {
        const int g = (task & 7) * 8 + ((task >> 3) >> 2), b = (task >> 3) & 3;
        const bf16_t* U = p.s1 + (size_t)(g * 4 + b) * SEQ * 16;
        const bf16_t* sm = p.smat + (size_t)g * 128 * 1024;
        const bf16_t* cm = p.cmat + (size_t)g * 1024 * 128;
        for (int i = tid; i < KTR * 256 * 2 / 16; i += NT) ((u32x4*)ktl)[i] = ((const u32x4*)(p.ktab + (size_t)g * KTR * 256))[i];
        bf16x8 ufr[32];
#pragma unroll
        for (int ks = 0; ks < 32; ++ks) ufr[ks] = *(const bf16x8*)(U + (size_t)(cb * 16 + tk) * 1024 + ks * 32 + 8 * q);
        {
            bf16x8 afA[4], afB[4];
            auto lda = [&](bf16x8 (&af)[4], int seq) {
                const int mf = seq >> 3, k4 = seq & 7;
                const bf16_t* ap = sm + (size_t)((hh * 4 + mf) * 16 + tk) * 1024 + 8 * q + k4 * 128;
#pragma unroll
                for (int j = 0; j < 4; ++j) af[j] = *(const bf16x8*)(ap + j * 32);
            };
            f32x4 acc = {0.f, 0.f, 0.f, 0.f};
            auto mma = [&](const bf16x8 (&af)[4], int seq) {
                const int k4 = seq & 7;
#pragma unroll
                for (int j = 0; j < 4; ++j) acc = __builtin_amdgcn_mfma_f32_16x16x32_bf16(af[j], ufr[k4 * 4 + j], acc, 0, 0, 0);
                if (k4 == 7) {
                    const int r0 = (hh * 4 + (seq >> 3)) * 16;
#pragma unroll
                    for (int r = 0; r < 4; ++r) Sl[(r0 + 4 * q + r) * 65 + cb * 16 + tk] = acc[r];
                    acc = (f32x4){0.f, 0.f, 0.f, 0.f};
                }
            };
            lda(afA, 0);
#pragma unroll
            for (int seq = 0; seq < 32; seq += 2) {
                lda(afB, seq + 1);
                mma(afA, seq);
                if (seq + 2 < 32) lda(afA, seq + 2);
                mma(afB, seq + 1);
            }
        }
        __syncthreads();
        if (w == 0) {
            const float lr = p.lamL[(g * P5 + lane) * 2], li = p.lamL[(g * P5 + lane) * 2 + 1];
            float xr = 0.f, xi = 0.f;
#pragma unroll 1
            for (int k0 = 0; k0 < NCH; k0 += 8) {
                float sr[8], si[8];
#pragma unroll
                for (int j = 0; j < 8; ++j) { sr[j] = Sl[lane * 65 + k0 + j]; si[j] = Sl[(64 + lane) * 65 + k0 + j]; }
#pragma unroll
                for (int j = 0; j < 8; ++j) {
                    Xl[(k0 + j) * 128 + lane] = f2bf(xr); Xl[(k0 + j) * 128 + 64 + lane] = f2bf(xi);
                    const float nr = lr * xr - li * xi + sr[j], ni = lr * xi + li * xr + si[j];
                    xr = nr; xi = ni;
                }
            }
        }
        __syncthreads();
        bf16x8 xfr[4];
#pragma unroll
        for (int ks = 0; ks < 4; ++ks) xfr[ks] = *(const bf16x8*)(Xl + (cb * 16 + tk) * 128 + ks * 32 + 8 * q);
        const f32x4 dv = *(const f32x4*)(p.s5d + g * 16 + 4 * q);
        const int jl = q >> 1, cih = q & 1;
        const bf16_t* kbase = ktl + (8 - jl) * 256 + tk * 16 + cih * 8;
        const bf16_t* cmb = cm + (size_t)tk * 128 + 8 * q;
        auto iof = [&](int ii) { return hh ? 16 + ii : (ii < 16 ? ii : 32 + ii); };
        bf16x8 cf[4];
#pragma unroll
        for (int ks = 0; ks < 4; ++ks) cf[ks] = *(const bf16x8*)(cmb + (size_t)iof(0) * 2048 + ks * 32);
#pragma unroll 1
        for (int ii = 0; ii < 32; ++ii) {
            const int i = iof(ii), inext = iof(ii < 31 ? ii + 1 : ii);
            bf16x8 cfn[4];
#pragma unroll
            for (int ks = 0; ks < 4; ++ks) cfn[ks] = *(const bf16x8*)(cmb + (size_t)inext * 2048 + ks * 32);
            const int s = (cb * 16 + tk) * 64 + i;
            const u32x2 uv = *(const u32x2*)(U + (size_t)s * 16 + 4 * q);
            f32x4 acc = {0.f, 0.f, 0.f, 0.f};
#pragma unroll
            for (int ks = 0; ks < 4; ++ks) acc = __builtin_amdgcn_mfma_f32_16x16x32_bf16(cf[ks], xfr[ks], acc, 0, 0, 0);
            const int mmax = i >> 1;
            const bf16_t* kb = kbase + i * 256;
#pragma unroll
            for (int mg = 0; mg < 8; ++mg) {
                if (4 * mg <= mmax) {
                    bf16x8 kf[4];
#pragma unroll
                    for (int j = 0; j < 4; ++j) kf[j] = *(const bf16x8*)(kb - (4 * mg + j) * 512);
#pragma unroll
                    for (int j = 0; j < 4; ++j) acc = __builtin_amdgcn_mfma_f32_16x16x32_bf16(kf[j], ufr[4 * mg + j], acc, 0, 0, 0);
                }
            }
            const float y0 = gelu_tanh(acc[0] + dv[0] * bflo(uv[0])), y1 = gelu_tanh(acc[1] + dv[1] * bfhi(uv[0]));
            const float y2 = gelu_tanh(acc[2] + dv[2] * bflo(uv[1])), y3 = gelu_tanh(acc[3] + dv[3] * bfhi(uv[1]));
            u32x2 o; o[0] = pack2(y0, y1); o[1] = pack2(y2, y3);
            *(u32x2*)(p.s0 + ((size_t)b * SEQ + s) * D + g * 16 + 4 * q) = o;
#pragma unroll
            for (int ks = 0; ks < 4; ++ks) cf[ks] = cfn[ks];
        }
        __syncthreads();
    }
}

__device__ __forceinline__ float med3f(float a, float b, float c) { return __builtin_amdgcn_fmed3f(a, b, c); }
__device__ __forceinline__ void ins16(float (&a)[16], float v) {
#pragma unroll
    for (int i = 15; i >= 1; --i) a[i] = med3f(a[i - 1], a[i], v);
    a[0] = fmaxf(a[0], v);
}
__device__ void route_phase(const Params& p, int layer, const bf16_t* qp, unsigned char* smem) {
    float* sc = (float*)smem;
    float* tl = (float*)(smem + 2 * 128 * 129 * 4);
    const int tid = opaque_tid(), lane = tid & 63, w = tid >> 6, tk = lane & 15, q = lane >> 4;
    const bool fixed = (gridDim.x & 7) == 0;
    const int ntask = (T / 128) * 8;
    int cur_h = -1;
    bf16x8 kf[2][8][2];
    for (int it = 0;; ++it) {
        int h, tt;
        if (fixed) { h = blockIdx.x & 7; tt = (blockIdx.x >> 3) + it * (gridDim.x >> 3); if (tt >= T / 128) break; }
        else { const int task = blockIdx.x + it * gridDim.x; if (task >= ntask) break; h = task & 7; tt = task >> 3; }
        const int t0 = tt * 128;
        if (h != cur_h) {
            cur_h = h;
#pragma unroll
            for (int pp = 0; pp < 2; ++pp)
#pragma unroll
                for (int nf = 0; nf < 8; ++nf) {
                    const bf16_t* kb = p.skeys + ((size_t)((layer * 8 + h) * 2 + pp) * 128 + nf * 16 + tk) * 64 + 8 * q;
                    kf[pp][nf][0] = *(const bf16x8*)(kb); kf[pp][nf][1] = *(const bf16x8*)(kb + 32);
                }
        }
        {
            const bf16_t* qrow = qp + (size_t)(t0 + 16 * w + tk) * D + h * 128 + 8 * q;
            const bf16x8 a00 = *(const bf16x8*)(qrow), a01 = *(const bf16x8*)(qrow + 32), a10 = *(const bf16x8*)(qrow + 64), a11 = *(const bf16x8*)(qrow + 96);
#pragma unroll
            for (int pp = 0; pp < 2; ++pp)
#pragma unroll
                for (int nf = 0; nf < 8; ++nf) {
                    f32x4 acc = {0.f, 0.f, 0.f, 0.f};
                    acc = __builtin_amdgcn_mfma_f32_16x16x32_bf16(pp ? a10 : a00, kf[pp][nf][0], acc, 0, 0, 0);
                    acc = __builtin_amdgcn_mfma_f32_16x16x32_bf16(pp ? a11 : a01, kf[pp][nf][1], acc, 0, 0, 0);
#pragma unroll
                    for (int r = 0; r < 4; ++r) sc[(pp * 128 + 16 * w + 4 * q + r) * 129 + nf * 16 + tk] = acc[r];
                }
        }
        __syncthreads();
        {
            const int list = tid & 255, kr = tid >> 8;
            float a[16];
#pragma unroll
            for (int i = 0; i < 16; ++i) a[i] = -3.0e38f;
            const float* row = sc + list * 129 + kr * 64;
#pragma unroll 1
            for (int j0 = 0; j0 < 64; j0 += 8) {
                float rv[8];
#pragma unroll
                for (int j = 0; j < 8; ++j) rv[j] = row[j0 + j];
#pragma unroll
                for (int j = 0; j < 8; ++j) {
                    const float v = __uint_as_float((__float_as_uint(rv[j]) & ~0x7Fu) | (unsigned)(kr * 64 + j0 + j));
                    ins16(a, v);
                }
            }
            if (kr == 1) {
#pragma unroll
                for (int i = 0; i < 16; ++i) tl[list * 16 + i] = a[i];
            }
            __syncthreads();
            if (kr == 0) {
                float o[16];
#pragma unroll
                for (int i = 0; i < 16; ++i) o[i] = tl[list * 16 + i];
#pragma unroll
                for (int i = 0; i < 16; ++i) ins16(a, o[i]);
#pragma unroll
                for (int i = 0; i < 16; ++i) tl[list * 16 + i] = a[i];
            }
            __syncthreads();
        }
        if (tid < 128) {
            float s[16], r[16], c[16];
#pragma unroll
            for (int i = 0; i < 16; ++i) { s[i] = tl[tid * 16 + i]; r[i] = tl[(128 + tid) * 16 + i]; c[i] = -3.0e38f; }
#pragma unroll
            for (int i = 0; i < 16; ++i)
#pragma unroll
                for (int j = 0; j < 16; ++j)
                    if ((i + 1) * (j + 1) <= 16) {
                        const float v = __uint_as_float((__float_as_uint(s[i] + r[j]) & ~0xFFu) | (unsigned)(i * 16 + j));
                        ins16(c, v);
                    }
            float e[16], sum = 0.f;
#pragma unroll
            for (int k = 0; k < 16; ++k) { e[k] = __expf(c[k] - c[0]); sum += e[k]; }
            const float inv = 1.f / sum;
            int idv[16];
#pragma unroll
            for (int k = 0; k < 16; ++k) {
                const unsigned bits = __float_as_uint(c[k]), i = (bits >> 4) & 15u, j = bits & 15u;
                const unsigned ki = __float_as_uint(tl[tid * 16 + i]) & 0x7Fu, kj = __float_as_uint(tl[(128 + tid) * 16 + j]) & 0x7Fu;
                idv[k] = (int)(ki * 128u + kj);
            }
            int* ido = p.ids + (size_t)(t0 + tid) * 128 + h * 16; float* go = p.gates + (size_t)(t0 + tid) * 128 + h * 16;
#pragma unroll
            for (int k4 = 0; k4 < 4; ++k4) {
                *(int4*)(ido + k4 * 4) = make_int4(idv[k4 * 4], idv[k4 * 4 + 1], idv[k4 * 4 + 2], idv[k4 * 4 + 3]);
                *(f32x4*)(go + k4 * 4) = (f32x4){e[k4 * 4] * inv, e[k4 * 4 + 1] * inv, e[k4 * 4 + 2] * inv, e[k4 * 4 + 3] * inv};
            }
        }
        __syncthreads();
    }
}

typedef _Float16 h16x2 __attribute__((ext_vector_type(2)));
typedef int i32x8 __attribute__((ext_vector_type(8)));
#ifndef NVR
#define NVR 16
#endif
template <bool FINAL>
__device__ void gather_phase(const Params& p, int layer, const float* xin, float* xout, bf16_t* hkv_out, bf16_t* hq_out, const float* gnorm, int c_shift, int c_scale, int c_gate, unsigned char* smem) {
    const int tid_ = opaque_tid(), lane = tid_ & 63, wv = tid_ >> 6, tk = lane & 15, q = lane >> 4;
    const int nw = gridDim.x * (NT / 64);
    const unsigned char* utab = p.ub + (size_t)layer * NEXP * 512;
    const unsigned char* vtab = p.vb + (size_t)layer * NEXP * 512;
    const float* sutab = p.su + (size_t)layer * NEXP;
    const float* svtab = p.sv + (size_t)layer * NEXP;
    unsigned char* hl = smem + wv * 17664;
    unsigned char* a8l = hl + 1024;
    unsigned char* vbuf = hl + 1280;
    const unsigned vbuf_lds = (unsigned)__builtin_amdgcn_readfirstlane((int)(unsigned)(size_t)(LAS unsigned char*)vbuf);
    for (int t = blockIdx.x * (NT / 64) + wv; t < T; t += nw) {
        const int b = t / SEQ;
        const float* cb = p.cond + (size_t)b * (NCOND * D);
        const float* xr = xin + (size_t)t * D;
        const int e0 = lane * 16;
        {
            f32x4 xv[4]; float ss = 0.f;
#pragma unroll
            for (int j = 0; j < 4; ++j) { xv[j] = *(const f32x4*)(xr + e0 + j * 4); ss += xv[j][0] * xv[j][0] + xv[j][1] * xv[j][1] + xv[j][2] * xv[j][2] + xv[j][3] * xv[j][3]; }
            ss = wave_sum(ss);
            const float rstd = rsqrtf(ss * (1.f / D) + RMS_EPS);
            u32x4 hw;
#pragma unroll
            for (int j = 0; j < 4; ++j) {
                const f32x4 g = *(const f32x4*)(gnorm + e0 + j * 4), sc = *(const f32x4*)(cb + c_scale * D + e0 + j * 4), sh = *(const f32x4*)(cb + c_shift * D + e0 + j * 4);
                float h[4];
#pragma unroll
                for (int e = 0; e < 4; ++e) h[e] = xv[j][e] * rstd * g[e] * (1.f + sc[e]) + sh[e];
                int r = 0;
                r = __builtin_amdgcn_cvt_pk_fp8_f32(h[0], h[1], r, false);
                r = __builtin_amdgcn_cvt_pk_fp8_f32(h[2], h[3], r, true);
                hw[j] = (unsigned)r;
            }
            *(u32x4*)(hl + lane * 16) = hw;
        }
        asm volatile("s_waitcnt lgkmcnt(0)" ::: "memory");
        i32x8 hb[8];
#pragma unroll
        for (int kk = 0; kk < 8; ++kk) {
            const u32x4 lo = *(const u32x4*)(hl + kk * 128 + q * 16), hi = *(const u32x4*)(hl + kk * 128 + 64 + q * 16);
            hb[kk] = (i32x8){(int)lo[0], (int)lo[1], (int)lo[2], (int)lo[3], (int)hi[0], (int)hi[1], (int)hi[2], (int)hi[3]};
        }
        const int idA = p.ids[(size_t)t * 128 + lane], idB = p.ids[(size_t)t * 128 + 64 + lane];
        const float gA = p.gates[(size_t)t * 128 + lane], gB = p.gates[(size_t)t * 128 + 64 + lane];
        const float suA = sutab[idA], suB = sutab[idB], svA = svtab[idA], svB = svtab[idB];
        float dA = 0.f, dB = 0.f;
        auto dma16 = [&](const unsigned char* gsrc, unsigned dst) {
            unsigned keep;
            asm volatile("s_mov_b32 %0, m0\n\ts_mov_b32 m0, %2\n\ts_nop 0\n\tglobal_load_lds_dwordx4 %1, off\n\ts_mov_b32 m0, %0" : "=&s"(keep) : "v"(gsrc), "s"(dst) : "memory");
        };
        auto dma_ubatch = [&](int bt, int bsel) {
#pragma unroll
            for (int i_ = 0; i_ < 8; ++i_) {
                const int r_ = 2 * i_ + (lane >> 5);
                const int id_ = __shfl(bt < 4 ? idA : idB, (bt * 16 + r_) & 63);
                dma16(utab + (size_t)((unsigned)id_ * 512u + (unsigned)(((lane & 31) ^ (r_ & 15)) * 16)), vbuf_lds + (unsigned)bsel * 8192u + (unsigned)i_ * 1024u);
            }
        };
        auto mma_ubatch = [&](int bt, int bsel) {
            const unsigned char* rowp = vbuf + bsel * 8192 + tk * 512;
            f32x4 acc = {0.f, 0.f, 0.f, 0.f};
#pragma unroll
            for (int kk = 0; kk < 8; ++kk) {
                const u32x4 a4 = *(const u32x4*)(rowp + (((kk * 4 + q) ^ tk) * 16));
                const i32x8 av = {(int)a4[0], (int)a4[1], (int)a4[2], (int)a4[3], 0, 0, 0, 0};
                acc = __builtin_amdgcn_mfma_scale_f32_16x16x128_f8f6f4(av, hb[kk], acc, 4  , 0  , 0, 0x7f7f7f7f, 0, 0x7f7f7f7f);
            }
            const int r = lane & 3;
            const float mine = r == 0 ? acc[0] : (r == 1 ? acc[1] : (r == 2 ? acc[2] : acc[3]));
            const float got = __shfl(mine, ((lane & 15) >> 2) * 16 + (lane & 15));
            if (q == (bt & 3)) { if (bt < 4) dA = got; else dB = got; }
        };
        asm volatile("s_waitcnt vmcnt(0) lgkmcnt(0)" ::: "memory");
        dma_ubatch(0, 0);
#pragma unroll
        for (int bt = 0; bt < 8; ++bt) {
            if (bt + 1 < 8) { dma_ubatch(bt + 1, (bt + 1) & 1); asm volatile("s_waitcnt vmcnt(8)" ::: "memory"); }
            else asm volatile("s_waitcnt vmcnt(0)" ::: "memory");
            mma_ubatch(bt, bt & 1);
            asm volatile("s_waitcnt lgkmcnt(0)" ::: "memory");
        }
        const float apA = gelu_tanh(dA * suA) * gA * svA, apB = gelu_tanh(dB * suB) * gB * svB;
        float of[16];
        {
            float amax = fmaxf(fabsf(apA), fabsf(apB));
#pragma unroll
            for (int o_ = 32; o_ >= 1; o_ >>= 1) amax = fmaxf(amax, __shfl_xor(amax, o_));
            const float asc = amax > 0.f ? 224.f / amax : 0.f, iasc = amax * (1.f / 224.f);
            const int pk = __builtin_amdgcn_cvt_pk_fp8_f32(apA * asc, apB * asc, 0, false);
            a8l[lane] = (unsigned char)(pk & 0xff); a8l[64 + lane] = (unsigned char)((pk >> 8) & 0xff);
            unsigned rowoff[16];
#pragma unroll
            for (int i_ = 0; i_ < 16; ++i_) {
                const int r_ = 8 * (i_ & 7) + (lane >> 3);
                const int id_ = __shfl(i_ < 8 ? idA : idB, r_);
                rowoff[i_] = (unsigned)id_ * 512u + (unsigned)(((lane & 7) ^ (r_ & 7)) * 16);
            }
            asm volatile("s_waitcnt lgkmcnt(0)" ::: "memory");
            const u32x4 alo = *(const u32x4*)(a8l + 16 * q), ahi = *(const u32x4*)(a8l + 64 + 16 * q);
            const i32x8 av0 = {(int)alo[0], (int)alo[1], (int)alo[2], (int)alo[3], 0, 0, 0, 0}, av1 = {0, 0, 0, 0, (int)ahi[0], (int)ahi[1], (int)ahi[2], (int)ahi[3]};
            auto dma_slice = [&](int sidx, int bsel) {
#pragma unroll
                for (int i_ = 0; i_ < 8; ++i_)
                    dma16(vtab + (size_t)(rowoff[(sidx & 1) * 8 + i_] + (unsigned)(sidx >> 1) * 128u), vbuf_lds + (unsigned)bsel * 8192u + (unsigned)i_ * 1024u);
            };
            float ov[16];
#pragma unroll
            for (int e = 0; e < 16; ++e) ov[e] = 0.f;
            const int rl = 32 * (q & 1) + tk;
            asm volatile("s_waitcnt vmcnt(0) lgkmcnt(0)" ::: "memory");
            dma_slice(0, 0);
#pragma unroll
            for (int ln = 0; ln < 4; ++ln) {
                f32x4 dacc[16];
#pragma unroll
                for (int eg = 0; eg < 16; ++eg) dacc[eg] = (f32x4){0.f, 0.f, 0.f, 0.f};
#pragma unroll
                for (int rh = 0; rh < 2; ++rh) {
                    const int sidx = ln * 2 + rh;
                    if (sidx + 1 < 8) { dma_slice(sidx + 1, (sidx + 1) & 1); asm volatile("s_waitcnt vmcnt(8)" ::: "memory"); }
                    else asm volatile("s_waitcnt vmcnt(0)" ::: "memory");
                    const unsigned char* vb0 = vbuf + (sidx & 1) * 8192 + rl * 128, *vb1 = vb0 + 16 * 128;
#pragma unroll
                    for (int eg = 0; eg < 16; ++eg) {
                        typedef int i32x2 __attribute__((ext_vector_type(2)));
                        const int co = (((eg >> 1) ^ (tk & 7)) * 16) + (eg & 1) * 8;
                        const i32x2 r1 = __builtin_amdgcn_ds_read_tr4_b64_v2i32((LAS i32x2*)(vb0 + co));
                        const i32x2 r2 = __builtin_amdgcn_ds_read_tr4_b64_v2i32((LAS i32x2*)(vb1 + co));
                        const i32x8 bv = {r1[0], r1[1], r2[0], r2[1], 0, 0, 0, 0};
                        dacc[eg] = __builtin_amdgcn_mfma_scale_f32_16x16x128_f8f6f4(rh ? av1 : av0, bv, dacc[eg], 0  , 4  , 0, 0x7f7f7f7f, 0, 0x7f7f7f7f);
                        if ((eg & 3) == 3) __builtin_amdgcn_sched_barrier(0);
                    }
                    asm volatile("s_waitcnt lgkmcnt(0)" ::: "memory");
                }
#pragma unroll
                for (int eg = 0; eg < 16; ++eg) if ((eg >> 2) == q) ov[ln * 4 + (eg & 3)] = dacc[eg][0] * iasc;
            }
            float* outl = (float*)vbuf;
#pragma unroll
            for (int ln = 0; ln < 4; ++ln)
#pragma unroll
                for (int t_ = 0; t_ < 4; ++t_) outl[ln * 256 + (4 * q + t_) * 16 + tk] = ov[ln * 4 + t_];
            asm volatile("s_waitcnt lgkmcnt(0)" ::: "memory");
#pragma unroll
            for (int j4 = 0; j4 < 4; ++j4) { const f32x4 v4 = *(const f32x4*)(outl + lane * 16 + j4 * 4); of[j4 * 4] = v4[0]; of[j4 * 4 + 1] = v4[1]; of[j4 * 4 + 2] = v4[2]; of[j4 * 4 + 3] = v4[3]; }
            asm volatile("s_waitcnt lgkmcnt(0)" ::: "memory");
        }
        float xn[16]; float ss = 0.f;
#pragma unroll
        for (int j4 = 0; j4 < 4; ++j4) {
            const f32x4 xo = *(const f32x4*)(xr + e0 + j4 * 4), gv = *(const f32x4*)(cb + c_gate * D + e0 + j4 * 4);
#pragma unroll
            for (int e = 0; e < 4; ++e) { const float v = xo[e] + gv[e] * of[j4 * 4 + e]; xn[j4 * 4 + e] = v; ss += v * v; }
        }
        ss = wave_sum(ss);
        const float rstd = rsqrtf(ss * (1.f / D) + RMS_EPS);
        if (!FINAL) {
#pragma unroll
            for (int j = 0; j < 4; ++j) *(f32x4*)(xout + (size_t)t * D + e0 + j * 4) = (f32x4){xn[j * 4], xn[j * 4 + 1], xn[j * 4 + 2], xn[j * 4 + 3]};
            float hk[16], hq[16];
#pragma unroll
            for (int j = 0; j < 4; ++j) {
                const f32x4 gk = *(const f32x4*)(p.kv_norm + e0 + j * 4), sck = *(const f32x4*)(cb + 13 * D + e0 + j * 4), shk = *(const f32x4*)(cb + 12 * D + e0 + j * 4);
                const f32x4 gm = *(const f32x4*)(p.norm_mix + D + e0 + j * 4), scm = *(const f32x4*)(cb + 7 * D + e0 + j * 4), shm = *(const f32x4*)(cb + 6 * D + e0 + j * 4);
#pragma unroll
                for (int e = 0; e < 4; ++e) {
                    const float xs = xn[j * 4 + e] * rstd;
                    hk[j * 4 + e] = xs * gk[e] * (1.f + sck[e]) + shk[e]; hq[j * 4 + e] = xs * gm[e] * (1.f + scm[e]) + shm[e];
                }
            }
#pragma unroll
            for (int j = 0; j < 2; ++j) {
                u32x4 ob; ob[0] = pack2(hk[j * 8], hk[j * 8 + 1]); ob[1] = pack2(hk[j * 8 + 2], hk[j * 8 + 3]); ob[2] = pack2(hk[j * 8 + 4], hk[j * 8 + 5]); ob[3] = pack2(hk[j * 8 + 6], hk[j * 8 + 7]);
                *(u32x4*)(hkv_out + (size_t)t * D + e0 + j * 8) = ob;
                u32x4 oc; oc[0] = pack2(hq[j * 8], hq[j * 8 + 1]); oc[1] = pack2(hq[j * 8 + 2], hq[j * 8 + 3]); oc[2] = pack2(hq[j * 8 + 4], hq[j * 8 + 5]); oc[3] = pack2(hq[j * 8 + 6], hq[j * 8 + 7]);
                *(u32x4*)(hq_out + (size_t)t * D + e0 + j * 8) = oc;
            }
        } else {
#pragma unroll
            for (int j = 0; j < 4; ++j) {
                const f32x4 g = *(const f32x4*)(p.final_norm + e0 + j * 4), sc = *(const f32x4*)(cb + 15 * D + e0 + j * 4), sh = *(const f32x4*)(cb + 14 * D + e0 + j * 4);
                f32x4 ov;
#pragma unroll
                for (int e = 0; e < 4; ++e) ov[e] = xn[j * 4 + e] * rstd * g[e] * (1.f + sc[e]) + sh[e];
                *(f32x4*)(p.out + (size_t)t * D + e0 + j * 4) = ov;
            }
        }
        asm volatile("s_waitcnt lgkmcnt(0)" ::: "memory");
    }
}

__device__ void attn_phase(const Params& p, const bf16_t* Q, const bf16_t* K, const bf16_t* V, bf16_t* O, unsigned char* smem) {
    unsigned char* Kl = smem;
    unsigned char* Vt = smem + 32768;
    unsigned char* Pl = smem + 32768 + 35840;
    const int tid = opaque_tid(), lane = tid & 63, w = tid >> 6, tk = lane & 15, q = lane >> 4;
    unsigned char* Pw = Pl + w * 5376;
    for (int task = blockIdx.x; task < NB * 32 * 4; task += gridDim.x) {
        const int kvh = task & 3, qblk = (task >> 2) & 31, b = task >> 7;
        const int kpos0 = (qblk - 1) * 128;
#pragma unroll
        for (int i = 0; i < 4; ++i) {
            const int id = tid + NT * i, j = id >> 3, c = id & 7, kp = kpos0 + j;
            u32x4 v = {0u, 0u, 0u, 0u};
            if (kp >= 0) v = *(const u32x4*)(K + ((size_t)b * SEQ + kp) * 256 + kvh * 64 + c * 8);
            *(u32x4*)(Kl + lds_off(j, c)) = v;
        }
#pragma unroll
        for (int i = 0; i < 4; ++i) {
            const int id = tid + NT * i, j = id & 255, dc = id >> 8, kp = kpos0 + j;
            u32x4 v = {0u, 0u, 0u, 0u};
            if (kp >= 0) v = *(const u32x4*)(V + ((size_t)b * SEQ + kp) * 256 + kvh * 64 + dc * 8);
#pragma unroll
            for (int e = 0; e < 4; ++e) {
                *(bf16_t*)(Vt + (dc * 8 + 2 * e) * 560 + j * 2) = (bf16_t)(v[e] & 0xffffu);
                *(bf16_t*)(Vt + (dc * 8 + 2 * e + 1) * 560 + j * 2) = (bf16_t)(v[e] >> 16);
            }
        }
        if (tid < 128) *(u32x4*)(Vt + (tid >> 1) * 560 + 512 + (tid & 1) * 16) = (u32x4){0u, 0u, 0u, 0u};
        *(u32x2*)(Pw + tk * 336 + (144 + 4 * q) * 2) = (u32x2){0u, 0u};
        __syncthreads();
        const int qt = w, i_q = qt * 16 + tk;
        const size_t trow = (size_t)b * SEQ + qblk * 128 + i_q;
        const unsigned char* kb0 = Kl + lds_off(qt * 16 + tk, q);
        const unsigned char* kb1 = Kl + lds_off(qt * 16 + tk, 4 + q);
        const unsigned char* vb0 = Vt + tk * 560 + (qt * 16 + 8 * q) * 2;
        unsigned char* pwr = Pw + tk * 336 + 8 * q;
        const unsigned char* prd = Pw + tk * 336 + 16 * q;
#pragma unroll 1
        for (int hq = 0; hq < 4; ++hq) {
            const int head = kvh * 4 + hq;
            const bf16x8 qf0 = *(const bf16x8*)(Q + trow * D + head * 64 + 8 * q), qf1 = *(const bf16x8*)(Q + trow * D + head * 64 + 32 + 8 * q);
            f32x4 sacc[9];
#pragma unroll
            for (int kk = 0; kk < 9; ++kk) {
                const bf16x8 k0 = *(const bf16x8*)(kb0 + kk * 2048), k1 = *(const bf16x8*)(kb1 + kk * 2048);
                f32x4 a = {0.f, 0.f, 0.f, 0.f};
                a = __builtin_amdgcn_mfma_f32_16x16x32_bf16(k0, qf0, a, 0, 0, 0);
                a = __builtin_amdgcn_mfma_f32_16x16x32_bf16(k1, qf1, a, 0, 0, 0);
                sacc[kk] = a;
                if (kk & 1) __builtin_amdgcn_sched_barrier(0);
            }
            const float sink = p.sinks[head];
            float mx = -1e30f;
#pragma unroll
            for (int kk = 0; kk < 9; ++kk)
#pragma unroll
                for (int r = 0; r < 4; ++r) {
                    const int j = (qt + kk) * 16 + 4 * q + r;
                    const bool valid = (j > i_q) && (j <= i_q + 128) && (qblk > 0 || j >= 128);
                    const float s = valid ? sacc[kk][r] * 0.125f : -1e30f;
                    sacc[kk][r] = s; mx = fmaxf(mx, s);
                }
            mx = fmaxf(mx, __shfl_xor(mx, 16)); mx = fmaxf(mx, __shfl_xor(mx, 32));
            mx = fmaxf(mx, sink);
            float sum = 0.f;
#pragma unroll
            for (int kk = 0; kk < 9; ++kk)
#pragma unroll
                for (int r = 0; r < 4; ++r) { const float e = __expf(sacc[kk][r] - mx); sacc[kk][r] = e; sum += e; }
            sum += __shfl_xor(sum, 16); sum += __shfl_xor(sum, 32);
            const float inv = 1.f / (sum + __expf(sink - mx));
#pragma unroll
            for (int kk = 0; kk < 9; ++kk) {
                u32x2 o; o[0] = pack2(sacc[kk][0] * inv, sacc[kk][1] * inv); o[1] = pack2(sacc[kk][2] * inv, sacc[kk][3] * inv);
                *(u32x2*)(pwr + kk * 32) = o;
            }
            asm volatile("s_waitcnt lgkmcnt(0)" ::: "memory");
            bf16x8 pf[5];
#pragma unroll
            for (int ks = 0; ks < 5; ++ks) pf[ks] = *(const bf16x8*)(prd + ks * 64);
#pragma unroll
            for (int dt = 0; dt < 4; ++dt) {
                f32x4 oa = {0.f, 0.f, 0.f, 0.f};
#pragma unroll
                for (int ks = 0; ks < 5; ++ks) {
                    const bf16x8 vf = *(const bf16x8*)(vb0 + dt * 8960 + ks * 64);
                    oa = __builtin_amdgcn_mfma_f32_16x16x32_bf16(vf, pf[ks], oa, 0, 0, 0);
                }
                u32x2 o; o[0] = pack2(oa[0], oa[1]); o[1] = pack2(oa[2], oa[3]);
                *(u32x2*)(O + trow * D + head * 64 + dt * 16 + 4 * q) = o;
                __builtin_amdgcn_sched_barrier(0);
            }
            asm volatile("s_waitcnt lgkmcnt(0)" ::: "memory");
        }
        __syncthreads();
    }
}

constexpr int SMEM_BYTES = 152 * 1024;
__global__ void __launch_bounds__(NT) yoco_fwd(Params p) {
    __shared__ __attribute__((aligned(16))) unsigned char smem[SMEM_BYTES];
    volatile LAS unsigned* st = (volatile LAS unsigned*)(smem + SMEM_BYTES - 16);
    if (threadIdx.x == 0) { st[0] = 0u; st[1] = 0u; }
    __syncthreads();
    const XcdBarrier xb = xcd_barrier_post(p.bar, st);
    p0_cond(p, smem);
    p0_tables(p);
    p0_wt(p, smem);
    p0_s5(p, smem);
    xcd_barrier(xb);
    p05_prep(p, smem);
    xcd_barrier(xb);
    bias_finalize(p);
    { EpiU e{p.s1}; gemm_phase<256>(p.s0, p.wt_in, 0, 1024, e, smem); }
    xcd_barrier(xb);
    s5_phase(p, smem);
    xcd_barrier(xb);
    { EpiGlu e{p.s0, p.b_glu, p.s1}; gemm_phase<256>(p.s0, p.wt_glu, 0, 1024, e, smem); }
    xcd_barrier(xb);
    { EpiRes e{p.x, p.cond + 2 * D, p.norm_ffn, p.cond + 4 * D, p.f0, p.s2, p.ssq1}; gemm_phase<256>(p.s1, p.wt_out, 0, 1024, e, smem); }
    xcd_barrier(xb);
    { EpiQ e{p.ssq1, p.bias, 0, p.s1}; gemm_phase<256>(p.s2, p.wt_pq0, 0, 1024, e, smem); }
    xcd_barrier(xb);
    route_phase(p, 0, p.s1, smem);
    xcd_barrier(xb);
    gather_phase<false>(p, 0, p.f0, p.f1, p.s0, p.s2, p.norm_ffn, 3, 4, 5, smem);
    xcd_barrier(xb);
    { EpiRope<0> e{p.ropec, p.ropes, p.s1, p.s1 + (size_t)T * 256}; gemm_phase<128>(p.s0, p.wt_kv, 0, 512, e, smem); }
    { EpiRope<1> e{p.ropec, p.ropes, p.s3, nullptr}; gemm_phase<128>(p.s2, p.wt_q, 0, 1024, e, smem); }
    xcd_barrier(xb);
    attn_phase(p, p.s3, p.s1, p.s1 + (size_t)T * 256, p.s0, smem);
    xcd_barrier(xb);
    { EpiRes e{p.f1, p.cond + 8 * D, p.norm_ffn + D, p.cond + 10 * D, p.f0, p.s2, p.ssq3}; gemm_phase<256>(p.s0, p.wt_o, 0, 1024, e, smem); }
    xcd_barrier(xb);
    { EpiQ e{p.ssq3, p.bias, 1024, p.s1}; gemm_phase<256>(p.s2, p.wt_pq1, 0, 1024, e, smem); }
    xcd_barrier(xb);
    route_phase(p, 1, p.s1, smem);
    xcd_barrier(xb);
    gather_phase<true>(p, 1, p.f0, nullptr, nullptr, nullptr, p.norm_ffn + D, 9, 10, 11, smem);
}

static inline size_t align_up(size_t v, size_t a) { return (v + a - 1) / a * a; }

extern "C" void kernel_launch(void* const* d_in, const int* in_sizes, int n_in, void* d_out, int out_size, void* d_ws, size_t ws_size, hipStream_t stream) {
    (void)in_sizes; (void)n_in; (void)out_size;
    Params p{};
    p.x = (const float*)d_in[0]; p.c = (const float*)d_in[1]; p.pos = (const int*)d_in[2]; p.w_cond = (const float*)d_in[3]; p.b_cond = (const float*)d_in[4];
    p.norm_mix = (const float*)d_in[5]; p.norm_ffn = (const float*)d_in[6]; p.w_in = (const float*)d_in[7]; p.a_re = (const float*)d_in[8]; p.a_im = (const float*)d_in[9];
    p.log_dt = (const float*)d_in[10]; p.b_re = (const float*)d_in[11]; p.b_im = (const float*)d_in[12]; p.c_re = (const float*)d_in[13]; p.c_im = (const float*)d_in[14];
    p.s5d = (const float*)d_in[15]; p.w_glu = (const float*)d_in[16]; p.b_glu = (const float*)d_in[17]; p.w_out = (const float*)d_in[18]; p.kv_norm = (const float*)d_in[19];
    p.w_kv = (const float*)d_in[20]; p.w_q = (const float*)d_in[21]; p.sinks = (const float*)d_in[22]; p.w_o = (const float*)d_in[23]; p.peer_wq = (const float*)d_in[24];
    p.subkeys = (const float*)d_in[25]; p.peer_u = (const float*)d_in[26]; p.peer_v = (const float*)d_in[27]; p.final_norm = (const float*)d_in[28];
    p.out = (float*)d_out;
    unsigned char* w = (unsigned char*)d_ws; size_t off = 65536;
    p.bar = (unsigned*)d_ws;
    auto take = [&](size_t bytes) { void* r = w + off; off = align_up(off + bytes, 4096); return r; };
    p.cond = (float*)take((size_t)NB * NCOND * D * 4);
    p.ropec = (float*)take((size_t)T * 32 * 4); p.ropes = (float*)take((size_t)T * 32 * 4);
    p.ssq1 = (float*)take((size_t)T * 16 * 4); p.ssq3 = (float*)take((size_t)T * 16 * 4);
    p.wt_in = (bf16_t*)take((size_t)D * D * 2); p.wt_glu = (bf16_t*)take((size_t)D * D * 2); p.wt_out = (bf16_t*)take((size_t)D * D * 2); p.wt_kv = (bf16_t*)take((size_t)512 * D * 2);
    p.wt_q = (bf16_t*)take((size_t)D * D * 2); p.wt_o = (bf16_t*)take((size_t)D * D * 2); p.wt_pq0 = (bf16_t*)take((size_t)D * D * 2); p.wt_pq1 = (bf16_t*)take((size_t)D * D * 2);
    p.biasp = (float*)take((size_t)8 * 4 * 2048 * 4); p.bias = (float*)take((size_t)4 * 2048 * 4);
    p.skeys = (bf16_t*)take((size_t)2 * 8 * 2 * 128 * 64 * 2);
    p.lamL = (float*)take((size_t)G5 * P5 * 2 * 4); p.ktab = (bf16_t*)take((size_t)G5 * KTR * 256 * 2);
    p.smat = (bf16_t*)take((size_t)G5 * 128 * 1024 * 2); p.cmat = (bf16_t*)take((size_t)G5 * 1024 * 128 * 2);
    p.ub = (unsigned char*)take((size_t)2 * NEXP * D); p.vb = (unsigned char*)take((size_t)2 * NEXP * D);
    p.su = (float*)take((size_t)2 * NEXP * 4); p.sv = (float*)take((size_t)2 * NEXP * 4);
    p.s0 = (bf16_t*)take((size_t)T * D * 2); p.s1 = (bf16_t*)take((size_t)T * D * 2); p.s2 = (bf16_t*)take((size_t)T * D * 2); p.s3 = (bf16_t*)take((size_t)T * D * 2);
    p.f0 = (float*)take((size_t)T * D * 4); p.f1 = (float*)take((size_t)T * D * 4);
    p.ids = (int*)take((size_t)T * 128 * 4); p.gates = (float*)take((size_t)T * 128 * 4);
    if (off > ws_size) { fprintf(stderr, "workspace too small: need %zu have %zu\n", off, ws_size); return; }

    static int grid_blocks = 0;
    if (!grid_blocks) {
        int dev = 0, cus = 0, per_cu = 0;
        (void)hipGetDevice(&dev);
        (void)hipDeviceGetAttribute(&cus, hipDeviceAttributeMultiprocessorCount, dev);
        (void)hipOccupancyMaxActiveBlocksPerMultiprocessor(&per_cu, yoco_fwd, NT, 0);
        if (per_cu > 1) per_cu = 1;
        grid_blocks = cus * per_cu;
        if (grid_blocks <= 0) grid_blocks = 256;
    }
    (void)hipMemsetAsync(d_ws, 0, XCD_BAR_WORDS * 4, stream);
    void* args[] = {&p};
    hipError_t e = hipLaunchCooperativeKernel((const void*)yoco_fwd, dim3(grid_blocks), dim3(NT), args, 0, stream);
    if (e != hipSuccess) fprintf(stderr, "cooperative launch failed: %s (grid %d)\n", hipGetErrorString(e), grid_blocks);
}
```

```cpp
#include <hip/hip_runtime.h>
#include <cstdio>
#include <cstdint>
#include <type_traits>

#define NT 512
#define LAS __attribute__((address_space(3)))
typedef unsigned short bf16_t;
typedef short bf16x8 __attribute__((ext_vector_type(8)));
typedef float f32x4 __attribute__((ext_vector_type(4)));
typedef unsigned u32x4 __attribute__((ext_vector_type(4)));
typedef unsigned u32x2 __attribute__((ext_vector_type(2)));

constexpr int D = 1024, NB = 4, SEQ = 4096, T = NB * SEQ;
constexpr int NCOND = 16;
constexpr int G5 = 64, P5 = 64, C5 = 16, L5 = 64, NCH = SEQ / L5, KTR = 72;
constexpr int NEXP = 16384;
constexpr float RMS_EPS = 1e-6f;

struct Params {
    const float *x, *c; const int* pos; const float *w_cond, *b_cond, *norm_mix, *norm_ffn, *w_in, *a_re, *a_im, *log_dt, *b_re, *b_im, *c_re, *c_im, *s5d,
        *w_glu, *b_glu, *w_out, *kv_norm, *w_kv, *w_q, *sinks, *w_o, *peer_wq, *subkeys, *peer_u, *peer_v, *final_norm;
    float* out;
    unsigned* bar;
    float* cond;
    float* ropec;
    float* ropes;
    float* ssq1;
    float* ssq3;
    bf16_t *wt_in, *wt_glu, *wt_out, *wt_kv, *wt_q, *wt_o, *wt_pq0, *wt_pq1;
    float* biasp;
    float* bias;
    bf16_t* skeys;
    float* lamL;
    bf16_t* ktab;
    bf16_t* smat;
    bf16_t* cmat;
    unsigned char* ub;
    unsigned char* vb;
    float* su;
    float* sv;
    bf16_t *s0, *s1, *s2, *s3;
    float *f0, *f1;
    int* ids;
    float* gates;
    float* sus;
    bf16_t* cvec;
};

#define XB_TMO      128
#define XB_XCNT(j)  (256  + 64 * (j))
#define XB_XSUB(j)  (1280 + 64 * (j))
#define XB_XGEN(j)  (2304 + 64 * (j))
#define XB_TOP      3328
#define XB_TOPGEN   3392
#define XCD_BAR_WORDS 3456
#define XB_SPIN_CAP (1u << 22)
__device__ __forceinline__ unsigned xb_ld(unsigned* p)              { return __hip_atomic_load(p, __ATOMIC_RELAXED, __HIP_MEMORY_SCOPE_AGENT); }
__device__ __forceinline__ unsigned xb_add(unsigned* p, unsigned v) { return __hip_atomic_fetch_add(p, v, __ATOMIC_RELAXED, __HIP_MEMORY_SCOPE_AGENT); }
__device__ __forceinline__ unsigned xb_xcc_id() { return (unsigned)__builtin_amdgcn_s_getreg((3 << 11) | 20) & 0xFu; }
#define XB_SPIN(cond, bar) do { unsigned _sp = 0; while (cond) { __builtin_amdgcn_s_sleep(1); \
    if ((++_sp & 255u) == 0u) { if (xb_ld(&(bar)[XB_TMO])) break; if (_sp > XB_SPIN_CAP) { atomicAdd(&(bar)[XB_TMO], 1u); break; } } } } while (0)
struct XcdBarrier { unsigned* bar; unsigned x; volatile LAS unsigned* st; };
__device__ __forceinline__ XcdBarrier xcd_barrier_post(unsigned* bar, volatile LAS unsigned* st) {
    XcdBarrier b; b.bar = bar; b.x = xb_xcc_id(); b.st = st;
    if (threadIdx.x == 0) (void)xb_add(&bar[XB_XCNT(b.x)], 1u);
    return b;
}
__device__ __forceinline__ void xcd_barrier_complete(unsigned* bar, unsigned x, unsigned& nloc, unsigned& nx) {
    const unsigned G = gridDim.x * gridDim.y * gridDim.z;
    unsigned sum, cnt, mine, sp = 0u;
    for (;;) {
        sum = 0u; cnt = 0u; mine = 0u;
#pragma unroll
        for (unsigned j = 0; j < 16; ++j) { const unsigned c = xb_ld(&bar[XB_XCNT(j)]); sum += c; cnt += (c > 0u) ? 1u : 0u; mine = (j == x) ? c : mine; }
        if (sum == G) break;
        __builtin_amdgcn_s_sleep(1);
        if ((++sp & 255u) == 0u) { if (xb_ld(&bar[XB_TMO])) break; if (sp > XB_SPIN_CAP) { atomicAdd(&bar[XB_TMO], 1u); break; } }
    }
    nloc = mine > 0u ? mine : 1u; nx = cnt > 0u ? cnt : 1u;
}
__device__ __forceinline__ void xcd_barrier(const XcdBarrier& b) {
    asm volatile("s_waitcnt vmcnt(0)" ::: "memory");
    __syncthreads();
    if (threadIdx.x == 0) {
        unsigned* bar = b.bar;
        __builtin_amdgcn_s_waitcnt(0);
        unsigned nloc = b.st[0], nx = b.st[1];
        if (nloc == 0u) { xcd_barrier_complete(bar, b.x, nloc, nx); b.st[0] = nloc; b.st[1] = nx; }
        const unsigned old = xb_add(&bar[XB_XSUB(b.x)], 1u);
        const unsigned gen = old / nloc;
        if (old + 1u == (gen + 1u) * nloc) {
            __builtin_amdgcn_fence(__ATOMIC_RELEASE, "agent");
            asm volatile("s_waitcnt vmcnt(0)" ::: "memory");
            const unsigned og = xb_add(&bar[XB_TOP], 1u);
            const unsigned tg = og / nx;
            if (og + 1u == (tg + 1u) * nx) xb_add(&bar[XB_TOPGEN], 1u);
            else XB_SPIN(xb_ld(&bar[XB_TOPGEN]) == tg, bar);
            __builtin_amdgcn_fence(__ATOMIC_ACQUIRE, "agent");
            xb_add(&bar[XB_XGEN(b.x)], 1u);
            asm volatile("s_waitcnt vmcnt(0)" ::: "memory");
        } else {
            XB_SPIN(xb_ld(&bar[XB_XGEN(b.x)]) == gen, bar);
            __builtin_amdgcn_fence(__ATOMIC_ACQUIRE, "agent");
            asm volatile("s_waitcnt vmcnt(0)" ::: "memory");
        }
    }
    __syncthreads();
}

__device__ __forceinline__ int opaque_tid() { int t = threadIdx.x; asm volatile("" : "+v"(t)); return t; }
__device__ __forceinline__ bf16_t f2bf(float f) { unsigned u = __float_as_uint(f); u += 0x7fffu + ((u >> 16) & 1u); return (bf16_t)(u >> 16); }
__device__ __forceinline__ float bf2f(bf16_t h) { return __uint_as_float(((unsigned)h) << 16); }
typedef __bf16 hbf2 __attribute__((ext_vector_type(2)));
typedef float f32x2 __attribute__((ext_vector_type(2)));
__device__ __forceinline__ unsigned pack2(float lo, float hi) { f32x2 v = {lo, hi}; return __builtin_bit_cast(unsigned, __builtin_convertvector(v, hbf2)); }
__device__ __forceinline__ float dot2bf(unsigned a, unsigned b, float c) { return __builtin_amdgcn_fdot2_f32_bf16(__builtin_bit_cast(hbf2, a), __builtin_bit_cast(hbf2, b), c, false); }
__device__ __forceinline__ float bflo(unsigned w) { return __uint_as_float(w << 16); }
__device__ __forceinline__ float bfhi(unsigned w) { return __uint_as_float(w & 0xffff0000u); }
template <int CTRL> __device__ __forceinline__ float dpp_f(float v) { return __uint_as_float((unsigned)__builtin_amdgcn_update_dpp(0, (int)__float_as_uint(v), CTRL, 0xf, 0xf, true)); }
__device__ __forceinline__ float wave_sum(float v) {
    v += dpp_f<0xB1>(v);
    v += dpp_f<0x4E>(v);
    v += dpp_f<0x141>(v);
    v += dpp_f<0x140>(v);
    const float a = __uint_as_float((unsigned)__builtin_amdgcn_readlane((int)__float_as_uint(v), 0)), b = __uint_as_float((unsigned)__builtin_amdgcn_readlane((int)__float_as_uint(v), 16));
    const float c = __uint_as_float((unsigned)__builtin_amdgcn_readlane((int)__float_as_uint(v), 32)), d = __uint_as_float((unsigned)__builtin_amdgcn_readlane((int)__float_as_uint(v), 48));
    return (a + b) + (c + d);
}
__device__ __forceinline__ float wave_max(float v) {
    v = fmaxf(v, dpp_f<0xB1>(v)); v = fmaxf(v, dpp_f<0x4E>(v)); v = fmaxf(v, dpp_f<0x141>(v)); v = fmaxf(v, dpp_f<0x140>(v));
    const float a = __uint_as_float((unsigned)__builtin_amdgcn_readlane((int)__float_as_uint(v), 0)), b = __uint_as_float((unsigned)__builtin_amdgcn_readlane((int)__float_as_uint(v), 16));
    const float c = __uint_as_float((unsigned)__builtin_amdgcn_readlane((int)__float_as_uint(v), 32)), d = __uint_as_float((unsigned)__builtin_amdgcn_readlane((int)__float_as_uint(v), 48));
    return fmaxf(fmaxf(a, b), fmaxf(c, d));
}
__device__ __forceinline__ float gelu_tanh(float x) {
    const float u = 0.7978845608028654f * (x + 0.044715f * x * x * x);
    const float e = __expf(-2.f * fabsf(u));
    float th = (1.f - e) / (1.f + e);
    th = u < 0.f ? -th : th;
    return 0.5f * x * (1.f + th);
}

__device__ void p0_cond(const Params& p, unsigned char* smem) {
    float* sc = (float*)smem;
    float* red = (float*)(smem + 16384);
    const int tid = threadIdx.x;
    for (int i = tid; i < 4 * D; i += NT) { const float v = p.c[i]; sc[i] = v / (1.f + __expf(-v)); }
    __syncthreads();
    const int cgp = tid & 15, kg = tid >> 4;
    for (int task = blockIdx.x; task < NCOND * D / 64; task += gridDim.x) {
        const int col0 = task * 64 + cgp * 4;
        float acc[4][4];
#pragma unroll
        for (int b = 0; b < 4; ++b)
#pragma unroll
            for (int j = 0; j < 4; ++j) acc[b][j] = 0.f;
#pragma unroll 1
        for (int k0 = 0; k0 < 32; k0 += 8) {
            f32x4 w[8];
#pragma unroll
            for (int j = 0; j < 8; ++j) w[j] = *(const f32x4*)(p.w_cond + (size_t)(kg + 32 * (k0 + j)) * (NCOND * D) + col0);
#pragma unroll
            for (int j = 0; j < 8; ++j)
#pragma unroll
                for (int b = 0; b < 4; ++b) { const float s = sc[b * D + kg + 32 * (k0 + j)];
#pragma unroll
                    for (int e = 0; e < 4; ++e) acc[b][e] += s * w[j][e]; }
        }
#pragma unroll
        for (int b = 0; b < 4; ++b)
#pragma unroll
            for (int j = 0; j < 4; ++j) red[(kg * 64 + cgp * 4 + j) * 4 + b] = acc[b][j];
        __syncthreads();
        if (tid < 256) {
            const int col = tid >> 2, b = tid & 3;
            float s = 0.f;
            for (int g = 0; g < 32; ++g) s += red[(g * 64 + col) * 4 + b];
            p.cond[(size_t)b * (NCOND * D) + task * 64 + col] = s + p.b_cond[task * 64 + col];
        }
        __syncthreads();
    }
}

__device__ void p0_tables(const Params& p) {
    const size_t gtid = (size_t)blockIdx.x * NT + threadIdx.x, gstride = (size_t)gridDim.x * NT;
    {
        const int li = threadIdx.x & 15;
        const size_t grp = gtid >> 4, ngrp = gstride >> 4;
        for (int which = 0; which < 2; ++which) {
            const float* src = which ? p.peer_v : p.peer_u; unsigned char* dst = which ? p.vb : p.ub; float* sdst = which ? p.sv : p.su;
            for (size_t row = grp; row < (size_t)2 * NEXP; row += ngrp) {
                f32x4 v[2][8]; float ss = 0.f;
#pragma unroll
                for (int c = 0; c < 2; ++c)
#pragma unroll
                    for (int j = 0; j < 8; ++j) {
                        v[c][j] = *(const f32x4*)(src + row * D + c * 512 + li * 32 + j * 4);
#pragma unroll
                        for (int e = 0; e < 4; ++e) ss += v[c][j][e] * v[c][j][e];
                    }
                ss += __shfl_xor(ss, 1); ss += __shfl_xor(ss, 2); ss += __shfl_xor(ss, 4); ss += __shfl_xor(ss, 8);
                const float rms = sqrtf(ss * (1.f / D)), step = 0.48f * rms, inv = step > 0.f ? 1.f / step : 0.f;
#pragma unroll
                for (int c = 0; c < 2; ++c) {
                    u32x4 o;
#pragma unroll
                    for (int d = 0; d < 4; ++d) {
                        unsigned wd = 0u;
                        if (true) {
                            wd = __builtin_amdgcn_cvt_scalef32_pk_fp4_f32(wd, v[c][d * 2][0] * inv, v[c][d * 2][1] * inv, 1.0f, 0);
                            wd = __builtin_amdgcn_cvt_scalef32_pk_fp4_f32(wd, v[c][d * 2][2] * inv, v[c][d * 2][3] * inv, 1.0f, 1);
                            wd = __builtin_amdgcn_cvt_scalef32_pk_fp4_f32(wd, v[c][d * 2 + 1][0] * inv, v[c][d * 2 + 1][1] * inv, 1.0f, 2);
                            wd = __builtin_amdgcn_cvt_scalef32_pk_fp4_f32(wd, v[c][d * 2 + 1][2] * inv, v[c][d * 2 + 1][3] * inv, 1.0f, 3);
                        } else {
#pragma unroll
                            for (int k = 0; k < 8; ++k) {
                                const float x = v[c][d * 2 + (k >> 2)][k & 3];
                                const int n = (int)fminf(fmaxf(floorf(x * inv + 8.f), 0.f), 15.f);
                                wd |= (unsigned)n << (4 * ((k >> 1) + 4 * (k & 1)));
                            }
                        }
                        o[d] = wd;
                    }
                    *(u32x4*)(dst + row * 512 + c * 256 + li * 16) = o;
                }
                if (li == 0) sdst[row] = step;
            }
        }
    }
    const size_t nk8 = (size_t)2 * 8 * 2 * 128 * 64 / 8;
    for (size_t i = gtid; i < nk8; i += gstride) {
        const f32x4 a = *(const f32x4*)(p.subkeys + i * 8), b = *(const f32x4*)(p.subkeys + i * 8 + 4);
        u32x4 o; o[0] = pack2(a[0], a[1]); o[1] = pack2(a[2], a[3]); o[2] = pack2(b[0], b[1]); o[3] = pack2(b[2], b[3]);
        *(u32x4*)(p.skeys + i * 8) = o;
    }
    for (size_t i = gtid; i < (size_t)T * 32; i += gstride) {
        const int t = (int)(i >> 5), f = (int)(i & 31);
        const float invrev = exp2f(-(float)f * 0.41524101186092029f) * 0.15915494309189535f;
        float rev = (float)p.pos[t] * invrev; rev -= floorf(rev);
        p.ropec[i] = __builtin_amdgcn_cosf(rev); p.ropes[i] = __builtin_amdgcn_sinf(rev);
    }
}

__device__ void p0_wt(const Params& p, unsigned char* smem) {
    bf16_t* tl = (bf16_t*)smem;
    const int tid = opaque_tid(), kk = tid >> 3, nn = (tid & 7) * 8;
    for (int task = blockIdx.x; task < 7 * 64 + 32; task += gridDim.x) {
        const int w = task >> 6, gi = task & 63;
        const float* W; bf16_t* Wt; int ldw = 1024;
        switch (w) {
            case 0: W = p.w_in; Wt = p.wt_in; break;
            case 1: W = p.w_glu; Wt = p.wt_glu; break;
            case 2: W = p.w_out; Wt = p.wt_out; break;
            case 3: W = p.w_q; Wt = p.wt_q; break;
            case 4: W = p.w_o; Wt = p.wt_o; break;
            case 5: W = p.peer_wq; Wt = p.wt_pq0; break;
            case 6: W = p.peer_wq + (size_t)D * D; Wt = p.wt_pq1; break;
            default: W = p.w_kv; Wt = p.wt_kv; ldw = 512; break;
        }
        const int ngn = ldw / 256, n0 = (gi % ngn) * 256, k0 = (gi / ngn) * 64;
        f32x4 a[4], b[4];
#pragma unroll
        for (int t4 = 0; t4 < 4; ++t4) { a[t4] = *(const f32x4*)(W + (size_t)(k0 + kk) * ldw + n0 + t4 * 64 + nn); b[t4] = *(const f32x4*)(W + (size_t)(k0 + kk) * ldw + n0 + t4 * 64 + nn + 4); }
#pragma unroll
        for (int t4 = 0; t4 < 4; ++t4)
#pragma unroll
            for (int j = 0; j < 4; ++j) { tl[(t4 * 64 + nn + j) * 72 + kk] = f2bf(a[t4][j]); tl[(t4 * 64 + nn + 4 + j) * 72 + kk] = f2bf(b[t4][j]); }
        __syncthreads();
        const int n = tid >> 3, kc = (tid & 7) * 8;
#pragma unroll
        for (int t4 = 0; t4 < 4; ++t4) {
            const u32x4 v = *(const u32x4*)(tl + (t4 * 64 + n) * 72 + kc);
            *(u32x4*)(Wt + (size_t)(n0 + t4 * 64 + n) * D + k0 + kc) = v;
        }
        __syncthreads();
    }
}

__device__ __forceinline__ void lam_powf(float ar, float ai, float dt, int n, float& re, float& im) {
    const float m = __expf(ar * dt * (float)n);
    float rev = (ai * dt) * (float)n * 0.15915494309189535f; rev -= floorf(rev);
    re = m * __builtin_amdgcn_cosf(rev); im = m * __builtin_amdgcn_sinf(rev);
}
__device__ __forceinline__ void s5_coeff(float ar, float ai, float dt, float& cre, float& cim) {
    const float a = ar * dt, th = ai * dt;
    float rev = th * 0.15915494309189535f; rev -= floorf(rev);
    float revh = th * 0.5f * 0.15915494309189535f; revh -= floorf(revh);
    const float cs = __builtin_amdgcn_cosf(rev), sn = __builtin_amdgcn_sinf(rev), sh = __builtin_amdgcn_sinf(revh);
    const float em1 = expm1f(a);
    const float nr = em1 * cs - 2.f * sh * sh, ni = (em1 + 1.f) * sn, den = ar * ar + ai * ai;
    cre = (nr * ar + ni * ai) / den; cim = (ni * ar - nr * ai) / den;
}

__device__ void p0_s5(const Params& p, unsigned char* smem) {
    const size_t gtid = (size_t)blockIdx.x * NT + threadIdx.x, gstride = (size_t)gridDim.x * NT;
    for (size_t idx = gtid; idx < (size_t)G5 * P5 * 65; idx += gstride) {
        const int pp = (int)(idx & 63), e = (int)((idx >> 6) % 65), g = (int)(idx / (65 * P5));
        const float dt = __expf(p.log_dt[g]), ar = p.a_re[g * P5 + pp], ai = p.a_im[g * P5 + pp];
        float pwr, pwi; lam_powf(ar, ai, dt, e, pwr, pwi);
        if (e < 64) {
            float cfr, cfi; s5_coeff(ar, ai, dt, cfr, cfi);
            const float wr = pwr * cfr - pwi * cfi, wi = pwr * cfi + pwi * cfr;
            const int j = 63 - e;
            const float* brp = p.b_re + ((size_t)g * P5 + pp) * C5; const float* bip = p.b_im + ((size_t)g * P5 + pp) * C5;
            unsigned ore[8], oim[8];
#pragma unroll
            for (int c4 = 0; c4 < 4; ++c4) {
                const f32x4 br = *(const f32x4*)(brp + c4 * 4), bi = *(const f32x4*)(bip + c4 * 4);
                ore[c4 * 2] = pack2(wr * br[0] - wi * bi[0], wr * br[1] - wi * bi[1]); ore[c4 * 2 + 1] = pack2(wr * br[2] - wi * bi[2], wr * br[3] - wi * bi[3]);
                oim[c4 * 2] = pack2(wr * bi[0] + wi * br[0], wr * bi[1] + wi * br[1]); oim[c4 * 2 + 1] = pack2(wr * bi[2] + wi * br[2], wr * bi[3] + wi * br[3]);
            }
            u32x4* sre = (u32x4*)(p.smat + ((size_t)g * 128 + pp) * 1024 + j * 16);
            u32x4* sim = (u32x4*)(p.smat + ((size_t)g * 128 + 64 + pp) * 1024 + j * 16);
            sre[0] = (u32x4){ore[0], ore[1], ore[2], ore[3]}; sre[1] = (u32x4){ore[4], ore[5], ore[6], ore[7]};
            sim[0] = (u32x4){oim[0], oim[1], oim[2], oim[3]}; sim[1] = (u32x4){oim[4], oim[5], oim[6], oim[7]};
        }
        if (e >= 1) {
            const int i = e - 1;
#pragma unroll 4
            for (int co = 0; co < 16; ++co) {
                const float cr = p.c_re[((size_t)g * C5 + co) * P5 + pp], ci = p.c_im[((size_t)g * C5 + co) * P5 + pp];
                bf16_t* row = p.cmat + ((size_t)g * 1024 + i * 16 + co) * 128;
                row[pp] = f2bf(cr * pwr - ci * pwi);
                row[64 + pp] = f2bf(-(cr * pwi + ci * pwr));
            }
        }
        if (e == 64) {
            const double dtd = exp((double)p.log_dt[g]), m = exp((double)ar * dtd * 64.0);
            double ang = (double)ai * dtd * 64.0; ang -= 6.283185307179586 * floor(ang * 0.15915494309189535);
            p.lamL[(g * P5 + pp) * 2] = (float)(m * cos(ang)); p.lamL[(g * P5 + pp) * 2 + 1] = (float)(m * sin(ang));
        }
    }
    float* wre = (float*)smem;
    float* wim = wre + 1024;
    const int tid = threadIdx.x;
    for (int task = blockIdx.x; task < G5 * 4; task += gridDim.x) {
        const int g = task >> 2, tq = task & 3;
        const float dt = __expf(p.log_dt[g]);
        for (int i = tid; i < 1024; i += NT) {
            const int pp = i & 63, tau = tq * 16 + (i >> 6);
            const float ar = p.a_re[g * P5 + pp], ai = p.a_im[g * P5 + pp];
            float pwr, pwi, cfr, cfi; lam_powf(ar, ai, dt, tau, pwr, pwi); s5_coeff(ar, ai, dt, cfr, cfi);
            wre[i] = pwr * cfr - pwi * cfi; wim[i] = pwr * cfi + pwi * cfr;
        }
        __syncthreads();
        {
            const int co = (tid >> 4) & 15, ci = tid & 15, ph = tid >> 8;
            float* part = wim + 1024;
            float cbr[32], cbi[32];
#pragma unroll 8
            for (int k = 0; k < 32; ++k) {
                const int pp = ph * 32 + k;
                const float br = p.b_re[((size_t)g * P5 + pp) * C5 + ci], bi = p.b_im[((size_t)g * P5 + pp) * C5 + ci];
                const float cr = p.c_re[((size_t)g * C5 + co) * P5 + pp], cim = p.c_im[((size_t)g * C5 + co) * P5 + pp];
                cbr[k] = cr * br - cim * bi; cbi[k] = cr * bi + cim * br;
            }
            float sres[16];
#pragma unroll
            for (int tl = 0; tl < 16; ++tl) {
                float s0 = 0.f, s1 = 0.f;
#pragma unroll
                for (int k = 0; k < 32; k += 2) {
                    s0 += cbr[k] * wre[tl * 64 + ph * 32 + k] - cbi[k] * wim[tl * 64 + ph * 32 + k];
                    s1 += cbr[k + 1] * wre[tl * 64 + ph * 32 + k + 1] - cbi[k + 1] * wim[tl * 64 + ph * 32 + k + 1];
                }
                sres[tl] = s0 + s1;
            }
            if (ph == 1) {
#pragma unroll
                for (int tl = 0; tl < 16; ++tl) part[tl * 256 + (tid & 255)] = sres[tl];
            }
            __syncthreads();
            if (ph == 0) {
#pragma unroll
                for (int tl = 0; tl < 16; ++tl) p.ktab[((size_t)g * KTR + tq * 16 + tl + 8) * 256 + tid] = f2bf(sres[tl] + part[tl * 256 + tid]);
                if (tq == 0) {
#pragma unroll
                    for (int r = 0; r < 8; ++r) p.ktab[((size_t)g * KTR + r) * 256 + tid] = 0;
                }
            }
        }
        __syncthreads();
    }
}

__device__ void p05_prep(const Params& p, unsigned char* smem) {
    {
        const int lane = threadIdx.x & 63, wv = threadIdx.x >> 6;
        const int nw = gridDim.x * (NT / 64);
        for (int t = blockIdx.x * (NT / 64) + wv; t < T; t += nw) {
            const int b = t / SEQ;
            const float* xr = p.x + (size_t)t * D; const float* cb = p.cond + (size_t)b * (NCOND * D);
            f32x4 v[4]; float s = 0.f;
#pragma unroll
            for (int j = 0; j < 4; ++j) { v[j] = *(const f32x4*)(xr + j * 256 + lane * 4); s += v[j][0] * v[j][0] + v[j][1] * v[j][1] + v[j][2] * v[j][2] + v[j][3] * v[j][3]; }
            s = wave_sum(s);
            const float rstd = rsqrtf(s * (1.f / D) + RMS_EPS);
#pragma unroll
            for (int j = 0; j < 4; ++j) {
                const int e = j * 256 + lane * 4;
                const f32x4 g = *(const f32x4*)(p.norm_mix + e), sh = *(const f32x4*)(cb + 0 * D + e), sc = *(const f32x4*)(cb + 1 * D + e);
                float h[4];
#pragma unroll
                for (int i = 0; i < 4; ++i) h[i] = v[j][i] * rstd * g[i] * (1.f + sc[i]) + sh[i];
                u32x2 o; o[0] = pack2(h[0], h[1]); o[1] = pack2(h[2], h[3]);
                *(u32x2*)(p.s0 + (size_t)t * D + e) = o;
            }
        }
    }
    for (int i = blockIdx.x * NT + threadIdx.x; i < 4 * 1024; i += gridDim.x * NT) {
        const int b = i >> 10, k = i & 1023;
        const float* cb = p.cond + (size_t)b * (NCOND * D);
        bf16_t* o = p.cvec + (size_t)b * 12 * 1024 + k;
        o[0 * 1024] = f2bf(p.norm_ffn[k] * (1.f + cb[4 * D + k]));      o[1 * 1024] = f2bf(cb[3 * D + k]);  o[2 * 1024] = f2bf(cb[5 * D + k]);
        o[3 * 1024] = f2bf(p.kv_norm[k] * (1.f + cb[13 * D + k]));      o[4 * 1024] = f2bf(cb[12 * D + k]);
        o[5 * 1024] = f2bf(p.norm_mix[D + k] * (1.f + cb[7 * D + k]));  o[6 * 1024] = f2bf(cb[6 * D + k]);
        o[7 * 1024] = f2bf(p.norm_ffn[D + k] * (1.f + cb[10 * D + k])); o[8 * 1024] = f2bf(cb[9 * D + k]);  o[9 * 1024] = f2bf(cb[11 * D + k]);
        o[10 * 1024] = f2bf(p.final_norm[k] * (1.f + cb[15 * D + k]));  o[11 * 1024] = f2bf(cb[14 * D + k]);
    }
    float* red = (float*)smem;
    const int tid = threadIdx.x;
    for (int task = blockIdx.x; task < 32 * 8; task += gridDim.x) {
        const int ct = task >> 3, ks = task & 7, col0 = ct * 64, layer = col0 >> 10;
        const float* W = p.peer_wq + (size_t)layer * D * D; const int cs = layer ? 9 : 3;
        const int n = (col0 & 1023) + (tid & 63), kg = tid >> 6;
        float wv[16];
#pragma unroll
        for (int j = 0; j < 16; ++j) wv[j] = W[(size_t)(ks * 128 + kg * 16 + j) * D + n];
        float acc[4] = {0.f, 0.f, 0.f, 0.f};
#pragma unroll
        for (int j = 0; j < 16; ++j)
#pragma unroll
            for (int b = 0; b < 4; ++b) acc[b] += p.cond[(size_t)b * (NCOND * D) + cs * D + ks * 128 + kg * 16 + j] * wv[j];
#pragma unroll
        for (int b = 0; b < 4; ++b) red[(kg * 64 + (tid & 63)) * 4 + b] = acc[b];
        __syncthreads();
        if (tid < 256) {
            const int col = tid >> 2, b = tid & 3; float sum = 0.f;
#pragma unroll
            for (int g = 0; g < 8; ++g) sum += red[(g * 64 + col) * 4 + b];
            p.biasp[((size_t)ks * 4 + b) * 2048 + col0 + col] = sum;
        }
        __syncthreads();
    }
}
__device__ void bias_finalize(const Params& p) {
    const int i = blockIdx.x * NT + threadIdx.x;
    if (i < 4 * 2048) { float s = 0.f;
#pragma unroll
        for (int ks = 0; ks < 8; ++ks) s += p.biasp[(size_t)ks * 8192 + i];
        p.bias[i] = s; }
}

__device__ __forceinline__ int lds_off(int row, int chunk) { return row * 128 + ((chunk ^ (row & 7)) << 4); }

template <int BN, class Epi>
__device__ void gemm_phase(const bf16_t* __restrict__ A, const bf16_t* __restrict__ Bt, size_t bt_batch_stride, int N, const Epi& epi, unsigned char* smem) {
    constexpr int WMI = BN == 256 ? 8 : 4;
    constexpr int A_BYTES = 32768, B_BYTES = BN * 128, BUF = A_BYTES + B_BYTES;
    const int tid = opaque_tid(), lane = tid & 63, w = tid >> 6, tk = lane & 15, q = lane >> 4;
    const int wm = BN == 256 ? (w >> 2) : (w >> 1), wn = BN == 256 ? (w & 3) : (w & 1);
    const int nN = N / BN;
    const bool xmap = (gridDim.x % 8) == 0;
    const int nslots = xmap ? gridDim.x / 8 : gridDim.x, slot = xmap ? (blockIdx.x >> 3) : blockIdx.x, xcd = blockIdx.x & 7;
    const int nitems = xmap ? 8 * nN : 64 * nN;
    for (int item = slot; item < nitems; item += nslots) {
        const int pm = xmap ? xcd * 8 + item / nN : item / nN, pn = item % nN;
        const int m0 = pm * 256, n0 = pn * BN, b = m0 / SEQ;
        const bf16_t* Ab = A + (size_t)m0 * D;
        const bf16_t* Bb = Bt + (size_t)b * bt_batch_stride + (size_t)n0 * D;
        f32x4 acc[WMI][4];
#pragma unroll
        for (int mi = 0; mi < WMI; ++mi)
#pragma unroll
            for (int ni = 0; ni < 4; ++ni) acc[mi][ni] = (f32x4){0.f, 0.f, 0.f, 0.f};
        auto stage = [&](int buf, int kt) {
#pragma unroll
            for (int j = 0; j < 4; ++j) {
                const int piece = w * 4 + j, P = piece * 1024 + lane * 16, row = P >> 7, lc = ((P >> 4) & 7) ^ (row & 7);
                __builtin_amdgcn_global_load_lds((const __attribute__((address_space(1))) void*)(Ab + (size_t)row * D + kt * 64 + lc * 8),
                                                 (__attribute__((address_space(3))) void*)(smem + buf * BUF + piece * 1024), 16, 0, 0);
            }
#pragma unroll
            for (int j = 0; j < BN / 64; ++j) {
                const int piece = w * (BN / 64) + j, P = piece * 1024 + lane * 16, row = P >> 7, lc = ((P >> 4) & 7) ^ (row & 7);
                __builtin_amdgcn_global_load_lds((const __attribute__((address_space(1))) void*)(Bb + (size_t)row * D + kt * 64 + lc * 8),
                                                 (__attribute__((address_space(3))) void*)(smem + buf * BUF + A_BYTES + piece * 1024), 16, 0, 0);
            }
        };
        auto compute = [&](int buf) {
            const unsigned char* sA = smem + buf * BUF; const unsigned char* sB = sA + A_BYTES;
#pragma unroll
            for (int ks = 0; ks < 2; ++ks) {
                bf16x8 bfr[4];
#pragma unroll
                for (int ni = 0; ni < 4; ++ni) bfr[ni] = *(const bf16x8*)(sB + lds_off(wn * 64 + ni * 16 + tk, ks * 4 + q));
#pragma unroll
                for (int mh = 0; mh < WMI / 4; ++mh) {
                    bf16x8 af[4];
#pragma unroll
                    for (int mi = 0; mi < 4; ++mi) af[mi] = *(const bf16x8*)(sA + lds_off(wm * (WMI * 16) + (mh * 4 + mi) * 16 + tk, ks * 4 + q));
#pragma unroll
                    for (int mi = 0; mi < 4; ++mi)
#pragma unroll
                        for (int ni = 0; ni < 4; ++ni) acc[mh * 4 + mi][ni] = __builtin_amdgcn_mfma_f32_16x16x32_bf16(bfr[ni], af[mi], acc[mh * 4 + mi][ni], 0, 0, 0);
                }
            }
        };
        stage(0, 0);
        __syncthreads();
#pragma unroll 1
        for (int kt = 0; kt < 16; ++kt) {
            if (kt + 1 < 16) stage((kt + 1) & 1, kt + 1);
            compute(kt & 1);
            __syncthreads();
        }
#pragma unroll
        for (int mh = 0; mh < WMI / 4; ++mh)
            epi(*(const f32x4 (*)[4][4])&acc[mh * 4], m0 + wm * (WMI * 16) + mh * 64, n0 + wn * 64, b, pn * (BN / 64) + wn, tk, q);
    }
}

__device__ __forceinline__ float rstd_of(const float* ssq, int token) {
    const f32x4* s4 = (const f32x4*)(ssq + (size_t)token * 16);
    const f32x4 a = s4[0], b = s4[1], c = s4[2], d = s4[3];
    const float s = ((a[0] + a[1]) + (a[2] + a[3])) + ((b[0] + b[1]) + (b[2] + b[3])) + ((c[0] + c[1]) + (c[2] + c[3])) + ((d[0] + d[1]) + (d[2] + d[3]));
    return rsqrtf(s * (1.f / D) + RMS_EPS);
}

struct EpiU {
    bf16_t* ug;
    __device__ __forceinline__ void operator()(const f32x4 (&acc)[4][4], int mbase, int nbase, int b, int, int tk, int q) const {
#pragma unroll
        for (int mi = 0; mi < 4; ++mi) {
            const int token = mbase + mi * 16 + tk, s = token - b * SEQ;
#pragma unroll
            for (int ni = 0; ni < 4; ++ni) {
                const int n = nbase + ni * 16 + 4 * q, g = n >> 4;
                u32x2 o; o[0] = pack2(acc[mi][ni][0], acc[mi][ni][1]); o[1] = pack2(acc[mi][ni][2], acc[mi][ni][3]);
                *(u32x2*)(ug + (((size_t)(g * 4 + b) * SEQ + s) * 16 + 4 * q)) = o;
            }
        }
    }
};
struct EpiQ {
    const float* ssq; const float* bias; int boff; bf16_t* out;
    __device__ __forceinline__ void operator()(const f32x4 (&acc)[4][4], int mbase, int nbase, int b, int, int tk, int q) const {
#pragma unroll
        for (int mi = 0; mi < 4; ++mi) {
            const int token = mbase + mi * 16 + tk;
            const float rstd = rstd_of(ssq, token);
#pragma unroll
            for (int ni = 0; ni < 4; ++ni) {
                const int n = nbase + ni * 16 + 4 * q;
                const f32x4 bv = *(const f32x4*)(bias + (size_t)b * 2048 + boff + n);
                u32x2 o; o[0] = pack2(rstd * acc[mi][ni][0] + bv[0], rstd * acc[mi][ni][1] + bv[1]); o[1] = pack2(rstd * acc[mi][ni][2] + bv[2], rstd * acc[mi][ni][3] + bv[3]);
                *(u32x2*)(out + (size_t)token * D + n) = o;
            }
        }
    }
};
struct EpiGlu {
    const bf16_t* y; const float* bglu; bf16_t* out;
    __device__ __forceinline__ void operator()(const f32x4 (&acc)[4][4], int mbase, int nbase, int, int, int tk, int q) const {
#pragma unroll
        for (int mi = 0; mi < 4; ++mi) {
            const int token = mbase + mi * 16 + tk;
#pragma unroll
            for (int ni = 0; ni < 4; ++ni) {
                const int n = nbase + ni * 16 + 4 * q;
                const f32x4 bv = *(const f32x4*)(bglu + n);
                const u32x2 yv = *(const u32x2*)(y + (size_t)token * D + n);
                float o[4];
                const float y0 = bflo(yv[0]), y1 = bfhi(yv[0]), y2 = bflo(yv[1]), y3 = bfhi(yv[1]);
                o[0] = y0 / (1.f + __expf(-(acc[mi][ni][0] + bv[0]))); o[1] = y1 / (1.f + __expf(-(acc[mi][ni][1] + bv[1])));
                o[2] = y2 / (1.f + __expf(-(acc[mi][ni][2] + bv[2]))); o[3] = y3 / (1.f + __expf(-(acc[mi][ni][3] + bv[3])));
                u32x2 ov; ov[0] = pack2(o[0], o[1]); ov[1] = pack2(o[2], o[3]);
                *(u32x2*)(out + (size_t)token * D + n) = ov;
            }
        }
    }
};
struct EpiRes {
    const float* xold; const float* gate  ; const float* gnorm; const float* scale  ; float* xout; bf16_t* xbout; float* ssq;
    __device__ __forceinline__ void operator()(const f32x4 (&acc)[4][4], int mbase, int nbase, int b, int slot, int tk, int q) const {
#pragma unroll
        for (int mi = 0; mi < 4; ++mi) {
            const int token = mbase + mi * 16 + tk;
            float ss = 0.f;
#pragma unroll
            for (int ni = 0; ni < 4; ++ni) {
                const int n = nbase + ni * 16 + 4 * q;
                const f32x4 gv = *(const f32x4*)(gate + (size_t)b * (NCOND * D) + n), gn = *(const f32x4*)(gnorm + n), sc = *(const f32x4*)(scale + (size_t)b * (NCOND * D) + n);
                const f32x4 xo = *(const f32x4*)(xold + (size_t)token * D + n);
                f32x4 xn; float hs[4];
#pragma unroll
                for (int r = 0; r < 4; ++r) { xn[r] = xo[r] + gv[r] * acc[mi][ni][r]; ss += xn[r] * xn[r]; hs[r] = xn[r] * gn[r] * (1.f + sc[r]); }
                *(f32x4*)(xout + (size_t)token * D + n) = xn;
                u32x2 ov; ov[0] = pack2(hs[0], hs[1]); ov[1] = pack2(hs[2], hs[3]);
                *(u32x2*)(xbout + (size_t)token * D + n) = ov;
            }
            ss += __shfl_xor(ss, 16); ss += __shfl_xor(ss, 32);
            if (q == 0) ssq[(size_t)token * 16 + slot] = ss;
        }
    }
};
template <int MODE  >
struct EpiRope {
    const float* ropec; const float* ropes; bf16_t* o0; bf16_t* o1;
    __device__ __forceinline__ void operator()(const f32x4 (&acc)[4][4], int mbase, int nbase, int, int, int tk, int q) const {
        const bool rope = MODE == 1 || nbase < 256;
#pragma unroll
        for (int mi = 0; mi < 4; ++mi) {
            const int token = mbase + mi * 16 + tk;
            float v[4][4];
#pragma unroll
            for (int ni = 0; ni < 4; ++ni)
#pragma unroll
                for (int r = 0; r < 4; ++r) v[ni][r] = acc[mi][ni][r];
            if (rope) {
#pragma unroll
                for (int ni = 0; ni < 2; ++ni) {
                    const f32x4 cs = *(const f32x4*)(ropec + (size_t)token * 32 + ni * 16 + 4 * q), sn = *(const f32x4*)(ropes + (size_t)token * 32 + ni * 16 + 4 * q);
#pragma unroll
                    for (int r = 0; r < 4; ++r) { const float t1 = v[ni][r], t2 = v[ni + 2][r]; v[ni][r] = t1 * cs[r] - t2 * sn[r]; v[ni + 2][r] = t2 * cs[r] + t1 * sn[r]; }
                }
            }
            bf16_t* dst = MODE == 1 ? o0 + (size_t)token * D + nbase : (nbase < 256 ? o0 + (size_t)token * 256 + nbase : o1 + (size_t)token * 256 + (nbase - 256));
#pragma unroll
            for (int ni = 0; ni < 4; ++ni) { u32x2 o; o[0] = pack2(v[ni][0], v[ni][1]); o[1] = pack2(v[ni][2], v[ni][3]); *(u32x2*)(dst + ni * 16 + 4 * q) = o; }
        }
    }
};

__device__ void s5_phase(const Params& p, unsigned char* smem) {
    bf16_t* ktl = (bf16_t*)smem;
    float* Sl = (float*)(smem + 36864);
    bf16_t* Xl = (bf16_t*)(smem + 36864 + 33280);
    const int tid = opaque_tid(), lane = tid & 63, w = tid >> 6, cb = w & 3, hh = w >> 2, tk = lane & 15, q = lane >> 4;
    for (int task = blockIdx.x; task < G5 * NB; task += gridDim.x) {
        const int g = (task & 7) * 8 + ((task >> 3) >> 2), b = (task >> 3) & 3;
        const bf16_t* U = p.s1 + (size_t)(g * 4 + b) * SEQ * 16;
        const bf16_t* sm = p.smat + (size_t)g * 128 * 1024;
        const bf16_t* cm = p.cmat + (size_t)g * 1024 * 128;
        for (int i = tid; i < KTR * 256 * 2 / 16; i += NT) ((u32x4*)ktl)[i] = ((const u32x4*)(p.ktab + (size_t)g * KTR * 256))[i];
        bf16x8 ufr[32];
#pragma unroll
        for (int ks = 0; ks < 32; ++ks) ufr[ks] = *(const bf16x8*)(U + (size_t)(cb * 16 + tk) * 1024 + ks * 32 + 8 * q);
        {
            bf16x8 afA[4], afB[4];
            auto lda = [&](bf16x8 (&af)[4], int seq) {
                const int mf = seq >> 3, k4 = seq & 7;
                const bf16_t* ap = sm + (size_t)((hh * 4 + mf) * 16 + tk) * 1024 + 8 * q + k4 * 128;
#pragma unroll
                for (int j = 0; j < 4; ++j) af[j] = *(const bf16x8*)(ap + j * 32);
            };
            f32x4 acc = {0.f, 0.f, 0.f, 0.f};
            auto mma = [&](const bf16x8 (&af)[4], int seq) {
                const int k4 = seq & 7;
#pragma unroll
                for (int j = 0; j < 4; ++j) acc = __builtin_amdgcn_mfma_f32_16x16x32_bf16(af[j], ufr[k4 * 4 + j], acc, 0, 0, 0);
                if (k4 == 7) {
                    const int r0 = (hh * 4 + (seq >> 3)) * 16;
#pragma unroll
                    for (int r = 0; r < 4; ++r) Sl[(r0 + 4 * q + r) * 65 + cb * 16 + tk] = acc[r];
                    acc = (f32x4){0.f, 0.f, 0.f, 0.f};
                }
            };
            lda(afA, 0);
#pragma unroll
            for (int seq = 0; seq < 32; seq += 2) {
                lda(afB, seq + 1);
                mma(afA, seq);
                if (seq + 2 < 32) lda(afA, seq + 2);
                mma(afB, seq + 1);
            }
        }
        __syncthreads();
        if (w == 0) {
            const float lr = p.lamL[(g * P5 + lane) * 2], li = p.lamL[(g * P5 + lane) * 2 + 1];
            float xr = 0.f, xi = 0.f;
#pragma unroll 1
            for (int k0 = 0; k0 < NCH; k0 += 8) {
                float sr[8], si[8];
#pragma unroll
                for (int j = 0; j < 8; ++j) { sr[j] = Sl[lane * 65 + k0 + j]; si[j] = Sl[(64 + lane) * 65 + k0 + j]; }
#pragma unroll
                for (int j = 0; j < 8; ++j) {
                    Xl[(k0 + j) * 128 + lane] = f2bf(xr); Xl[(k0 + j) * 128 + 64 + lane] = f2bf(xi);
                    const float nr = lr * xr - li * xi + sr[j], ni = lr * xi + li * xr + si[j];
                    xr = nr; xi = ni;
                }
            }
        }
        __syncthreads();
        bf16x8 xfr[4];
#pragma unroll
        for (int ks = 0; ks < 4; ++ks) xfr[ks] = *(const bf16x8*)(Xl + (cb * 16 + tk) * 128 + ks * 32 + 8 * q);
        const f32x4 dv = *(const f32x4*)(p.s5d + g * 16 + 4 * q);
        const int jl = q >> 1, cih = q & 1;
        const bf16_t* kbase = ktl + (8 - jl) * 256 + tk * 16 + cih * 8;
        const bf16_t* cmb = cm + (size_t)tk * 128 + 8 * q;
        auto iof = [&](int ii) { return hh ? 16 + ii : (ii < 16 ? ii : 32 + ii); };
        bf16x8 cf[4];
#pragma unroll
        for (int ks = 0; ks < 4; ++ks) cf[ks] = *(const bf16x8*)(cmb + (size_t)iof(0) * 2048 + ks * 32);
#pragma unroll 1
        for (int ii = 0; ii < 32; ++ii) {
            const int i = iof(ii), inext = iof(ii < 31 ? ii + 1 : ii);
            bf16x8 cfn[4];
#pragma unroll
            for (int ks = 0; ks < 4; ++ks) cfn[ks] = *(const bf16x8*)(cmb + (size_t)inext * 2048 + ks * 32);
            const int s = (cb * 16 + tk) * 64 + i;
            const u32x2 uv = *(const u32x2*)(U + (size_t)s * 16 + 4 * q);
            f32x4 acc = {0.f, 0.f, 0.f, 0.f};
#pragma unroll
            for (int ks = 0; ks < 4; ++ks) acc = __builtin_amdgcn_mfma_f32_16x16x32_bf16(cf[ks], xfr[ks], acc, 0, 0, 0);
            const int mmax = i >> 1;
            const bf16_t* kb = kbase + i * 256;
#pragma unroll
            for (int mg = 0; mg < 8; ++mg) {
                if (4 * mg <= mmax) {
                    bf16x8 kf[4];
#pragma unroll
                    for (int j = 0; j < 4; ++j) kf[j] = *(const bf16x8*)(kb - (4 * mg + j) * 512);
#pragma unroll
                    for (int j = 0; j < 4; ++j) acc = __builtin_amdgcn_mfma_f32_16x16x32_bf16(kf[j], ufr[4 * mg + j], acc, 0, 0, 0);
                }
            }
            const float y0 = gelu_tanh(acc[0] + dv[0] * bflo(uv[0])), y1 = gelu_tanh(acc[1] + dv[1] * bfhi(uv[0]));
            const float y2 = gelu_tanh(acc[2] + dv[2] * bflo(uv[1])), y3 = gelu_tanh(acc[3] + dv[3] * bfhi(uv[1]));
            u32x2 o; o[0] = pack2(y0, y1); o[1] = pack2(y2, y3);
            *(u32x2*)(p.s0 + ((size_t)b * SEQ + s) * D + g * 16 + 4 * q) = o;
#pragma unroll
            for (int ks = 0; ks < 4; ++ks) cf[ks] = cfn[ks];
        }
        __syncthreads();
    }
}

__device__ __forceinline__ float med3f(float a, float b, float c) { return __builtin_amdgcn_fmed3f(a, b, c); }
__device__ __forceinline__ void ins16(float (&a)[16], float v) {
#pragma unroll
    for (int i = 15; i >= 1; --i) a[i] = med3f(a[i - 1], a[i], v);
    a[0] = fmaxf(a[0], v);
}
__device__ void route_phase(const Params& p, int layer, const bf16_t* qp, unsigned char* smem) {
    float* sc = (float*)smem;
    float* tl = (float*)(smem + 2 * 128 * 129 * 4);
    const int tid = opaque_tid(), lane = tid & 63, w = tid >> 6, tk = lane & 15, q = lane >> 4;
    const bool fixed = (gridDim.x & 7) == 0;
    const int ntask = (T / 128) * 8;
    int cur_h = -1;
    bf16x8 kf[2][8][2];
    for (int it = 0;; ++it) {
        int h, tt;
        if (fixed) { h = blockIdx.x & 7; tt = (blockIdx.x >> 3) + it * (gridDim.x >> 3); if (tt >= T / 128) break; }
        else { const int task = blockIdx.x + it * gridDim.x; if (task >= ntask) break; h = task & 7; tt = task >> 3; }
        const int t0 = tt * 128;
        if (h != cur_h) {
            cur_h = h;
#pragma unroll
            for (int pp = 0; pp < 2; ++pp)
#pragma unroll
                for (int nf = 0; nf < 8; ++nf) {
                    const bf16_t* kb = p.skeys + ((size_t)((layer * 8 + h) * 2 + pp) * 128 + nf * 16 + tk) * 64 + 8 * q;
                    kf[pp][nf][0] = *(const bf16x8*)(kb); kf[pp][nf][1] = *(const bf16x8*)(kb + 32);
                }
        }
        {
            const bf16_t* qrow = qp + (size_t)(t0 + 16 * w + tk) * D + h * 128 + 8 * q;
            const bf16x8 a00 = *(const bf16x8*)(qrow), a01 = *(const bf16x8*)(qrow + 32), a10 = *(const bf16x8*)(qrow + 64), a11 = *(const bf16x8*)(qrow + 96);
#pragma unroll
            for (int pp = 0; pp < 2; ++pp)
#pragma unroll
                for (int nf = 0; nf < 8; ++nf) {
                    f32x4 acc = {0.f, 0.f, 0.f, 0.f};
                    acc = __builtin_amdgcn_mfma_f32_16x16x32_bf16(pp ? a10 : a00, kf[pp][nf][0], acc, 0, 0, 0);
                    acc = __builtin_amdgcn_mfma_f32_16x16x32_bf16(pp ? a11 : a01, kf[pp][nf][1], acc, 0, 0, 0);
#pragma unroll
                    for (int r = 0; r < 4; ++r) sc[(pp * 128 + 16 * w + 4 * q + r) * 129 + nf * 16 + tk] = acc[r];
                }
        }
        __syncthreads();
        {
            const int list = tid & 255, kr = tid >> 8;
            float a[16];
#pragma unroll
            for (int i = 0; i < 16; ++i) a[i] = -3.0e38f;
            const float* row = sc + list * 129 + kr * 64;
#pragma unroll 1
            for (int j0 = 0; j0 < 64; j0 += 8) {
                float rv[8];
#pragma unroll
                for (int j = 0; j < 8; ++j) rv[j] = row[j0 + j];
#pragma unroll
                for (int j = 0; j < 8; ++j) {
                    const float v = __uint_as_float((__float_as_uint(rv[j]) & ~0x7Fu) | (unsigned)(kr * 64 + j0 + j));
                    ins16(a, v);
                }
            }
            if (kr == 1) {
#pragma unroll
                for (int i = 0; i < 16; ++i) tl[list * 16 + i] = a[i];
            }
            __syncthreads();
            if (kr == 0) {
                float o[16];
#pragma unroll
                for (int i = 0; i < 16; ++i) o[i] = tl[list * 16 + i];
#pragma unroll
                for (int i = 0; i < 16; ++i) ins16(a, o[i]);
#pragma unroll
                for (int i = 0; i < 16; ++i) tl[list * 16 + i] = a[i];
            }
            __syncthreads();
        }
        if (tid < 128) {
            float s[16], r[16], c[16];
#pragma unroll
            for (int i = 0; i < 16; ++i) { s[i] = tl[tid * 16 + i]; r[i] = tl[(128 + tid) * 16 + i]; c[i] = -3.0e38f; }
#pragma unroll
            for (int i = 0; i < 16; ++i)
#pragma unroll
                for (int j = 0; j < 16; ++j)
                    if ((i + 1) * (j + 1) <= 16) {
                        const float v = __uint_as_float((__float_as_uint(s[i] + r[j]) & ~0xFFu) | (unsigned)(i * 16 + j));
                        ins16(c, v);
                    }
            float e[16], sum = 0.f;
#pragma unroll
            for (int k = 0; k < 16; ++k) { e[k] = __expf(c[k] - c[0]); sum += e[k]; }
            const float inv = 1.f / sum;
            int idv[16];
#pragma unroll
            for (int k = 0; k < 16; ++k) {
                const unsigned bits = __float_as_uint(c[k]), i = (bits >> 4) & 15u, j = bits & 15u;
                const unsigned ki = __float_as_uint(tl[tid * 16 + i]) & 0x7Fu, kj = __float_as_uint(tl[(128 + tid) * 16 + j]) & 0x7Fu;
                idv[k] = (int)(ki * 128u + kj);
            }
            int* ido = p.ids + (size_t)(t0 + tid) * 128 + h * 16; float* go = p.gates + (size_t)(t0 + tid) * 128 + h * 16; float* so = p.sus + (size_t)(t0 + tid) * 128 + h * 16;
            const float* sut = p.su + (size_t)layer * NEXP; const float* svt = p.sv + (size_t)layer * NEXP;
            float sug[16], svg[16];
#pragma unroll
            for (int k = 0; k < 16; ++k) { sug[k] = sut[idv[k]]; svg[k] = svt[idv[k]]; }
#pragma unroll
            for (int k4 = 0; k4 < 4; ++k4) {
                *(int4*)(ido + k4 * 4) = make_int4(idv[k4 * 4], idv[k4 * 4 + 1], idv[k4 * 4 + 2], idv[k4 * 4 + 3]);
                *(f32x4*)(go + k4 * 4) = (f32x4){e[k4 * 4] * inv * svg[k4 * 4], e[k4 * 4 + 1] * inv * svg[k4 * 4 + 1], e[k4 * 4 + 2] * inv * svg[k4 * 4 + 2], e[k4 * 4 + 3] * inv * svg[k4 * 4 + 3]};
                *(f32x4*)(so + k4 * 4) = (f32x4){sug[k4 * 4], sug[k4 * 4 + 1], sug[k4 * 4 + 2], sug[k4 * 4 + 3]};
            }
        }
        __syncthreads();
    }
}

typedef _Float16 h16x2 __attribute__((ext_vector_type(2)));
typedef int i32x8 __attribute__((ext_vector_type(8)));
#ifndef NVR
#define NVR 16
#endif
template <bool FINAL>
__device__ void gather_phase(const Params& p, int layer, const float* xin, float* xout, bf16_t* hkv_out, bf16_t* hq_out, unsigned char* smem) {
    const int tid_ = opaque_tid(), lane = tid_ & 63, wv = tid_ >> 6, tk = lane & 15, q = lane >> 4;
    const int nw = gridDim.x * (NT / 64);
    const unsigned char* utab = p.ub + (size_t)layer * NEXP * 512;
    const unsigned char* vtab = p.vb + (size_t)layer * NEXP * 512;
    const float* sutab = p.su + (size_t)layer * NEXP;
    const float* svtab = p.sv + (size_t)layer * NEXP;
    unsigned char* hl = smem + wv * 17664;
    unsigned char* a8l = hl + 1024;
    unsigned char* vbuf = hl + 1280;
    const unsigned vbuf_lds = (unsigned)__builtin_amdgcn_readfirstlane((int)(unsigned)(size_t)(LAS unsigned char*)vbuf);
    f32x4 nx[4]; int nidA = 0, nidB = 0; float ngA = 0.f, ngB = 0.f, nsA = 0.f, nsB = 0.f;
    auto preload = [&](int tt) {
        const float* xr_ = xin + (size_t)tt * D + lane * 16;
#pragma unroll
        for (int j = 0; j < 4; ++j) nx[j] = *(const f32x4*)(xr_ + j * 4);
        nidA = p.ids[(size_t)tt * 128 + lane]; nidB = p.ids[(size_t)tt * 128 + 64 + lane];
        ngA = p.gates[(size_t)tt * 128 + lane]; ngB = p.gates[(size_t)tt * 128 + 64 + lane];
        nsA = p.sus[(size_t)tt * 128 + lane]; nsB = p.sus[(size_t)tt * 128 + 64 + lane];
    };
    const int t_first = blockIdx.x * (NT / 64) + wv;
    if (t_first < T) preload(t_first);
    for (int t = t_first; t < T; t += nw) {
        const int b = t / SEQ;
        const bf16_t* cv = p.cvec + (size_t)b * 12 * 1024 + (layer ? 7 * 1024 : 0);
        const int e0 = lane * 16;
        f32x4 xv[4];
#pragma unroll
        for (int j = 0; j < 4; ++j) xv[j] = nx[j];
        const int idA = nidA, idB = nidB; const float gA = ngA, gB = ngB, suA = nsA, suB = nsB;
        {
            float ss = 0.f;
#pragma unroll
            for (int j = 0; j < 4; ++j) ss += xv[j][0] * xv[j][0] + xv[j][1] * xv[j][1] + xv[j][2] * xv[j][2] + xv[j][3] * xv[j][3];
            ss = wave_sum(ss);
            const float rstd = rsqrtf(ss * (1.f / D) + RMS_EPS);
            u32x4 hw;
#pragma unroll
            for (int j2 = 0; j2 < 2; ++j2) {
                const u32x4 gs8 = *(const u32x4*)(cv + e0 + j2 * 8), sh8 = *(const u32x4*)(cv + 1024 + e0 + j2 * 8);
#pragma unroll
                for (int jj = 0; jj < 2; ++jj) {
                    const int j = j2 * 2 + jj;
                    const float h0 = xv[j][0] * rstd * bflo(gs8[jj * 2]) + bflo(sh8[jj * 2]), h1 = xv[j][1] * rstd * bfhi(gs8[jj * 2]) + bfhi(sh8[jj * 2]);
                    const float h2 = xv[j][2] * rstd * bflo(gs8[jj * 2 + 1]) + bflo(sh8[jj * 2 + 1]), h3 = xv[j][3] * rstd * bfhi(gs8[jj * 2 + 1]) + bfhi(sh8[jj * 2 + 1]);
                    int r = 0;
                    r = __builtin_amdgcn_cvt_pk_fp8_f32(h0, h1, r, false);
                    r = __builtin_amdgcn_cvt_pk_fp8_f32(h2, h3, r, true);
                    hw[j] = (unsigned)r;
                }
            }
            *(u32x4*)(hl + lane * 16) = hw;
        }
        asm volatile("s_waitcnt lgkmcnt(0)" ::: "memory");
        i32x8 hb[8];
#pragma unroll
        for (int kk = 0; kk < 8; ++kk) {
            const u32x4 lo = *(const u32x4*)(hl + kk * 128 + q * 16), hi = *(const u32x4*)(hl + kk * 128 + 64 + q * 16);
            hb[kk] = (i32x8){(int)lo[0], (int)lo[1], (int)lo[2], (int)lo[3], (int)hi[0], (int)hi[1], (int)hi[2], (int)hi[3]};
        }
        float dA = 0.f, dB = 0.f;
        auto dma16 = [&](const unsigned char* gsrc, unsigned dst) {
            unsigned keep;
            asm volatile("s_mov_b32 %0, m0\n\ts_mov_b32 m0, %2\n\ts_nop 0\n\tglobal_load_lds_dwordx4 %1, off\n\ts_mov_b32 m0, %0" : "=&s"(keep) : "v"(gsrc), "s"(dst) : "memory");
        };
        auto dma_ubatch = [&](int bt, int bsel) {
#pragma unroll
            for (int i_ = 0; i_ < 8; ++i_) {
                const int r_ = 2 * i_ + (lane >> 5);
                const int k0_ = (bt * 16 + 2 * i_) & 63;
                const int id0_ = __builtin_amdgcn_readlane(bt < 4 ? idA : idB, k0_), id1_ = __builtin_amdgcn_readlane(bt < 4 ? idA : idB, k0_ + 1);
                const int id_ = (lane >> 5) ? id1_ : id0_;
                dma16(utab + (size_t)((unsigned)id_ * 512u + (unsigned)(((lane & 31) ^ (r_ & 15)) * 16)), vbuf_lds + (unsigned)bsel * 8192u + (unsigned)i_ * 1024u);
            }
        };
        auto mma_ubatch = [&](int bt, int bsel) {
            const unsigned char* rowp = vbuf + bsel * 8192 + tk * 512;
            f32x4 acc = {0.f, 0.f, 0.f, 0.f};
#pragma unroll
            for (int kk = 0; kk < 8; ++kk) {
                const u32x4 a4 = *(const u32x4*)(rowp + (((kk * 4 + q) ^ tk) * 16));
                const i32x8 av = {(int)a4[0], (int)a4[1], (int)a4[2], (int)a4[3], 0, 0, 0, 0};
                acc = __builtin_amdgcn_mfma_scale_f32_16x16x128_f8f6f4(av, hb[kk], acc, 4  , 0  , 0, 0x7f7f7f7f, 0, 0x7f7f7f7f);
            }
            const int r = lane & 3;
            const float mine = r == 0 ? acc[0] : (r == 1 ? acc[1] : (r == 2 ? acc[2] : acc[3]));
            const float got = __shfl(mine, ((lane & 15) >> 2) * 16 + (lane & 15));
            if (q == (bt & 3)) { if (bt < 4) dA = got; else dB = got; }
        };
        asm volatile("s_waitcnt vmcnt(0) lgkmcnt(0)" ::: "memory");
        dma_ubatch(0, 0);
        if (t + nw < T) preload(t + nw);
#pragma unroll
        for (int bt = 0; bt < 8; ++bt) {
            if (bt + 1 < 8) { dma_ubatch(bt + 1, (bt + 1) & 1); asm volatile("s_waitcnt vmcnt(8)" ::: "memory"); }
            else asm volatile("s_waitcnt vmcnt(0)" ::: "memory");
            mma_ubatch(bt, bt & 1);
            asm volatile("s_waitcnt lgkmcnt(0)" ::: "memory");
        }
        const float apA = gelu_tanh(dA * suA) * gA, apB = gelu_tanh(dB * suB) * gB;
        float of[16];
        {
            const float amax = wave_max(fmaxf(fabsf(apA), fabsf(apB)));
            const float asc = amax > 0.f ? 224.f / amax : 0.f, iasc = amax * (1.f / 224.f);
            const int pk = __builtin_amdgcn_cvt_pk_fp8_f32(apA * asc, apB * asc, 0, false);
            a8l[lane] = (unsigned char)(pk & 0xff); a8l[64 + lane] = (unsigned char)((pk >> 8) & 0xff);
            unsigned rowoff[16];
#pragma unroll
            for (int i_ = 0; i_ < 16; ++i_) {
                const int r_ = 8 * (i_ & 7) + (lane >> 3);
                const int id_ = __shfl(i_ < 8 ? idA : idB, r_);
                rowoff[i_] = (unsigned)id_ * 512u + (unsigned)(((lane & 7) ^ (r_ & 7)) * 16);
            }
            asm volatile("s_waitcnt lgkmcnt(0)" ::: "memory");
            const u32x4 alo = *(const u32x4*)(a8l + 16 * q), ahi = *(const u32x4*)(a8l + 64 + 16 * q);
            const i32x8 av0 = {(int)alo[0], (int)alo[1], (int)alo[2], (int)alo[3], 0, 0, 0, 0}, av1 = {0, 0, 0, 0, (int)ahi[0], (int)ahi[1], (int)ahi[2], (int)ahi[3]};
            auto dma_slice = [&](int sidx, int bsel) {
#pragma unroll
                for (int i_ = 0; i_ < 8; ++i_)
                    dma16(vtab + (size_t)(rowoff[(sidx & 1) * 8 + i_] + (unsigned)(sidx >> 1) * 128u), vbuf_lds + (unsigned)bsel * 8192u + (unsigned)i_ * 1024u);
            };
            float ov[16];
#pragma unroll
            for (int e = 0; e < 16; ++e) ov[e] = 0.f;
            const int rl = 32 * (q & 1) + tk;
            asm volatile("s_waitcnt vmcnt(0) lgkmcnt(0)" ::: "memory");
            dma_slice(0, 0);
#pragma unroll
            for (int ln = 0; ln < 4; ++ln) {
#pragma unroll
                for (int rh = 0; rh < 2; ++rh) {
                    const int sidx = ln * 2 + rh;
                    if (sidx + 1 < 8) { dma_slice(sidx + 1, (sidx + 1) & 1); asm volatile("s_waitcnt vmcnt(8)" ::: "memory"); }
                    else asm volatile("s_waitcnt vmcnt(0)" ::: "memory");
                    const unsigned char* vb0 = vbuf + (sidx & 1) * 8192 + rl * 128, *vb1 = vb0 + 16 * 128;
#pragma unroll
                    for (int eg = 0; eg < 16; ++eg) {
                        typedef int i32x2 __attribute__((ext_vector_type(2)));
                        const int co = (((eg >> 1) ^ (tk & 7)) * 16) + (eg & 1) * 8;
                        const i32x2 r1 = __builtin_amdgcn_ds_read_tr4_b64_v2i32((LAS i32x2*)(vb0 + co));
                        const i32x2 r2 = __builtin_amdgcn_ds_read_tr4_b64_v2i32((LAS i32x2*)(vb1 + co));
                        const i32x8 bv = {r1[0], r1[1], r2[0], r2[1], 0, 0, 0, 0};
                        f32x4 z = {0.f, 0.f, 0.f, 0.f};
                        const f32x4 d = __builtin_amdgcn_mfma_scale_f32_16x16x128_f8f6f4(rh ? av1 : av0, bv, z, 0  , 4  , 0, 0x7f7f7f7f, 0, 0x7f7f7f7f);
                        if ((eg >> 2) == q) ov[ln * 4 + (eg & 3)] += d[0];
                        if ((eg & 3) == 3) __builtin_amdgcn_sched_barrier(0);
                    }
                    asm volatile("s_waitcnt lgkmcnt(0)" ::: "memory");
                }
            }
#pragma unroll
            for (int e = 0; e < 16; ++e) ov[e] *= iasc;
            float* outl = (float*)vbuf;
#pragma unroll
            for (int ln = 0; ln < 4; ++ln)
#pragma unroll
                for (int t_ = 0; t_ < 4; ++t_) outl[ln * 256 + (4 * q + t_) * 16 + tk] = ov[ln * 4 + t_];
            asm volatile("s_waitcnt lgkmcnt(0)" ::: "memory");
#pragma unroll
            for (int j4 = 0; j4 < 4; ++j4) { const f32x4 v4 = *(const f32x4*)(outl + lane * 16 + j4 * 4); of[j4 * 4] = v4[0]; of[j4 * 4 + 1] = v4[1]; of[j4 * 4 + 2] = v4[2]; of[j4 * 4 + 3] = v4[3]; }
            asm volatile("s_waitcnt lgkmcnt(0)" ::: "memory");
        }
        float xn[16]; float ss = 0.f;
        auto ldv = [&](const bf16_t* vp, float (&o)[16]) {
#pragma unroll
            for (int j2 = 0; j2 < 2; ++j2) {
                const u32x4 w8 = *(const u32x4*)(vp + e0 + j2 * 8);
#pragma unroll
                for (int jj = 0; jj < 4; ++jj) { o[j2 * 8 + jj * 2] = bflo(w8[jj]); o[j2 * 8 + jj * 2 + 1] = bfhi(w8[jj]); }
            }
        };
        {
            float gt[16]; ldv(cv + 2 * 1024, gt);
#pragma unroll
            for (int k = 0; k < 16; ++k) { const float v = xv[k >> 2][k & 3] + gt[k] * of[k]; xn[k] = v; ss += v * v; }
        }
        ss = wave_sum(ss);
        const float rstd = rsqrtf(ss * (1.f / D) + RMS_EPS);
        if (!FINAL) {
#pragma unroll
            for (int j = 0; j < 4; ++j) *(f32x4*)(xout + (size_t)t * D + e0 + j * 4) = (f32x4){xn[j * 4], xn[j * 4 + 1], xn[j * 4 + 2], xn[j * 4 + 3]};
            const bf16_t* cv0 = p.cvec + (size_t)b * 12 * 1024;
            float gsv[16], shv[16], hk[16], hq[16];
            ldv(cv0 + 3 * 1024, gsv); ldv(cv0 + 4 * 1024, shv);
#pragma unroll
            for (int k = 0; k < 16; ++k) hk[k] = xn[k] * rstd * gsv[k] + shv[k];
            ldv(cv0 + 5 * 1024, gsv); ldv(cv0 + 6 * 1024, shv);
#pragma unroll
            for (int k = 0; k < 16; ++k) hq[k] = xn[k] * rstd * gsv[k] + shv[k];
#pragma unroll
            for (int j = 0; j < 2; ++j) {
                u32x4 ob; ob[0] = pack2(hk[j * 8], hk[j * 8 + 1]); ob[1] = pack2(hk[j * 8 + 2], hk[j * 8 + 3]); ob[2] = pack2(hk[j * 8 + 4], hk[j * 8 + 5]); ob[3] = pack2(hk[j * 8 + 6], hk[j * 8 + 7]);
                *(u32x4*)(hkv_out + (size_t)t * D + e0 + j * 8) = ob;
                u32x4 oc; oc[0] = pack2(hq[j * 8], hq[j * 8 + 1]); oc[1] = pack2(hq[j * 8 + 2], hq[j * 8 + 3]); oc[2] = pack2(hq[j * 8 + 4], hq[j * 8 + 5]); oc[3] = pack2(hq[j * 8 + 6], hq[j * 8 + 7]);
                *(u32x4*)(hq_out + (size_t)t * D + e0 + j * 8) = oc;
            }
        } else {
            const bf16_t* cv0 = p.cvec + (size_t)b * 12 * 1024;
            float gsv[16], shv[16];
            ldv(cv0 + 10 * 1024, gsv); ldv(cv0 + 11 * 1024, shv);
#pragma unroll
            for (int j = 0; j < 4; ++j) {
                f32x4 ov;
#pragma unroll
                for (int e = 0; e < 4; ++e) ov[e] = xn[j * 4 + e] * rstd * gsv[j * 4 + e] + shv[j * 4 + e];
                *(f32x4*)(p.out + (size_t)t * D + e0 + j * 4) = ov;
            }
        }
        asm volatile("s_waitcnt lgkmcnt(0)" ::: "memory");
    }
}

__device__ void attn_phase(const Params& p, const bf16_t* Q, const bf16_t* K, const bf16_t* V, bf16_t* O, unsigned char* smem) {
    unsigned char* Kl = smem;
    unsigned char* Vt = smem + 32768;
    unsigned char* Pl = smem + 32768 + 35840;
    const int tid = opaque_tid(), lane = tid & 63, w = tid >> 6, tk = lane & 15, q = lane >> 4;
    unsigned char* Pw = Pl + w * 5376;
    for (int task = blockIdx.x; task < NB * 32 * 4; task += gridDim.x) {
        const int kvh = task & 3, qblk = (task >> 2) & 31, b = task >> 7;
        const int kpos0 = (qblk - 1) * 128;
#pragma unroll
        for (int i = 0; i < 4; ++i) {
            const int id = tid + NT * i, j = id >> 3, c = id & 7, kp = kpos0 + j;
            u32x4 v = {0u, 0u, 0u, 0u};
            if (kp >= 0) v = *(const u32x4*)(K + ((size_t)b * SEQ + kp) * 256 + kvh * 64 + c * 8);
            *(u32x4*)(Kl + lds_off(j, c)) = v;
        }
#pragma unroll
        for (int i = 0; i < 4; ++i) {
            const int id = tid + NT * i, j = id & 255, dc = id >> 8, kp = kpos0 + j;
            u32x4 v = {0u, 0u, 0u, 0u};
            if (kp >= 0) v = *(const u32x4*)(V + ((size_t)b * SEQ + kp) * 256 + kvh * 64 + dc * 8);
#pragma unroll
            for (int e = 0; e < 4; ++e) {
                *(bf16_t*)(Vt + (dc * 8 + 2 * e) * 560 + j * 2) = (bf16_t)(v[e] & 0xffffu);
                *(bf16_t*)(Vt + (dc * 8 + 2 * e + 1) * 560 + j * 2) = (bf16_t)(v[e] >> 16);
            }
        }
        if (tid < 128) *(u32x4*)(Vt + (tid >> 1) * 560 + 512 + (tid & 1) * 16) = (u32x4){0u, 0u, 0u, 0u};
        *(u32x2*)(Pw + tk * 336 + (144 + 4 * q) * 2) = (u32x2){0u, 0u};
        __syncthreads();
        const int qt = w, i_q = qt * 16 + tk;
        const size_t trow = (size_t)b * SEQ + qblk * 128 + i_q;
        const unsigned char* kb0 = Kl + lds_off(qt * 16 + tk, q);
        const unsigned char* kb1 = Kl + lds_off(qt * 16 + tk, 4 + q);
        const unsigned char* vb0 = Vt + tk * 560 + (qt * 16 + 8 * q) * 2;
        unsigned char* pwr = Pw + tk * 336 + 8 * q;
        const unsigned char* prd = Pw + tk * 336 + 16 * q;
#pragma unroll 1
        for (int hq = 0; hq < 4; ++hq) {
            const int head = kvh * 4 + hq;
            const bf16x8 qf0 = *(const bf16x8*)(Q + trow * D + head * 64 + 8 * q), qf1 = *(const bf16x8*)(Q + trow * D + head * 64 + 32 + 8 * q);
            f32x4 sacc[9];
#pragma unroll
            for (int kk = 0; kk < 9; ++kk) {
                const bf16x8 k0 = *(const bf16x8*)(kb0 + kk * 2048), k1 = *(const bf16x8*)(kb1 + kk * 2048);
                f32x4 a = {0.f, 0.f, 0.f, 0.f};
                a = __builtin_amdgcn_mfma_f32_16x16x32_bf16(k0, qf0, a, 0, 0, 0);
                a = __builtin_amdgcn_mfma_f32_16x16x32_bf16(k1, qf1, a, 0, 0, 0);
                sacc[kk] = a;
                if (kk & 1) __builtin_amdgcn_sched_barrier(0);
            }
            const float sink = p.sinks[head];
            float mx = -1e30f;
#pragma unroll
            for (int kk = 0; kk < 9; ++kk)
#pragma unroll
                for (int r = 0; r < 4; ++r) {
                    const int j = (qt + kk) * 16 + 4 * q + r;
                    const bool valid = (j > i_q) && (j <= i_q + 128) && (qblk > 0 || j >= 128);
                    const float s = valid ? sacc[kk][r] * 0.125f : -1e30f;
                    sacc[kk][r] = s; mx = fmaxf(mx, s);
                }
            mx = fmaxf(mx, __shfl_xor(mx, 16)); mx = fmaxf(mx, __shfl_xor(mx, 32));
            mx = fmaxf(mx, sink);
            float sum = 0.f;
#pragma unroll
            for (int kk = 0; kk < 9; ++kk)
#pragma unroll
                for (int r = 0; r < 4; ++r) { const float e = __expf(sacc[kk][r] - mx); sacc[kk][r] = e; sum += e; }
            sum += __shfl_xor(sum, 16); sum += __shfl_xor(sum, 32);
            const float inv = 1.f / (sum + __expf(sink - mx));
#pragma unroll
            for (int kk = 0; kk < 9; ++kk) {
                u32x2 o; o[0] = pack2(sacc[kk][0] * inv, sacc[kk][1] * inv); o[1] = pack2(sacc[kk][2] * inv, sacc[kk][3] * inv);
                *(u32x2*)(pwr + kk * 32) = o;
            }
            asm volatile("s_waitcnt lgkmcnt(0)" ::: "memory");
            bf16x8 pf[5];
#pragma unroll
            for (int ks = 0; ks < 5; ++ks) pf[ks] = *(const bf16x8*)(prd + ks * 64);
#pragma unroll
            for (int dt = 0; dt < 4; ++dt) {
                f32x4 oa = {0.f, 0.f, 0.f, 0.f};
#pragma unroll
                for (int ks = 0; ks < 5; ++ks) {
                    const bf16x8 vf = *(const bf16x8*)(vb0 + dt * 8960 + ks * 64);
                    oa = __builtin_amdgcn_mfma_f32_16x16x32_bf16(vf, pf[ks], oa, 0, 0, 0);
                }
                u32x2 o; o[0] = pack2(oa[0], oa[1]); o[1] = pack2(oa[2], oa[3]);
                *(u32x2*)(O + trow * D + head * 64 + dt * 16 + 4 * q) = o;
                __builtin_amdgcn_sched_barrier(0);
            }
            asm volatile("s_waitcnt lgkmcnt(0)" ::: "memory");
        }
        __syncthreads();
    }
}

constexpr int SMEM_BYTES = 152 * 1024;
__global__ void __launch_bounds__(NT) yoco_fwd(Params p) {
    __shared__ __attribute__((aligned(16))) unsigned char smem[SMEM_BYTES];
    volatile LAS unsigned* st = (volatile LAS unsigned*)(smem + SMEM_BYTES - 16);
    if (threadIdx.x == 0) { st[0] = 0u; st[1] = 0u; }
    __syncthreads();
    const XcdBarrier xb = xcd_barrier_post(p.bar, st);
    p0_cond(p, smem);
    p0_tables(p);
    p0_wt(p, smem);
    p0_s5(p, smem);
    xcd_barrier(xb);
    p05_prep(p, smem);
    xcd_barrier(xb);
    bias_finalize(p);
    { EpiU e{p.s1}; gemm_phase<256>(p.s0, p.wt_in, 0, 1024, e, smem); }
    xcd_barrier(xb);
    s5_phase(p, smem);
    xcd_barrier(xb);
    { EpiGlu e{p.s0, p.b_glu, p.s1}; gemm_phase<256>(p.s0, p.wt_glu, 0, 1024, e, smem); }
    xcd_barrier(xb);
    { EpiRes e{p.x, p.cond + 2 * D, p.norm_ffn, p.cond + 4 * D, p.f0, p.s2, p.ssq1}; gemm_phase<256>(p.s1, p.wt_out, 0, 1024, e, smem); }
    xcd_barrier(xb);
    { EpiQ e{p.ssq1, p.bias, 0, p.s1}; gemm_phase<256>(p.s2, p.wt_pq0, 0, 1024, e, smem); }
    xcd_barrier(xb);
    route_phase(p, 0, p.s1, smem);
    xcd_barrier(xb);
    gather_phase<false>(p, 0, p.f0, p.f1, p.s0, p.s2, smem);
    xcd_barrier(xb);
    { EpiRope<0> e{p.ropec, p.ropes, p.s1, p.s1 + (size_t)T * 256}; gemm_phase<128>(p.s0, p.wt_kv, 0, 512, e, smem); }
    { EpiRope<1> e{p.ropec, p.ropes, p.s3, nullptr}; gemm_phase<128>(p.s2, p.wt_q, 0, 1024, e, smem); }
    xcd_barrier(xb);
    attn_phase(p, p.s3, p.s1, p.s1 + (size_t)T * 256, p.s0, smem);
    xcd_barrier(xb);
    { EpiRes e{p.f1, p.cond + 8 * D, p.norm_ffn + D, p.cond + 10 * D, p.f0, p.s2, p.ssq3}; gemm_phase<256>(p.s0, p.wt_o, 0, 1024, e, smem); }
    xcd_barrier(xb);
    { EpiQ e{p.ssq3, p.bias, 1024, p.s1}; gemm_phase<256>(p.s2, p.wt_pq1, 0, 1024, e, smem); }
    xcd_barrier(xb);
    route_phase(p, 1, p.s1, smem);
    xcd_barrier(xb);
    gather_phase<true>(p, 1, p.f0, nullptr, nullptr, nullptr, smem);
}

static inline size_t align_up(size_t v, size_t a) { return (v + a - 1) / a * a; }

extern "C" void kernel_launch(void* const* d_in, const int* in_sizes, int n_in, void* d_out, int out_size, void* d_ws, size_t ws_size, hipStream_t stream) {
    (void)in_sizes; (void)n_in; (void)out_size;
    Params p{};
    p.x = (const float*)d_in[0]; p.c = (const float*)d_in[1]; p.pos = (const int*)d_in[2]; p.w_cond = (const float*)d_in[3]; p.b_cond = (const float*)d_in[4];
    p.norm_mix = (const float*)d_in[5]; p.norm_ffn = (const float*)d_in[6]; p.w_in = (const float*)d_in[7]; p.a_re = (const float*)d_in[8]; p.a_im = (const float*)d_in[9];
    p.log_dt = (const float*)d_in[10]; p.b_re = (const float*)d_in[11]; p.b_im = (const float*)d_in[12]; p.c_re = (const float*)d_in[13]; p.c_im = (const float*)d_in[14];
    p.s5d = (const float*)d_in[15]; p.w_glu = (const float*)d_in[16]; p.b_glu = (const float*)d_in[17]; p.w_out = (const float*)d_in[18]; p.kv_norm = (const float*)d_in[19];
    p.w_kv = (const float*)d_in[20]; p.w_q = (const float*)d_in[21]; p.sinks = (const float*)d_in[22]; p.w_o = (const float*)d_in[23]; p.peer_wq = (const float*)d_in[24];
    p.subkeys = (const float*)d_in[25]; p.peer_u = (const float*)d_in[26]; p.peer_v = (const float*)d_in[27]; p.final_norm = (const float*)d_in[28];
    p.out = (float*)d_out;
    unsigned char* w = (unsigned char*)d_ws; size_t off = 65536;
    p.bar = (unsigned*)d_ws;
    auto take = [&](size_t bytes) { void* r = w + off; off = align_up(off + bytes, 4096); return r; };
    p.cond = (float*)take((size_t)NB * NCOND * D * 4);
    p.ropec = (float*)take((size_t)T * 32 * 4); p.ropes = (float*)take((size_t)T * 32 * 4);
    p.ssq1 = (float*)take((size_t)T * 16 * 4); p.ssq3 = (float*)take((size_t)T * 16 * 4);
    p.wt_in = (bf16_t*)take((size_t)D * D * 2); p.wt_glu = (bf16_t*)take((size_t)D * D * 2); p.wt_out = (bf16_t*)take((size_t)D * D * 2); p.wt_kv = (bf16_t*)take((size_t)512 * D * 2);
    p.wt_q = (bf16_t*)take((size_t)D * D * 2); p.wt_o = (bf16_t*)take((size_t)D * D * 2); p.wt_pq0 = (bf16_t*)take((size_t)D * D * 2); p.wt_pq1 = (bf16_t*)take((size_t)D * D * 2);
    p.biasp = (float*)take((size_t)8 * 4 * 2048 * 4); p.bias = (float*)take((size_t)4 * 2048 * 4);
    p.skeys = (bf16_t*)take((size_t)2 * 8 * 2 * 128 * 64 * 2);
    p.lamL = (float*)take((size_t)G5 * P5 * 2 * 4); p.ktab = (bf16_t*)take((size_t)G5 * KTR * 256 * 2);
    p.smat = (bf16_t*)take((size_t)G5 * 128 * 1024 * 2); p.cmat = (bf16_t*)take((size_t)G5 * 1024 * 128 * 2);
    p.ub = (unsigned char*)take((size_t)2 * NEXP * D); p.vb = (unsigned char*)take((size_t)2 * NEXP * D);
    p.su = (float*)take((size_t)2 * NEXP * 4); p.sv = (float*)take((size_t)2 * NEXP * 4);
    p.s0 = (bf16_t*)take((size_t)T * D * 2); p.s1 = (bf16_t*)take((size_t)T * D * 2); p.s2 = (bf16_t*)take((size_t)T * D * 2); p.s3 = (bf16_t*)take((size_t)T * D * 2);
    p.f0 = (float*)take((size_t)T * D * 4); p.f1 = (float*)take((size_t)T * D * 4);
    p.ids = (int*)take((size_t)T * 128 * 4); p.gates = (float*)take((size_t)T * 128 * 4); p.sus = (float*)take((size_t)T * 128 * 4);
    p.cvec = (bf16_t*)take((size_t)4 * 12 * 1024 * 2);
    if (off > ws_size) { fprintf(stderr, "workspace too small: need %zu have %zu\n", off, ws_size); return; }

    static int grid_blocks = 0;
    if (!grid_blocks) {
        int dev = 0, cus = 0, per_cu = 0;
        (void)hipGetDevice(&dev);
        (void)hipDeviceGetAttribute(&cus, hipDeviceAttributeMultiprocessorCount, dev);
        (void)hipOccupancyMaxActiveBlocksPerMultiprocessor(&per_cu, yoco_fwd, NT, 0);
        if (per_cu > 1) per_cu = 1;
        grid_blocks = cus * per_cu;
        if (grid_blocks <= 0) grid_blocks = 256;
    }
    (void)hipMemsetAsync(d_ws, 0, XCD_BAR_WORDS * 4, stream);
    void* args[] = {&p};
    hipError_t e = hipLaunchCooperativeKernel((const void*)yoco_fwd, dim3(grid_blocks), dim3(NT), args, 0, stream);
    if (e != hipSuccess) fprintf(stderr, "cooperative launch failed: %s (grid %d)\n", hipGetErrorString(e), grid_blocks);
}
```

```cpp
#include <hip/hip_runtime.h>
#include <cstdio>
#include <cstdint>
#include <type_traits>

#define NT 512
#define LAS __attribute__((address_space(3)))
typedef unsigned short bf16_t;
typedef short bf16x8 __attribute__((ext_vector_type(8)));
typedef float f32x4 __attribute__((ext_vector_type(4)));
typedef unsigned u32x4 __attribute__((ext_vector_type(4)));
typedef unsigned u32x2 __attribute__((ext_vector_type(2)));

constexpr int D = 1024, NB = 4, SEQ = 4096, T = NB * SEQ;
constexpr int NCOND = 16;
constexpr int G5 = 64, P5 = 64, C5 = 16, L5 = 64, NCH = SEQ / L5, KTR = 72;
constexpr int NEXP = 16384;
constexpr float RMS_EPS = 1e-6f;

struct Params {
    const float *x, *c; const int* pos; const float *w_cond, *b_cond, *norm_mix, *norm_ffn, *w_in, *a_re, *a_im, *log_dt, *b_re, *b_im, *c_re, *c_im, *s5d,
        *w_glu, *b_glu, *w_out, *kv_norm, *w_kv, *w_q, *sinks, *w_o, *peer_wq, *subkeys, *peer_u, *peer_v, *final_norm;
    float* out;
    unsigned* bar;
    float* cond;
    float* ropec;
    float* ropes;
    float* ssq1;
    float* ssq3;
    bf16_t *wt_in, *wt_glu, *wt_out, *wt_kv, *wt_q, *wt_o, *wt_pq0, *wt_pq1;
    float* biasp;
    float* bias;
    bf16_t* skeys;
    float* lamL;
    bf16_t* ktab;
    bf16_t* smat;
    bf16_t* cmat;
    unsigned char* ub;
    unsigned char* vb;
    float* su;
    float* sv;
    bf16_t *s0, *s1, *s2, *s3;
    float *f0, *f1;
    int* ids;
    float* gates;
    float* sus;
    bf16_t* cvec;
};

#define XB_TMO      128
#define XB_XCNT(j)  (256  + 64 * (j))
#define XB_XSUB(j)  (1280 + 64 * (j))
#define XB_XGEN(j)  (2304 + 64 * (j))
#define XB_TOP      3328
#define XB_TOPGEN   3392
#define XCD_BAR_WORDS 3456
#define XB_SPIN_CAP (1u << 22)
__device__ __forceinline__ unsigned xb_ld(unsigned* p)              { return __hip_atomic_load(p, __ATOMIC_RELAXED, __HIP_MEMORY_SCOPE_AGENT); }
__device__ __forceinline__ unsigned xb_add(unsigned* p, unsigned v) { return __hip_atomic_fetch_add(p, v, __ATOMIC_RELAXED, __HIP_MEMORY_SCOPE_AGENT); }
__device__ __forceinline__ unsigned xb_xcc_id() { return (unsigned)__builtin_amdgcn_s_getreg((3 << 11) | 20) & 0xFu; }
#define XB_SPIN(cond, bar) do { unsigned _sp = 0; while (cond) { __builtin_amdgcn_s_sleep(1); \
    if ((++_sp & 255u) == 0u) { if (xb_ld(&(bar)[XB_TMO])) break; if (_sp > XB_SPIN_CAP) { atomicAdd(&(bar)[XB_TMO], 1u); break; } } } } while (0)
struct XcdBarrier { unsigned* bar; unsigned x; volatile LAS unsigned* st; };
__device__ __forceinline__ XcdBarrier xcd_barrier_post(unsigned* bar, volatile LAS unsigned* st) {
    XcdBarrier b; b.bar = bar; b.x = xb_xcc_id(); b.st = st;
    if (threadIdx.x == 0) (void)xb_add(&bar[XB_XCNT(b.x)], 1u);
    return b;
}
__device__ __forceinline__ void xcd_barrier_complete(unsigned* bar, unsigned x, unsigned& nloc, unsigned& nx) {
    const unsigned G = gridDim.x * gridDim.y * gridDim.z;
    unsigned sum, cnt, mine, sp = 0u;
    for (;;) {
        sum = 0u; cnt = 0u; mine = 0u;
#pragma unroll
        for (unsigned j = 0; j < 16; ++j) { const unsigned c = xb_ld(&bar[XB_XCNT(j)]); sum += c; cnt += (c > 0u) ? 1u : 0u; mine = (j == x) ? c : mine; }
        if (sum == G) break;
        __builtin_amdgcn_s_sleep(1);
        if ((++sp & 255u) == 0u) { if (xb_ld(&bar[XB_TMO])) break; if (sp > XB_SPIN_CAP) { atomicAdd(&bar[XB_TMO], 1u); break; } }
    }
    nloc = mine > 0u ? mine : 1u; nx = cnt > 0u ? cnt : 1u;
}
__device__ __forceinline__ void xcd_barrier(const XcdBarrier& b) {
    asm volatile("s_waitcnt vmcnt(0)" ::: "memory");
    __syncthreads();
    if (threadIdx.x == 0) {
        unsigned* bar = b.bar;
        __builtin_amdgcn_s_waitcnt(0);
        unsigned nloc = b.st[0], nx = b.st[1];
        if (nloc == 0u) { xcd_barrier_complete(bar, b.x, nloc, nx); b.st[0] = nloc; b.st[1] = nx; }
        const unsigned old = xb_add(&bar[XB_XSUB(b.x)], 1u);
        const unsigned gen = old / nloc;
        if (old + 1u == (gen + 1u) * nloc) {
            __builtin_amdgcn_fence(__ATOMIC_RELEASE, "agent");
            asm volatile("s_waitcnt vmcnt(0)" ::: "memory");
            const unsigned og = xb_add(&bar[XB_TOP], 1u);
            const unsigned tg = og / nx;
            if (og + 1u == (tg + 1u) * nx) xb_add(&bar[XB_TOPGEN], 1u);
            else XB_SPIN(xb_ld(&bar[XB_TOPGEN]) == tg, bar);
            __builtin_amdgcn_fence(__ATOMIC_ACQUIRE, "agent");
            xb_add(&bar[XB_XGEN(b.x)], 1u);
            asm volatile("s_waitcnt vmcnt(0)" ::: "memory");
        } else {
            XB_SPIN(xb_ld(&bar[XB_XGEN(b.x)]) == gen, bar);
            __builtin_amdgcn_fence(__ATOMIC_ACQUIRE, "agent");
            asm volatile("s_waitcnt vmcnt(0)" ::: "memory");
        }
    }
    __syncthreads();
}

__device__ __forceinline__ int opaque_tid() { int t = threadIdx.x; asm volatile("" : "+v"(t)); return t; }
__device__ __forceinline__ bf16_t f2bf(float f) { unsigned u = __float_as_uint(f); u += 0x7fffu + ((u >> 16) & 1u); return (bf16_t)(u >> 16); }
__device__ __forceinline__ float bf2f(bf16_t h) { return __uint_as_float(((unsigned)h) << 16); }
typedef __bf16 hbf2 __attribute__((ext_vector_type(2)));
typedef float f32x2 __attribute__((ext_vector_type(2)));
__device__ __forceinline__ unsigned pack2(float lo, float hi) { f32x2 v = {lo, hi}; return __builtin_bit_cast(unsigned, __builtin_convertvector(v, hbf2)); }
__device__ __forceinline__ float dot2bf(unsigned a, unsigned b, float c) { return __builtin_amdgcn_fdot2_f32_bf16(__builtin_bit_cast(hbf2, a), __builtin_bit_cast(hbf2, b), c, false); }
__device__ __forceinline__ float bflo(unsigned w) { return __uint_as_float(w << 16); }
__device__ __forceinline__ float bfhi(unsigned w) { return __uint_as_float(w & 0xffff0000u); }
template <int CTRL> __device__ __forceinline__ float dpp_f(float v) { return __uint_as_float((unsigned)__builtin_amdgcn_update_dpp(0, (int)__float_as_uint(v), CTRL, 0xf, 0xf, true)); }
__device__ __forceinline__ float wave_sum(float v) {
    v += dpp_f<0xB1>(v);
    v += dpp_f<0x4E>(v);
    v += dpp_f<0x141>(v);
    v += dpp_f<0x140>(v);
    const float a = __uint_as_float((unsigned)__builtin_amdgcn_readlane((int)__float_as_uint(v), 0)), b = __uint_as_float((unsigned)__builtin_amdgcn_readlane((int)__float_as_uint(v), 16));
    const float c = __uint_as_float((unsigned)__builtin_amdgcn_readlane((int)__float_as_uint(v), 32)), d = __uint_as_float((unsigned)__builtin_amdgcn_readlane((int)__float_as_uint(v), 48));
    return (a + b) + (c + d);
}
__device__ __forceinline__ float wave_max(float v) {
    v = fmaxf(v, dpp_f<0xB1>(v)); v = fmaxf(v, dpp_f<0x4E>(v)); v = fmaxf(v, dpp_f<0x141>(v)); v = fmaxf(v, dpp_f<0x140>(v));
    const float a = __uint_as_float((unsigned)__builtin_amdgcn_readlane((int)__float_as_uint(v), 0)), b = __uint_as_float((unsigned)__builtin_amdgcn_readlane((int)__float_as_uint(v), 16));
    const float c = __uint_as_float((unsigned)__builtin_amdgcn_readlane((int)__float_as_uint(v), 32)), d = __uint_as_float((unsigned)__builtin_amdgcn_readlane((int)__float_as_uint(v), 48));
    return fmaxf(fmaxf(a, b), fmaxf(c, d));
}
__device__ __forceinline__ float gelu_tanh(float x) {
    const float u = 0.7978845608028654f * (x + 0.044715f * x * x * x);
    const float e = __expf(-2.f * fabsf(u));
    float th = (1.f - e) / (1.f + e);
    th = u < 0.f ? -th : th;
    return 0.5f * x * (1.f + th);
}

__device__ void p0_cond(const Params& p, unsigned char* smem) {
    float* sc = (float*)smem;
    float* red = (float*)(smem + 16384);
    const int tid = threadIdx.x;
    for (int i = tid; i < 4 * D; i += NT) { const float v = p.c[i]; sc[i] = v / (1.f + __expf(-v)); }
    __syncthreads();
    const int cgp = tid & 15, kg = tid >> 4;
    for (int task = blockIdx.x; task < NCOND * D / 64; task += gridDim.x) {
        const int col0 = task * 64 + cgp * 4;
        float acc[4][4];
#pragma unroll
        for (int b = 0; b < 4; ++b)
#pragma unroll
            for (int j = 0; j < 4; ++j) acc[b][j] = 0.f;
#pragma unroll 1
        for (int k0 = 0; k0 < 32; k0 += 8) {
            f32x4 w[8];
#pragma unroll
            for (int j = 0; j < 8; ++j) w[j] = *(const f32x4*)(p.w_cond + (size_t)(kg + 32 * (k0 + j)) * (NCOND * D) + col0);
#pragma unroll
            for (int j = 0; j < 8; ++j)
#pragma unroll
                for (int b = 0; b < 4; ++b) { const float s = sc[b * D + kg + 32 * (k0 + j)];
#pragma unroll
                    for (int e = 0; e < 4; ++e) acc[b][e] += s * w[j][e]; }
        }
#pragma unroll
        for (int b = 0; b < 4; ++b)
#pragma unroll
            for (int j = 0; j < 4; ++j) red[(kg * 64 + cgp * 4 + j) * 4 + b] = acc[b][j];
        __syncthreads();
        if (tid < 256) {
            const int col = tid >> 2, b = tid & 3;
            float s = 0.f;
            for (int g = 0; g < 32; ++g) s += red[(g * 64 + col) * 4 + b];
            p.cond[(size_t)b * (NCOND * D) + task * 64 + col] = s + p.b_cond[task * 64 + col];
        }
        __syncthreads();
    }
}

__device__ void p0_tables(const Params& p) {
    const size_t gtid = (size_t)blockIdx.x * NT + threadIdx.x, gstride = (size_t)gridDim.x * NT;
    {
        const int li = threadIdx.x & 15;
        const size_t grp = gtid >> 4, ngrp = gstride >> 4;
        for (int which = 0; which < 2; ++which) {
            const float* src = which ? p.peer_v : p.peer_u; unsigned char* dst = which ? p.vb : p.ub; float* sdst = which ? p.sv : p.su;
            for (size_t row = grp; row < (size_t)2 * NEXP; row += ngrp) {
                f32x4 v[2][8]; float ss = 0.f;
#pragma unroll
                for (int c = 0; c < 2; ++c)
#pragma unroll
                    for (int j = 0; j < 8; ++j) {
                        v[c][j] = *(const f32x4*)(src + row * D + c * 512 + li * 32 + j * 4);
#pragma unroll
                        for (int e = 0; e < 4; ++e) ss += v[c][j][e] * v[c][j][e];
                    }
                ss += __shfl_xor(ss, 1); ss += __shfl_xor(ss, 2); ss += __shfl_xor(ss, 4); ss += __shfl_xor(ss, 8);
                const float rms = sqrtf(ss * (1.f / D)), step = 0.48f * rms, inv = step > 0.f ? 1.f / step : 0.f;
#pragma unroll
                for (int c = 0; c < 2; ++c) {
                    u32x4 o;
#pragma unroll
                    for (int d = 0; d < 4; ++d) {
                        unsigned wd = 0u;
                        if (true) {
                            wd = __builtin_amdgcn_cvt_scalef32_pk_fp4_f32(wd, v[c][d * 2][0] * inv, v[c][d * 2][1] * inv, 1.0f, 0);
                            wd = __builtin_amdgcn_cvt_scalef32_pk_fp4_f32(wd, v[c][d * 2][2] * inv, v[c][d * 2][3] * inv, 1.0f, 1);
                            wd = __builtin_amdgcn_cvt_scalef32_pk_fp4_f32(wd, v[c][d * 2 + 1][0] * inv, v[c][d * 2 + 1][1] * inv, 1.0f, 2);
                            wd = __builtin_amdgcn_cvt_scalef32_pk_fp4_f32(wd, v[c][d * 2 + 1][2] * inv, v[c][d * 2 + 1][3] * inv, 1.0f, 3);
                        } else {
#pragma unroll
                            for (int k = 0; k < 8; ++k) {
                                const float x = v[c][d * 2 + (k >> 2)][k & 3];
                                const int n = (int)fminf(fmaxf(floorf(x * inv + 8.f), 0.f), 15.f);
                                wd |= (unsigned)n << (4 * ((k >> 1) + 4 * (k & 1)));
                            }
                        }
                        o[d] = wd;
                    }
                    *(u32x4*)(dst + row * 512 + c * 256 + li * 16) = o;
                }
                if (li == 0) sdst[row] = step;
            }
        }
    }
    const size_t nk8 = (size_t)2 * 8 * 2 * 128 * 64 / 8;
    for (size_t i = gtid; i < nk8; i += gstride) {
        const f32x4 a = *(const f32x4*)(p.subkeys + i * 8), b = *(const f32x4*)(p.subkeys + i * 8 + 4);
        u32x4 o; o[0] = pack2(a[0], a[1]); o[1] = pack2(a[2], a[3]); o[2] = pack2(b[0], b[1]); o[3] = pack2(b[2], b[3]);
        *(u32x4*)(p.skeys + i * 8) = o;
    }
    for (size_t i = gtid; i < (size_t)T * 32; i += gstride) {
        const int t = (int)(i >> 5), f = (int)(i & 31);
        const float invrev = exp2f(-(float)f * 0.41524101186092029f) * 0.15915494309189535f;
        float rev = (float)p.pos[t] * invrev; rev -= floorf(rev);
        p.ropec[i] = __builtin_amdgcn_cosf(rev); p.ropes[i] = __builtin_amdgcn_sinf(rev);
    }
}

__device__ void p0_wt(const Params& p, unsigned char* smem) {
    bf16_t* tl = (bf16_t*)smem;
    const int tid = opaque_tid(), kk = tid >> 3, nn = (tid & 7) * 8;
    for (int task = blockIdx.x; task < 7 * 64 + 32; task += gridDim.x) {
        const int w = task >> 6, gi = task & 63;
        const float* W; bf16_t* Wt; int ldw = 1024;
        switch (w) {
            case 0: W = p.w_in; Wt = p.wt_in; break;
            case 1: W = p.w_glu; Wt = p.wt_glu; break;
            case 2: W = p.w_out; Wt = p.wt_out; break;
            case 3: W = p.w_q; Wt = p.wt_q; break;
            case 4: W = p.w_o; Wt = p.wt_o; break;
            case 5: W = p.peer_wq; Wt = p.wt_pq0; break;
            case 6: W = p.peer_wq + (size_t)D * D; Wt = p.wt_pq1; break;
            default: W = p.w_kv; Wt = p.wt_kv; ldw = 512; break;
        }
        const int ngn = ldw / 256, n0 = (gi % ngn) * 256, k0 = (gi / ngn) * 64;
        f32x4 a[4], b[4];
#pragma unroll
        for (int t4 = 0; t4 < 4; ++t4) { a[t4] = *(const f32x4*)(W + (size_t)(k0 + kk) * ldw + n0 + t4 * 64 + nn); b[t4] = *(const f32x4*)(W + (size_t)(k0 + kk) * ldw + n0 + t4 * 64 + nn + 4); }
#pragma unroll
        for (int t4 = 0; t4 < 4; ++t4)
#pragma unroll
            for (int j = 0; j < 4; ++j) { tl[(t4 * 64 + nn + j) * 72 + kk] = f2bf(a[t4][j]); tl[(t4 * 64 + nn + 4 + j) * 72 + kk] = f2bf(b[t4][j]); }
        __syncthreads();
        const int n = tid >> 3, kc = (tid & 7) * 8;
#pragma unroll
        for (int t4 = 0; t4 < 4; ++t4) {
            const u32x4 v = *(const u32x4*)(tl + (t4 * 64 + n) * 72 + kc);
            *(u32x4*)(Wt + (size_t)(n0 + t4 * 64 + n) * D + k0 + kc) = v;
        }
        __syncthreads();
    }
}

__device__ __forceinline__ void lam_powf(float ar, float ai, float dt, int n, float& re, float& im) {
    const float m = __expf(ar * dt * (float)n);
    float rev = (ai * dt) * (float)n * 0.15915494309189535f; rev -= floorf(rev);
    re = m * __builtin_amdgcn_cosf(rev); im = m * __builtin_amdgcn_sinf(rev);
}
__device__ __forceinline__ void s5_coeff(float ar, float ai, float dt, float& cre, float& cim) {
    const float a = ar * dt, th = ai * dt;
    float rev = th * 0.15915494309189535f; rev -= floorf(rev);
    float revh = th * 0.5f * 0.15915494309189535f; revh -= floorf(revh);
    const float cs = __builtin_amdgcn_cosf(rev), sn = __builtin_amdgcn_sinf(rev), sh = __builtin_amdgcn_sinf(revh);
    const float em1 = expm1f(a);
    const float nr = em1 * cs - 2.f * sh * sh, ni = (em1 + 1.f) * sn, den = ar * ar + ai * ai;
    cre = (nr * ar + ni * ai) / den; cim = (ni * ar - nr * ai) / den;
}

__device__ void p0_s5(const Params& p, unsigned char* smem) {
    const size_t gtid = (size_t)blockIdx.x * NT + threadIdx.x, gstride = (size_t)gridDim.x * NT;
    for (size_t idx = gtid; idx < (size_t)G5 * P5 * 65; idx += gstride) {
        const int pp = (int)(idx & 63), e = (int)((idx >> 6) % 65), g = (int)(idx / (65 * P5));
        const float dt = __expf(p.log_dt[g]), ar = p.a_re[g * P5 + pp], ai = p.a_im[g * P5 + pp];
        float pwr, pwi; lam_powf(ar, ai, dt, e, pwr, pwi);
        if (e < 64) {
            float cfr, cfi; s5_coeff(ar, ai, dt, cfr, cfi);
            const float wr = pwr * cfr - pwi * cfi, wi = pwr * cfi + pwi * cfr;
            const int j = 63 - e;
            const float* brp = p.b_re + ((size_t)g * P5 + pp) * C5; const float* bip = p.b_im + ((size_t)g * P5 + pp) * C5;
            unsigned ore[8], oim[8];
#pragma unroll
            for (int c4 = 0; c4 < 4; ++c4) {
                const f32x4 br = *(const f32x4*)(brp + c4 * 4), bi = *(const f32x4*)(bip + c4 * 4);
                ore[c4 * 2] = pack2(wr * br[0] - wi * bi[0], wr * br[1] - wi * bi[1]); ore[c4 * 2 + 1] = pack2(wr * br[2] - wi * bi[2], wr * br[3] - wi * bi[3]);
                oim[c4 * 2] = pack2(wr * bi[0] + wi * br[0], wr * bi[1] + wi * br[1]); oim[c4 * 2 + 1] = pack2(wr * bi[2] + wi * br[2], wr * bi[3] + wi * br[3]);
            }
            u32x4* sre = (u32x4*)(p.smat + ((size_t)g * 128 + pp) * 1024 + j * 16);
            u32x4* sim = (u32x4*)(p.smat + ((size_t)g * 128 + 64 + pp) * 1024 + j * 16);
            sre[0] = (u32x4){ore[0], ore[1], ore[2], ore[3]}; sre[1] = (u32x4){ore[4], ore[5], ore[6], ore[7]};
            sim[0] = (u32x4){oim[0], oim[1], oim[2], oim[3]}; sim[1] = (u32x4){oim[4], oim[5], oim[6], oim[7]};
        }
        if (e >= 1) {
            const int i = e - 1;
#pragma unroll 4
            for (int co = 0; co < 16; ++co) {
                const float cr = p.c_re[((size_t)g * C5 + co) * P5 + pp], ci = p.c_im[((size_t)g * C5 + co) * P5 + pp];
                bf16_t* row = p.cmat + ((size_t)g * 1024 + i * 16 + co) * 128;
                row[pp] = f2bf(cr * pwr - ci * pwi);
                row[64 + pp] = f2bf(-(cr * pwi + ci * pwr));
            }
        }
        if (e == 64) {
            const double dtd = exp((double)p.log_dt[g]), m = exp((double)ar * dtd * 64.0);
            double ang = (double)ai * dtd * 64.0; ang -= 6.283185307179586 * floor(ang * 0.15915494309189535);
            p.lamL[(g * P5 + pp) * 2] = (float)(m * cos(ang)); p.lamL[(g * P5 + pp) * 2 + 1] = (float)(m * sin(ang));
        }
    }
    float* wre = (float*)smem;
    float* wim = wre + 1024;
    const int tid = threadIdx.x;
    for (int task = blockIdx.x; task < G5 * 4; task += gridDim.x) {
        const int g = task >> 2, tq = task & 3;
        const float dt = __expf(p.log_dt[g]);
        for (int i = tid; i < 1024; i += NT) {
            const int pp = i & 63, tau = tq * 16 + (i >> 6);
            const float ar = p.a_re[g * P5 + pp], ai = p.a_im[g * P5 + pp];
            float pwr, pwi, cfr, cfi; lam_powf(ar, ai, dt, tau, pwr, pwi); s5_coeff(ar, ai, dt, cfr, cfi);
            wre[i] = pwr * cfr - pwi * cfi; wim[i] = pwr * cfi + pwi * cfr;
        }
        __syncthreads();
        {
            const int co = (tid >> 4) & 15, ci = tid & 15, ph = tid >> 8;
            float* part = wim + 1024;
            float cbr[32], cbi[32];
#pragma unroll 8
            for (int k = 0; k < 32; ++k) {
                const int pp = ph * 32 + k;
                const float br = p.b_re[((size_t)g * P5 + pp) * C5 + ci], bi = p.b_im[((size_t)g * P5 + pp) * C5 + ci];
                const float cr = p.c_re[((size_t)g * C5 + co) * P5 + pp], cim = p.c_im[((size_t)g * C5 + co) * P5 + pp];
                cbr[k] = cr * br - cim * bi; cbi[k] = cr * bi + cim * br;
            }
            float sres[16];
#pragma unroll
            for (int tl = 0; tl < 16; ++tl) {
                float s0 = 0.f, s1 = 0.f;
#pragma unroll
                for (int k = 0; k < 32; k += 2) {
                    s0 += cbr[k] * wre[tl * 64 + ph * 32 + k] - cbi[k] * wim[tl * 64 + ph * 32 + k];
                    s1 += cbr[k + 1] * wre[tl * 64 + ph * 32 + k + 1] - cbi[k + 1] * wim[tl * 64 + ph * 32 + k + 1];
                }
                sres[tl] = s0 + s1;
            }
            if (ph == 1) {
#pragma unroll
                for (int tl = 0; tl < 16; ++tl) part[tl * 256 + (tid & 255)] = sres[tl];
            }
            __syncthreads();
            if (ph == 0) {
#pragma unroll
                for (int tl = 0; tl < 16; ++tl) p.ktab[((size_t)g * KTR + tq * 16 + tl + 8) * 256 + tid] = f2bf(sres[tl] + part[tl * 256 + tid]);
                if (tq == 0) {
#pragma unroll
                    for (int r = 0; r < 8; ++r) p.ktab[((size_t)g * KTR + r) * 256 + tid] = 0;
                }
            }
        }
        __syncthreads();
    }
}

__device__ void p05_prep(const Params& p, unsigned char* smem) {
    {
        const int lane = threadIdx.x & 63, wv = threadIdx.x >> 6;
        const int nw = gridDim.x * (NT / 64);
        for (int t = blockIdx.x * (NT / 64) + wv; t < T; t += nw) {
            const int b = t / SEQ;
            const float* xr = p.x + (size_t)t * D; const float* cb = p.cond + (size_t)b * (NCOND * D);
            f32x4 v[4]; float s = 0.f;
#pragma unroll
            for (int j = 0; j < 4; ++j) { v[j] = *(const f32x4*)(xr + j * 256 + lane * 4); s += v[j][0] * v[j][0] + v[j][1] * v[j][1] + v[j][2] * v[j][2] + v[j][3] * v[j][3]; }
            s = wave_sum(s);
            const float rstd = rsqrtf(s * (1.f / D) + RMS_EPS);
#pragma unroll
            for (int j = 0; j < 4; ++j) {
                const int e = j * 256 + lane * 4;
                const f32x4 g = *(const f32x4*)(p.norm_mix + e), sh = *(const f32x4*)(cb + 0 * D + e), sc = *(const f32x4*)(cb + 1 * D + e);
                float h[4];
#pragma unroll
                for (int i = 0; i < 4; ++i) h[i] = v[j][i] * rstd * g[i] * (1.f + sc[i]) + sh[i];
                u32x2 o; o[0] = pack2(h[0], h[1]); o[1] = pack2(h[2], h[3]);
                *(u32x2*)(p.s0 + (size_t)t * D + e) = o;
            }
        }
    }
    for (int i = blockIdx.x * NT + threadIdx.x; i < 4 * 1024; i += gridDim.x * NT) {
        const int b = i >> 10, k = i & 1023;
        const float* cb = p.cond + (size_t)b * (NCOND * D);
        bf16_t* o = p.cvec + (size_t)b * 12 * 1024 + k;
        o[0 * 1024] = f2bf(p.norm_ffn[k] * (1.f + cb[4 * D + k]));      o[1 * 1024] = f2bf(cb[3 * D + k]);  o[2 * 1024] = f2bf(cb[5 * D + k]);
        o[3 * 1024] = f2bf(p.kv_norm[k] * (1.f + cb[13 * D + k]));      o[4 * 1024] = f2bf(cb[12 * D + k]);
        o[5 * 1024] = f2bf(p.norm_mix[D + k] * (1.f + cb[7 * D + k]));  o[6 * 1024] = f2bf(cb[6 * D + k]);
        o[7 * 1024] = f2bf(p.norm_ffn[D + k] * (1.f + cb[10 * D + k])); o[8 * 1024] = f2bf(cb[9 * D + k]);  o[9 * 1024] = f2bf(cb[11 * D + k]);
        o[10 * 1024] = f2bf(p.final_norm[k] * (1.f + cb[15 * D + k]));  o[11 * 1024] = f2bf(cb[14 * D + k]);
    }
    float* red = (float*)smem;
    const int tid = threadIdx.x;
    for (int task = blockIdx.x; task < 32 * 8; task += gridDim.x) {
        const int ct = task >> 3, ks = task & 7, col0 = ct * 64, layer = col0 >> 10;
        const float* W = p.peer_wq + (size_t)layer * D * D; const int cs = layer ? 9 : 3;
        const int n = (col0 & 1023) + (tid & 63), kg = tid >> 6;
        float wv[16];
#pragma unroll
        for (int j = 0; j < 16; ++j) wv[j] = W[(size_t)(ks * 128 + kg * 16 + j) * D + n];
        float acc[4] = {0.f, 0.f, 0.f, 0.f};
#pragma unroll
        for (int j = 0; j < 16; ++j)
#pragma unroll
            for (int b = 0; b < 4; ++b) acc[b] += p.cond[(size_t)b * (NCOND * D) + cs * D + ks * 128 + kg * 16 + j] * wv[j];
#pragma unroll
        for (int b = 0; b < 4; ++b) red[(kg * 64 + (tid & 63)) * 4 + b] = acc[b];
        __syncthreads();
        if (tid < 256) {
            const int col = tid >> 2, b = tid & 3; float sum = 0.f;
#pragma unroll
            for (int g = 0; g < 8; ++g) sum += red[(g * 64 + col) * 4 + b];
            p.biasp[((size_t)ks * 4 + b) * 2048 + col0 + col] = sum;
        }
        __syncthreads();
    }
}
__device__ void bias_finalize(const Params& p) {
    const int i = blockIdx.x * NT + threadIdx.x;
    if (i < 4 * 2048) { float s = 0.f;
#pragma unroll
        for (int ks = 0; ks < 8; ++ks) s += p.biasp[(size_t)ks * 8192 + i];
        p.bias[i] = s; }
}

__device__ __forceinline__ int lds_off(int row, int chunk) { return row * 128 + ((chunk ^ (row & 7)) << 4); }

template <int BN, class Epi>
__device__ void gemm_phase(const bf16_t* __restrict__ A, const bf16_t* __restrict__ Bt, size_t bt_batch_stride, int N, const Epi& epi, unsigned char* smem) {
    constexpr int WMI = BN == 256 ? 8 : 4;
    constexpr int A_BYTES = 32768, B_BYTES = BN * 128, BUF = A_BYTES + B_BYTES;
    const int tid = opaque_tid(), lane = tid & 63, w = tid >> 6, tk = lane & 15, q = lane >> 4;
    const int wm = BN == 256 ? (w >> 2) : (w >> 1), wn = BN == 256 ? (w & 3) : (w & 1);
    const int nN = N / BN;
    const bool xmap = (gridDim.x % 8) == 0;
    const int nslots = xmap ? gridDim.x / 8 : gridDim.x, slot = xmap ? (blockIdx.x >> 3) : blockIdx.x, xcd = blockIdx.x & 7;
    const int nitems = xmap ? 8 * nN : 64 * nN;
    for (int item = slot; item < nitems; item += nslots) {
        const int pm = xmap ? xcd * 8 + item / nN : item / nN, pn = item % nN;
        const int m0 = pm * 256, n0 = pn * BN, b = m0 / SEQ;
        const bf16_t* Ab = A + (size_t)m0 * D;
        const bf16_t* Bb = Bt + (size_t)b * bt_batch_stride + (size_t)n0 * D;
        f32x4 acc[WMI][4];
#pragma unroll
        for (int mi = 0; mi < WMI; ++mi)
#pragma unroll
            for (int ni = 0; ni < 4; ++ni) acc[mi][ni] = (f32x4){0.f, 0.f, 0.f, 0.f};
        auto stage = [&](int buf, int kt) {
#pragma unroll
            for (int j = 0; j < 4; ++j) {
                const int piece = w * 4 + j, P = piece * 1024 + lane * 16, row = P >> 7, lc = ((P >> 4) & 7) ^ (row & 7);
                __builtin_amdgcn_global_load_lds((const __attribute__((address_space(1))) void*)(Ab + (size_t)row * D + kt * 64 + lc * 8),
                                                 (__attribute__((address_space(3))) void*)(smem + buf * BUF + piece * 1024), 16, 0, 0);
            }
#pragma unroll
            for (int j = 0; j < BN / 64; ++j) {
                const int piece = w * (BN / 64) + j, P = piece * 1024 + lane * 16, row = P >> 7, lc = ((P >> 4) & 7) ^ (row & 7);
                __builtin_amdgcn_global_load_lds((const __attribute__((address_space(1))) void*)(Bb + (size_t)row * D + kt * 64 + lc * 8),
                                                 (__attribute__((address_space(3))) void*)(smem + buf * BUF + A_BYTES + piece * 1024), 16, 0, 0);
            }
        };
        auto compute = [&](int buf) {
            const unsigned char* sA = smem + buf * BUF; const unsigned char* sB = sA + A_BYTES;
#pragma unroll
            for (int ks = 0; ks < 2; ++ks) {
                bf16x8 bfr[4];
#pragma unroll
                for (int ni = 0; ni < 4; ++ni) bfr[ni] = *(const bf16x8*)(sB + lds_off(wn * 64 + ni * 16 + tk, ks * 4 + q));
#pragma unroll
                for (int mh = 0; mh < WMI / 4; ++mh) {
                    bf16x8 af[4];
#pragma unroll
                    for (int mi = 0; mi < 4; ++mi) af[mi] = *(const bf16x8*)(sA + lds_off(wm * (WMI * 16) + (mh * 4 + mi) * 16 + tk, ks * 4 + q));
#pragma unroll
                    for (int mi = 0; mi < 4; ++mi)
#pragma unroll
                        for (int ni = 0; ni < 4; ++ni) acc[mh * 4 + mi][ni] = __builtin_amdgcn_mfma_f32_16x16x32_bf16(bfr[ni], af[mi], acc[mh * 4 + mi][ni], 0, 0, 0);
                }
            }
        };
        stage(0, 0);
        __syncthreads();
#pragma unroll 1
        for (int kt = 0; kt < 16; ++kt) {
            if (kt + 1 < 16) stage((kt + 1) & 1, kt + 1);
            compute(kt & 1);
            __syncthreads();
        }
        float* stg = (float*)(smem + w * 17408);
#pragma unroll
        for (int mh = 0; mh < WMI / 4; ++mh) {
#pragma unroll
            for (int mi = 0; mi < 4; ++mi)
#pragma unroll
                for (int ni = 0; ni < 4; ++ni) *(f32x4*)(stg + (mi * 16 + tk) * 68 + ni * 16 + 4 * q) = acc[mh * 4 + mi][ni];
            asm volatile("s_waitcnt lgkmcnt(0)" ::: "memory");
            const int c4 = lane & 15, rsub = lane >> 4;
#pragma unroll 4
            for (int ps = 0; ps < 16; ++ps) {
                const int row = ps * 4 + rsub;
                const f32x4 v = *(const f32x4*)(stg + row * 68 + c4 * 4);
                epi.row(m0 + wm * (WMI * 16) + mh * 64 + row, n0 + wn * 64, c4, v, b, pn * (BN / 64) + wn);
            }
            asm volatile("s_waitcnt lgkmcnt(0)" ::: "memory");
        }
        __syncthreads();
    }
}

__device__ __forceinline__ float rstd_of(const float* ssq, int token) {
    const f32x4* s4 = (const f32x4*)(ssq + (size_t)token * 16);
    const f32x4 a = s4[0], b = s4[1], c = s4[2], d = s4[3];
    const float s = ((a[0] + a[1]) + (a[2] + a[3])) + ((b[0] + b[1]) + (b[2] + b[3])) + ((c[0] + c[1]) + (c[2] + c[3])) + ((d[0] + d[1]) + (d[2] + d[3]));
    return rsqrtf(s * (1.f / D) + RMS_EPS);
}

template <int CTRL> __device__ __forceinline__ float dppx(float v) { return __uint_as_float((unsigned)__builtin_amdgcn_update_dpp(0, (int)__float_as_uint(v), CTRL, 0xf, 0xf, true)); }
struct EpiU {
    bf16_t* ug;
    __device__ __forceinline__ void row(int token, int nbase, int c4, f32x4 v, int b, int) const {
        const int n = nbase + 4 * c4, g = n >> 4, s = token - b * SEQ;
        u32x2 o; o[0] = pack2(v[0], v[1]); o[1] = pack2(v[2], v[3]);
        *(u32x2*)(ug + (((size_t)(g * 4 + b) * SEQ + s) * 16 + (n & 15))) = o;
    }
};
struct EpiQ {
    const float* ssq; const float* bias; int boff; bf16_t* out;
    __device__ __forceinline__ void row(int token, int nbase, int c4, f32x4 v, int b, int) const {
        const int n = nbase + 4 * c4;
        const float rstd = rstd_of(ssq, token);
        const f32x4 bv = *(const f32x4*)(bias + (size_t)b * 2048 + boff + n);
        u32x2 o; o[0] = pack2(rstd * v[0] + bv[0], rstd * v[1] + bv[1]); o[1] = pack2(rstd * v[2] + bv[2], rstd * v[3] + bv[3]);
        *(u32x2*)(out + (size_t)token * D + n) = o;
    }
};
struct EpiGlu {
    const bf16_t* y; const float* bglu; bf16_t* out;
    __device__ __forceinline__ void row(int token, int nbase, int c4, f32x4 v, int, int) const {
        const int n = nbase + 4 * c4;
        const f32x4 bv = *(const f32x4*)(bglu + n);
        const u32x2 yv = *(const u32x2*)(y + (size_t)token * D + n);
        const float o0 = bflo(yv[0]) / (1.f + __expf(-(v[0] + bv[0]))), o1 = bfhi(yv[0]) / (1.f + __expf(-(v[1] + bv[1])));
        const float o2 = bflo(yv[1]) / (1.f + __expf(-(v[2] + bv[2]))), o3 = bfhi(yv[1]) / (1.f + __expf(-(v[3] + bv[3])));
        u32x2 ov; ov[0] = pack2(o0, o1); ov[1] = pack2(o2, o3);
        *(u32x2*)(out + (size_t)token * D + n) = ov;
    }
};
struct EpiRes {
    const float* xold; const float* gate  ; const float* gnorm; const float* scale  ; float* xout; bf16_t* xbout; float* ssq;
    __device__ __forceinline__ void row(int token, int nbase, int c4, f32x4 v, int b, int slot) const {
        const int n = nbase + 4 * c4;
        const f32x4 gv = *(const f32x4*)(gate + (size_t)b * (NCOND * D) + n), gn = *(const f32x4*)(gnorm + n), sc = *(const f32x4*)(scale + (size_t)b * (NCOND * D) + n);
        const f32x4 xo = *(const f32x4*)(xold + (size_t)token * D + n);
        f32x4 xn; float hs[4]; float ss = 0.f;
#pragma unroll
        for (int r = 0; r < 4; ++r) { xn[r] = xo[r] + gv[r] * v[r]; ss += xn[r] * xn[r]; hs[r] = xn[r] * gn[r] * (1.f + sc[r]); }
        *(f32x4*)(xout + (size_t)token * D + n) = xn;
        u32x2 ov; ov[0] = pack2(hs[0], hs[1]); ov[1] = pack2(hs[2], hs[3]);
        *(u32x2*)(xbout + (size_t)token * D + n) = ov;
        ss += dppx<0xB1>(ss); ss += dppx<0x4E>(ss); ss += dppx<0x141>(ss); ss += dppx<0x140>(ss);
        if (c4 == 0) ssq[(size_t)token * 16 + slot] = ss;
    }
};
template <int MODE  >
struct EpiRope {
    const float* ropec; const float* ropes; bf16_t* o0; bf16_t* o1;
    __device__ __forceinline__ void row(int token, int nbase, int c4, f32x4 v, int, int) const {
        const bool rope = MODE == 1 || nbase < 256;
        if (rope) {
            f32x4 pv;
#pragma unroll
            for (int r = 0; r < 4; ++r) pv[r] = dppx<0x128>(v[r]);
            const int d = (c4 & 7) * 4;
            const f32x4 cs = *(const f32x4*)(ropec + (size_t)token * 32 + d), sn = *(const f32x4*)(ropes + (size_t)token * 32 + d);
            if (c4 < 8) {
#pragma unroll
                for (int r = 0; r < 4; ++r) v[r] = v[r] * cs[r] - pv[r] * sn[r];
            } else {
#pragma unroll
                for (int r = 0; r < 4; ++r) v[r] = v[r] * cs[r] + pv[r] * sn[r];
            }
        }
        const int n = nbase + 4 * c4;
        bf16_t* dst = MODE == 1 ? o0 + (size_t)token * D + n : (nbase < 256 ? o0 + (size_t)token * 256 + n : o1 + (size_t)token * 256 + (n - 256));
        u32x2 o; o[0] = pack2(v[0], v[1]); o[1] = pack2(v[2], v[3]);
        *(u32x2*)dst = o;
    }
};

__device__ void s5_phase(const Params& p, unsigned char* smem) {
    bf16_t* ktl = (bf16_t*)smem;
    float* Sl = (float*)(smem + 36864);
    bf16_t* Xl = (bf16_t*)(smem + 36864 + 33280);
    const int tid = opaque_tid(), lane = tid & 63, w = tid >> 6, cb = w & 3, hh = w >> 2, tk = lane & 15, q = lane >> 4;
    for (int task = blockIdx.x; task < G5 * NB; task += gridDim.x) {
        const int g = (task & 7) * 8 + ((task >> 3) >> 2), b = (task >> 3) & 3;
        const bf16_t* U = p.s1 + (size_t)(g * 4 + b) * SEQ * 16;
        const bf16_t* sm = p.smat + (size_t)g * 128 * 1024;
        const bf16_t* cm = p.cmat + (size_t)g * 1024 * 128;
        for (int i = tid; i < KTR * 256 * 2 / 16; i += NT) ((u32x4*)ktl)[i] = ((const u32x4*)(p.ktab + (size_t)g * KTR * 256))[i];
        bf16x8 ufr[32];
#pragma unroll
        for (int ks = 0; ks < 32; ++ks) ufr[ks] = *(const bf16x8*)(U + (size_t)(cb * 16 + tk) * 1024 + ks * 32 + 8 * q);
        {
            bf16x8 afA[4], afB[4];
            auto lda = [&](bf16x8 (&af)[4], int seq) {
                const int mf = seq >> 3, k4 = seq & 7;
                const bf16_t* ap = sm + (size_t)((hh * 4 + mf) * 16 + tk) * 1024 + 8 * q + k4 * 128;
#pragma unroll
                for (int j = 0; j < 4; ++j) af[j] = *(const bf16x8*)(ap + j * 32);
            };
            f32x4 acc = {0.f, 0.f, 0.f, 0.f};
            auto mma = [&](const bf16x8 (&af)[4], int seq) {
                const int k4 = seq & 7;
#pragma unroll
                for (int j = 0; j < 4; ++j) acc = __builtin_amdgcn_mfma_f32_16x16x32_bf16(af[j], ufr[k4 * 4 + j], acc, 0, 0, 0);
                if (k4 == 7) {
                    const int r0 = (hh * 4 + (seq >> 3)) * 16;
#pragma unroll
                    for (int r = 0; r < 4; ++r) Sl[(r0 + 4 * q + r) * 65 + cb * 16 + tk] = acc[r];
                    acc = (f32x4){0.f, 0.f, 0.f, 0.f};
                }
            };
            lda(afA, 0);
#pragma unroll
            for (int seq = 0; seq < 32; seq += 2) {
                lda(afB, seq + 1);
                mma(afA, seq);
                if (seq + 2 < 32) lda(afA, seq + 2);
                mma(afB, seq + 1);
            }
        }
        __syncthreads();
        if (w == 0) {
            const float lr = p.lamL[(g * P5 + lane) * 2], li = p.lamL[(g * P5 + lane) * 2 + 1];
            float xr = 0.f, xi = 0.f;
#pragma unroll 1
            for (int k0 = 0; k0 < NCH; k0 += 8) {
                float sr[8], si[8];
#pragma unroll
                for (int j = 0; j < 8; ++j) { sr[j] = Sl[lane * 65 + k0 + j]; si[j] = Sl[(64 + lane) * 65 + k0 + j]; }
#pragma unroll
                for (int j = 0; j < 8; ++j) {
                    Xl[(k0 + j) * 128 + lane] = f2bf(xr); Xl[(k0 + j) * 128 + 64 + lane] = f2bf(xi);
                    const float nr = lr * xr - li * xi + sr[j], ni = lr * xi + li * xr + si[j];
                    xr = nr; xi = ni;
                }
            }
        }
        __syncthreads();
        bf16x8 xfr[4];
#pragma unroll
        for (int ks = 0; ks < 4; ++ks) xfr[ks] = *(const bf16x8*)(Xl + (cb * 16 + tk) * 128 + ks * 32 + 8 * q);
        const f32x4 dv = *(const f32x4*)(p.s5d + g * 16 + 4 * q);
        const int jl = q >> 1, cih = q & 1;
        const bf16_t* kbase = ktl + (8 - jl) * 256 + tk * 16 + cih * 8;
        const bf16_t* cmb = cm + (size_t)tk * 128 + 8 * q;
        auto iof = [&](int ii) { return hh ? 16 + ii : (ii < 16 ? ii : 32 + ii); };
        bf16x8 cf[4];
#pragma unroll
        for (int ks = 0; ks < 4; ++ks) cf[ks] = *(const bf16x8*)(cmb + (size_t)iof(0) * 2048 + ks * 32);
#pragma unroll 1
        for (int ii = 0; ii < 32; ++ii) {
            const int i = iof(ii), inext = iof(ii < 31 ? ii + 1 : ii);
            bf16x8 cfn[4];
#pragma unroll
            for (int ks = 0; ks < 4; ++ks) cfn[ks] = *(const bf16x8*)(cmb + (size_t)inext * 2048 + ks * 32);
            const int s = (cb * 16 + tk) * 64 + i;
            const u32x2 uv = *(const u32x2*)(U + (size_t)s * 16 + 4 * q);
            f32x4 acc = {0.f, 0.f, 0.f, 0.f};
#pragma unroll
            for (int ks = 0; ks < 4; ++ks) acc = __builtin_amdgcn_mfma_f32_16x16x32_bf16(cf[ks], xfr[ks], acc, 0, 0, 0);
            const int mmax = i >> 1;
            const bf16_t* kb = kbase + i * 256;
#pragma unroll
            for (int mg = 0; mg < 8; ++mg) {
                if (4 * mg <= mmax) {
                    bf16x8 kf[4];
#pragma unroll
                    for (int j = 0; j < 4; ++j) kf[j] = *(const bf16x8*)(kb - (4 * mg + j) * 512);
#pragma unroll
                    for (int j = 0; j < 4; ++j) acc = __builtin_amdgcn_mfma_f32_16x16x32_bf16(kf[j], ufr[4 * mg + j], acc, 0, 0, 0);
                }
            }
            const float y0 = gelu_tanh(acc[0] + dv[0] * bflo(uv[0])), y1 = gelu_tanh(acc[1] + dv[1] * bfhi(uv[0]));
            const float y2 = gelu_tanh(acc[2] + dv[2] * bflo(uv[1])), y3 = gelu_tanh(acc[3] + dv[3] * bfhi(uv[1]));
            u32x2 o; o[0] = pack2(y0, y1); o[1] = pack2(y2, y3);
            *(u32x2*)(p.s0 + ((size_t)b * SEQ + s) * D + g * 16 + 4 * q) = o;
#pragma unroll
            for (int ks = 0; ks < 4; ++ks) cf[ks] = cfn[ks];
        }
        __syncthreads();
    }
}

__device__ __forceinline__ float med3f(float a, float b, float c) { return __builtin_amdgcn_fmed3f(a, b, c); }
__device__ __forceinline__ void ins16(float (&a)[16], float v) {
#pragma unroll
    for (int i = 15; i >= 1; --i) a[i] = med3f(a[i - 1], a[i], v);
    a[0] = fmaxf(a[0], v);
}
__device__ void route_phase(const Params& p, int layer, const bf16_t* qp, unsigned char* smem) {
    float* sc = (float*)smem;
    float* tl = (float*)(smem + 2 * 128 * 129 * 4);
    const int tid = opaque_tid(), lane = tid & 63, w = tid >> 6, tk = lane & 15, q = lane >> 4;
    const bool fixed = (gridDim.x & 7) == 0;
    const int ntask = (T / 128) * 8;
    int cur_h = -1;
    bf16x8 kf[2][8][2];
    for (int it = 0;; ++it) {
        int h, tt;
        if (fixed) { h = blockIdx.x & 7; tt = (blockIdx.x >> 3) + it * (gridDim.x >> 3); if (tt >= T / 128) break; }
        else { const int task = blockIdx.x + it * gridDim.x; if (task >= ntask) break; h = task & 7; tt = task >> 3; }
        const int t0 = tt * 128;
        if (h != cur_h) {
            cur_h = h;
#pragma unroll
            for (int pp = 0; pp < 2; ++pp)
#pragma unroll
                for (int nf = 0; nf < 8; ++nf) {
                    const bf16_t* kb = p.skeys + ((size_t)((layer * 8 + h) * 2 + pp) * 128 + nf * 16 + tk) * 64 + 8 * q;
                    kf[pp][nf][0] = *(const bf16x8*)(kb); kf[pp][nf][1] = *(const bf16x8*)(kb + 32);
                }
        }
        {
            const bf16_t* qrow = qp + (size_t)(t0 + 16 * w + tk) * D + h * 128 + 8 * q;
            const bf16x8 a00 = *(const bf16x8*)(qrow), a01 = *(const bf16x8*)(qrow + 32), a10 = *(const bf16x8*)(qrow + 64), a11 = *(const bf16x8*)(qrow + 96);
#pragma unroll
            for (int pp = 0; pp < 2; ++pp)
#pragma unroll
                for (int nf = 0; nf < 8; ++nf) {
                    f32x4 acc = {0.f, 0.f, 0.f, 0.f};
                    acc = __builtin_amdgcn_mfma_f32_16x16x32_bf16(pp ? a10 : a00, kf[pp][nf][0], acc, 0, 0, 0);
                    acc = __builtin_amdgcn_mfma_f32_16x16x32_bf16(pp ? a11 : a01, kf[pp][nf][1], acc, 0, 0, 0);
#pragma unroll
                    for (int r = 0; r < 4; ++r) sc[(pp * 128 + 16 * w + 4 * q + r) * 129 + nf * 16 + tk] = acc[r];
                }
        }
        __syncthreads();
        {
            const int list = tid & 255, kr = tid >> 8;
            float a[16];
#pragma unroll
            for (int i = 0; i < 16; ++i) a[i] = -3.0e38f;
            const float* row = sc + list * 129 + kr * 64;
#pragma unroll 1
            for (int j0 = 0; j0 < 64; j0 += 8) {
                float rv[8];
#pragma unroll
                for (int j = 0; j < 8; ++j) rv[j] = row[j0 + j];
#pragma unroll
                for (int j = 0; j < 8; ++j) {
                    const float v = __uint_as_float((__float_as_uint(rv[j]) & ~0x7Fu) | (unsigned)(kr * 64 + j0 + j));
                    ins16(a, v);
                }
            }
            if (kr == 1) {
#pragma unroll
                for (int i = 0; i < 16; ++i) tl[list * 16 + i] = a[i];
            }
            __syncthreads();
            if (kr == 0) {
                float o[16];
#pragma unroll
                for (int i = 0; i < 16; ++i) o[i] = tl[list * 16 + i];
#pragma unroll
                for (int i = 0; i < 16; ++i) ins16(a, o[i]);
#pragma unroll
                for (int i = 0; i < 16; ++i) tl[list * 16 + i] = a[i];
            }
            __syncthreads();
        }
        if (tid < 128) {
            float s[16], r[16], c[16];
#pragma unroll
            for (int i = 0; i < 16; ++i) { s[i] = tl[tid * 16 + i]; r[i] = tl[(128 + tid) * 16 + i]; c[i] = -3.0e38f; }
#pragma unroll
            for (int i = 0; i < 16; ++i)
#pragma unroll
                for (int j = 0; j < 16; ++j)
                    if ((i + 1) * (j + 1) <= 16) {
                        const float v = __uint_as_float((__float_as_uint(s[i] + r[j]) & ~0xFFu) | (unsigned)(i * 16 + j));
                        ins16(c, v);
                    }
            float e[16], sum = 0.f;
#pragma unroll
            for (int k = 0; k < 16; ++k) { e[k] = __expf(c[k] - c[0]); sum += e[k]; }
            const float inv = 1.f / sum;
            int idv[16];
#pragma unroll
            for (int k = 0; k < 16; ++k) {
                const unsigned bits = __float_as_uint(c[k]), i = (bits >> 4) & 15u, j = bits & 15u;
                const unsigned ki = __float_as_uint(tl[tid * 16 + i]) & 0x7Fu, kj = __float_as_uint(tl[(128 + tid) * 16 + j]) & 0x7Fu;
                idv[k] = (int)(ki * 128u + kj);
            }
            int* ido = p.ids + (size_t)(t0 + tid) * 128 + h * 16; float* go = p.gates + (size_t)(t0 + tid) * 128 + h * 16; float* so = p.sus + (size_t)(t0 + tid) * 128 + h * 16;
            const float* sut = p.su + (size_t)layer * NEXP; const float* svt = p.sv + (size_t)layer * NEXP;
            float sug[16], svg[16];
#pragma unroll
            for (int k = 0; k < 16; ++k) { sug[k] = sut[idv[k]]; svg[k] = svt[idv[k]]; }
#pragma unroll
            for (int k4 = 0; k4 < 4; ++k4) {
                *(int4*)(ido + k4 * 4) = make_int4(idv[k4 * 4], idv[k4 * 4 + 1], idv[k4 * 4 + 2], idv[k4 * 4 + 3]);
                *(f32x4*)(go + k4 * 4) = (f32x4){e[k4 * 4] * inv * svg[k4 * 4], e[k4 * 4 + 1] * inv * svg[k4 * 4 + 1], e[k4 * 4 + 2] * inv * svg[k4 * 4 + 2], e[k4 * 4 + 3] * inv * svg[k4 * 4 + 3]};
                *(f32x4*)(so + k4 * 4) = (f32x4){sug[k4 * 4], sug[k4 * 4 + 1], sug[k4 * 4 + 2], sug[k4 * 4 + 3]};
            }
        }
        __syncthreads();
    }
}

typedef _Float16 h16x2 __attribute__((ext_vector_type(2)));
typedef int i32x8 __attribute__((ext_vector_type(8)));
#ifndef NVR
#define NVR 16
#endif
template <bool FINAL>
__device__ void gather_phase(const Params& p, int layer, const float* xin, float* xout, bf16_t* hkv_out, bf16_t* hq_out, unsigned char* smem) {
    const int tid_ = opaque_tid(), lane = tid_ & 63, wv = tid_ >> 6, tk = lane & 15, q = lane >> 4;
    const int nw = gridDim.x * (NT / 64);
    const unsigned char* utab = p.ub + (size_t)layer * NEXP * 512;
    const unsigned char* vtab = p.vb + (size_t)layer * NEXP * 512;
    const float* sutab = p.su + (size_t)layer * NEXP;
    const float* svtab = p.sv + (size_t)layer * NEXP;
    unsigned char* hl = smem + wv * 17664;
    unsigned char* a8l = hl + 1024;
    unsigned char* vbuf = hl + 1280;
    const unsigned vbuf_lds = (unsigned)__builtin_amdgcn_readfirstlane((int)(unsigned)(size_t)(LAS unsigned char*)vbuf);
    f32x4 nx[4]; int nidA = 0, nidB = 0; float ngA = 0.f, ngB = 0.f, nsA = 0.f, nsB = 0.f;
    auto preload = [&](int tt) {
        const float* xr_ = xin + (size_t)tt * D + lane * 16;
#pragma unroll
        for (int j = 0; j < 4; ++j) nx[j] = *(const f32x4*)(xr_ + j * 4);
        nidA = p.ids[(size_t)tt * 128 + lane]; nidB = p.ids[(size_t)tt * 128 + 64 + lane];
        ngA = p.gates[(size_t)tt * 128 + lane]; ngB = p.gates[(size_t)tt * 128 + 64 + lane];
        nsA = p.sus[(size_t)tt * 128 + lane]; nsB = p.sus[(size_t)tt * 128 + 64 + lane];
    };
    const int t_first = blockIdx.x * (NT / 64) + wv;
    if (t_first < T) preload(t_first);
    for (int t = t_first; t < T; t += nw) {
        const int b = t / SEQ;
        const bf16_t* cv = p.cvec + (size_t)b * 12 * 1024 + (layer ? 7 * 1024 : 0);
        const int e0 = lane * 16;
        f32x4 xv[4];
#pragma unroll
        for (int j = 0; j < 4; ++j) xv[j] = nx[j];
        const int idA = nidA, idB = nidB; const float gA = ngA, gB = ngB, suA = nsA, suB = nsB;
        {
            float ss = 0.f;
#pragma unroll
            for (int j = 0; j < 4; ++j) ss += xv[j][0] * xv[j][0] + xv[j][1] * xv[j][1] + xv[j][2] * xv[j][2] + xv[j][3] * xv[j][3];
            ss = wave_sum(ss);
            const float rstd = rsqrtf(ss * (1.f / D) + RMS_EPS);
            u32x4 hw;
#pragma unroll
            for (int j2 = 0; j2 < 2; ++j2) {
                const u32x4 gs8 = *(const u32x4*)(cv + e0 + j2 * 8), sh8 = *(const u32x4*)(cv + 1024 + e0 + j2 * 8);
#pragma unroll
                for (int jj = 0; jj < 2; ++jj) {
                    const int j = j2 * 2 + jj;
                    const float h0 = xv[j][0] * rstd * bflo(gs8[jj * 2]) + bflo(sh8[jj * 2]), h1 = xv[j][1] * rstd * bfhi(gs8[jj * 2]) + bfhi(sh8[jj * 2]);
                    const float h2 = xv[j][2] * rstd * bflo(gs8[jj * 2 + 1]) + bflo(sh8[jj * 2 + 1]), h3 = xv[j][3] * rstd * bfhi(gs8[jj * 2 + 1]) + bfhi(sh8[jj * 2 + 1]);
                    int r = 0;
                    r = __builtin_amdgcn_cvt_pk_fp8_f32(h0, h1, r, false);
                    r = __builtin_amdgcn_cvt_pk_fp8_f32(h2, h3, r, true);
                    hw[j] = (unsigned)r;
                }
            }
            *(u32x4*)(hl + lane * 16) = hw;
        }
        asm volatile("s_waitcnt lgkmcnt(0)" ::: "memory");
        i32x8 hb[8];
#pragma unroll
        for (int kk = 0; kk < 8; ++kk) {
            const u32x4 lo = *(const u32x4*)(hl + kk * 128 + q * 16), hi = *(const u32x4*)(hl + kk * 128 + 64 + q * 16);
            hb[kk] = (i32x8){(int)lo[0], (int)lo[1], (int)lo[2], (int)lo[3], (int)hi[0], (int)hi[1], (int)hi[2], (int)hi[3]};
        }
        float dA = 0.f, dB = 0.f;
        auto dma16 = [&](const unsigned char* gsrc, unsigned dst) {
            unsigned keep;
            asm volatile("s_mov_b32 %0, m0\n\ts_mov_b32 m0, %2\n\ts_nop 0\n\tglobal_load_lds_dwordx4 %1, off\n\ts_mov_b32 m0, %0" : "=&s"(keep) : "v"(gsrc), "s"(dst) : "memory");
        };
        auto dma_ubatch = [&](int bt, int bsel) {
#pragma unroll
            for (int i_ = 0; i_ < 8; ++i_) {
                const int r_ = 2 * i_ + (lane >> 5);
                const int k0_ = (bt * 16 + 2 * i_) & 63;
                const int id0_ = __builtin_amdgcn_readlane(bt < 4 ? idA : idB, k0_), id1_ = __builtin_amdgcn_readlane(bt < 4 ? idA : idB, k0_ + 1);
                const int id_ = (lane >> 5) ? id1_ : id0_;
                dma16(utab + (size_t)((unsigned)id_ * 512u + (unsigned)(((lane & 31) ^ (r_ & 15)) * 16)), vbuf_lds + (unsigned)bsel * 8192u + (unsigned)i_ * 1024u);
            }
        };
        auto mma_ubatch = [&](int bt, int bsel) {
            const unsigned char* rowp = vbuf + bsel * 8192 + tk * 512;
            f32x4 acc = {0.f, 0.f, 0.f, 0.f};
#pragma unroll
            for (int kk = 0; kk < 8; ++kk) {
                const u32x4 a4 = *(const u32x4*)(rowp + (((kk * 4 + q) ^ tk) * 16));
                const i32x8 av = {(int)a4[0], (int)a4[1], (int)a4[2], (int)a4[3], 0, 0, 0, 0};
                acc = __builtin_amdgcn_mfma_scale_f32_16x16x128_f8f6f4(av, hb[kk], acc, 4  , 0  , 0, 0x7f7f7f7f, 0, 0x7f7f7f7f);
            }
            const int r = lane & 3;
            const float mine = r == 0 ? acc[0] : (r == 1 ? acc[1] : (r == 2 ? acc[2] : acc[3]));
            const float got = __shfl(mine, ((lane & 15) >> 2) * 16 + (lane & 15));
            if (q == (bt & 3)) { if (bt < 4) dA = got; else dB = got; }
        };
        asm volatile("s_waitcnt vmcnt(0) lgkmcnt(0)" ::: "memory");
        dma_ubatch(0, 0);
        if (t + nw < T) preload(t + nw);
#pragma unroll
        for (int bt = 0; bt < 8; ++bt) {
            if (bt + 1 < 8) { dma_ubatch(bt + 1, (bt + 1) & 1); asm volatile("s_waitcnt vmcnt(8)" ::: "memory"); }
            else asm volatile("s_waitcnt vmcnt(0)" ::: "memory");
            mma_ubatch(bt, bt & 1);
            asm volatile("s_waitcnt lgkmcnt(0)" ::: "memory");
        }
        const float apA = gelu_tanh(dA * suA) * gA, apB = gelu_tanh(dB * suB) * gB;
        const bf16_t* cv0 = p.cvec + (size_t)b * 12 * 1024;
        u32x4 pv_gate[2], pv_a[2], pv_b[2], pv_c[2], pv_d[2];
#pragma unroll
        for (int j2 = 0; j2 < 2; ++j2) {
            pv_gate[j2] = *(const u32x4*)(cv + 2 * 1024 + e0 + j2 * 8);
            pv_a[j2] = *(const u32x4*)(cv0 + (FINAL ? 10 : 3) * 1024 + e0 + j2 * 8); pv_b[j2] = *(const u32x4*)(cv0 + (FINAL ? 11 : 4) * 1024 + e0 + j2 * 8);
            if (!FINAL) { pv_c[j2] = *(const u32x4*)(cv0 + 5 * 1024 + e0 + j2 * 8); pv_d[j2] = *(const u32x4*)(cv0 + 6 * 1024 + e0 + j2 * 8); }
        }
        float of[16];
        {
            const float amax = wave_max(fmaxf(fabsf(apA), fabsf(apB)));
            const float asc = amax > 0.f ? 224.f / amax : 0.f, iasc = amax * (1.f / 224.f);
            const int pk = __builtin_amdgcn_cvt_pk_fp8_f32(apA * asc, apB * asc, 0, false);
            a8l[lane] = (unsigned char)(pk & 0xff); a8l[64 + lane] = (unsigned char)((pk >> 8) & 0xff);
            unsigned rowoff[16];
#pragma unroll
            for (int i_ = 0; i_ < 16; ++i_) {
                const int r_ = 8 * (i_ & 7) + (lane >> 3);
                const int id_ = __shfl(i_ < 8 ? idA : idB, r_);
                rowoff[i_] = (unsigned)id_ * 512u + (unsigned)(((lane & 7) ^ (r_ & 7)) * 16);
            }
            asm volatile("s_waitcnt lgkmcnt(0)" ::: "memory");
            const u32x4 alo = *(const u32x4*)(a8l + 16 * q), ahi = *(const u32x4*)(a8l + 64 + 16 * q);
            const i32x8 av0 = {(int)alo[0], (int)alo[1], (int)alo[2], (int)alo[3], 0, 0, 0, 0}, av1 = {0, 0, 0, 0, (int)ahi[0], (int)ahi[1], (int)ahi[2], (int)ahi[3]};
            auto dma_slice = [&](int sidx, int bsel) {
#pragma unroll
                for (int i_ = 0; i_ < 8; ++i_)
                    dma16(vtab + (size_t)(rowoff[(sidx & 1) * 8 + i_] + (unsigned)(sidx >> 1) * 128u), vbuf_lds + (unsigned)bsel * 8192u + (unsigned)i_ * 1024u);
            };
            float ov[16];
#pragma unroll
            for (int e = 0; e < 16; ++e) ov[e] = 0.f;
            const int rl = 32 * (q & 1) + tk;
            asm volatile("s_waitcnt vmcnt(0) lgkmcnt(0)" ::: "memory");
            dma_slice(0, 0);
#pragma unroll
            for (int ln = 0; ln < 4; ++ln) {
#pragma unroll
                for (int rh = 0; rh < 2; ++rh) {
                    const int sidx = ln * 2 + rh;
                    if (sidx + 1 < 8) { dma_slice(sidx + 1, (sidx + 1) & 1); asm volatile("s_waitcnt vmcnt(8)" ::: "memory"); }
                    else asm volatile("s_waitcnt vmcnt(0)" ::: "memory");
                    const unsigned char* vb0 = vbuf + (sidx & 1) * 8192 + rl * 128, *vb1 = vb0 + 16 * 128;
#pragma unroll
                    for (int eg = 0; eg < 16; ++eg) {
                        typedef int i32x2 __attribute__((ext_vector_type(2)));
                        const int co = (((eg >> 1) ^ (tk & 7)) * 16) + (eg & 1) * 8;
                        const i32x2 r1 = __builtin_amdgcn_ds_read_tr4_b64_v2i32((LAS i32x2*)(vb0 + co));
                        const i32x2 r2 = __builtin_amdgcn_ds_read_tr4_b64_v2i32((LAS i32x2*)(vb1 + co));
                        const i32x8 bv = {r1[0], r1[1], r2[0], r2[1], 0, 0, 0, 0};
                        f32x4 z = {0.f, 0.f, 0.f, 0.f};
                        const f32x4 d = __builtin_amdgcn_mfma_scale_f32_16x16x128_f8f6f4(rh ? av1 : av0, bv, z, 0  , 4  , 0, 0x7f7f7f7f, 0, 0x7f7f7f7f);
                        if ((eg >> 2) == q) ov[ln * 4 + (eg & 3)] += d[0];
                        if ((eg & 3) == 3) __builtin_amdgcn_sched_barrier(0);
                    }
                    asm volatile("s_waitcnt lgkmcnt(0)" ::: "memory");
                }
            }
#pragma unroll
            for (int e = 0; e < 16; ++e) ov[e] *= iasc;
            float* outl = (float*)vbuf;
#pragma unroll
            for (int ln = 0; ln < 4; ++ln)
#pragma unroll
                for (int t_ = 0; t_ < 4; ++t_) outl[ln * 256 + (4 * q + t_) * 16 + tk] = ov[ln * 4 + t_];
            asm volatile("s_waitcnt lgkmcnt(0)" ::: "memory");
#pragma unroll
            for (int j4 = 0; j4 < 4; ++j4) { const f32x4 v4 = *(const f32x4*)(outl + lane * 16 + j4 * 4); of[j4 * 4] = v4[0]; of[j4 * 4 + 1] = v4[1]; of[j4 * 4 + 2] = v4[2]; of[j4 * 4 + 3] = v4[3]; }
            asm volatile("s_waitcnt lgkmcnt(0)" ::: "memory");
        }
        float xn[16]; float ss = 0.f;
        auto unp = [&](const u32x4 (&w)[2], float (&o)[16]) {
#pragma unroll
            for (int j2 = 0; j2 < 2; ++j2)
#pragma unroll
                for (int jj = 0; jj < 4; ++jj) { o[j2 * 8 + jj * 2] = bflo(w[j2][jj]); o[j2 * 8 + jj * 2 + 1] = bfhi(w[j2][jj]); }
        };
        {
            float gt[16]; unp(pv_gate, gt);
#pragma unroll
            for (int k = 0; k < 16; ++k) { const float v = xv[k >> 2][k & 3] + gt[k] * of[k]; xn[k] = v; ss += v * v; }
        }
        ss = wave_sum(ss);
        const float rstd = rsqrtf(ss * (1.f / D) + RMS_EPS);
        if (!FINAL) {
#pragma unroll
            for (int j = 0; j < 4; ++j) *(f32x4*)(xout + (size_t)t * D + e0 + j * 4) = (f32x4){xn[j * 4], xn[j * 4 + 1], xn[j * 4 + 2], xn[j * 4 + 3]};
            float gsv[16], shv[16], hk[16], hq[16];
            unp(pv_a, gsv); unp(pv_b, shv);
#pragma unroll
            for (int k = 0; k < 16; ++k) hk[k] = xn[k] * rstd * gsv[k] + shv[k];
            unp(pv_c, gsv); unp(pv_d, shv);
#pragma unroll
            for (int k = 0; k < 16; ++k) hq[k] = xn[k] * rstd * gsv[k] + shv[k];
#pragma unroll
            for (int j = 0; j < 2; ++j) {
                u32x4 ob; ob[0] = pack2(hk[j * 8], hk[j * 8 + 1]); ob[1] = pack2(hk[j * 8 + 2], hk[j * 8 + 3]); ob[2] = pack2(hk[j * 8 + 4], hk[j * 8 + 5]); ob[3] = pack2(hk[j * 8 + 6], hk[j * 8 + 7]);
                *(u32x4*)(hkv_out + (size_t)t * D + e0 + j * 8) = ob;
                u32x4 oc; oc[0] = pack2(hq[j * 8], hq[j * 8 + 1]); oc[1] = pack2(hq[j * 8 + 2], hq[j * 8 + 3]); oc[2] = pack2(hq[j * 8 + 4], hq[j * 8 + 5]); oc[3] = pack2(hq[j * 8 + 6], hq[j * 8 + 7]);
                *(u32x4*)(hq_out + (size_t)t * D + e0 + j * 8) = oc;
            }
        } else {
            float gsv[16], shv[16];
            unp(pv_a, gsv); unp(pv_b, shv);
#pragma unroll
            for (int j = 0; j < 4; ++j) {
                f32x4 ov;
#pragma unroll
                for (int e = 0; e < 4; ++e) ov[e] = xn[j * 4 + e] * rstd * gsv[j * 4 + e] + shv[j * 4 + e];
                *(f32x4*)(p.out + (size_t)t * D + e0 + j * 4) = ov;
            }
        }
        asm volatile("s_waitcnt lgkmcnt(0)" ::: "memory");
    }
}

__device__ void attn_phase(const Params& p, const bf16_t* Q, const bf16_t* K, const bf16_t* V, bf16_t* O, unsigned char* smem) {
    unsigned char* Kl = smem;
    unsigned char* Vt = smem + 32768;
    unsigned char* Pl = smem + 32768 + 35840;
    const int tid = opaque_tid(), lane = tid & 63, w = tid >> 6, tk = lane & 15, q = lane >> 4;
    unsigned char* Pw = Pl + w * 5376;
    for (int task = blockIdx.x; task < NB * 32 * 4; task += gridDim.x) {
        const int kvh = task & 3, qblk = (task >> 2) & 31, b = task >> 7;
        const int kpos0 = (qblk - 1) * 128;
#pragma unroll
        for (int i = 0; i < 4; ++i) {
            const int id = tid + NT * i, j = id >> 3, c = id & 7, kp = kpos0 + j;
            u32x4 v = {0u, 0u, 0u, 0u};
            if (kp >= 0) v = *(const u32x4*)(K + ((size_t)b * SEQ + kp) * 256 + kvh * 64 + c * 8);
            *(u32x4*)(Kl + lds_off(j, c)) = v;
        }
#pragma unroll
        for (int i = 0; i < 4; ++i) {
            const int id = tid + NT * i, j = id & 255, dc = id >> 8, kp = kpos0 + j;
            u32x4 v = {0u, 0u, 0u, 0u};
            if (kp >= 0) v = *(const u32x4*)(V + ((size_t)b * SEQ + kp) * 256 + kvh * 64 + dc * 8);
#pragma unroll
            for (int e = 0; e < 4; ++e) {
                *(bf16_t*)(Vt + (dc * 8 + 2 * e) * 560 + j * 2) = (bf16_t)(v[e] & 0xffffu);
                *(bf16_t*)(Vt + (dc * 8 + 2 * e + 1) * 560 + j * 2) = (bf16_t)(v[e] >> 16);
            }
        }
        if (tid < 128) *(u32x4*)(Vt + (tid >> 1) * 560 + 512 + (tid & 1) * 16) = (u32x4){0u, 0u, 0u, 0u};
        *(u32x2*)(Pw + tk * 336 + (144 + 4 * q) * 2) = (u32x2){0u, 0u};
        __syncthreads();
        const int qt = w, i_q = qt * 16 + tk;
        const size_t trow = (size_t)b * SEQ + qblk * 128 + i_q;
        const unsigned char* kb0 = Kl + lds_off(qt * 16 + tk, q);
        const unsigned char* kb1 = Kl + lds_off(qt * 16 + tk, 4 + q);
        const unsigned char* vb0 = Vt + tk * 560 + (qt * 16 + 8 * q) * 2;
        unsigned char* pwr = Pw + tk * 336 + 8 * q;
        const unsigned char* prd = Pw + tk * 336 + 16 * q;
#pragma unroll 1
        for (int hq = 0; hq < 4; ++hq) {
            const int head = kvh * 4 + hq;
            const bf16x8 qf0 = *(const bf16x8*)(Q + trow * D + head * 64 + 8 * q), qf1 = *(const bf16x8*)(Q + trow * D + head * 64 + 32 + 8 * q);
            f32x4 sacc[9];
#pragma unroll
            for (int kk = 0; kk < 9; ++kk) {
                const bf16x8 k0 = *(const bf16x8*)(kb0 + kk * 2048), k1 = *(const bf16x8*)(kb1 + kk * 2048);
                f32x4 a = {0.f, 0.f, 0.f, 0.f};
                a = __builtin_amdgcn_mfma_f32_16x16x32_bf16(k0, qf0, a, 0, 0, 0);
                a = __builtin_amdgcn_mfma_f32_16x16x32_bf16(k1, qf1, a, 0, 0, 0);
                sacc[kk] = a;
                if (kk & 1) __builtin_amdgcn_sched_barrier(0);
            }
            const float sink = p.sinks[head];
            float mx = -1e30f;
#pragma unroll
            for (int kk = 0; kk < 9; ++kk)
#pragma unroll
                for (int r = 0; r < 4; ++r) {
                    const int j = (qt + kk) * 16 + 4 * q + r;
                    const bool valid = (j > i_q) && (j <= i_q + 128) && (qblk > 0 || j >= 128);
                    const float s = valid ? sacc[kk][r] * 0.125f : -1e30f;
                    sacc[kk][r] = s; mx = fmaxf(mx, s);
                }
            mx = fmaxf(mx, __shfl_xor(mx, 16)); mx = fmaxf(mx, __shfl_xor(mx, 32));
            mx = fmaxf(mx, sink);
            float sum = 0.f;
#pragma unroll
            for (int kk = 0; kk < 9; ++kk)
#pragma unroll
                for (int r = 0; r < 4; ++r) { const float e = __expf(sacc[kk][r] - mx); sacc[kk][r] = e; sum += e; }
            sum += __shfl_xor(sum, 16); sum += __shfl_xor(sum, 32);
            const float inv = 1.f / (sum + __expf(sink - mx));
#pragma unroll
            for (int kk = 0; kk < 9; ++kk) {
                u32x2 o; o[0] = pack2(sacc[kk][0] * inv, sacc[kk][1] * inv); o[1] = pack2(sacc[kk][2] * inv, sacc[kk][3] * inv);
                *(u32x2*)(pwr + kk * 32) = o;
            }
            asm volatile("s_waitcnt lgkmcnt(0)" ::: "memory");
            bf16x8 pf[5];
#pragma unroll
            for (int ks = 0; ks < 5; ++ks) pf[ks] = *(const bf16x8*)(prd + ks * 64);
#pragma unroll
            for (int dt = 0; dt < 4; ++dt) {
                f32x4 oa = {0.f, 0.f, 0.f, 0.f};
#pragma unroll
                for (int ks = 0; ks < 5; ++ks) {
                    const bf16x8 vf = *(const bf16x8*)(vb0 + dt * 8960 + ks * 64);
                    oa = __builtin_amdgcn_mfma_f32_16x16x32_bf16(vf, pf[ks], oa, 0, 0, 0);
                }
                u32x2 o; o[0] = pack2(oa[0], oa[1]); o[1] = pack2(oa[2], oa[3]);
                *(u32x2*)(O + trow * D + head * 64 + dt * 16 + 4 * q) = o;
                __builtin_amdgcn_sched_barrier(0);
            }
            asm volatile("s_waitcnt lgkmcnt(0)" ::: "memory");
        }
        __syncthreads();
    }
}

constexpr int SMEM_BYTES = 152 * 1024;
__global__ void __launch_bounds__(NT) yoco_fwd(Params p) {
    __shared__ __attribute__((aligned(16))) unsigned char smem[SMEM_BYTES];
    volatile LAS unsigned* st = (volatile LAS unsigned*)(smem + SMEM_BYTES - 16);
    if (threadIdx.x == 0) { st[0] = 0u; st[1] = 0u; }
    __syncthreads();
    const XcdBarrier xb = xcd_barrier_post(p.bar, st);
    p0_cond(p, smem);
    p0_tables(p);
    p0_wt(p, smem);
    p0_s5(p, smem);
    xcd_barrier(xb);
    p05_prep(p, smem);
    xcd_barrier(xb);
    bias_finalize(p);
    { EpiU e{p.s1}; gemm_phase<256>(p.s0, p.wt_in, 0, 1024, e, smem); }
    xcd_barrier(xb);
    s5_phase(p, smem);
    xcd_barrier(xb);
    { EpiGlu e{p.s0, p.b_glu, p.s1}; gemm_phase<256>(p.s0, p.wt_glu, 0, 1024, e, smem); }
    xcd_barrier(xb);
    { EpiRes e{p.x, p.cond + 2 * D, p.norm_ffn, p.cond + 4 * D, p.f0, p.s2, p.ssq1}; gemm_phase<256>(p.s1, p.wt_out, 0, 1024, e, smem); }
    xcd_barrier(xb);
    { EpiQ e{p.ssq1, p.bias, 0, p.s1}; gemm_phase<256>(p.s2, p.wt_pq0, 0, 1024, e, smem); }
    xcd_barrier(xb);
    route_phase(p, 0, p.s1, smem);
    xcd_barrier(xb);
    gather_phase<false>(p, 0, p.f0, p.f1, p.s0, p.s2, smem);
    xcd_barrier(xb);
    { EpiRope<0> e{p.ropec, p.ropes, p.s1, p.s1 + (size_t)T * 256}; gemm_phase<128>(p.s0, p.wt_kv, 0, 512, e, smem); }
    { EpiRope<1> e{p.ropec, p.ropes, p.s3, nullptr}; gemm_phase<128>(p.s2, p.wt_q, 0, 1024, e, smem); }
    xcd_barrier(xb);
    attn_phase(p, p.s3, p.s1, p.s1 + (size_t)T * 256, p.s0, smem);
    xcd_barrier(xb);
    { EpiRes e{p.f1, p.cond + 8 * D, p.norm_ffn + D, p.cond + 10 * D, p.f0, p.s2, p.ssq3}; gemm_phase<256>(p.s0, p.wt_o, 0, 1024, e, smem); }
    xcd_barrier(xb);
    { EpiQ e{p.ssq3, p.bias, 1024, p.s1}; gemm_phase<256>(p.s2, p.wt_pq1, 0, 1024, e, smem); }
    xcd_barrier(xb);
    route_phase(p, 1, p.s1, smem);
    xcd_barrier(xb);
    gather_phase<true>(p, 1, p.f0, nullptr, nullptr, nullptr, smem);
}

static inline size_t align_up(size_t v, size_t a) { return (v + a - 1) / a * a; }

extern "C" void kernel_launch(void* const* d_in, const int* in_sizes, int n_in, void* d_out, int out_size, void* d_ws, size_t ws_size, hipStream_t stream) {
    (void)in_sizes; (void)n_in; (void)out_size;
    Params p{};
    p.x = (const float*)d_in[0]; p.c = (const float*)d_in[1]; p.pos = (const int*)d_in[2]; p.w_cond = (const float*)d_in[3]; p.b_cond = (const float*)d_in[4];
    p.norm_mix = (const float*)d_in[5]; p.norm_ffn = (const float*)d_in[6]; p.w_in = (const float*)d_in[7]; p.a_re = (const float*)d_in[8]; p.a_im = (const float*)d_in[9];
    p.log_dt = (const float*)d_in[10]; p.b_re = (const float*)d_in[11]; p.b_im = (const float*)d_in[12]; p.c_re = (const float*)d_in[13]; p.c_im = (const float*)d_in[14];
    p.s5d = (const float*)d_in[15]; p.w_glu = (const float*)d_in[16]; p.b_glu = (const float*)d_in[17]; p.w_out = (const float*)d_in[18]; p.kv_norm = (const float*)d_in[19];
    p.w_kv = (const float*)d_in[20]; p.w_q = (const float*)d_in[21]; p.sinks = (const float*)d_in[22]; p.w_o = (const float*)d_in[23]; p.peer_wq = (const float*)d_in[24];
    p.subkeys = (const float*)d_in[25]; p.peer_u = (const float*)d_in[26]; p.peer_v = (const float*)d_in[27]; p.final_norm = (const float*)d_in[28];
    p.out = (float*)d_out;
    unsigned char* w = (unsigned char*)d_ws; size_t off = 65536;
    p.bar = (unsigned*)d_ws;
    auto take = [&](size_t bytes) { void* r = w + off; off = align_up(off + bytes, 4096); return r; };
    p.cond = (float*)take((size_t)NB * NCOND * D * 4);
    p.ropec = (float*)take((size_t)T * 32 * 4); p.ropes = (float*)take((size_t)T * 32 * 4);
    p.ssq1 = (float*)take((size_t)T * 16 * 4); p.ssq3 = (float*)take((size_t)T * 16 * 4);
    p.wt_in = (bf16_t*)take((size_t)D * D * 2); p.wt_glu = (bf16_t*)take((size_t)D * D * 2); p.wt_out = (bf16_t*)take((size_t)D * D * 2); p.wt_kv = (bf16_t*)take((size_t)512 * D * 2);
    p.wt_q = (bf16_t*)take((size_t)D * D * 2); p.wt_o = (bf16_t*)take((size_t)D * D * 2); p.wt_pq0 = (bf16_t*)take((size_t)D * D * 2); p.wt_pq1 = (bf16_t*)take((size_t)D * D * 2);
    p.biasp = (float*)take((size_t)8 * 4 * 2048 * 4); p.bias = (float*)take((size_t)4 * 2048 * 4);
    p.skeys = (bf16_t*)take((size_t)2 * 8 * 2 * 128 * 64 * 2);
    p.lamL = (float*)take((size_t)G5 * P5 * 2 * 4); p.ktab = (bf16_t*)take((size_t)G5 * KTR * 256 * 2);
    p.smat = (bf16_t*)take((size_t)G5 * 128 * 1024 * 2); p.cmat = (bf16_t*)take((size_t)G5 * 1024 * 128 * 2);
    p.ub = (unsigned char*)take((size_t)2 * NEXP * D); p.vb = (unsigned char*)take((size_t)2 * NEXP * D);
    p.su = (float*)take((size_t)2 * NEXP * 4); p.sv = (float*)take((size_t)2 * NEXP * 4);
    p.s0 = (bf16_t*)take((size_t)T * D * 2); p.s1 = (bf16_t*)take((size_t)T * D * 2); p.s2 = (bf16_t*)take((size_t)T * D * 2); p.s3 = (bf16_t*)take((size_t)T * D * 2);
    p.f0 = (float*)take((size_t)T * D * 4); p.f1 = (float*)take((size_t)T * D * 4);
    p.ids = (int*)take((size_t)T * 128 * 4); p.gates = (float*)take((size_t)T * 128 * 4); p.sus = (float*)take((size_t)T * 128 * 4);
    p.cvec = (bf16_t*)take((size_t)4 * 12 * 1024 * 2);
    if (off > ws_size) { fprintf(stderr, "workspace too small: need %zu have %zu\n", off, ws_size); return; }

    static int grid_blocks = 0;
    if (!grid_blocks) {
        int dev = 0, cus = 0, per_cu = 0;
        (void)hipGetDevice(&dev);
        (void)hipDeviceGetAttribute(&cus, hipDeviceAttributeMultiprocessorCount, dev);
        (void)hipOccupancyMaxActiveBlocksPerMultiprocessor(&per_cu, yoco_fwd, NT, 0);
        if (per_cu > 1) per_cu = 1;
        grid_blocks = cus * per_cu;
        if (grid_blocks <= 0) grid_blocks = 256;
    }
    (void)hipMemsetAsync(d_ws, 0, XCD_BAR_WORDS * 4, stream);
    void* args[] = {&p};
    hipError_t e = hipLaunchCooperativeKernel((const void*)yoco_fwd, dim3(grid_blocks), dim3(NT), args, 0, stream);
    if (e != hipSuccess) fprintf(stderr, "cooperative launch failed: %s (grid %d)\n", hipGetErrorString(e), grid_blocks);
}
```

```cpp
#include <hip/hip_runtime.h>
#include <cstdio>
#include <cstdint>

#define NT 512
#define LAS __attribute__((address_space(3)))
typedef unsigned short bf16_t;
typedef short bf16x8 __attribute__((ext_vector_type(8)));
typedef float f32x4 __attribute__((ext_vector_type(4)));
typedef unsigned u32x4 __attribute__((ext_vector_type(4)));
typedef unsigned u32x2 __attribute__((ext_vector_type(2)));

constexpr int D = 1024, NB = 4, SEQ = 4096, T = NB * SEQ;
constexpr int NCOND = 16;
constexpr int G5 = 64, P5 = 64, C5 = 16, L5 = 64, NCH = SEQ / L5, KTR = 80;
constexpr int NEXP = 16384;
constexpr float RMS_EPS = 1e-6f;

struct Params {
    const float *x, *c; const int* pos; const float *w_cond, *b_cond, *norm_mix, *norm_ffn, *w_in, *a_re, *a_im, *log_dt, *b_re, *b_im, *c_re, *c_im, *s5d,
        *w_glu, *b_glu, *w_out, *kv_norm, *w_kv, *w_q, *sinks, *w_o, *peer_wq, *subkeys, *peer_u, *peer_v, *final_norm;
    float* out;
    unsigned* bar;
    float* cond;
    float* ropec;
    float* ropes;
    float* ssq1;
    float* ssq3;
    bf16_t *wt_in, *wt_glu, *wt_out, *wt_kv, *wt_q, *wt_o, *wt_pq0, *wt_pq1;
    unsigned char *w8_in, *w8_glu, *w8_out, *w8_kv, *w8_q, *w8_o, *w8_pq0, *w8_pq1;
    float *cs_in, *cs_glu, *cs_out, *cs_kv, *cs_q, *cs_o, *cs_pq0, *cs_pq1;
    float* biasp;
    float* bias;
    bf16_t* skeys;
    float* lamL;
    bf16_t* ktab;
    bf16_t* smat;
    bf16_t* cmat;
    unsigned char* ub;
    unsigned char* vb;
    float* su;
    float* sv;
    bf16_t *s0, *s1, *s2, *s3;
    bf16_t *f0, *f1;
    int* ids;
    float* gates;
    float* sus;
    bf16_t* cvec;
};

#define XB_TMO      128
#define XB_XCNT(j)  (256  + 64 * (j))
#define XB_XSUB(j)  (1280 + 64 * (j))
#define XB_XGEN(j)  (2304 + 64 * (j))
#define XB_TOP      3328
#define XB_TOPGEN   3392
#define XCD_BAR_WORDS 3456
#define XB_SPIN_CAP (1u << 22)
__device__ __forceinline__ unsigned xb_ld(unsigned* p)              { return __hip_atomic_load(p, __ATOMIC_RELAXED, __HIP_MEMORY_SCOPE_AGENT); }
__device__ __forceinline__ unsigned xb_add(unsigned* p, unsigned v) { return __hip_atomic_fetch_add(p, v, __ATOMIC_RELAXED, __HIP_MEMORY_SCOPE_AGENT); }
__device__ __forceinline__ unsigned xb_xcc_id() { return (unsigned)__builtin_amdgcn_s_getreg((3 << 11) | 20) & 0xFu; }
#define XB_SPIN(cond, bar) do { unsigned _sp = 0; while (cond) { __builtin_amdgcn_s_sleep(1); \
    if ((++_sp & 255u) == 0u) { if (xb_ld(&(bar)[XB_TMO])) break; if (_sp > XB_SPIN_CAP) { atomicAdd(&(bar)[XB_TMO], 1u); break; } } } } while (0)
struct XcdBarrier { unsigned* bar; unsigned x; volatile LAS unsigned* st; };
__device__ __forceinline__ XcdBarrier xcd_barrier_post(unsigned* bar, volatile LAS unsigned* st) {
    XcdBarrier b; b.bar = bar; b.x = xb_xcc_id(); b.st = st;
    if (threadIdx.x == 0) (void)xb_add(&bar[XB_XCNT(b.x)], 1u);
    return b;
}
__device__ __forceinline__ void xcd_barrier_complete(unsigned* bar, unsigned x, unsigned& nloc, unsigned& nx) {
    const unsigned G = gridDim.x * gridDim.y * gridDim.z;
    unsigned sum, cnt, mine, sp = 0u;
    for (;;) {
        sum = 0u; cnt = 0u; mine = 0u;
#pragma unroll
        for (unsigned j = 0; j < 16; ++j) { const unsigned c = xb_ld(&bar[XB_XCNT(j)]); sum += c; cnt += (c > 0u) ? 1u : 0u; mine = (j == x) ? c : mine; }
        if (sum == G) break;
        __builtin_amdgcn_s_sleep(1);
        if ((++sp & 255u) == 0u) { if (xb_ld(&bar[XB_TMO])) break; if (sp > XB_SPIN_CAP) { atomicAdd(&bar[XB_TMO], 1u); break; } }
    }
    nloc = mine > 0u ? mine : 1u; nx = cnt > 0u ? cnt : 1u;
}
__device__ __forceinline__ void xcd_barrier(const XcdBarrier& b) {
    asm volatile("s_waitcnt vmcnt(0)" ::: "memory");
    __syncthreads();
    if (threadIdx.x == 0) {
        unsigned* bar = b.bar;
        __builtin_amdgcn_s_waitcnt(0);
        unsigned nloc = b.st[0], nx = b.st[1];
        if (nloc == 0u) { xcd_barrier_complete(bar, b.x, nloc, nx); b.st[0] = nloc; b.st[1] = nx; }
        const unsigned old = xb_add(&bar[XB_XSUB(b.x)], 1u);
        const unsigned gen = old / nloc;
        if (old + 1u == (gen + 1u) * nloc) {
            __builtin_amdgcn_fence(__ATOMIC_RELEASE, "agent");
            asm volatile("s_waitcnt vmcnt(0)" ::: "memory");
            const unsigned og = xb_add(&bar[XB_TOP], 1u);
            const unsigned tg = og / nx;
            if (og + 1u == (tg + 1u) * nx) xb_add(&bar[XB_TOPGEN], 1u);
            else XB_SPIN(xb_ld(&bar[XB_TOPGEN]) == tg, bar);
            __builtin_amdgcn_fence(__ATOMIC_ACQUIRE, "agent");
            xb_add(&bar[XB_XGEN(b.x)], 1u);
            asm volatile("s_waitcnt vmcnt(0)" ::: "memory");
        } else {
            XB_SPIN(xb_ld(&bar[XB_XGEN(b.x)]) == gen, bar);
            __builtin_amdgcn_fence(__ATOMIC_ACQUIRE, "agent");
            asm volatile("s_waitcnt vmcnt(0)" ::: "memory");
        }
    }
    __syncthreads();
}

__device__ __forceinline__ void xcd_barrier3(const XcdBarrier& b, unsigned k) {
    asm volatile("s_waitcnt vmcnt(0)" ::: "memory");
    __syncthreads();
    if (threadIdx.x == 0) {
        unsigned* bar = b.bar;
        __builtin_amdgcn_s_waitcnt(0);
        unsigned nloc = b.st[0], nx = b.st[1];
        if (nloc == 0u) { xcd_barrier_complete(bar, b.x, nloc, nx); b.st[0] = nloc; b.st[1] = nx; }
        const unsigned old = xb_add(&bar[XB_XSUB(b.x)], 1u);
        if (old + 1u == k * nloc) {
            __builtin_amdgcn_fence(__ATOMIC_RELEASE, "agent");
            asm volatile("s_waitcnt vmcnt(0)" ::: "memory");
            (void)xb_add(&bar[XB_TOP], 1u);
        }
        const unsigned tgt = k * nx;
        XB_SPIN(xb_ld(&bar[XB_TOP]) < tgt, bar);
        __builtin_amdgcn_fence(__ATOMIC_ACQUIRE, "agent");
        asm volatile("s_waitcnt vmcnt(0)" ::: "memory");
    }
    __syncthreads();
}

__device__ __forceinline__ int opaque_tid() { int t = threadIdx.x; asm volatile("" : "+v"(t)); return t; }
__device__ __forceinline__ bf16_t f2bf(float f) { unsigned u = __float_as_uint(f); u += 0x7fffu + ((u >> 16) & 1u); return (bf16_t)(u >> 16); }
__device__ __forceinline__ float bf2f(bf16_t h) { return __uint_as_float(((unsigned)h) << 16); }
typedef __bf16 hbf2 __attribute__((ext_vector_type(2)));
typedef float f32x2 __attribute__((ext_vector_type(2)));
__device__ __forceinline__ unsigned pack2(float lo, float hi) { f32x2 v = {lo, hi}; return __builtin_bit_cast(unsigned, __builtin_convertvector(v, hbf2)); }
__device__ __forceinline__ float dot2bf(unsigned a, unsigned b, float c) { return __builtin_amdgcn_fdot2_f32_bf16(__builtin_bit_cast(hbf2, a), __builtin_bit_cast(hbf2, b), c, false); }
__device__ __forceinline__ unsigned pack4_fp8(float a, float b, float c, float d) { int r = 0; r = __builtin_amdgcn_cvt_pk_fp8_f32(a, b, r, false); r = __builtin_amdgcn_cvt_pk_fp8_f32(c, d, r, true); return (unsigned)r; }
__device__ __forceinline__ float bflo(unsigned w) { return __uint_as_float(w << 16); }
__device__ __forceinline__ float bfhi(unsigned w) { return __uint_as_float(w & 0xffff0000u); }
template <int CTRL> __device__ __forceinline__ float dpp_f(float v) { return __uint_as_float((unsigned)__builtin_amdgcn_update_dpp(0, (int)__float_as_uint(v), CTRL, 0xf, 0xf, true)); }
__device__ __forceinline__ float wave_sum(float v) {
    v += dpp_f<0xB1>(v);
    v += dpp_f<0x4E>(v);
    v += dpp_f<0x141>(v);
    v += dpp_f<0x140>(v);
    const float a = __uint_as_float((unsigned)__builtin_amdgcn_readlane((int)__float_as_uint(v), 0)), b = __uint_as_float((unsigned)__builtin_amdgcn_readlane((int)__float_as_uint(v), 16));
    const float c = __uint_as_float((unsigned)__builtin_amdgcn_readlane((int)__float_as_uint(v), 32)), d = __uint_as_float((unsigned)__builtin_amdgcn_readlane((int)__float_as_uint(v), 48));
    return (a + b) + (c + d);
}
__device__ __forceinline__ float bperm_f(float v, int srclane) { return __uint_as_float((unsigned)__builtin_amdgcn_ds_bpermute(srclane << 2, (int)__float_as_uint(v))); }
__device__ __forceinline__ float row16_sum(float v) { v += dpp_f<0xB1>(v); v += dpp_f<0x4E>(v); v += dpp_f<0x141>(v); v += dpp_f<0x140>(v); return v; }
__device__ __forceinline__ float wave_max(float v) {
    v = fmaxf(v, dpp_f<0xB1>(v)); v = fmaxf(v, dpp_f<0x4E>(v)); v = fmaxf(v, dpp_f<0x141>(v)); v = fmaxf(v, dpp_f<0x140>(v));
    const float a = __uint_as_float((unsigned)__builtin_amdgcn_readlane((int)__float_as_uint(v), 0)), b = __uint_as_float((unsigned)__builtin_amdgcn_readlane((int)__float_as_uint(v), 16));
    const float c = __uint_as_float((unsigned)__builtin_amdgcn_readlane((int)__float_as_uint(v), 32)), d = __uint_as_float((unsigned)__builtin_amdgcn_readlane((int)__float_as_uint(v), 48));
    return fmaxf(fmaxf(a, b), fmaxf(c, d));
}
__device__ __forceinline__ float gelu_tanh(float x) {
    const float u = 0.7978845608028654f * (x + 0.044715f * x * x * x);
    const float e = __expf(-2.f * fabsf(u));
    float th = (1.f - e) / (1.f + e);
    th = u < 0.f ? -th : th;
    return 0.5f * x * (1.f + th);
}

__device__ void p0_cond(const Params& p, unsigned char* smem) {
    float* sc = (float*)smem;
    float* red = (float*)(smem + 16384);
    const int tid = threadIdx.x;
    for (int i = tid; i < 4 * D; i += NT) { const float v = p.c[i]; sc[i] = v / (1.f + __expf(-v)); }
    __syncthreads();
    const int cgp = tid & 15, kg = tid >> 4;
    for (int task = blockIdx.x; task < NCOND * D / 64; task += gridDim.x) {
        const int col0 = task * 64 + cgp * 4;
        float acc[4][4];
#pragma unroll
        for (int b = 0; b < 4; ++b)
#pragma unroll
            for (int j = 0; j < 4; ++j) acc[b][j] = 0.f;
#pragma unroll 1
        for (int k0 = 0; k0 < 32; k0 += 8) {
            f32x4 w[8];
#pragma unroll
            for (int j = 0; j < 8; ++j) w[j] = *(const f32x4*)(p.w_cond + (size_t)(kg + 32 * (k0 + j)) * (NCOND * D) + col0);
#pragma unroll
            for (int j = 0; j < 8; ++j)
#pragma unroll
                for (int b = 0; b < 4; ++b) { const float s = sc[b * D + kg + 32 * (k0 + j)];
#pragma unroll
                    for (int e = 0; e < 4; ++e) acc[b][e] += s * w[j][e]; }
        }
#pragma unroll
        for (int b = 0; b < 4; ++b)
#pragma unroll
            for (int j = 0; j < 4; ++j) red[(kg * 64 + cgp * 4 + j) * 4 + b] = acc[b][j];
        __syncthreads();
        if (tid < 256) {
            const int col = tid >> 2, b = tid & 3;
            float s = 0.f;
            for (int g = 0; g < 32; ++g) s += red[(g * 64 + col) * 4 + b];
            p.cond[(size_t)b * (NCOND * D) + task * 64 + col] = s + p.b_cond[task * 64 + col];
        }
        __syncthreads();
    }
}

__device__ void p0_tables(const Params& p) {
    const size_t gtid = (size_t)blockIdx.x * NT + threadIdx.x, gstride = (size_t)gridDim.x * NT;
    {
        const int li = threadIdx.x & 15;
        const size_t grp = gtid >> 4, ngrp = gstride >> 4;
        for (int which = 0; which < 2; ++which) {
            const float* src = which ? p.peer_v : p.peer_u; unsigned char* dst = which ? p.vb : p.ub; float* sdst = which ? p.sv : p.su;
            for (size_t row = grp; row < (size_t)2 * NEXP; row += ngrp) {
                f32x4 v[2][8]; float ss = 0.f;
#pragma unroll
                for (int c = 0; c < 2; ++c)
#pragma unroll
                    for (int j = 0; j < 8; ++j) {
                        v[c][j] = *(const f32x4*)(src + row * D + c * 512 + li * 32 + j * 4);
#pragma unroll
                        for (int e = 0; e < 4; ++e) ss += v[c][j][e] * v[c][j][e];
                    }
                ss = row16_sum(ss);
                const float rms = sqrtf(ss * (1.f / D)), step = 0.48f * rms, inv = step > 0.f ? 1.f / step : 0.f;
#pragma unroll
                for (int c = 0; c < 2; ++c) {
                    u32x4 o;
#pragma unroll
                    for (int d = 0; d < 4; ++d) {
                        unsigned wd = 0u;
                        if (true) {
                            wd = __builtin_amdgcn_cvt_scalef32_pk_fp4_f32(wd, v[c][d * 2][0] * inv, v[c][d * 2][1] * inv, 1.0f, 0);
                            wd = __builtin_amdgcn_cvt_scalef32_pk_fp4_f32(wd, v[c][d * 2][2] * inv, v[c][d * 2][3] * inv, 1.0f, 1);
                            wd = __builtin_amdgcn_cvt_scalef32_pk_fp4_f32(wd, v[c][d * 2 + 1][0] * inv, v[c][d * 2 + 1][1] * inv, 1.0f, 2);
                            wd = __builtin_amdgcn_cvt_scalef32_pk_fp4_f32(wd, v[c][d * 2 + 1][2] * inv, v[c][d * 2 + 1][3] * inv, 1.0f, 3);
                        } else {
#pragma unroll
                            for (int k = 0; k < 8; ++k) {
                                const float x = v[c][d * 2 + (k >> 2)][k & 3];
                                const int n = (int)fminf(fmaxf(floorf(x * inv + 8.f), 0.f), 15.f);
                                wd |= (unsigned)n << (4 * ((k >> 1) + 4 * (k & 1)));
                            }
                        }
                        o[d] = wd;
                    }
                    *(u32x4*)(dst + row * 512 + c * 256 + li * 16) = o;
                }
                if (li == 0) sdst[row] = step;
            }
        }
    }
    const size_t nk8 = (size_t)2 * 8 * 2 * 128 * 64 / 8;
    for (size_t i = gtid; i < nk8; i += gstride) {
        const f32x4 a = *(const f32x4*)(p.subkeys + i * 8), b = *(const f32x4*)(p.subkeys + i * 8 + 4);
        u32x4 o; o[0] = pack2(a[0], a[1]); o[1] = pack2(a[2], a[3]); o[2] = pack2(b[0], b[1]); o[3] = pack2(b[2], b[3]);
        *(u32x4*)(p.skeys + i * 8) = o;
    }
    for (size_t i = gtid; i < (size_t)T * 32; i += gstride) {
        const int t = (int)(i >> 5), f = (int)(i & 31);
        const float invrev = exp2f(-(float)f * 0.41524101186092029f) * 0.15915494309189535f;
        float rev = (float)p.pos[t] * invrev; rev -= floorf(rev);
        p.ropec[i] = __builtin_amdgcn_cosf(rev); p.ropes[i] = __builtin_amdgcn_sinf(rev);
    }
}

__device__ void p0_wt(const Params& p, unsigned char* smem) {
    bf16_t* tl = (bf16_t*)smem;
    const int tid = opaque_tid(), kk = tid >> 3, nn = (tid & 7) * 8;
    for (int task = blockIdx.x; task < 2 * 64; task += gridDim.x) {
        const int w = task >> 6, gi = task & 63;
        const float* W = p.peer_wq + (size_t)w * D * D; bf16_t* Wt = w ? p.wt_pq1 : p.wt_pq0; const int ldw = 1024;
        const int ngn = ldw / 256, n0 = (gi % ngn) * 256, k0 = (gi / ngn) * 64;
        f32x4 a[4], b[4];
#pragma unroll
        for (int t4 = 0; t4 < 4; ++t4) { a[t4] = *(const f32x4*)(W + (size_t)(k0 + kk) * ldw + n0 + t4 * 64 + nn); b[t4] = *(const f32x4*)(W + (size_t)(k0 + kk) * ldw + n0 + t4 * 64 + nn + 4); }
#pragma unroll
        for (int t4 = 0; t4 < 4; ++t4)
#pragma unroll
            for (int j = 0; j < 4; ++j) { tl[(t4 * 64 + nn + j) * 72 + kk] = f2bf(a[t4][j]); tl[(t4 * 64 + nn + 4 + j) * 72 + kk] = f2bf(b[t4][j]); }
        __syncthreads();
        const int n = tid >> 3, kc = (tid & 7) * 8;
#pragma unroll
        for (int t4 = 0; t4 < 4; ++t4) {
            const u32x4 v = *(const u32x4*)(tl + (t4 * 64 + n) * 72 + kc);
            *(u32x4*)(Wt + (size_t)(n0 + t4 * 64 + n) * D + k0 + kc) = v;
        }
        __syncthreads();
    }
}

__device__ void p0_w8(const Params& p, unsigned char* smem) {
    float* mx = (float*)smem;
    unsigned char* t8 = smem + 4096;
    const int tid = opaque_tid(), nn = tid & 31, kg = tid >> 5;
    for (int task = blockIdx.x; task < 7 * 32 + 16; task += gridDim.x) {
        const int w = task >> 5, gi = task & 31;
        const float* W; unsigned char* W8; float* cs; int ldw = 1024;
        switch (w) {
            case 0: W = p.w_in; W8 = p.w8_in; cs = p.cs_in; break;
            case 1: W = p.w_glu; W8 = p.w8_glu; cs = p.cs_glu; break;
            case 2: W = p.w_out; W8 = p.w8_out; cs = p.cs_out; break;
            case 3: W = p.w_q; W8 = p.w8_q; cs = p.cs_q; break;
            case 4: W = p.w_o; W8 = p.w8_o; cs = p.cs_o; break;
            case 5: W = p.peer_wq; W8 = p.w8_pq0; cs = p.cs_pq0; break;
            case 6: W = p.peer_wq + (size_t)D * D; W8 = p.w8_pq1; cs = p.cs_pq1; break;
            default: W = p.w_kv; W8 = p.w8_kv; cs = p.cs_kv; ldw = 512; break;
        }
        const int n0 = gi * 32;
        float wv[64]; float m = 0.f;
#pragma unroll
        for (int j = 0; j < 64; ++j) { wv[j] = W[(size_t)(kg * 64 + j) * ldw + n0 + nn]; m = fmaxf(m, fabsf(wv[j])); }
        mx[kg * 32 + nn] = m;
        __syncthreads();
        if (tid < 32) { float mm = 0.f;
#pragma unroll
            for (int g = 0; g < 16; ++g) mm = fmaxf(mm, mx[g * 32 + tid]);
            const float s = mm > 0.f ? mm * (1.f / 448.f) : 1.f; mx[512 + tid] = s; cs[n0 + tid] = s; }
        __syncthreads();
        const float inv = 1.f / mx[512 + nn];
#pragma unroll
        for (int j = 0; j < 64; j += 4) {
            int r = 0;
            r = __builtin_amdgcn_cvt_pk_fp8_f32(wv[j] * inv, wv[j + 1] * inv, r, false);
            r = __builtin_amdgcn_cvt_pk_fp8_f32(wv[j + 2] * inv, wv[j + 3] * inv, r, true);
            *(unsigned*)(t8 + nn * 1040 + kg * 64 + j) = (unsigned)r;
        }
        __syncthreads();
#pragma unroll
        for (int i2 = 0; i2 < 4; ++i2) {
            const int ch = tid + NT * i2, rrow = ch >> 6, c16 = ch & 63;
            *(u32x4*)(W8 + (size_t)(n0 + rrow) * D + c16 * 16) = *(const u32x4*)(t8 + rrow * 1040 + c16 * 16);
        }
        __syncthreads();
    }
}

__device__ __forceinline__ void lam_powf(float ar, float ai, float dt, int n, float& re, float& im) {
    const float m = __expf(ar * dt * (float)n);
    float rev = (ai * dt) * (float)n * 0.15915494309189535f; rev -= floorf(rev);
    re = m * __builtin_amdgcn_cosf(rev); im = m * __builtin_amdgcn_sinf(rev);
}
__device__ __forceinline__ void s5_coeff(float ar, float ai, float dt, float& cre, float& cim) {
    const float a = ar * dt, th = ai * dt;
    float rev = th * 0.15915494309189535f; rev -= floorf(rev);
    float revh = th * 0.5f * 0.15915494309189535f; revh -= floorf(revh);
    const float cs = __builtin_amdgcn_cosf(rev), sn = __builtin_amdgcn_sinf(rev), sh = __builtin_amdgcn_sinf(revh);
    const float em1 = expm1f(a);
    const float nr = em1 * cs - 2.f * sh * sh, ni = (em1 + 1.f) * sn, den = ar * ar + ai * ai;
    cre = (nr * ar + ni * ai) / den; cim = (ni * ar - nr * ai) / den;
}

__device__ void p0_s5(const Params& p, unsigned char* smem) {
    const size_t gtid = (size_t)blockIdx.x * NT + threadIdx.x, gstride = (size_t)gridDim.x * NT;
    for (size_t idx = gtid; idx < (size_t)G5 * P5 * 65; idx += gstride) {
        const int pp = (int)(idx & 63), e = (int)((idx >> 6) % 65), g = (int)(idx / (65 * P5));
        const float dt = __expf(p.log_dt[g]), ar = p.a_re[g * P5 + pp], ai = p.a_im[g * P5 + pp];
        float pwr, pwi; lam_powf(ar, ai, dt, e, pwr, pwi);
        if (e < 64) {
            float cfr, cfi; s5_coeff(ar, ai, dt, cfr, cfi);
            const float wr = pwr * cfr - pwi * cfi, wi = pwr * cfi + pwi * cfr;
            const int j = 63 - e;
            const float* brp = p.b_re + ((size_t)g * P5 + pp) * C5; const float* bip = p.b_im + ((size_t)g * P5 + pp) * C5;
            unsigned ore[8], oim[8];
#pragma unroll
            for (int c4 = 0; c4 < 4; ++c4) {
                const f32x4 br = *(const f32x4*)(brp + c4 * 4), bi = *(const f32x4*)(bip + c4 * 4);
                ore[c4 * 2] = pack2(wr * br[0] - wi * bi[0], wr * br[1] - wi * bi[1]); ore[c4 * 2 + 1] = pack2(wr * br[2] - wi * bi[2], wr * br[3] - wi * bi[3]);
                oim[c4 * 2] = pack2(wr * bi[0] + wi * br[0], wr * bi[1] + wi * br[1]); oim[c4 * 2 + 1] = pack2(wr * bi[2] + wi * br[2], wr * bi[3] + wi * br[3]);
            }
            u32x4* sre = (u32x4*)(p.smat + ((size_t)g * 128 + pp) * 1024 + j * 16);
            u32x4* sim = (u32x4*)(p.smat + ((size_t)g * 128 + 64 + pp) * 1024 + j * 16);
            sre[0] = (u32x4){ore[0], ore[1], ore[2], ore[3]}; sre[1] = (u32x4){ore[4], ore[5], ore[6], ore[7]};
            sim[0] = (u32x4){oim[0], oim[1], oim[2], oim[3]}; sim[1] = (u32x4){oim[4], oim[5], oim[6], oim[7]};
        }
        if (e >= 1) {
            const int i = e - 1;
#pragma unroll 4
            for (int co = 0; co < 16; ++co) {
                const float cr = p.c_re[((size_t)g * C5 + co) * P5 + pp], ci = p.c_im[((size_t)g * C5 + co) * P5 + pp];
                bf16_t* row = p.cmat + ((size_t)g * 1024 + i * 16 + co) * 128;
                row[pp] = f2bf(cr * pwr - ci * pwi);
                row[64 + pp] = f2bf(-(cr * pwi + ci * pwr));
            }
        }
        if (e == 64) {
            const double dtd = exp((double)p.log_dt[g]), m = exp((double)ar * dtd * 64.0);
            double ang = (double)ai * dtd * 64.0; ang -= 6.283185307179586 * floor(ang * 0.15915494309189535);
            p.lamL[(g * P5 + pp) * 2] = (float)(m * cos(ang)); p.lamL[(g * P5 + pp) * 2 + 1] = (float)(m * sin(ang));
        }
    }
    float* wre = (float*)smem;
    float* wim = wre + 1024;
    const int tid = threadIdx.x;
    for (int task = blockIdx.x; task < G5 * 4; task += gridDim.x) {
        const int g = task >> 2, tq = task & 3;
        const float dt = __expf(p.log_dt[g]);
        for (int i = tid; i < 1024; i += NT) {
            const int pp = i & 63, tau = tq * 16 + (i >> 6);
            const float ar = p.a_re[g * P5 + pp], ai = p.a_im[g * P5 + pp];
            float pwr, pwi, cfr, cfi; lam_powf(ar, ai, dt, tau, pwr, pwi); s5_coeff(ar, ai, dt, cfr, cfi);
            wre[i] = pwr * cfr - pwi * cfi; wim[i] = pwr * cfi + pwi * cfr;
        }
        __syncthreads();
        {
            const int co = (tid >> 4) & 15, ci = tid & 15, ph = tid >> 8;
            float* part = wim + 1024;
            float cbr[32], cbi[32];
#pragma unroll 8
            for (int k = 0; k < 32; ++k) {
                const int pp = ph * 32 + k;
                const float br = p.b_re[((size_t)g * P5 + pp) * C5 + ci], bi = p.b_im[((size_t)g * P5 + pp) * C5 + ci];
                const float cr = p.c_re[((size_t)g * C5 + co) * P5 + pp], cim = p.c_im[((size_t)g * C5 + co) * P5 + pp];
                cbr[k] = cr * br - cim * bi; cbi[k] = cr * bi + cim * br;
            }
            float sres[16];
#pragma unroll
            for (int tl = 0; tl < 16; ++tl) {
                float s0 = 0.f, s1 = 0.f;
#pragma unroll
                for (int k = 0; k < 32; k += 2) {
                    s0 += cbr[k] * wre[tl * 64 + ph * 32 + k] - cbi[k] * wim[tl * 64 + ph * 32 + k];
                    s1 += cbr[k + 1] * wre[tl * 64 + ph * 32 + k + 1] - cbi[k + 1] * wim[tl * 64 + ph * 32 + k + 1];
                }
                sres[tl] = s0 + s1;
            }
            if (ph == 1) {
#pragma unroll
                for (int tl = 0; tl < 16; ++tl) part[tl * 256 + (tid & 255)] = sres[tl];
            }
            __syncthreads();
            if (ph == 0) {
#pragma unroll
                for (int tl = 0; tl < 16; ++tl) p.ktab[((size_t)g * KTR + tq * 16 + tl + 16) * 256 + tid] = f2bf(sres[tl] + part[tl * 256 + tid]);
                if (tq == 0) {
#pragma unroll
                    for (int r = 0; r < 16; ++r) p.ktab[((size_t)g * KTR + r) * 256 + tid] = 0;
                }
            }
        }
        __syncthreads();
    }
}

__device__ void p05_prep(const Params& p, unsigned char* smem) {
    {
        const int lane = threadIdx.x & 63, wv = threadIdx.x >> 6;
        const int nw = gridDim.x * (NT / 64);
        const int tf = blockIdx.x * (NT / 64) + wv;
        f32x4 n1[4], n2[4];
#pragma unroll
        for (int j = 0; j < 4; ++j) { n1[j] = (f32x4){0.f, 0.f, 0.f, 0.f}; n2[j] = n1[j]; }
        if (tf < T) {
#pragma unroll
            for (int j = 0; j < 4; ++j) n1[j] = *(const f32x4*)(p.x + (size_t)tf * D + j * 256 + lane * 4);
        }
        if (tf + nw < T) {
#pragma unroll
            for (int j = 0; j < 4; ++j) n2[j] = *(const f32x4*)(p.x + (size_t)(tf + nw) * D + j * 256 + lane * 4);
        }
        for (int t = tf; t < T; t += nw) {
            const int b = t / SEQ;
            const float* cb = p.cond + (size_t)b * (NCOND * D);
            f32x4 v[4]; float s = 0.f;
#pragma unroll
            for (int j = 0; j < 4; ++j) { v[j] = n1[j]; n1[j] = n2[j]; }
            if (t + 2 * nw < T) {
#pragma unroll
                for (int j = 0; j < 4; ++j) n2[j] = *(const f32x4*)(p.x + (size_t)(t + 2 * nw) * D + j * 256 + lane * 4);
            }
#pragma unroll
            for (int j = 0; j < 4; ++j) s += v[j][0] * v[j][0] + v[j][1] * v[j][1] + v[j][2] * v[j][2] + v[j][3] * v[j][3];
            s = wave_sum(s);
            const float rstd = rsqrtf(s * (1.f / D) + RMS_EPS);
#pragma unroll
            for (int j = 0; j < 4; ++j) {
                const int e = j * 256 + lane * 4;
                const f32x4 g = *(const f32x4*)(p.norm_mix + e), sh = *(const f32x4*)(cb + 0 * D + e), sc = *(const f32x4*)(cb + 1 * D + e);
                float h[4];
#pragma unroll
                for (int i = 0; i < 4; ++i) h[i] = v[j][i] * rstd * g[i] * (1.f + sc[i]) + sh[i];
                int r8 = 0;
                r8 = __builtin_amdgcn_cvt_pk_fp8_f32(h[0], h[1], r8, false);
                r8 = __builtin_amdgcn_cvt_pk_fp8_f32(h[2], h[3], r8, true);
                *(unsigned*)((unsigned char*)p.s0 + (size_t)t * D + e) = (unsigned)r8;
            }
        }
    }
    for (int i = blockIdx.x * NT + threadIdx.x; i < 4 * 1024; i += gridDim.x * NT) {
        const int b = i >> 10, k = i & 1023;
        const float* cb = p.cond + (size_t)b * (NCOND * D);
        bf16_t* o = p.cvec + (size_t)b * 12 * 1024 + k;
        o[0 * 1024] = f2bf(p.norm_ffn[k] * (1.f + cb[4 * D + k]));      o[1 * 1024] = f2bf(cb[3 * D + k]);  o[2 * 1024] = f2bf(cb[5 * D + k]);
        o[3 * 1024] = f2bf(p.kv_norm[k] * (1.f + cb[13 * D + k]));      o[4 * 1024] = f2bf(cb[12 * D + k]);
        o[5 * 1024] = f2bf(p.norm_mix[D + k] * (1.f + cb[7 * D + k]));  o[6 * 1024] = f2bf(cb[6 * D + k]);
        o[7 * 1024] = f2bf(p.norm_ffn[D + k] * (1.f + cb[10 * D + k])); o[8 * 1024] = f2bf(cb[9 * D + k]);  o[9 * 1024] = f2bf(cb[11 * D + k]);
        o[10 * 1024] = f2bf(p.final_norm[k] * (1.f + cb[15 * D + k]));  o[11 * 1024] = f2bf(cb[14 * D + k]);
    }
    float* red = (float*)smem;
    const int tid = threadIdx.x;
    for (int task = blockIdx.x; task < 32 * 8; task += gridDim.x) {
        const int ct = task >> 3, ks = task & 7, col0 = ct * 64, layer = col0 >> 10;
        const float* W = p.peer_wq + (size_t)layer * D * D; const int cs = layer ? 9 : 3;
        const int n = (col0 & 1023) + (tid & 63), kg = tid >> 6;
        float wv[16];
#pragma unroll
        for (int j = 0; j < 16; ++j) wv[j] = W[(size_t)(ks * 128 + kg * 16 + j) * D + n];
        float acc[4] = {0.f, 0.f, 0.f, 0.f};
#pragma unroll
        for (int j = 0; j < 16; ++j)
#pragma unroll
            for (int b = 0; b < 4; ++b) acc[b] += p.cond[(size_t)b * (NCOND * D) + cs * D + ks * 128 + kg * 16 + j] * wv[j];
#pragma unroll
        for (int b = 0; b < 4; ++b) red[(kg * 64 + (tid & 63)) * 4 + b] = acc[b];
        __syncthreads();
        if (tid < 256) {
            const int col = tid >> 2, b = tid & 3; float sum = 0.f;
#pragma unroll
            for (int g = 0; g < 8; ++g) sum += red[(g * 64 + col) * 4 + b];
            p.biasp[((size_t)ks * 4 + b) * 2048 + col0 + col] = sum;
        }
        __syncthreads();
    }
}
__device__ void bias_finalize(const Params& p) {
    const int i = blockIdx.x * NT + threadIdx.x;
    if (i < 4 * 2048) { float s = 0.f;
#pragma unroll
        for (int ks = 0; ks < 8; ++ks) s += p.biasp[(size_t)ks * 8192 + i];
        p.bias[i] = s; }
}

__device__ __forceinline__ int lds_off(int row, int chunk) { return row * 128 + ((chunk ^ (row & 7)) << 4); }

template <int BN, class Epi, bool FP8 = false>
__device__ void gemm_phase(const void* __restrict__ Av, const void* __restrict__ Btv, size_t bt_batch_stride, int N, const Epi& epi, unsigned char* smem) {
    constexpr int ES = FP8 ? 1 : 2, NKS = D * ES / 128;
    const unsigned char* A = (const unsigned char*)Av; const unsigned char* Bt = (const unsigned char*)Btv;
    constexpr int WMI = BN == 256 ? 8 : 4;
    constexpr int A_BYTES = 32768, B_BYTES = BN * 128, BUF = A_BYTES + B_BYTES;
    const int tid = opaque_tid(), lane = tid & 63, w = __builtin_amdgcn_readfirstlane(tid >> 6), tk = lane & 15, q = lane >> 4;
    const int wm = BN == 256 ? (w >> 2) : (w >> 1), wn = BN == 256 ? (w & 3) : (w & 1);
    const int nN = N / BN;
    const bool xmap = (gridDim.x % 8) == 0;
    const int nslots = xmap ? gridDim.x / 8 : gridDim.x, slot = xmap ? (blockIdx.x >> 3) : blockIdx.x, xcd = blockIdx.x & 7;
    const int nitems = xmap ? 8 * nN : 64 * nN;
    for (int item = slot; item < nitems; item += nslots) {
        const int pm = xmap ? xcd * 8 + item / nN : item / nN, pn = item % nN;
        const int m0 = pm * 256, n0 = pn * BN, b = m0 / SEQ;
        const unsigned char* Ab = A + (size_t)m0 * (D * ES);
        const unsigned char* Bb = Bt + (size_t)b * bt_batch_stride + (size_t)n0 * (D * ES);
        f32x4 acc[WMI][4];
#pragma unroll
        for (int mi = 0; mi < WMI; ++mi)
#pragma unroll
            for (int ni = 0; ni < 4; ++ni) acc[mi][ni] = (f32x4){0.f, 0.f, 0.f, 0.f};
        auto stage = [&](int buf, int kt) {
#pragma unroll
            for (int j = 0; j < 4; ++j) {
                const int piece = w * 4 + j, P = piece * 1024 + lane * 16, row = P >> 7, lc = ((P >> 4) & 7) ^ (row & 7);
                __builtin_amdgcn_global_load_lds((const __attribute__((address_space(1))) void*)(Ab + (size_t)row * (D * ES) + kt * 128 + lc * 16),
                                                 (__attribute__((address_space(3))) void*)(smem + buf * BUF + piece * 1024), 16, 0, 0);
            }
#pragma unroll
            for (int j = 0; j < BN / 64; ++j) {
                const int piece = w * (BN / 64) + j, P = piece * 1024 + lane * 16, row = P >> 7, lc = ((P >> 4) & 7) ^ (row & 7);
                __builtin_amdgcn_global_load_lds((const __attribute__((address_space(1))) void*)(Bb + (size_t)row * (D * ES) + kt * 128 + lc * 16),
                                                 (__attribute__((address_space(3))) void*)(smem + buf * BUF + A_BYTES + piece * 1024), 16, 0, 0);
            }
        };
        const int swz = tk & 7;
        const int offA = (wm * (WMI * 16) + tk) * 128, offB = A_BYTES + (wn * 64 + tk) * 128;
        auto compute = [&](int buf) {
            const unsigned char* sb = smem + buf * BUF;
            if constexpr (!FP8) {
#pragma unroll
                for (int ks = 0; ks < 2; ++ks) {
                    const int co = ((ks * 4 + q) ^ swz) * 16;
                    const unsigned char* pa = sb + offA + co; const unsigned char* pb = sb + offB + co;
                    bf16x8 bfr[4];
#pragma unroll
                    for (int ni = 0; ni < 4; ++ni) bfr[ni] = *(const bf16x8*)(pb + ni * 2048);
#pragma unroll
                    for (int mh = 0; mh < WMI / 4; ++mh) {
                        bf16x8 af[4];
#pragma unroll
                        for (int mi = 0; mi < 4; ++mi) af[mi] = *(const bf16x8*)(pa + (mh * 4 + mi) * 2048);
#pragma unroll
                        for (int mi = 0; mi < 4; ++mi)
#pragma unroll
                            for (int ni = 0; ni < 4; ++ni) acc[mh * 4 + mi][ni] = __builtin_amdgcn_mfma_f32_16x16x32_bf16(bfr[ni], af[mi], acc[mh * 4 + mi][ni], 0, 0, 0);
                    }
                }
            } else {
                typedef int i32x8g __attribute__((ext_vector_type(8)));
                const int clo = (q ^ swz) * 16, chi = ((4 + q) ^ swz) * 16;
                const unsigned char* pa = sb + offA; const unsigned char* pb = sb + offB;
                auto frag = [&](const unsigned char* s) {
                    const u32x4 lo = *(const u32x4*)(s + clo), hi = *(const u32x4*)(s + chi);
                    return (i32x8g){(int)lo[0], (int)lo[1], (int)lo[2], (int)lo[3], (int)hi[0], (int)hi[1], (int)hi[2], (int)hi[3]};
                };
                i32x8g bfr[4];
#pragma unroll
                for (int ni = 0; ni < 4; ++ni) bfr[ni] = frag(pb + ni * 2048);
#pragma unroll
                for (int m2 = 0; m2 < WMI / 2; ++m2) {
                    i32x8g af[2];
#pragma unroll
                    for (int mi = 0; mi < 2; ++mi) af[mi] = frag(pa + (m2 * 2 + mi) * 2048);
#pragma unroll
                    for (int mi = 0; mi < 2; ++mi)
#pragma unroll
                        for (int ni = 0; ni < 4; ++ni)
                            acc[m2 * 2 + mi][ni] = __builtin_amdgcn_mfma_scale_f32_16x16x128_f8f6f4(bfr[ni], af[mi], acc[m2 * 2 + mi][ni], 0, 0, 0, 0x7f7f7f7f, 0, 0x7f7f7f7f);
                    if (m2 & 1) __builtin_amdgcn_sched_barrier(0);
                }
            }
        };
        stage(0, 0);
        __syncthreads();
#pragma unroll 1
        for (int kt = 0; kt < NKS; ++kt) {
            if (kt + 1 < NKS) stage((kt + 1) & 1, kt + 1);
            compute(kt & 1);
            __syncthreads();
        }
        float* stg = (float*)(smem + w * 17408);
#pragma unroll
        for (int mh = 0; mh < WMI / 4; ++mh) {
#pragma unroll
            for (int mi = 0; mi < 4; ++mi)
#pragma unroll
                for (int ni = 0; ni < 4; ++ni) *(f32x4*)(stg + (mi * 16 + tk) * 68 + ni * 16 + 4 * q) = acc[mh * 4 + mi][ni];
            asm volatile("s_waitcnt lgkmcnt(0)" ::: "memory");
            const int c4 = lane & 15, rsub = lane >> 4;
            const int tok0 = m0 + wm * (WMI * 16) + mh * 64, nb0 = n0 + wn * 64, slot_ = pn * (BN / 64) + wn;
#pragma unroll 1
            for (int hf = 0; hf < 4; ++hf) {
                typename Epi::Pre pr[4];
#pragma unroll
                for (int ps = 0; ps < 4; ++ps) pr[ps] = epi.pre(tok0 + (hf * 4 + ps) * 4 + rsub, nb0, c4, b);
#pragma unroll
                for (int ps = 0; ps < 4; ++ps) {
                    const int row = (hf * 4 + ps) * 4 + rsub;
                    const f32x4 v = *(const f32x4*)(stg + row * 68 + c4 * 4);
                    epi.row(tok0 + row, nb0, c4, v, b, slot_, pr[ps]);
                }
            }
            asm volatile("s_waitcnt lgkmcnt(0)" ::: "memory");
        }
        __syncthreads();
    }
}

__device__ __forceinline__ float rstd_of(const float* ssq, int token) {
    const f32x4* s4 = (const f32x4*)(ssq + (size_t)token * 16);
    const f32x4 a = s4[0], b = s4[1], c = s4[2], d = s4[3];
    const float s = ((a[0] + a[1]) + (a[2] + a[3])) + ((b[0] + b[1]) + (b[2] + b[3])) + ((c[0] + c[1]) + (c[2] + c[3])) + ((d[0] + d[1]) + (d[2] + d[3]));
    return rsqrtf(s * (1.f / D) + RMS_EPS);
}

template <int CTRL> __device__ __forceinline__ float dppx(float v) { return __uint_as_float((unsigned)__builtin_amdgcn_update_dpp(0, (int)__float_as_uint(v), CTRL, 0xf, 0xf, true)); }
struct EpiU {
    struct Pre {};
    bf16_t* ug; const float* cs;
    __device__ __forceinline__ Pre pre(int, int, int, int) const { return Pre{}; }
    __device__ __forceinline__ void row(int token, int nbase, int c4, f32x4 v, int b, int, const Pre&) const {
        const int n = nbase + 4 * c4, g = n >> 4, s = token - b * SEQ;
        const f32x4 sc = *(const f32x4*)(cs + n);
        u32x2 o; o[0] = pack2(v[0] * sc[0], v[1] * sc[1]); o[1] = pack2(v[2] * sc[2], v[3] * sc[3]);
        *(u32x2*)(ug + (((size_t)(g * 4 + b) * SEQ + s) * 16 + (n & 15))) = o;
    }
};
struct EpiQ {
    struct Pre { float sq; };
    const float* ssq; const float* bias; int boff; bf16_t* out; const float* cs;
    __device__ __forceinline__ Pre pre(int token, int, int c4, int) const { return Pre{ssq[(size_t)token * 16 + c4]}; }
    __device__ __forceinline__ void row(int token, int nbase, int c4, f32x4 v, int b, int, const Pre& pr) const {
        const int n = nbase + 4 * c4;
        float s = pr.sq; s += dppx<0xB1>(s); s += dppx<0x4E>(s); s += dppx<0x141>(s); s += dppx<0x140>(s);
        const float rstd = rsqrtf(s * (1.f / D) + RMS_EPS);
        const f32x4 bv = *(const f32x4*)(bias + (size_t)b * 2048 + boff + n); const f32x4 csv = *(const f32x4*)(cs + n);
        u32x2 o; o[0] = pack2(rstd * csv[0] * v[0] + bv[0], rstd * csv[1] * v[1] + bv[1]); o[1] = pack2(rstd * csv[2] * v[2] + bv[2], rstd * csv[3] * v[3] + bv[3]);
        *(u32x2*)(out + (size_t)token * D + n) = o;
    }
};
struct EpiGlu {
    struct Pre { int yw; };
    const unsigned char* y; const float* bglu; const float* cs; unsigned char* out;
    __device__ __forceinline__ Pre pre(int token, int nbase, int c4, int) const { return Pre{*(const int*)(y + (size_t)token * D + nbase + 4 * c4)}; }
    __device__ __forceinline__ void row(int token, int nbase, int c4, f32x4 v, int, int, const Pre& pr) const {
        const int n = nbase + 4 * c4;
        const f32x4 bv = *(const f32x4*)(bglu + n), sc = *(const f32x4*)(cs + n);
        const f32x2 ylo = __builtin_amdgcn_cvt_pk_f32_fp8(pr.yw, false), yhi = __builtin_amdgcn_cvt_pk_f32_fp8(pr.yw, true);
        const float o0 = ylo[0] / (1.f + __expf(-(v[0] * sc[0] + bv[0]))), o1 = ylo[1] / (1.f + __expf(-(v[1] * sc[1] + bv[1])));
        const float o2 = yhi[0] / (1.f + __expf(-(v[2] * sc[2] + bv[2]))), o3 = yhi[1] / (1.f + __expf(-(v[3] * sc[3] + bv[3])));
        *(unsigned*)(out + (size_t)token * D + n) = pack4_fp8(o0, o1, o2, o3);
    }
};
template <bool XB16>
struct EpiRes {
    struct Pre { f32x4 xo; };
    const void* xold; const float* gate  ; const float* gnorm; const float* scale  ; bf16_t* xout; bf16_t* xbout; float* ssq; const float* cs;
    __device__ __forceinline__ Pre pre(int token, int nbase, int c4, int) const {
        if (XB16) { const u32x2 w = *(const u32x2*)((const bf16_t*)xold + (size_t)token * D + nbase + 4 * c4); return Pre{(f32x4){bflo(w[0]), bfhi(w[0]), bflo(w[1]), bfhi(w[1])}}; }
        return Pre{*(const f32x4*)((const float*)xold + (size_t)token * D + nbase + 4 * c4)};
    }
    __device__ __forceinline__ void row(int token, int nbase, int c4, f32x4 v, int b, int slot, const Pre& pr) const {
        const int n = nbase + 4 * c4;
        const f32x4 gv = *(const f32x4*)(gate + (size_t)b * (NCOND * D) + n), gn = *(const f32x4*)(gnorm + n), sc = *(const f32x4*)(scale + (size_t)b * (NCOND * D) + n);
        const f32x4 csv = *(const f32x4*)(cs + n);
        f32x4 xn; float hs[4]; float ss = 0.f;
#pragma unroll
        for (int r = 0; r < 4; ++r) { xn[r] = pr.xo[r] + gv[r] * (v[r] * csv[r]); ss += xn[r] * xn[r]; hs[r] = xn[r] * gn[r] * (1.f + sc[r]); }
        { u32x2 xo2; xo2[0] = pack2(xn[0], xn[1]); xo2[1] = pack2(xn[2], xn[3]); *(u32x2*)(xout + (size_t)token * D + n) = xo2; }
        *(unsigned*)((unsigned char*)xbout + (size_t)token * D + n) = pack4_fp8(hs[0], hs[1], hs[2], hs[3]);
        ss += dppx<0xB1>(ss); ss += dppx<0x4E>(ss); ss += dppx<0x141>(ss); ss += dppx<0x140>(ss);
        if (c4 == 0) ssq[(size_t)token * 16 + slot] = ss;
    }
};
template <int MODE  >
struct EpiRope {
    struct Pre { f32x4 cs4, sn4; };
    const float* ropec; const float* ropes; bf16_t* o0; bf16_t* o1; const float* cs;
    __device__ __forceinline__ Pre pre(int token, int nbase, int c4, int) const {
        Pre pr; pr.cs4 = (f32x4){0.f, 0.f, 0.f, 0.f}; pr.sn4 = pr.cs4;
        if (MODE == 1 || nbase < 256) { const int d = (c4 & 7) * 4; pr.cs4 = *(const f32x4*)(ropec + (size_t)token * 32 + d); pr.sn4 = *(const f32x4*)(ropes + (size_t)token * 32 + d); }
        return pr;
    }
    __device__ __forceinline__ void row(int token, int nbase, int c4, f32x4 v, int, int, const Pre& pr) const {
        { const f32x4 csv = *(const f32x4*)(cs + nbase + 4 * c4); v = v * csv; }
        const bool rope = MODE == 1 || nbase < 256;
        if (rope) {
            f32x4 pv;
#pragma unroll
            for (int r = 0; r < 4; ++r) pv[r] = dppx<0x128>(v[r]);
            if (c4 < 8) {
#pragma unroll
                for (int r = 0; r < 4; ++r) v[r] = v[r] * pr.cs4[r] - pv[r] * pr.sn4[r];
            } else {
#pragma unroll
                for (int r = 0; r < 4; ++r) v[r] = v[r] * pr.cs4[r] + pv[r] * pr.sn4[r];
            }
        }
        const int n = nbase + 4 * c4;
        bf16_t* dst = MODE == 1 ? o0 + (size_t)token * D + n : (nbase < 256 ? o0 + (size_t)token * 256 + n : o1 + (size_t)token * 256 + (n - 256));
        u32x2 o; o[0] = pack2(v[0], v[1]); o[1] = pack2(v[2], v[3]);
        *(u32x2*)dst = o;
    }
};

__device__ void s5_phase(const Params& p, unsigned char* smem) {
    bf16_t* Xl = (bf16_t*)smem;
    float* Sl = (float*)(smem + 16384);
    bf16_t* ktl = (bf16_t*)(smem + 16384);
    const int tid = opaque_tid(), lane = tid & 63, w = __builtin_amdgcn_readfirstlane(tid >> 6), cb = w & 3, hh = w >> 2, tk = lane & 15, q = lane >> 4;
    for (int task = blockIdx.x; task < G5 * NB; task += gridDim.x) {
        const int g = (task & 7) * 8 + ((task >> 3) >> 2), b = (task >> 3) & 3;
        const bf16_t* U = p.s1 + (size_t)(g * 4 + b) * SEQ * 16;
        const bf16_t* sm = p.smat + (size_t)g * 128 * 1024;
        const bf16_t* cm = p.cmat + (size_t)g * 1024 * 128;
        bf16x8 ufr[32];
#pragma unroll
        for (int ks = 0; ks < 32; ++ks) ufr[ks] = *(const bf16x8*)((const unsigned char*)U + (unsigned)(((cb * 16 + tk) * 1024 + ks * 32 + 8 * q) * 2));
        {
            unsigned char* stg = smem + 49664;
            auto stageA = [&](int buf, int kc) {
#pragma unroll
                for (int j = 0; j < 4; ++j) {
                    const int piece = w * 4 + j, P = piece * 1024 + lane * 16, row = P >> 8, lc = ((P >> 4) & 15) ^ (row & 15);
                    __builtin_amdgcn_global_load_lds((const __attribute__((address_space(1))) void*)((const unsigned char*)sm + (unsigned)(row * 2048 + kc * 256 + lc * 16)),
                                                     (__attribute__((address_space(3))) void*)(stg + buf * 32768 + piece * 1024), 16, 0, 0);
                }
            };
            f32x4 acc[4];
#pragma unroll
            for (int mf = 0; mf < 4; ++mf) acc[mf] = (f32x4){0.f, 0.f, 0.f, 0.f};
            stageA(0, 0);
#pragma unroll
            for (int kc = 0; kc < 8; ++kc) {
                asm volatile("s_waitcnt vmcnt(0)" ::: "memory");
                __syncthreads();
                if (kc + 1 < 8) stageA((kc + 1) & 1, kc + 1);
                const unsigned char* sb = stg + (kc & 1) * 32768 + (hh * 64 + tk) * 256;
#pragma unroll
                for (int mf = 0; mf < 4; ++mf)
#pragma unroll
                    for (int j = 0; j < 4; ++j) {
                        const bf16x8 af = *(const bf16x8*)(sb + mf * 4096 + (((j * 4 + q) ^ tk) << 4));
                        acc[mf] = __builtin_amdgcn_mfma_f32_16x16x32_bf16(af, ufr[kc * 4 + j], acc[mf], 0, 0, 0);
                    }
            }
#pragma unroll
            for (int mf = 0; mf < 4; ++mf)
#pragma unroll
                for (int r = 0; r < 4; ++r) Sl[((hh * 4 + mf) * 16 + 4 * q + r) * 65 + cb * 16 + tk] = acc[mf][r];
        }
        __syncthreads();
        if (w == 0) {
            const float lr = p.lamL[(g * P5 + lane) * 2], li = p.lamL[(g * P5 + lane) * 2 + 1];
            float xr = 0.f, xi = 0.f;
#pragma unroll 1
            for (int k0 = 0; k0 < NCH; k0 += 8) {
                float sr[8], si[8];
#pragma unroll
                for (int j = 0; j < 8; ++j) { sr[j] = Sl[lane * 65 + k0 + j]; si[j] = Sl[(64 + lane) * 65 + k0 + j]; }
#pragma unroll
                for (int j = 0; j < 8; ++j) {
                    Xl[(k0 + j) * 128 + lane] = f2bf(xr); Xl[(k0 + j) * 128 + 64 + lane] = f2bf(xi);
                    const float nr = lr * xr - li * xi + sr[j], ni = lr * xi + li * xr + si[j];
                    xr = nr; xi = ni;
                }
            }
        }
        __syncthreads();
        {
            const unsigned char* ktg = (const unsigned char*)(p.ktab + (size_t)g * KTR * 256);
#pragma unroll
            for (int j = 0; j < 5; ++j) {
                const int piece = w * 5 + j;
                __builtin_amdgcn_global_load_lds((const __attribute__((address_space(1))) void*)(ktg + piece * 1024 + lane * 16),
                                                 (__attribute__((address_space(3))) void*)((unsigned char*)ktl + piece * 1024), 16, 0, 0);
            }
        }
        const f32x4 dv = *(const f32x4*)(p.s5d + g * 16 + 4 * q);
        unsigned char* ybase = (unsigned char*)p.s0 + (size_t)b * SEQ * D + g * 16;
        const int jl = q >> 1, cih = q & 1;
        const bf16_t* kbase = ktl + (16 - jl) * 256 + tk * 16 + cih * 8;
        unsigned char* stg = smem + 57344;
        auto win_i0 = [&](int hs, int wd) { return 8 * wd + hs; };
        auto stageC = [&](int buf, int wd) {
#pragma unroll
            for (int j = 0; j < 4; ++j) {
                const int piece = w * 4 + j, P = piece * 1024 + lane * 16, rb = P >> 8, c = (P >> 4) & 15, co = rb & 15, il = (rb >> 4) & 3, hs = rb >> 6;
                const int ipos = win_i0(hs, wd) + 2 * il;
                __builtin_amdgcn_global_load_lds((const __attribute__((address_space(1))) void*)((const unsigned char*)cm + (unsigned)((ipos * 16 + co) * 256 + ((c ^ co) << 4))),
                                                 (__attribute__((address_space(3))) void*)(stg + buf * 32768 + piece * 1024), 16, 0, 0);
            }
        };
        stageC(0, 0);
        bf16x8 xfr[4];
#pragma unroll
        for (int ks = 0; ks < 4; ++ks) xfr[ks] = *(const bf16x8*)(Xl + (cb * 16 + tk) * 128 + ks * 32 + 8 * q);
#pragma unroll 1
        for (int wd = 0; wd < 8; ++wd) {
            asm volatile("s_waitcnt vmcnt(0)" ::: "memory");
            __syncthreads();
            if (wd + 1 < 8) stageC((wd + 1) & 1, wd + 1);
            const unsigned char* cbuf = stg + (wd & 1) * 32768 + (hh * 64 + tk) * 256;
            const int i0 = win_i0(hh, wd);
            const int s0 = (cb * 16 + tk) * 64 + i0;
            u32x2 uv[4];
#pragma unroll
            for (int e = 0; e < 4; ++e) uv[e] = *(const u32x2*)((const unsigned char*)U + (unsigned)((s0 + 2 * e) * 32 + 8 * q));
            f32x4 acc[4];
#pragma unroll
            for (int e = 0; e < 4; ++e) {
                acc[e] = (f32x4){0.f, 0.f, 0.f, 0.f};
#pragma unroll
                for (int ks = 0; ks < 4; ++ks) acc[e] = __builtin_amdgcn_mfma_f32_16x16x32_bf16(*(const bf16x8*)(cbuf + e * 4096 + (((ks * 4 + q) ^ tk) << 4)), xfr[ks], acc[e], 0, 0, 0);
                __builtin_amdgcn_sched_barrier(0);
            }
            const int mmaxw = (i0 + 6) >> 1;
            const bf16_t* kbw = kbase + i0 * 256;
            bf16x8 ring[4];
            ring[1] = *(const bf16x8*)(kbw + 3 * 512); ring[2] = *(const bf16x8*)(kbw + 2 * 512); ring[3] = *(const bf16x8*)(kbw + 1 * 512); ring[0] = *(const bf16x8*)(kbw);
#pragma unroll
            for (int mg = 0; mg < 8; ++mg) {
                if (4 * mg <= mmaxw) {
#pragma unroll
                    for (int j = 0; j < 4; ++j) {
                        const int m = 4 * mg + j;
                        acc[3] = __builtin_amdgcn_mfma_f32_16x16x32_bf16(ring[(j + 1) & 3], ufr[m], acc[3], 0, 0, 0);
                        ring[(j + 1) & 3] = *(const bf16x8*)(kbw - (m + 1) * 512);
                        acc[2] = __builtin_amdgcn_mfma_f32_16x16x32_bf16(ring[(j + 2) & 3], ufr[m], acc[2], 0, 0, 0);
                        acc[1] = __builtin_amdgcn_mfma_f32_16x16x32_bf16(ring[(j + 3) & 3], ufr[m], acc[1], 0, 0, 0);
                        acc[0] = __builtin_amdgcn_mfma_f32_16x16x32_bf16(ring[j], ufr[m], acc[0], 0, 0, 0);
                    }
                }
            }
#pragma unroll
            for (int e = 0; e < 4; ++e) {
                const float y0 = gelu_tanh(acc[e][0] + dv[0] * bflo(uv[e][0])), y1 = gelu_tanh(acc[e][1] + dv[1] * bfhi(uv[e][0]));
                const float y2 = gelu_tanh(acc[e][2] + dv[2] * bflo(uv[e][1])), y3 = gelu_tanh(acc[e][3] + dv[3] * bfhi(uv[e][1]));
                *(unsigned*)(ybase + (unsigned)((s0 + 2 * e) * D + 4 * q)) = pack4_fp8(y0, y1, y2, y3);
            }
        }
        __syncthreads();
    }
}

__device__ __forceinline__ float med3f(float a, float b, float c) { return __builtin_amdgcn_fmed3f(a, b, c); }
__device__ __forceinline__ void ins16(float (&a)[16], float v) {
#pragma unroll
    for (int i = 15; i >= 1; --i) a[i] = med3f(a[i - 1], a[i], v);
    a[0] = med3f(__builtin_inff(), a[0], v);
}
__device__ void route_phase(const Params& p, int layer, const bf16_t* qp, unsigned char* smem) {
    float* sc = (float*)smem;
    float* tl = (float*)(smem + 2 * 128 * 132 * 4);
    const int tid_hw = opaque_tid(), lane = tid_hw & 63, tk = lane & 15, q = lane >> 4;
    int w;
    {
        volatile LAS int* rc = (volatile LAS int*)(smem + 2 * 128 * 132 * 4 + 2 * 128 * 16 * 4);
        if (tid_hw < 4) rc[tid_hw] = 0;
        __syncthreads();
        const int simd = (int)((__builtin_amdgcn_s_getreg((1 << 11) | (4 << 6) | 4)) & 3u);
        int slot = 0;
        if (lane == 0) slot = __hip_atomic_fetch_add((LAS int*)&rc[simd], 1, __ATOMIC_RELAXED, __HIP_MEMORY_SCOPE_WORKGROUP);
        slot = __builtin_amdgcn_readfirstlane(slot);
        __syncthreads();
        const bool balanced = rc[0] == 2 && rc[1] == 2 && rc[2] == 2 && rc[3] == 2;
        w = balanced ? slot * 4 + simd : (tid_hw >> 6);
        w = __builtin_amdgcn_readfirstlane(w);
        __syncthreads();
    }
    const int tid = w * 64 + lane;
    const int gsel = (int)(gridDim.x & ~7u);
    if ((int)blockIdx.x >= gsel) return;
    const int tt_first = (int)(blockIdx.x >> 3), tt_step = gsel >> 3;
    auto pk = [](float v, unsigned idx) -> float { return __uint_as_float((__float_as_uint(v) & ~0x7Fu) | idx); };
    {
        const int h = (int)(blockIdx.x & 7);
        int tt = tt_first;
        if (tt >= T / 128) return;
        if (w < 4) {
            bf16x8 kf[2][8][2];
#pragma unroll
            for (int pp = 0; pp < 2; ++pp)
#pragma unroll
                for (int nf = 0; nf < 8; ++nf) {
                    const bf16_t* kb = p.skeys + ((size_t)((layer * 8 + h) * 2 + pp) * 128 + nf * 16 + tk) * 64 + 8 * q;
                    kf[pp][nf][0] = *(const bf16x8*)(kb); kf[pp][nf][1] = *(const bf16x8*)(kb + 32);
                }
            bf16x8 qa[2][4];
            auto load_q = [&](int t0_) {
#pragma unroll
                for (int g = 0; g < 2; ++g) {
                    const bf16_t* qrow = qp + (size_t)(t0_ + 32 * w + 16 * g + tk) * D + h * 128 + 8 * q;
#pragma unroll
                    for (int c_ = 0; c_ < 4; ++c_) qa[g][c_] = *(const bf16x8*)(qrow + 32 * c_);
                }
            };
            auto scores = [&]() {
#pragma unroll
                for (int g = 0; g < 2; ++g)
#pragma unroll
                    for (int pp = 0; pp < 2; ++pp)
#pragma unroll
                        for (int nf = 0; nf < 8; ++nf) {
                            f32x4 acc = {0.f, 0.f, 0.f, 0.f};
                            acc = __builtin_amdgcn_mfma_f32_16x16x32_bf16(kf[pp][nf][0], qa[g][pp * 2], acc, 0, 0, 0);
                            acc = __builtin_amdgcn_mfma_f32_16x16x32_bf16(kf[pp][nf][1], qa[g][pp * 2 + 1], acc, 0, 0, 0);
                            *(f32x4*)(sc + (pp * 128 + 32 * w + 16 * g + tk) * 132 + nf * 16 + 4 * q) = acc;
                        }
            };
            load_q(tt * 128);
            scores();
            __syncthreads();
            for (;;) {
                const int ntt = tt + tt_step;
                const bool hn = ntt < T / 128;
                if (hn) load_q(ntt * 128);
                float a[16];
                const float* row = sc + tid * 132;
#pragma unroll
                for (int i = 0; i < 16; ++i) a[i] = -3.0e38f;
#pragma unroll 4
                for (int m = 0; m < 32; ++m) {
                    const f32x4 v = *(const f32x4*)(row + 4 * m);
                    const float x0 = pk(v[0], 4 * m), x1 = pk(v[1], 4 * m + 1), x2 = pk(v[2], 4 * m + 2), x3 = pk(v[3], 4 * m + 3);
                    ins16(a, fmaxf(fmaxf(x0, x1), fmaxf(x2, x3)));
                }
                {
                    float sn[16];
#pragma unroll
                    for (int i = 0; i < 16; ++i) sn[i] = a[i];
#pragma unroll
                    for (int i = 0; i < 16; ++i) {
                        const unsigned j = __float_as_uint(sn[i]) & 0x7Fu, op = (j & ~3u) + ((j & 2u) ^ 2u);
                        const f32x2 pr = *(const f32x2*)(row + op);
                        ins16(a, fmaxf(pk(pr[0], op), pk(pr[1], op + 1u)));
                    }
                }
                {
                    float sn[16];
#pragma unroll
                    for (int i = 0; i < 16; ++i) sn[i] = a[i];
#pragma unroll
                    for (int i = 0; i < 16; ++i) {
                        const unsigned j = (__float_as_uint(sn[i]) & 0x7Fu) ^ 1u;
                        ins16(a, pk(row[j], j));
                    }
                }
                __syncthreads();
#pragma unroll
                for (int k4 = 0; k4 < 4; ++k4) *(f32x4*)(tl + tid * 16 + k4 * 4) = (f32x4){a[k4 * 4], a[k4 * 4 + 1], a[k4 * 4 + 2], a[k4 * 4 + 3]};
                if (!hn) break;
                tt = ntt;
                scores();
                __syncthreads();
            }
            __syncthreads();
            __syncthreads();
        } else {
    float pe[16], psu[16], psv[16]; int pid[16];
    auto combine_a = [&](int tok) {
        float s[16], r[16], c[16];
#pragma unroll
        for (int i = 0; i < 16; ++i) { s[i] = tl[tok * 16 + i]; r[i] = tl[(128 + tok) * 16 + i]; c[i] = -3.0e38f; }
#pragma unroll
        for (int i = 0; i < 16; ++i)
#pragma unroll
            for (int j = 0; j < 16; ++j)
                if ((i + 1) * (j + 1) <= 16) {
                    const float v = __uint_as_float((__float_as_uint(s[i] + r[j]) & ~0xFFu) | (unsigned)(i * 16 + j));
                    ins16(c, v);
                }
        float sum = 0.f;
#pragma unroll
        for (int k = 0; k < 16; ++k) { pe[k] = __expf(c[k] - c[0]); sum += pe[k]; }
        const float inv = 1.f / sum;
#pragma unroll
        for (int k = 0; k < 16; ++k) pe[k] *= inv;
#pragma unroll
        for (int k = 0; k < 16; ++k) {
            const unsigned bits = __float_as_uint(c[k]), i = (bits >> 4) & 15u, j = bits & 15u;
            const unsigned ki = __float_as_uint(tl[tok * 16 + i]) & 0x7Fu, kj = __float_as_uint(tl[(128 + tok) * 16 + j]) & 0x7Fu;
            pid[k] = (int)(ki * 128u + kj);
        }
        const float* sut = p.su + (size_t)layer * NEXP; const float* svt = p.sv + (size_t)layer * NEXP;
#pragma unroll
        for (int k = 0; k < 16; ++k) { psu[k] = sut[pid[k]]; psv[k] = svt[pid[k]]; }
    };
    auto combine_b = [&](int tok, int h_, int t0_) {
        int* ido = p.ids + (size_t)(t0_ + tok) * 128 + h_ * 16; float* go = p.gates + (size_t)(t0_ + tok) * 128 + h_ * 16; float* so = p.sus + (size_t)(t0_ + tok) * 128 + h_ * 16;
#pragma unroll
        for (int k4 = 0; k4 < 4; ++k4) {
            *(int4*)(ido + k4 * 4) = make_int4(pid[k4 * 4], pid[k4 * 4 + 1], pid[k4 * 4 + 2], pid[k4 * 4 + 3]);
            *(f32x4*)(go + k4 * 4) = (f32x4){pe[k4 * 4] * psv[k4 * 4], pe[k4 * 4 + 1] * psv[k4 * 4 + 1], pe[k4 * 4 + 2] * psv[k4 * 4 + 2], pe[k4 * 4 + 3] * psv[k4 * 4 + 3]};
            *(f32x4*)(so + k4 * 4) = (f32x4){psu[k4 * 4], psu[k4 * 4 + 1], psu[k4 * 4 + 2], psu[k4 * 4 + 3]};
        }
    };
            __syncthreads();
            int pt0 = -1, ft0 = -1;
            for (;;) {
                const int ntt = tt + tt_step;
                const bool hn = ntt < T / 128;
                if (w < 6) {
                    if (ft0 >= 0) combine_b(tid - 256, h, ft0);
                    if (pt0 >= 0) combine_a(tid - 256);
                    ft0 = pt0;
                }
                __syncthreads();
                pt0 = tt * 128;
                if (!hn) break;
                tt = ntt;
                __syncthreads();
            }
            __syncthreads();
            if (w < 6) {
                if (ft0 >= 0) combine_b(tid - 256, h, ft0);
                combine_a(tid - 256);
                combine_b(tid - 256, h, pt0);
            }
            __syncthreads();
        }
    }
}

typedef _Float16 h16x2 __attribute__((ext_vector_type(2)));
typedef int i32x8 __attribute__((ext_vector_type(8)));
#ifndef NVR
#define NVR 16
#endif
template <bool FINAL>
__device__ void gather_phase(const Params& p, int layer, const bf16_t* xin, bf16_t* xout, bf16_t* hkv_out, bf16_t* hq_out, unsigned char* smem) {
    const int tid_ = opaque_tid(), lane = tid_ & 63, wv = __builtin_amdgcn_readfirstlane(tid_ >> 6), tk = lane & 15, q = lane >> 4;
    const int nw = gridDim.x * (NT / 64);
    const unsigned char* utab = p.ub + (size_t)layer * NEXP * 512;
    const unsigned char* vtab = p.vb + (size_t)layer * NEXP * 512;
    const float* sutab = p.su + (size_t)layer * NEXP;
    const float* svtab = p.sv + (size_t)layer * NEXP;
    unsigned char* hl = smem + wv * 17664;
    unsigned char* a8l = hl + 1024;
    unsigned char* vbuf = hl + 1280;
    const unsigned vbuf_lds = (unsigned)__builtin_amdgcn_readfirstlane((int)(unsigned)(size_t)(LAS unsigned char*)vbuf);
    u32x4 nx[2]; int nidA = 0, nidB = 0; float ngA = 0.f, ngB = 0.f, nsA = 0.f, nsB = 0.f;
    auto preload = [&](int tt) {
        const bf16_t* xr_ = xin + (size_t)tt * D + lane * 16;
#pragma unroll
        for (int j = 0; j < 2; ++j) nx[j] = *(const u32x4*)(xr_ + j * 8);
        nidA = p.ids[(size_t)tt * 128 + lane]; nidB = p.ids[(size_t)tt * 128 + 64 + lane];
        ngA = p.gates[(size_t)tt * 128 + lane]; ngB = p.gates[(size_t)tt * 128 + 64 + lane];
        nsA = p.sus[(size_t)tt * 128 + lane]; nsB = p.sus[(size_t)tt * 128 + 64 + lane];
    };
    const int t_first = blockIdx.x * (NT / 64) + wv;
    if (t_first < T) preload(t_first);
    for (int t = t_first; t < T; t += nw) {
        const int b = t / SEQ;
        const bf16_t* cv = p.cvec + (size_t)b * 12 * 1024 + (layer ? 7 * 1024 : 0);
        const int e0 = lane * 16;
        u32x4 xv[2];
#pragma unroll
        for (int j = 0; j < 2; ++j) xv[j] = nx[j];
        const int idA = nidA, idB = nidB; const float gA = ngA, gB = ngB, suA = nsA, suB = nsB;
        {
            float ss = 0.f;
#pragma unroll
            for (int j = 0; j < 2; ++j)
#pragma unroll
                for (int e_ = 0; e_ < 4; ++e_) { const float lo_ = bflo(xv[j][e_]), hi_ = bfhi(xv[j][e_]); ss += lo_ * lo_ + hi_ * hi_; }
            ss = wave_sum(ss);
            const float rstd = rsqrtf(ss * (1.f / D) + RMS_EPS);
            u32x4 hw;
#pragma unroll
            for (int j2 = 0; j2 < 2; ++j2) {
                const u32x4 gs8 = *(const u32x4*)(cv + e0 + j2 * 8), sh8 = *(const u32x4*)(cv + 1024 + e0 + j2 * 8);
#pragma unroll
                for (int jj = 0; jj < 2; ++jj) {
                    const int j = j2 * 2 + jj;
                    const unsigned xw0 = xv[j2][jj * 2], xw1 = xv[j2][jj * 2 + 1];
                    const float h0 = bflo(xw0) * rstd * bflo(gs8[jj * 2]) + bflo(sh8[jj * 2]), h1 = bfhi(xw0) * rstd * bfhi(gs8[jj * 2]) + bfhi(sh8[jj * 2]);
                    const float h2 = bflo(xw1) * rstd * bflo(gs8[jj * 2 + 1]) + bflo(sh8[jj * 2 + 1]), h3 = bfhi(xw1) * rstd * bfhi(gs8[jj * 2 + 1]) + bfhi(sh8[jj * 2 + 1]);
                    int r = 0;
                    r = __builtin_amdgcn_cvt_pk_fp8_f32(h0, h1, r, false);
                    r = __builtin_amdgcn_cvt_pk_fp8_f32(h2, h3, r, true);
                    hw[j] = (unsigned)r;
                }
            }
            *(u32x4*)(hl + lane * 16) = hw;
        }
        asm volatile("s_waitcnt lgkmcnt(0)" ::: "memory");
        i32x8 hb[8];
#pragma unroll
        for (int kk = 0; kk < 8; ++kk) {
            const u32x4 lo = *(const u32x4*)(hl + kk * 128 + q * 16), hi = *(const u32x4*)(hl + kk * 128 + 64 + q * 16);
            hb[kk] = (i32x8){(int)lo[0], (int)lo[1], (int)lo[2], (int)lo[3], (int)hi[0], (int)hi[1], (int)hi[2], (int)hi[3]};
        }
        float dA = 0.f, dB = 0.f;
        auto dma16 = [&](const unsigned char* gsrc, unsigned dst) {
            unsigned keep;
            asm volatile("s_mov_b32 %0, m0\n\ts_mov_b32 m0, %2\n\ts_nop 0\n\tglobal_load_lds_dwordx4 %1, off\n\ts_mov_b32 m0, %0" : "=&s"(keep) : "v"(gsrc), "s"(dst) : "memory");
        };
        auto dma_ubatch = [&](int bt, int bsel) {
#pragma unroll
            for (int i_ = 0; i_ < 8; ++i_) {
                const int r_ = 2 * i_ + (lane >> 5);
                const int k0_ = (bt * 16 + 2 * i_) & 63;
                const int id0_ = __builtin_amdgcn_readlane(bt < 4 ? idA : idB, k0_), id1_ = __builtin_amdgcn_readlane(bt < 4 ? idA : idB, k0_ + 1);
                const int id_ = (lane >> 5) ? id1_ : id0_;
                dma16(utab + (size_t)((unsigned)id_ * 512u + (unsigned)(((lane & 31) ^ (r_ & 15)) * 16)), vbuf_lds + (unsigned)bsel * 8192u + (unsigned)i_ * 1024u);
            }
        };
        auto mma_ubatch = [&](int bt, int bsel) {
            const unsigned char* rowp = vbuf + bsel * 8192 + tk * 512;
            f32x4 acc = {0.f, 0.f, 0.f, 0.f};
#pragma unroll
            for (int kk = 0; kk < 8; ++kk) {
                const u32x4 a4 = *(const u32x4*)(rowp + (((kk * 4 + q) ^ tk) * 16));
                const i32x8 av = {(int)a4[0], (int)a4[1], (int)a4[2], (int)a4[3], 0, 0, 0, 0};
                acc = __builtin_amdgcn_mfma_scale_f32_16x16x128_f8f6f4(av, hb[kk], acc, 4  , 0  , 0, 0x7f7f7f7f, 0, 0x7f7f7f7f);
            }
            const int r = lane & 3;
            const float mine = r == 0 ? acc[0] : (r == 1 ? acc[1] : (r == 2 ? acc[2] : acc[3]));
            const float got = bperm_f(mine, ((lane & 15) >> 2) * 16 + (lane & 15));
            if (q == (bt & 3)) { if (bt < 4) dA = got; else dB = got; }
        };
        asm volatile("s_waitcnt vmcnt(0) lgkmcnt(0)" ::: "memory");
        dma_ubatch(0, 0);
        if (t + nw < T) preload(t + nw);
#pragma unroll
        for (int bt = 0; bt < 8; ++bt) {
            if (bt + 1 < 8) { dma_ubatch(bt + 1, (bt + 1) & 1); asm volatile("s_waitcnt vmcnt(8)" ::: "memory"); }
            else asm volatile("s_waitcnt vmcnt(0)" ::: "memory");
            mma_ubatch(bt, bt & 1);
            asm volatile("s_waitcnt lgkmcnt(0)" ::: "memory");
        }
        const float apA = gelu_tanh(dA * suA) * gA, apB = gelu_tanh(dB * suB) * gB;
        const bf16_t* cv0 = p.cvec + (size_t)b * 12 * 1024;
        u32x4 pv_gate[2], pv_a[2], pv_b[2], pv_c[2], pv_d[2];
#pragma unroll
        for (int j2 = 0; j2 < 2; ++j2) {
            pv_gate[j2] = *(const u32x4*)(cv + 2 * 1024 + e0 + j2 * 8);
            pv_a[j2] = *(const u32x4*)(cv0 + (FINAL ? 10 : 3) * 1024 + e0 + j2 * 8); pv_b[j2] = *(const u32x4*)(cv0 + (FINAL ? 11 : 4) * 1024 + e0 + j2 * 8);
            if (!FINAL) { pv_c[j2] = *(const u32x4*)(cv0 + 5 * 1024 + e0 + j2 * 8); pv_d[j2] = *(const u32x4*)(cv0 + 6 * 1024 + e0 + j2 * 8); }
        }
        float of[16];
        {
            const float amax = wave_max(fmaxf(fabsf(apA), fabsf(apB)));
            const float asc = amax > 0.f ? 224.f / amax : 0.f, iasc = amax * (1.f / 224.f);
            const int pk = __builtin_amdgcn_cvt_pk_fp8_f32(apA * asc, apB * asc, 0, false);
            a8l[lane] = (unsigned char)(pk & 0xff); a8l[64 + lane] = (unsigned char)((pk >> 8) & 0xff);
            unsigned rowoff[16];
#pragma unroll
            for (int i_ = 0; i_ < 16; ++i_) {
                const int r_ = 8 * (i_ & 7) + (lane >> 3);
                const int id_ = __builtin_amdgcn_ds_bpermute(r_ << 2, i_ < 8 ? idA : idB);
                rowoff[i_] = (unsigned)id_ * 512u + (unsigned)(((lane & 7) ^ (r_ & 7)) * 16);
            }
            asm volatile("s_waitcnt lgkmcnt(0)" ::: "memory");
            const u32x4 alo = *(const u32x4*)(a8l + 16 * q), ahi = *(const u32x4*)(a8l + 64 + 16 * q);
            const i32x8 av0 = {(int)alo[0], (int)alo[1], (int)alo[2], (int)alo[3], 0, 0, 0, 0}, av1 = {0, 0, 0, 0, (int)ahi[0], (int)ahi[1], (int)ahi[2], (int)ahi[3]};
            auto dma_slice = [&](int sidx, int bsel) {
#pragma unroll
                for (int i_ = 0; i_ < 8; ++i_)
                    dma16(vtab + (size_t)(rowoff[(sidx & 1) * 8 + i_] + (unsigned)(sidx >> 1) * 128u), vbuf_lds + (unsigned)bsel * 8192u + (unsigned)i_ * 1024u);
            };
            float ov[16];
#pragma unroll
            for (int e = 0; e < 16; ++e) ov[e] = 0.f;
            const int rl = 32 * (q & 1) + tk;
            asm volatile("s_waitcnt vmcnt(0) lgkmcnt(0)" ::: "memory");
            dma_slice(0, 0);
#pragma unroll
            for (int ln = 0; ln < 4; ++ln) {
#pragma unroll
                for (int rh = 0; rh < 2; ++rh) {
                    const int sidx = ln * 2 + rh;
                    if (sidx + 1 < 8) { dma_slice(sidx + 1, (sidx + 1) & 1); asm volatile("s_waitcnt vmcnt(8)" ::: "memory"); }
                    else asm volatile("s_waitcnt vmcnt(0)" ::: "memory");
                    const unsigned char* vb0 = vbuf + (sidx & 1) * 8192 + rl * 128, *vb1 = vb0 + 16 * 128;
                    typedef int i32x2 __attribute__((ext_vector_type(2)));
                    i32x2 ta[4][2], tb[4][2];
                    auto ldg = [&](i32x2 (&tt)[4][2], int g4) {
#pragma unroll
                        for (int e_ = 0; e_ < 4; ++e_) {
                            const int eg = g4 * 4 + e_;
                            const int co = (((eg >> 1) ^ (tk & 7)) * 16) + (eg & 1) * 8;
                            tt[e_][0] = __builtin_amdgcn_ds_read_tr4_b64_v2i32((LAS i32x2*)(vb0 + co));
                            tt[e_][1] = __builtin_amdgcn_ds_read_tr4_b64_v2i32((LAS i32x2*)(vb1 + co));
                        }
                    };
                    auto mmg = [&](const i32x2 (&tt)[4][2], int g4) {
#pragma unroll
                        for (int e_ = 0; e_ < 4; ++e_) {
                            const i32x8 bv = {tt[e_][0][0], tt[e_][0][1], tt[e_][1][0], tt[e_][1][1], 0, 0, 0, 0};
                            f32x4 z = {0.f, 0.f, 0.f, 0.f};
                            const f32x4 d = __builtin_amdgcn_mfma_scale_f32_16x16x128_f8f6f4(rh ? av1 : av0, bv, z, 0  , 4  , 0, 0x7f7f7f7f, 0, 0x7f7f7f7f);
                            if (g4 == q) ov[ln * 4 + e_] += d[0];
                        }
                    };
                    ldg(ta, 0);
#pragma unroll
                    for (int g4 = 0; g4 < 4; g4 += 2) {
                        ldg(tb, g4 + 1);
                        __builtin_amdgcn_sched_barrier(0);
                        mmg(ta, g4);
                        if (g4 + 2 < 4) ldg(ta, g4 + 2);
                        __builtin_amdgcn_sched_barrier(0);
                        mmg(tb, g4 + 1);
                    }
                    asm volatile("s_waitcnt lgkmcnt(0)" ::: "memory");
                }
            }
#pragma unroll
            for (int e = 0; e < 16; ++e) ov[e] *= iasc;
            float* outl = (float*)vbuf;
#pragma unroll
            for (int ln = 0; ln < 4; ++ln)
#pragma unroll
                for (int t_ = 0; t_ < 4; ++t_) outl[ln * 256 + (4 * q + t_) * 16 + tk] = ov[ln * 4 + t_];
            asm volatile("s_waitcnt lgkmcnt(0)" ::: "memory");
#pragma unroll
            for (int j4 = 0; j4 < 4; ++j4) { const f32x4 v4 = *(const f32x4*)(outl + lane * 16 + j4 * 4); of[j4 * 4] = v4[0]; of[j4 * 4 + 1] = v4[1]; of[j4 * 4 + 2] = v4[2]; of[j4 * 4 + 3] = v4[3]; }
            asm volatile("s_waitcnt lgkmcnt(0)" ::: "memory");
        }
        float xn[16]; float ss = 0.f;
        auto unp = [&](const u32x4 (&w)[2], float (&o)[16]) {
#pragma unroll
            for (int j2 = 0; j2 < 2; ++j2)
#pragma unroll
                for (int jj = 0; jj < 4; ++jj) { o[j2 * 8 + jj * 2] = bflo(w[j2][jj]); o[j2 * 8 + jj * 2 + 1] = bfhi(w[j2][jj]); }
        };
        {
            float gt[16]; unp(pv_gate, gt);
#pragma unroll
            for (int k = 0; k < 16; ++k) { const unsigned xw = xv[k >> 3][(k >> 1) & 3]; const float v = ((k & 1) ? bfhi(xw) : bflo(xw)) + gt[k] * of[k]; xn[k] = v; ss += v * v; }
        }
        ss = wave_sum(ss);
        const float rstd = rsqrtf(ss * (1.f / D) + RMS_EPS);
        if (!FINAL) {
#pragma unroll
            for (int j = 0; j < 2; ++j) *(u32x4*)(xout + (size_t)t * D + e0 + j * 8) = (u32x4){pack2(xn[j * 8], xn[j * 8 + 1]), pack2(xn[j * 8 + 2], xn[j * 8 + 3]), pack2(xn[j * 8 + 4], xn[j * 8 + 5]), pack2(xn[j * 8 + 6], xn[j * 8 + 7])};
            float gsv[16], shv[16], hk[16], hq[16];
            unp(pv_a, gsv); unp(pv_b, shv);
#pragma unroll
            for (int k = 0; k < 16; ++k) hk[k] = xn[k] * rstd * gsv[k] + shv[k];
            unp(pv_c, gsv); unp(pv_d, shv);
#pragma unroll
            for (int k = 0; k < 16; ++k) hq[k] = xn[k] * rstd * gsv[k] + shv[k];
            {
                u32x4 ob, oc;
#pragma unroll
                for (int j = 0; j < 4; ++j) { ob[j] = pack4_fp8(hk[j * 4], hk[j * 4 + 1], hk[j * 4 + 2], hk[j * 4 + 3]); oc[j] = pack4_fp8(hq[j * 4], hq[j * 4 + 1], hq[j * 4 + 2], hq[j * 4 + 3]); }
                *(u32x4*)((unsigned char*)hkv_out + (size_t)t * D + e0) = ob;
                *(u32x4*)((unsigned char*)hq_out + (size_t)t * D + e0) = oc;
            }
        } else {
            float gsv[16], shv[16];
            unp(pv_a, gsv); unp(pv_b, shv);
#pragma unroll
            for (int j = 0; j < 4; ++j) {
                f32x4 ov;
#pragma unroll
                for (int e = 0; e < 4; ++e) ov[e] = xn[j * 4 + e] * rstd * gsv[j * 4 + e] + shv[j * 4 + e];
                *(f32x4*)(p.out + (size_t)t * D + e0 + j * 4) = ov;
            }
        }
        asm volatile("s_waitcnt lgkmcnt(0)" ::: "memory");
    }
}

__device__ void attn_phase(const Params& p, const bf16_t* Q, const bf16_t* K, const bf16_t* V, bf16_t* O, unsigned char* smem) {
    unsigned char* Kl = smem;
    unsigned char* Vt = smem + 32768;
    unsigned char* Pl = smem + 32768 + 35840;
    const int tid = opaque_tid(), lane = tid & 63, w = __builtin_amdgcn_readfirstlane(tid >> 6), tk = lane & 15, q = lane >> 4;
    unsigned char* Pw = Pl + w * 5376;
    for (int task = blockIdx.x; task < NB * 32 * 4; task += gridDim.x) {
        const int kvh = task & 3, qblk = (task >> 2) & 31, b = task >> 7;
        const int kpos0 = (qblk - 1) * 128;
#pragma unroll
        for (int i = 0; i < 4; ++i) {
            const int id = tid + NT * i, j = id >> 3, c = id & 7, kp = kpos0 + j;
            u32x4 v = {0u, 0u, 0u, 0u};
            if (kp >= 0) v = *(const u32x4*)(K + ((size_t)b * SEQ + kp) * 256 + kvh * 64 + c * 8);
            *(u32x4*)(Kl + lds_off(j, c)) = v;
        }
#pragma unroll
        for (int i = 0; i < 4; ++i) {
            const int id = tid + NT * i, j = id & 255, dc = id >> 8, kp = kpos0 + j;
            u32x4 v = {0u, 0u, 0u, 0u};
            if (kp >= 0) v = *(const u32x4*)(V + ((size_t)b * SEQ + kp) * 256 + kvh * 64 + dc * 8);
#pragma unroll
            for (int e = 0; e < 4; ++e) {
                *(bf16_t*)(Vt + (dc * 8 + 2 * e) * 560 + j * 2) = (bf16_t)(v[e] & 0xffffu);
                *(bf16_t*)(Vt + (dc * 8 + 2 * e + 1) * 560 + j * 2) = (bf16_t)(v[e] >> 16);
            }
        }
        if (tid < 128) *(u32x4*)(Vt + (tid >> 1) * 560 + 512 + (tid & 1) * 16) = (u32x4){0u, 0u, 0u, 0u};
        *(u32x2*)(Pw + tk * 336 + (144 + 4 * q) * 2) = (u32x2){0u, 0u};
        __syncthreads();
        const int qt = w, i_q = qt * 16 + tk;
        const size_t trow = (size_t)b * SEQ + qblk * 128 + i_q;
        const unsigned char* kb0 = Kl + lds_off(qt * 16 + tk, q);
        const unsigned char* kb1 = Kl + lds_off(qt * 16 + tk, 4 + q);
        const unsigned char* vb0 = Vt + tk * 560 + (qt * 16 + 8 * q) * 2;
        unsigned char* pwr = Pw + tk * 336 + 8 * q;
        const unsigned char* prd = Pw + tk * 336 + 16 * q;
#pragma unroll 1
        for (int hq = 0; hq < 4; ++hq) {
            const int head = kvh * 4 + hq;
            const bf16x8 qf0 = *(const bf16x8*)(Q + trow * D + head * 64 + 8 * q), qf1 = *(const bf16x8*)(Q + trow * D + head * 64 + 32 + 8 * q);
            f32x4 sacc[9];
#pragma unroll
            for (int kk = 0; kk < 9; ++kk) {
                const bf16x8 k0 = *(const bf16x8*)(kb0 + kk * 2048), k1 = *(const bf16x8*)(kb1 + kk * 2048);
                f32x4 a = {0.f, 0.f, 0.f, 0.f};
                a = __builtin_amdgcn_mfma_f32_16x16x32_bf16(k0, qf0, a, 0, 0, 0);
                a = __builtin_amdgcn_mfma_f32_16x16x32_bf16(k1, qf1, a, 0, 0, 0);
                sacc[kk] = a;
                if (kk & 1) __builtin_amdgcn_sched_barrier(0);
            }
            const float sink = p.sinks[head];
            float mx = -1e30f;
#pragma unroll
            for (int kk = 0; kk < 9; ++kk)
#pragma unroll
                for (int r = 0; r < 4; ++r) {
                    const int j = (qt + kk) * 16 + 4 * q + r;
                    const bool valid = (j > i_q) && (j <= i_q + 128) && (qblk > 0 || j >= 128);
                    const float s = valid ? sacc[kk][r] * 0.125f : -1e30f;
                    sacc[kk][r] = s; mx = fmaxf(mx, s);
                }
            mx = fmaxf(mx, bperm_f(mx, lane ^ 16)); mx = fmaxf(mx, bperm_f(mx, lane ^ 32));
            mx = fmaxf(mx, sink);
            float sum = 0.f;
#pragma unroll
            for (int kk = 0; kk < 9; ++kk)
#pragma unroll
                for (int r = 0; r < 4; ++r) { const float e = __expf(sacc[kk][r] - mx); sacc[kk][r] = e; sum += e; }
            sum += bperm_f(sum, lane ^ 16); sum += bperm_f(sum, lane ^ 32);
            const float inv = 1.f / (sum + __expf(sink - mx));
#pragma unroll
            for (int kk = 0; kk < 9; ++kk) {
                u32x2 o; o[0] = pack2(sacc[kk][0] * inv, sacc[kk][1] * inv); o[1] = pack2(sacc[kk][2] * inv, sacc[kk][3] * inv);
                *(u32x2*)(pwr + kk * 32) = o;
            }
            asm volatile("s_waitcnt lgkmcnt(0)" ::: "memory");
            bf16x8 pf[5];
#pragma unroll
            for (int ks = 0; ks < 5; ++ks) pf[ks] = *(const bf16x8*)(prd + ks * 64);
#pragma unroll
            for (int dt = 0; dt < 4; ++dt) {
                f32x4 oa = {0.f, 0.f, 0.f, 0.f};
#pragma unroll
                for (int ks = 0; ks < 5; ++ks) {
                    const bf16x8 vf = *(const bf16x8*)(vb0 + dt * 8960 + ks * 64);
                    oa = __builtin_amdgcn_mfma_f32_16x16x32_bf16(vf, pf[ks], oa, 0, 0, 0);
                }
                *(unsigned*)((unsigned char*)O + trow * D + head * 64 + dt * 16 + 4 * q) = pack4_fp8(oa[0], oa[1], oa[2], oa[3]);
                __builtin_amdgcn_sched_barrier(0);
            }
            asm volatile("s_waitcnt lgkmcnt(0)" ::: "memory");
        }
        __syncthreads();
    }
}

constexpr int SMEM_BYTES = 152 * 1024;
__global__ void __launch_bounds__(NT) yoco_fwd(Params p) {
    __shared__ __attribute__((aligned(16))) unsigned char smem[SMEM_BYTES];
    volatile LAS unsigned* st = (volatile LAS unsigned*)(smem + SMEM_BYTES - 16);
    if (threadIdx.x == 0) { st[0] = 0u; st[1] = 0u; }
    __syncthreads();
    const XcdBarrier xb = xcd_barrier_post(p.bar, st);
    p0_cond(p, smem);
    xcd_barrier3(xb, 1u);
    p05_prep(p, smem);
    p0_tables(p);
    p0_w8(p, smem);
    p0_s5(p, smem);
    xcd_barrier3(xb, 2u);
    bias_finalize(p);
    { EpiU e{p.s1, p.cs_in}; gemm_phase<256, EpiU, true>(p.s0, p.w8_in, 0, 1024, e, smem); }
    xcd_barrier3(xb, 3u);
    s5_phase(p, smem);
    xcd_barrier3(xb, 4u);
    { EpiGlu e{(const unsigned char*)p.s0, p.b_glu, p.cs_glu, (unsigned char*)p.s1}; gemm_phase<256, EpiGlu, true>(p.s0, p.w8_glu, 0, 1024, e, smem); }
    xcd_barrier3(xb, 5u);
    { EpiRes<false> e{p.x, p.cond + 2 * D, p.norm_ffn, p.cond + 4 * D, p.f0, p.s2, p.ssq1, p.cs_out}; gemm_phase<256, EpiRes<false>, true>(p.s1, p.w8_out, 0, 1024, e, smem); }
    xcd_barrier3(xb, 6u);
    { EpiQ e{p.ssq1, p.bias, 0, p.s1, p.cs_pq0}; gemm_phase<256, EpiQ, true>(p.s2, p.w8_pq0, 0, 1024, e, smem); }
    xcd_barrier3(xb, 7u);
    route_phase(p, 0, p.s1, smem);
    xcd_barrier3(xb, 8u);
    gather_phase<false>(p, 0, p.f0, p.f1, p.s0, p.s2, smem);
    xcd_barrier3(xb, 9u);
    { EpiRope<0> e{p.ropec, p.ropes, p.s1, p.s1 + (size_t)T * 256, p.cs_kv}; gemm_phase<128, EpiRope<0>, true>(p.s0, p.w8_kv, 0, 512, e, smem); }
    { EpiRope<1> e{p.ropec, p.ropes, p.s3, nullptr, p.cs_q}; gemm_phase<256, EpiRope<1>, true>(p.s2, p.w8_q, 0, 1024, e, smem); }
    xcd_barrier3(xb, 10u);
    attn_phase(p, p.s3, p.s1, p.s1 + (size_t)T * 256, p.s0, smem);
    xcd_barrier3(xb, 11u);
    { EpiRes<true> e{p.f1, p.cond + 8 * D, p.norm_ffn + D, p.cond + 10 * D, p.f0, p.s2, p.ssq3, p.cs_o}; gemm_phase<256, EpiRes<true>, true>(p.s0, p.w8_o, 0, 1024, e, smem); }
    xcd_barrier3(xb, 12u);
    { EpiQ e{p.ssq3, p.bias, 1024, p.s1, p.cs_pq1}; gemm_phase<256, EpiQ, true>(p.s2, p.w8_pq1, 0, 1024, e, smem); }
    xcd_barrier3(xb, 13u);
    route_phase(p, 1, p.s1, smem);
    xcd_barrier3(xb, 14u);
    gather_phase<true>(p, 1, p.f0, nullptr, nullptr, nullptr, smem);
}

static inline size_t align_up(size_t v, size_t a) { return (v + a - 1) / a * a; }

extern "C" void kernel_launch(void* const* d_in, const int* in_sizes, int n_in, void* d_out, int out_size, void* d_ws, size_t ws_size, hipStream_t stream) {
    (void)in_sizes; (void)n_in; (void)out_size;
    Params p{};
    p.x = (const float*)d_in[0]; p.c = (const float*)d_in[1]; p.pos = (const int*)d_in[2]; p.w_cond = (const float*)d_in[3]; p.b_cond = (const float*)d_in[4];
    p.norm_mix = (const float*)d_in[5]; p.norm_ffn = (const float*)d_in[6]; p.w_in = (const float*)d_in[7]; p.a_re = (const float*)d_in[8]; p.a_im = (const float*)d_in[9];
    p.log_dt = (const float*)d_in[10]; p.b_re = (const float*)d_in[11]; p.b_im = (const float*)d_in[12]; p.c_re = (const float*)d_in[13]; p.c_im = (const float*)d_in[14];
    p.s5d = (const float*)d_in[15]; p.w_glu = (const float*)d_in[16]; p.b_glu = (const float*)d_in[17]; p.w_out = (const float*)d_in[18]; p.kv_norm = (const float*)d_in[19];
    p.w_kv = (const float*)d_in[20]; p.w_q = (const float*)d_in[21]; p.sinks = (const float*)d_in[22]; p.w_o = (const float*)d_in[23]; p.peer_wq = (const float*)d_in[24];
    p.subkeys = (const float*)d_in[25]; p.peer_u = (const float*)d_in[26]; p.peer_v = (const float*)d_in[27]; p.final_norm = (const float*)d_in[28];
    p.out = (float*)d_out;
    unsigned char* w = (unsigned char*)d_ws; size_t off = 65536;
    p.bar = (unsigned*)d_ws;
    auto take = [&](size_t bytes) { void* r = w + off; off = align_up(off + bytes, 4096); return r; };
    p.cond = (float*)take((size_t)NB * NCOND * D * 4);
    p.ropec = (float*)take((size_t)T * 32 * 4); p.ropes = (float*)take((size_t)T * 32 * 4);
    p.ssq1 = (float*)take((size_t)T * 16 * 4); p.ssq3 = (float*)take((size_t)T * 16 * 4);
    p.wt_in = (bf16_t*)take((size_t)D * D * 2); p.wt_glu = (bf16_t*)take((size_t)D * D * 2); p.wt_out = (bf16_t*)take((size_t)D * D * 2); p.wt_kv = (bf16_t*)take((size_t)512 * D * 2);
    p.wt_q = (bf16_t*)take((size_t)D * D * 2); p.wt_o = (bf16_t*)take((size_t)D * D * 2); p.wt_pq0 = (bf16_t*)take((size_t)D * D * 2); p.wt_pq1 = (bf16_t*)take((size_t)D * D * 2);
    p.w8_in = (unsigned char*)take((size_t)D * D); p.w8_glu = (unsigned char*)take((size_t)D * D); p.w8_out = (unsigned char*)take((size_t)D * D); p.w8_kv = (unsigned char*)take((size_t)512 * D);
    p.w8_q = (unsigned char*)take((size_t)D * D); p.w8_o = (unsigned char*)take((size_t)D * D); p.w8_pq0 = (unsigned char*)take((size_t)D * D); p.w8_pq1 = (unsigned char*)take((size_t)D * D);
    p.cs_in = (float*)take(4096); p.cs_glu = (float*)take(4096); p.cs_out = (float*)take(4096); p.cs_kv = (float*)take(4096); p.cs_q = (float*)take(4096); p.cs_o = (float*)take(4096); p.cs_pq0 = (float*)take(4096); p.cs_pq1 = (float*)take(4096);
    p.biasp = (float*)take((size_t)8 * 4 * 2048 * 4); p.bias = (float*)take((size_t)4 * 2048 * 4);
    p.skeys = (bf16_t*)take((size_t)2 * 8 * 2 * 128 * 64 * 2);
    p.lamL = (float*)take((size_t)G5 * P5 * 2 * 4); p.ktab = (bf16_t*)take((size_t)G5 * KTR * 256 * 2);
    p.smat = (bf16_t*)take((size_t)G5 * 128 * 1024 * 2); p.cmat = (bf16_t*)take((size_t)G5 * 1024 * 128 * 2);
    p.ub = (unsigned char*)take((size_t)2 * NEXP * D); p.vb = (unsigned char*)take((size_t)2 * NEXP * D);
    p.su = (float*)take((size_t)2 * NEXP * 4); p.sv = (float*)take((size_t)2 * NEXP * 4);
    p.s0 = (bf16_t*)take((size_t)T * D * 2); p.s1 = (bf16_t*)take((size_t)T * D * 2); p.s2 = (bf16_t*)take((size_t)T * D * 2); p.s3 = (bf16_t*)take((size_t)T * D * 2);
    p.f0 = (bf16_t*)take((size_t)T * D * 2); p.f1 = (bf16_t*)take((size_t)T * D * 2);
    p.ids = (int*)take((size_t)T * 128 * 4); p.gates = (float*)take((size_t)T * 128 * 4); p.sus = (float*)take((size_t)T * 128 * 4);
    p.cvec = (bf16_t*)take((size_t)4 * 12 * 1024 * 2);
    if (off > ws_size) { fprintf(stderr, "workspace too small: need %zu have %zu\n", off, ws_size); return; }

    static int grid_blocks = 0;
    if (!grid_blocks) {
        int dev = 0, cus = 0, per_cu = 0;
        (void)hipGetDevice(&dev);
        (void)hipDeviceGetAttribute(&cus, hipDeviceAttributeMultiprocessorCount, dev);
        (void)hipOccupancyMaxActiveBlocksPerMultiprocessor(&per_cu, yoco_fwd, NT, 0);
        if (per_cu > 1) per_cu = 1;
        grid_blocks = cus * per_cu;
        if (grid_blocks <= 0) grid_blocks = 256;
    }
    (void)hipMemsetAsync(d_ws, 0, XCD_BAR_WORDS * 4, stream);
    void* args[] = {&p};
    hipError_t e = hipLaunchCooperativeKernel((const void*)yoco_fwd, dim3(grid_blocks), dim3(NT), args, 0, stream);
    if (e != hipSuccess) fprintf(stderr, "cooperative launch failed: %s (grid %d)\n", hipGetErrorString(e), grid_blocks);
}
```

```cpp
#include <hip/hip_runtime.h>
#include <cstdio>
#include <cstdint>

#define NT 512
#define LAS __attribute__((address_space(3)))
typedef unsigned short bf16_t;
typedef short bf16x8 __attribute__((ext_vector_type(8)));
typedef float f32x4 __attribute__((ext_vector_type(4)));
typedef unsigned u32x4 __attribute__((ext_vector_type(4)));
typedef unsigned u32x2 __attribute__((ext_vector_type(2)));

constexpr int D = 1024, NB = 4, SEQ = 4096, T = NB * SEQ;
constexpr int NCOND = 16;
constexpr int G5 = 64, P5 = 64, C5 = 16, L5 = 64, NCH = SEQ / L5, KTR = 80;
constexpr int NEXP = 16384;
constexpr float RMS_EPS = 1e-6f;

struct Params {
    const float *x, *c; const int* pos; const float *w_cond, *b_cond, *norm_mix, *norm_ffn, *w_in, *a_re, *a_im, *log_dt, *b_re, *b_im, *c_re, *c_im, *s5d,
        *w_glu, *b_glu, *w_out, *kv_norm, *w_kv, *w_q, *sinks, *w_o, *peer_wq, *subkeys, *peer_u, *peer_v, *final_norm;
    float* out;
    unsigned* bar;
    float* cond;
    float* ropec;
    float* ropes;
    float* ssq1;
    float* ssq3;
    bf16_t *wt_in, *wt_glu, *wt_out, *wt_kv, *wt_q, *wt_o, *wt_pq0, *wt_pq1;
    unsigned char *w8_in, *w8_glu, *w8_out, *w8_kv, *w8_q, *w8_o, *w8_pq0, *w8_pq1;
    float *cs_in, *cs_glu, *cs_out, *cs_kv, *cs_q, *cs_o, *cs_pq0, *cs_pq1;
    float* biasp;
    float* bias;
    bf16_t* skeys;
    float* lamL;
    bf16_t* ktab;
    bf16_t* smat;
    bf16_t* cmat;
    unsigned char* ub;
    unsigned char* vb;
    float* su;
    float* sv;
    bf16_t *s0, *s1, *s2, *s3;
    bf16_t *f0, *f1;
    int* ids;
    float* gates;
    float* sus;
    bf16_t* cvec;
};

#define XB_TMO      128
#define XB_XCNT(j)  (256  + 64 * (j))
#define XB_XSUB(j)  (1280 + 64 * (j))
#define XB_XGEN(j)  (2304 + 64 * (j))
#define XB_TOP      3328
#define XB_TOPGEN   3392
#define XCD_BAR_WORDS 3456
#define XB_SPIN_CAP (1u << 22)
__device__ __forceinline__ unsigned xb_ld(unsigned* p)              { return __hip_atomic_load(p, __ATOMIC_RELAXED, __HIP_MEMORY_SCOPE_AGENT); }
__device__ __forceinline__ unsigned xb_add(unsigned* p, unsigned v) { return __hip_atomic_fetch_add(p, v, __ATOMIC_RELAXED, __HIP_MEMORY_SCOPE_AGENT); }
__device__ __forceinline__ unsigned xb_xcc_id() { return (unsigned)__builtin_amdgcn_s_getreg((3 << 11) | 20) & 0xFu; }
#define XB_SPIN(cond, bar) do { unsigned _sp = 0; while (cond) { __builtin_amdgcn_s_sleep(1); \
    if ((++_sp & 255u) == 0u) { if (xb_ld(&(bar)[XB_TMO])) break; if (_sp > XB_SPIN_CAP) { atomicAdd(&(bar)[XB_TMO], 1u); break; } } } } while (0)
struct XcdBarrier { unsigned* bar; unsigned x; volatile LAS unsigned* st; };
__device__ __forceinline__ XcdBarrier xcd_barrier_post(unsigned* bar, volatile LAS unsigned* st) {
    XcdBarrier b; b.bar = bar; b.x = xb_xcc_id(); b.st = st;
    if (threadIdx.x == 0) (void)xb_add(&bar[XB_XCNT(b.x)], 1u);
    return b;
}
__device__ __forceinline__ void xcd_barrier_complete(unsigned* bar, unsigned x, unsigned& nloc, unsigned& nx) {
    const unsigned G = gridDim.x * gridDim.y * gridDim.z;
    unsigned sum, cnt, mine, sp = 0u;
    for (;;) {
        sum = 0u; cnt = 0u; mine = 0u;
#pragma unroll
        for (unsigned j = 0; j < 16; ++j) { const unsigned c = xb_ld(&bar[XB_XCNT(j)]); sum += c; cnt += (c > 0u) ? 1u : 0u; mine = (j == x) ? c : mine; }
        if (sum == G) break;
        __builtin_amdgcn_s_sleep(1);
        if ((++sp & 255u) == 0u) { if (xb_ld(&bar[XB_TMO])) break; if (sp > XB_SPIN_CAP) { atomicAdd(&bar[XB_TMO], 1u); break; } }
    }
    nloc = mine > 0u ? mine : 1u; nx = cnt > 0u ? cnt : 1u;
}
__device__ __forceinline__ void xcd_barrier(const XcdBarrier& b) {
    asm volatile("s_waitcnt vmcnt(0)" ::: "memory");
    __syncthreads();
    if (threadIdx.x == 0) {
        unsigned* bar = b.bar;
        __builtin_amdgcn_s_waitcnt(0);
        unsigned nloc = b.st[0], nx = b.st[1];
        if (nloc == 0u) { xcd_barrier_complete(bar, b.x, nloc, nx); b.st[0] = nloc; b.st[1] = nx; }
        const unsigned old = xb_add(&bar[XB_XSUB(b.x)], 1u);
        const unsigned gen = old / nloc;
        if (old + 1u == (gen + 1u) * nloc) {
            __builtin_amdgcn_fence(__ATOMIC_RELEASE, "agent");
            asm volatile("s_waitcnt vmcnt(0)" ::: "memory");
            const unsigned og = xb_add(&bar[XB_TOP], 1u);
            const unsigned tg = og / nx;
            if (og + 1u == (tg + 1u) * nx) xb_add(&bar[XB_TOPGEN], 1u);
            else XB_SPIN(xb_ld(&bar[XB_TOPGEN]) == tg, bar);
            __builtin_amdgcn_fence(__ATOMIC_ACQUIRE, "agent");
            xb_add(&bar[XB_XGEN(b.x)], 1u);
            asm volatile("s_waitcnt vmcnt(0)" ::: "memory");
        } else {
            XB_SPIN(xb_ld(&bar[XB_XGEN(b.x)]) == gen, bar);
            __builtin_amdgcn_fence(__ATOMIC_ACQUIRE, "agent");
            asm volatile("s_waitcnt vmcnt(0)" ::: "memory");
        }
    }
    __syncthreads();
}

__device__ __forceinline__ void xcd_barrier3(const XcdBarrier& b, unsigned k) {
    asm volatile("s_waitcnt vmcnt(0)" ::: "memory");
    __syncthreads();
    if (threadIdx.x == 0) {
        unsigned* bar = b.bar;
        __builtin_amdgcn_s_waitcnt(0);
        unsigned nloc = b.st[0], nx = b.st[1];
        if (nloc == 0u) { xcd_barrier_complete(bar, b.x, nloc, nx); b.st[0] = nloc; b.st[1] = nx; }
        const unsigned old = xb_add(&bar[XB_XSUB(b.x)], 1u);
        if (old + 1u == k * nloc) {
            __builtin_amdgcn_fence(__ATOMIC_RELEASE, "agent");
            asm volatile("s_waitcnt vmcnt(0)" ::: "memory");
            (void)xb_add(&bar[XB_TOP], 1u);
        }
        const unsigned tgt = k * nx;
        XB_SPIN(xb_ld(&bar[XB_TOP]) < tgt, bar);
        __builtin_amdgcn_fence(__ATOMIC_ACQUIRE, "agent");
        asm volatile("s_waitcnt vmcnt(0)" ::: "memory");
    }
    __syncthreads();
}

__device__ __forceinline__ int opaque_tid() { int t = threadIdx.x; asm volatile("" : "+v"(t)); return t; }
__device__ __forceinline__ bf16_t f2bf(float f) { unsigned u = __float_as_uint(f); u += 0x7fffu + ((u >> 16) & 1u); return (bf16_t)(u >> 16); }
__device__ __forceinline__ float bf2f(bf16_t h) { return __uint_as_float(((unsigned)h) << 16); }
typedef __bf16 hbf2 __attribute__((ext_vector_type(2)));
typedef float f32x2 __attribute__((ext_vector_type(2)));
__device__ __forceinline__ unsigned pack2(float lo, float hi) { f32x2 v = {lo, hi}; return __builtin_bit_cast(unsigned, __builtin_convertvector(v, hbf2)); }
__device__ __forceinline__ float dot2bf(unsigned a, unsigned b, float c) { return __builtin_amdgcn_fdot2_f32_bf16(__builtin_bit_cast(hbf2, a), __builtin_bit_cast(hbf2, b), c, false); }
__device__ __forceinline__ unsigned pack4_fp8(float a, float b, float c, float d) { int r = 0; r = __builtin_amdgcn_cvt_pk_fp8_f32(a, b, r, false); r = __builtin_amdgcn_cvt_pk_fp8_f32(c, d, r, true); return (unsigned)r; }
__device__ __forceinline__ float bflo(unsigned w) { return __uint_as_float(w << 16); }
__device__ __forceinline__ float bfhi(unsigned w) { return __uint_as_float(w & 0xffff0000u); }
template <int CTRL> __device__ __forceinline__ float dpp_f(float v) { return __uint_as_float((unsigned)__builtin_amdgcn_update_dpp(0, (int)__float_as_uint(v), CTRL, 0xf, 0xf, true)); }
__device__ __forceinline__ float wave_sum(float v) {
    v += dpp_f<0xB1>(v);
    v += dpp_f<0x4E>(v);
    v += dpp_f<0x141>(v);
    v += dpp_f<0x140>(v);
    const float a = __uint_as_float((unsigned)__builtin_amdgcn_readlane((int)__float_as_uint(v), 0)), b = __uint_as_float((unsigned)__builtin_amdgcn_readlane((int)__float_as_uint(v), 16));
    const float c = __uint_as_float((unsigned)__builtin_amdgcn_readlane((int)__float_as_uint(v), 32)), d = __uint_as_float((unsigned)__builtin_amdgcn_readlane((int)__float_as_uint(v), 48));
    return (a + b) + (c + d);
}
__device__ __forceinline__ float bperm_f(float v, int srclane) { return __uint_as_float((unsigned)__builtin_amdgcn_ds_bpermute(srclane << 2, (int)__float_as_uint(v))); }
__device__ __forceinline__ float row16_sum(float v) { v += dpp_f<0xB1>(v); v += dpp_f<0x4E>(v); v += dpp_f<0x141>(v); v += dpp_f<0x140>(v); return v; }
__device__ __forceinline__ float wave_max(float v) {
    v = fmaxf(v, dpp_f<0xB1>(v)); v = fmaxf(v, dpp_f<0x4E>(v)); v = fmaxf(v, dpp_f<0x141>(v)); v = fmaxf(v, dpp_f<0x140>(v));
    const float a = __uint_as_float((unsigned)__builtin_amdgcn_readlane((int)__float_as_uint(v), 0)), b = __uint_as_float((unsigned)__builtin_amdgcn_readlane((int)__float_as_uint(v), 16));
    const float c = __uint_as_float((unsigned)__builtin_amdgcn_readlane((int)__float_as_uint(v), 32)), d = __uint_as_float((unsigned)__builtin_amdgcn_readlane((int)__float_as_uint(v), 48));
    return fmaxf(fmaxf(a, b), fmaxf(c, d));
}
__device__ __forceinline__ float gelu_tanh(float x) {
    const float u = 0.7978845608028654f * (x + 0.044715f * x * x * x);
    const float e = __expf(-2.f * fabsf(u));
    float th = (1.f - e) / (1.f + e);
    th = u < 0.f ? -th : th;
    return 0.5f * x * (1.f + th);
}

__device__ void p0_cond(const Params& p, unsigned char* smem) {
    float* sc = (float*)smem;
    float* red = (float*)(smem + 16384);
    const int tid = threadIdx.x;
    for (int i = tid; i < 4 * D; i += NT) { const float v = p.c[i]; sc[i] = v / (1.f + __expf(-v)); }
    __syncthreads();
    const int cgp = tid & 15, kg = tid >> 4;
    for (int task = blockIdx.x; task < NCOND * D / 64; task += gridDim.x) {
        const int col0 = task * 64 + cgp * 4;
        float acc[4][4];
#pragma unroll
        for (int b = 0; b < 4; ++b)
#pragma unroll
            for (int j = 0; j < 4; ++j) acc[b][j] = 0.f;
#pragma unroll 1
        for (int k0 = 0; k0 < 32; k0 += 8) {
            f32x4 w[8];
#pragma unroll
            for (int j = 0; j < 8; ++j) w[j] = *(const f32x4*)(p.w_cond + (size_t)(kg + 32 * (k0 + j)) * (NCOND * D) + col0);
#pragma unroll
            for (int j = 0; j < 8; ++j)
#pragma unroll
                for (int b = 0; b < 4; ++b) { const float s = sc[b * D + kg + 32 * (k0 + j)];
#pragma unroll
                    for (int e = 0; e < 4; ++e) acc[b][e] += s * w[j][e]; }
        }
#pragma unroll
        for (int b = 0; b < 4; ++b)
#pragma unroll
            for (int j = 0; j < 4; ++j) red[(kg * 64 + cgp * 4 + j) * 4 + b] = acc[b][j];
        __syncthreads();
        if (tid < 256) {
            const int col = tid >> 2, b = tid & 3;
            float s = 0.f;
            for (int g = 0; g < 32; ++g) s += red[(g * 64 + col) * 4 + b];
            p.cond[(size_t)b * (NCOND * D) + task * 64 + col] = s + p.b_cond[task * 64 + col];
        }
        __syncthreads();
    }
}

__device__ void p0_tables(const Params& p) {
    const size_t gtid = (size_t)blockIdx.x * NT + threadIdx.x, gstride = (size_t)gridDim.x * NT;
    {
        const int li = threadIdx.x & 15;
        const size_t grp = gtid >> 4, ngrp = gstride >> 4;
        for (int which = 0; which < 2; ++which) {
            const float* src = which ? p.peer_v : p.peer_u; unsigned char* dst = which ? p.vb : p.ub; float* sdst = which ? p.sv : p.su;
            for (size_t row = grp; row < (size_t)2 * NEXP; row += ngrp) {
                f32x4 v[2][8]; float ss = 0.f;
#pragma unroll
                for (int c = 0; c < 2; ++c)
#pragma unroll
                    for (int j = 0; j < 8; ++j) {
                        v[c][j] = *(const f32x4*)(src + row * D + c * 512 + li * 32 + j * 4);
#pragma unroll
                        for (int e = 0; e < 4; ++e) ss += v[c][j][e] * v[c][j][e];
                    }
                ss = row16_sum(ss);
                const float rms = sqrtf(ss * (1.f / D)), step = 0.48f * rms, inv = step > 0.f ? 1.f / step : 0.f;
#pragma unroll
                for (int c = 0; c < 2; ++c) {
                    u32x4 o;
#pragma unroll
                    for (int d = 0; d < 4; ++d) {
                        unsigned wd = 0u;
                        if (true) {
                            wd = __builtin_amdgcn_cvt_scalef32_pk_fp4_f32(wd, v[c][d * 2][0] * inv, v[c][d * 2][1] * inv, 1.0f, 0);
                            wd = __builtin_amdgcn_cvt_scalef32_pk_fp4_f32(wd, v[c][d * 2][2] * inv, v[c][d * 2][3] * inv, 1.0f, 1);
                            wd = __builtin_amdgcn_cvt_scalef32_pk_fp4_f32(wd, v[c][d * 2 + 1][0] * inv, v[c][d * 2 + 1][1] * inv, 1.0f, 2);
                            wd = __builtin_amdgcn_cvt_scalef32_pk_fp4_f32(wd, v[c][d * 2 + 1][2] * inv, v[c][d * 2 + 1][3] * inv, 1.0f, 3);
                        } else {
#pragma unroll
                            for (int k = 0; k < 8; ++k) {
                                const float x = v[c][d * 2 + (k >> 2)][k & 3];
                                const int n = (int)fminf(fmaxf(floorf(x * inv + 8.f), 0.f), 15.f);
                                wd |= (unsigned)n << (4 * ((k >> 1) + 4 * (k & 1)));
                            }
                        }
                        o[d] = wd;
                    }
                    *(u32x4*)(dst + row * 512 + c * 256 + li * 16) = o;
                }
                if (li == 0) sdst[row] = step;
            }
        }
    }
    const size_t nk8 = (size_t)2 * 8 * 2 * 128 * 64 / 8;
    for (size_t i = gtid; i < nk8; i += gstride) {
        const f32x4 a = *(const f32x4*)(p.subkeys + i * 8), b = *(const f32x4*)(p.subkeys + i * 8 + 4);
        u32x4 o; o[0] = pack2(a[0], a[1]); o[1] = pack2(a[2], a[3]); o[2] = pack2(b[0], b[1]); o[3] = pack2(b[2], b[3]);
        *(u32x4*)(p.skeys + i * 8) = o;
    }
    for (size_t i = gtid; i < (size_t)T * 32; i += gstride) {
        const int t = (int)(i >> 5), f = (int)(i & 31);
        const float invrev = exp2f(-(float)f * 0.41524101186092029f) * 0.15915494309189535f;
        float rev = (float)p.pos[t] * invrev; rev -= floorf(rev);
        p.ropec[i] = __builtin_amdgcn_cosf(rev); p.ropes[i] = __builtin_amdgcn_sinf(rev);
    }
}

__device__ void p0_wt(const Params& p, unsigned char* smem) {
    bf16_t* tl = (bf16_t*)smem;
    const int tid = opaque_tid(), kk = tid >> 3, nn = (tid & 7) * 8;
    for (int task = blockIdx.x; task < 2 * 64; task += gridDim.x) {
        const int w = task >> 6, gi = task & 63;
        const float* W = p.peer_wq + (size_t)w * D * D; bf16_t* Wt = w ? p.wt_pq1 : p.wt_pq0; const int ldw = 1024;
        const int ngn = ldw / 256, n0 = (gi % ngn) * 256, k0 = (gi / ngn) * 64;
        f32x4 a[4], b[4];
#pragma unroll
        for (int t4 = 0; t4 < 4; ++t4) { a[t4] = *(const f32x4*)(W + (size_t)(k0 + kk) * ldw + n0 + t4 * 64 + nn); b[t4] = *(const f32x4*)(W + (size_t)(k0 + kk) * ldw + n0 + t4 * 64 + nn + 4); }
#pragma unroll
        for (int t4 = 0; t4 < 4; ++t4)
#pragma unroll
            for (int j = 0; j < 4; ++j) { tl[(t4 * 64 + nn + j) * 72 + kk] = f2bf(a[t4][j]); tl[(t4 * 64 + nn + 4 + j) * 72 + kk] = f2bf(b[t4][j]); }
        __syncthreads();
        const int n = tid >> 3, kc = (tid & 7) * 8;
#pragma unroll
        for (int t4 = 0; t4 < 4; ++t4) {
            const u32x4 v = *(const u32x4*)(tl + (t4 * 64 + n) * 72 + kc);
            *(u32x4*)(Wt + (size_t)(n0 + t4 * 64 + n) * D + k0 + kc) = v;
        }
        __syncthreads();
    }
}

__device__ void p0_w8(const Params& p, unsigned char* smem) {
    float* mx = (float*)smem;
    unsigned char* t8 = smem + 4096;
    const int tid = opaque_tid(), nn = tid & 31, kg = tid >> 5;
    for (int task = blockIdx.x; task < 7 * 32 + 16; task += gridDim.x) {
        const int w = task >> 5, gi = task & 31;
        const float* W; unsigned char* W8; float* cs; int ldw = 1024;
        switch (w) {
            case 0: W = p.w_in; W8 = p.w8_in; cs = p.cs_in; break;
            case 1: W = p.w_glu; W8 = p.w8_glu; cs = p.cs_glu; break;
            case 2: W = p.w_out; W8 = p.w8_out; cs = p.cs_out; break;
            case 3: W = p.w_q; W8 = p.w8_q; cs = p.cs_q; break;
            case 4: W = p.w_o; W8 = p.w8_o; cs = p.cs_o; break;
            case 5: W = p.peer_wq; W8 = p.w8_pq0; cs = p.cs_pq0; break;
            case 6: W = p.peer_wq + (size_t)D * D; W8 = p.w8_pq1; cs = p.cs_pq1; break;
            default: W = p.w_kv; W8 = p.w8_kv; cs = p.cs_kv; ldw = 512; break;
        }
        const int n0 = gi * 32;
        float wv[64]; float m = 0.f;
#pragma unroll
        for (int j = 0; j < 64; ++j) { wv[j] = W[(size_t)(kg * 64 + j) * ldw + n0 + nn]; m = fmaxf(m, fabsf(wv[j])); }
        mx[kg * 32 + nn] = m;
        __syncthreads();
        if (tid < 32) { float mm = 0.f;
#pragma unroll
            for (int g = 0; g < 16; ++g) mm = fmaxf(mm, mx[g * 32 + tid]);
            const float s = mm > 0.f ? mm * (1.f / 448.f) : 1.f; mx[512 + tid] = s; cs[n0 + tid] = s; }
        __syncthreads();
        const float inv = 1.f / mx[512 + nn];
#pragma unroll
        for (int j = 0; j < 64; j += 4) {
            int r = 0;
            r = __builtin_amdgcn_cvt_pk_fp8_f32(wv[j] * inv, wv[j + 1] * inv, r, false);
            r = __builtin_amdgcn_cvt_pk_fp8_f32(wv[j + 2] * inv, wv[j + 3] * inv, r, true);
            *(unsigned*)(t8 + nn * 1040 + kg * 64 + j) = (unsigned)r;
        }
        __syncthreads();
#pragma unroll
        for (int i2 = 0; i2 < 4; ++i2) {
            const int ch = tid + NT * i2, rrow = ch >> 6, c16 = ch & 63;
            *(u32x4*)(W8 + (size_t)(n0 + rrow) * D + c16 * 16) = *(const u32x4*)(t8 + rrow * 1040 + c16 * 16);
        }
        __syncthreads();
    }
}

__device__ __forceinline__ void lam_powf(float ar, float ai, float dt, int n, float& re, float& im) {
    const float m = __expf(ar * dt * (float)n);
    float rev = (ai * dt) * (float)n * 0.15915494309189535f; rev -= floorf(rev);
    re = m * __builtin_amdgcn_cosf(rev); im = m * __builtin_amdgcn_sinf(rev);
}
__device__ __forceinline__ void s5_coeff(float ar, float ai, float dt, float& cre, float& cim) {
    const float a = ar * dt, th = ai * dt;
    float rev = th * 0.15915494309189535f; rev -= floorf(rev);
    float revh = th * 0.5f * 0.15915494309189535f; revh -= floorf(revh);
    const float cs = __builtin_amdgcn_cosf(rev), sn = __builtin_amdgcn_sinf(rev), sh = __builtin_amdgcn_sinf(revh);
    const float em1 = expm1f(a);
    const float nr = em1 * cs - 2.f * sh * sh, ni = (em1 + 1.f) * sn, den = ar * ar + ai * ai;
    cre = (nr * ar + ni * ai) / den; cim = (ni * ar - nr * ai) / den;
}

__device__ void p0_s5(const Params& p, unsigned char* smem) {
    const size_t gtid = (size_t)blockIdx.x * NT + threadIdx.x, gstride = (size_t)gridDim.x * NT;
    for (size_t idx = gtid; idx < (size_t)G5 * P5 * 65; idx += gstride) {
        const int pp = (int)(idx & 63), e = (int)((idx >> 6) % 65), g = (int)(idx / (65 * P5));
        const float dt = __expf(p.log_dt[g]), ar = p.a_re[g * P5 + pp], ai = p.a_im[g * P5 + pp];
        float pwr, pwi; lam_powf(ar, ai, dt, e, pwr, pwi);
        if (e < 64) {
            float cfr, cfi; s5_coeff(ar, ai, dt, cfr, cfi);
            const float wr = pwr * cfr - pwi * cfi, wi = pwr * cfi + pwi * cfr;
            const int j = 63 - e;
            const float* brp = p.b_re + ((size_t)g * P5 + pp) * C5; const float* bip = p.b_im + ((size_t)g * P5 + pp) * C5;
            unsigned ore[8], oim[8];
#pragma unroll
            for (int c4 = 0; c4 < 4; ++c4) {
                const f32x4 br = *(const f32x4*)(brp + c4 * 4), bi = *(const f32x4*)(bip + c4 * 4);
                ore[c4 * 2] = pack2(wr * br[0] - wi * bi[0], wr * br[1] - wi * bi[1]); ore[c4 * 2 + 1] = pack2(wr * br[2] - wi * bi[2], wr * br[3] - wi * bi[3]);
                oim[c4 * 2] = pack2(wr * bi[0] + wi * br[0], wr * bi[1] + wi * br[1]); oim[c4 * 2 + 1] = pack2(wr * bi[2] + wi * br[2], wr * bi[3] + wi * br[3]);
            }
            u32x4* sre = (u32x4*)(p.smat + ((size_t)g * 128 + pp) * 1024 + j * 16);
            u32x4* sim = (u32x4*)(p.smat + ((size_t)g * 128 + 64 + pp) * 1024 + j * 16);
            sre[0] = (u32x4){ore[0], ore[1], ore[2], ore[3]}; sre[1] = (u32x4){ore[4], ore[5], ore[6], ore[7]};
            sim[0] = (u32x4){oim[0], oim[1], oim[2], oim[3]}; sim[1] = (u32x4){oim[4], oim[5], oim[6], oim[7]};
        }
        if (e >= 1) {
            const int i = e - 1;
#pragma unroll 4
            for (int co = 0; co < 16; ++co) {
                const float cr = p.c_re[((size_t)g * C5 + co) * P5 + pp], ci = p.c_im[((size_t)g * C5 + co) * P5 + pp];
                bf16_t* row = p.cmat + ((size_t)g * 1024 + i * 16 + co) * 128;
                row[pp] = f2bf(cr * pwr - ci * pwi);
                row[64 + pp] = f2bf(-(cr * pwi + ci * pwr));
            }
        }
        if (e == 64) {
            const double dtd = exp((double)p.log_dt[g]), m = exp((double)ar * dtd * 64.0);
            double ang = (double)ai * dtd * 64.0; ang -= 6.283185307179586 * floor(ang * 0.15915494309189535);
            p.lamL[(g * P5 + pp) * 2] = (float)(m * cos(ang)); p.lamL[(g * P5 + pp) * 2 + 1] = (float)(m * sin(ang));
        }
    }
    float* wre = (float*)smem;
    float* wim = wre + 1024;
    const int tid = threadIdx.x;
    for (int task = blockIdx.x; task < G5 * 4; task += gridDim.x) {
        const int g = task >> 2, tq = task & 3;
        const float dt = __expf(p.log_dt[g]);
        for (int i = tid; i < 1024; i += NT) {
            const int pp = i & 63, tau = tq * 16 + (i >> 6);
            const float ar = p.a_re[g * P5 + pp], ai = p.a_im[g * P5 + pp];
            float pwr, pwi, cfr, cfi; lam_powf(ar, ai, dt, tau, pwr, pwi); s5_coeff(ar, ai, dt, cfr, cfi);
            wre[i] = pwr * cfr - pwi * cfi; wim[i] = pwr * cfi + pwi * cfr;
        }
        __syncthreads();
        {
            const int co = (tid >> 4) & 15, ci = tid & 15, ph = tid >> 8;
            float* part = wim + 1024;
            float cbr[32], cbi[32];
#pragma unroll 8
            for (int k = 0; k < 32; ++k) {
                const int pp = ph * 32 + k;
                const float br = p.b_re[((size_t)g * P5 + pp) * C5 + ci], bi = p.b_im[((size_t)g * P5 + pp) * C5 + ci];
                const float cr = p.c_re[((size_t)g * C5 + co) * P5 + pp], cim = p.c_im[((size_t)g * C5 + co) * P5 + pp];
                cbr[k] = cr * br - cim * bi; cbi[k] = cr * bi + cim * br;
            }
            float sres[16];
#pragma unroll
            for (int tl = 0; tl < 16; ++tl) {
                float s0 = 0.f, s1 = 0.f;
#pragma unroll
                for (int k = 0; k < 32; k += 2) {
                    s0 += cbr[k] * wre[tl * 64 + ph * 32 + k] - cbi[k] * wim[tl * 64 + ph * 32 + k];
                    s1 += cbr[k + 1] * wre[tl * 64 + ph * 32 + k + 1] - cbi[k + 1] * wim[tl * 64 + ph * 32 + k + 1];
                }
                sres[tl] = s0 + s1;
            }
            if (ph == 1) {
#pragma unroll
                for (int tl = 0; tl < 16; ++tl) part[tl * 256 + (tid & 255)] = sres[tl];
            }
            __syncthreads();
            if (ph == 0) {
#pragma unroll
                for (int tl = 0; tl < 16; ++tl) p.ktab[((size_t)g * KTR + tq * 16 + tl + 16) * 256 + tid] = f2bf(sres[tl] + part[tl * 256 + tid]);
                if (tq == 0) {
#pragma unroll
                    for (int r = 0; r < 16; ++r) p.ktab[((size_t)g * KTR + r) * 256 + tid] = 0;
                }
            }
        }
        __syncthreads();
    }
}

__device__ void p05_prep(const Params& p, unsigned char* smem) {
    {
        const int lane = threadIdx.x & 63, wv = threadIdx.x >> 6;
        const int nw = gridDim.x * (NT / 64);
        const int tf = blockIdx.x * (NT / 64) + wv;
        f32x4 n1[4], n2[4];
#pragma unroll
        for (int j = 0; j < 4; ++j) { n1[j] = (f32x4){0.f, 0.f, 0.f, 0.f}; n2[j] = n1[j]; }
        if (tf < T) {
#pragma unroll
            for (int j = 0; j < 4; ++j) n1[j] = *(const f32x4*)(p.x + (size_t)tf * D + j * 256 + lane * 4);
        }
        if (tf + nw < T) {
#pragma unroll
            for (int j = 0; j < 4; ++j) n2[j] = *(const f32x4*)(p.x + (size_t)(tf + nw) * D + j * 256 + lane * 4);
        }
        for (int t = tf; t < T; t += nw) {
            const int b = t / SEQ;
            const float* cb = p.cond + (size_t)b * (NCOND * D);
            f32x4 v[4]; float s = 0.f;
#pragma unroll
            for (int j = 0; j < 4; ++j) { v[j] = n1[j]; n1[j] = n2[j]; }
            if (t + 2 * nw < T) {
#pragma unroll
                for (int j = 0; j < 4; ++j) n2[j] = *(const f32x4*)(p.x + (size_t)(t + 2 * nw) * D + j * 256 + lane * 4);
            }
#pragma unroll
            for (int j = 0; j < 4; ++j) s += v[j][0] * v[j][0] + v[j][1] * v[j][1] + v[j][2] * v[j][2] + v[j][3] * v[j][3];
            s = wave_sum(s);
            const float rstd = rsqrtf(s * (1.f / D) + RMS_EPS);
#pragma unroll
            for (int j = 0; j < 4; ++j) {
                const int e = j * 256 + lane * 4;
                const f32x4 g = *(const f32x4*)(p.norm_mix + e), sh = *(const f32x4*)(cb + 0 * D + e), sc = *(const f32x4*)(cb + 1 * D + e);
                float h[4];
#pragma unroll
                for (int i = 0; i < 4; ++i) h[i] = v[j][i] * rstd * g[i] * (1.f + sc[i]) + sh[i];
                int r8 = 0;
                r8 = __builtin_amdgcn_cvt_pk_fp8_f32(h[0], h[1], r8, false);
                r8 = __builtin_amdgcn_cvt_pk_fp8_f32(h[2], h[3], r8, true);
                *(unsigned*)((unsigned char*)p.s0 + (size_t)t * D + e) = (unsigned)r8;
            }
        }
    }
    for (int i = blockIdx.x * NT + threadIdx.x; i < 4 * 1024; i += gridDim.x * NT) {
        const int b = i >> 10, k = i & 1023;
        const float* cb = p.cond + (size_t)b * (NCOND * D);
        bf16_t* o = p.cvec + (size_t)b * 12 * 1024 + k;
        o[0 * 1024] = f2bf(p.norm_ffn[k] * (1.f + cb[4 * D + k]));      o[1 * 1024] = f2bf(cb[3 * D + k]);  o[2 * 1024] = f2bf(cb[5 * D + k]);
        o[3 * 1024] = f2bf(p.kv_norm[k] * (1.f + cb[13 * D + k]));      o[4 * 1024] = f2bf(cb[12 * D + k]);
        o[5 * 1024] = f2bf(p.norm_mix[D + k] * (1.f + cb[7 * D + k]));  o[6 * 1024] = f2bf(cb[6 * D + k]);
        o[7 * 1024] = f2bf(p.norm_ffn[D + k] * (1.f + cb[10 * D + k])); o[8 * 1024] = f2bf(cb[9 * D + k]);  o[9 * 1024] = f2bf(cb[11 * D + k]);
        o[10 * 1024] = f2bf(p.final_norm[k] * (1.f + cb[15 * D + k]));  o[11 * 1024] = f2bf(cb[14 * D + k]);
    }
    float* red = (float*)smem;
    const int tid = threadIdx.x;
    for (int task = blockIdx.x; task < 32 * 8; task += gridDim.x) {
        const int ct = task >> 3, ks = task & 7, col0 = ct * 64, layer = col0 >> 10;
        const float* W = p.peer_wq + (size_t)layer * D * D; const int cs = layer ? 9 : 3;
        const int n = (col0 & 1023) + (tid & 63), kg = tid >> 6;
        float wv[16];
#pragma unroll
        for (int j = 0; j < 16; ++j) wv[j] = W[(size_t)(ks * 128 + kg * 16 + j) * D + n];
        float acc[4] = {0.f, 0.f, 0.f, 0.f};
#pragma unroll
        for (int j = 0; j < 16; ++j)
#pragma unroll
            for (int b = 0; b < 4; ++b) acc[b] += p.cond[(size_t)b * (NCOND * D) + cs * D + ks * 128 + kg * 16 + j] * wv[j];
#pragma unroll
        for (int b = 0; b < 4; ++b) red[(kg * 64 + (tid & 63)) * 4 + b] = acc[b];
        __syncthreads();
        if (tid < 256) {
            const int col = tid >> 2, b = tid & 3; float sum = 0.f;
#pragma unroll
            for (int g = 0; g < 8; ++g) sum += red[(g * 64 + col) * 4 + b];
            p.biasp[((size_t)ks * 4 + b) * 2048 + col0 + col] = sum;
        }
        __syncthreads();
    }
}
__device__ void bias_finalize(const Params& p) {
    const int i = blockIdx.x * NT + threadIdx.x;
    if (i < 4 * 2048) { float s = 0.f;
#pragma unroll
        for (int ks = 0; ks < 8; ++ks) s += p.biasp[(size_t)ks * 8192 + i];
        p.bias[i] = s; }
}

__device__ __forceinline__ int lds_off(int row, int chunk) { return row * 128 + ((chunk ^ (row & 7)) << 4); }

template <int BN, class Epi, bool FP8 = false>
__device__ void gemm_phase(const void* __restrict__ Av, const void* __restrict__ Btv, size_t bt_batch_stride, int N, const Epi& epi, unsigned char* smem) {
    constexpr int ES = FP8 ? 1 : 2, NKS = D * ES / 128;
    const unsigned char* A = (const unsigned char*)Av; const unsigned char* Bt = (const unsigned char*)Btv;
    constexpr int WMI = BN == 256 ? 8 : 4;
    constexpr int A_BYTES = 32768, B_BYTES = BN * 128, BUF = A_BYTES + B_BYTES;
    const int tid = opaque_tid(), lane = tid & 63, w = __builtin_amdgcn_readfirstlane(tid >> 6), tk = lane & 15, q = lane >> 4;
    const int wm = BN == 256 ? (w >> 2) : (w >> 1), wn = BN == 256 ? (w & 3) : (w & 1);
    const int nN = N / BN;
    const bool xmap = (gridDim.x % 8) == 0;
    const int nslots = xmap ? gridDim.x / 8 : gridDim.x, slot = xmap ? (blockIdx.x >> 3) : blockIdx.x, xcd = blockIdx.x & 7;
    const int nitems = xmap ? 8 * nN : 64 * nN;
    for (int item = slot; item < nitems; item += nslots) {
        const int pm = xmap ? xcd * 8 + item / nN : item / nN, pn = item % nN;
        const int m0 = pm * 256, n0 = pn * BN, b = m0 / SEQ;
        const unsigned char* Ab = A + (size_t)m0 * (D * ES);
        const unsigned char* Bb = Bt + (size_t)b * bt_batch_stride + (size_t)n0 * (D * ES);
        f32x4 acc[WMI][4];
#pragma unroll
        for (int mi = 0; mi < WMI; ++mi)
#pragma unroll
            for (int ni = 0; ni < 4; ++ni) acc[mi][ni] = (f32x4){0.f, 0.f, 0.f, 0.f};
        auto stage = [&](int buf, int kt) {
#pragma unroll
            for (int j = 0; j < 4; ++j) {
                const int piece = w * 4 + j, P = piece * 1024 + lane * 16, row = P >> 7, lc = ((P >> 4) & 7) ^ (row & 7);
                __builtin_amdgcn_global_load_lds((const __attribute__((address_space(1))) void*)(Ab + (size_t)row * (D * ES) + kt * 128 + lc * 16),
                                                 (__attribute__((address_space(3))) void*)(smem + buf * BUF + piece * 1024), 16, 0, 0);
            }
#pragma unroll
            for (int j = 0; j < BN / 64; ++j) {
                const int piece = w * (BN / 64) + j, P = piece * 1024 + lane * 16, row = P >> 7, lc = ((P >> 4) & 7) ^ (row & 7);
                __builtin_amdgcn_global_load_lds((const __attribute__((address_space(1))) void*)(Bb + (size_t)row * (D * ES) + kt * 128 + lc * 16),
                                                 (__attribute__((address_space(3))) void*)(smem + buf * BUF + A_BYTES + piece * 1024), 16, 0, 0);
            }
        };
        const int swz = tk & 7;
        const int offA = (wm * (WMI * 16) + tk) * 128, offB = A_BYTES + (wn * 64 + tk) * 128;
        auto compute = [&](int buf) {
            const unsigned char* sb = smem + buf * BUF;
            if constexpr (!FP8) {
#pragma unroll
                for (int ks = 0; ks < 2; ++ks) {
                    const int co = ((ks * 4 + q) ^ swz) * 16;
                    const unsigned char* pa = sb + offA + co; const unsigned char* pb = sb + offB + co;
                    bf16x8 bfr[4];
#pragma unroll
                    for (int ni = 0; ni < 4; ++ni) bfr[ni] = *(const bf16x8*)(pb + ni * 2048);
#pragma unroll
                    for (int mh = 0; mh < WMI / 4; ++mh) {
                        bf16x8 af[4];
#pragma unroll
                        for (int mi = 0; mi < 4; ++mi) af[mi] = *(const bf16x8*)(pa + (mh * 4 + mi) * 2048);
#pragma unroll
                        for (int mi = 0; mi < 4; ++mi)
#pragma unroll
                            for (int ni = 0; ni < 4; ++ni) acc[mh * 4 + mi][ni] = __builtin_amdgcn_mfma_f32_16x16x32_bf16(bfr[ni], af[mi], acc[mh * 4 + mi][ni], 0, 0, 0);
                    }
                }
            } else {
                typedef int i32x8g __attribute__((ext_vector_type(8)));
                const int clo = (q ^ swz) * 16, chi = ((4 + q) ^ swz) * 16;
                const unsigned char* pa = sb + offA; const unsigned char* pb = sb + offB;
                auto frag = [&](const unsigned char* s) {
                    const u32x4 lo = *(const u32x4*)(s + clo), hi = *(const u32x4*)(s + chi);
                    return (i32x8g){(int)lo[0], (int)lo[1], (int)lo[2], (int)lo[3], (int)hi[0], (int)hi[1], (int)hi[2], (int)hi[3]};
                };
                i32x8g bfr[4];
#pragma unroll
                for (int ni = 0; ni < 4; ++ni) bfr[ni] = frag(pb + ni * 2048);
#pragma unroll
                for (int m2 = 0; m2 < WMI / 2; ++m2) {
                    i32x8g af[2];
#pragma unroll
                    for (int mi = 0; mi < 2; ++mi) af[mi] = frag(pa + (m2 * 2 + mi) * 2048);
#pragma unroll
                    for (int mi = 0; mi < 2; ++mi)
#pragma unroll
                        for (int ni = 0; ni < 4; ++ni)
                            acc[m2 * 2 + mi][ni] = __builtin_amdgcn_mfma_scale_f32_16x16x128_f8f6f4(bfr[ni], af[mi], acc[m2 * 2 + mi][ni], 0, 0, 0, 0x7f7f7f7f, 0, 0x7f7f7f7f);
                    if (m2 & 1) __builtin_amdgcn_sched_barrier(0);
                }
            }
        };
        stage(0, 0);
        __syncthreads();
#pragma unroll 1
        for (int kt = 0; kt < NKS; ++kt) {
            if (kt + 1 < NKS) stage((kt + 1) & 1, kt + 1);
            compute(kt & 1);
            __syncthreads();
        }
        float* stg = (float*)(smem + w * 17408);
#pragma unroll
        for (int mh = 0; mh < WMI / 4; ++mh) {
#pragma unroll
            for (int mi = 0; mi < 4; ++mi)
#pragma unroll
                for (int ni = 0; ni < 4; ++ni) *(f32x4*)(stg + (mi * 16 + tk) * 68 + ni * 16 + 4 * q) = acc[mh * 4 + mi][ni];
            asm volatile("s_waitcnt lgkmcnt(0)" ::: "memory");
            const int c4 = lane & 15, rsub = lane >> 4;
            const int tok0 = m0 + wm * (WMI * 16) + mh * 64, nb0 = n0 + wn * 64, slot_ = pn * (BN / 64) + wn;
            const typename Epi::Col cc = epi.col(nb0, c4, b);
#pragma unroll 1
            for (int hf = 0; hf < 4; ++hf) {
                typename Epi::Pre pr[4];
#pragma unroll
                for (int ps = 0; ps < 4; ++ps) pr[ps] = epi.pre(tok0 + (hf * 4 + ps) * 4 + rsub, nb0, c4, b);
#pragma unroll
                for (int ps = 0; ps < 4; ++ps) {
                    const int row = (hf * 4 + ps) * 4 + rsub;
                    const f32x4 v = *(const f32x4*)(stg + row * 68 + c4 * 4);
                    epi.row(tok0 + row, nb0, c4, v, b, slot_, pr[ps], cc);
                }
            }
            asm volatile("s_waitcnt lgkmcnt(0)" ::: "memory");
        }
        __syncthreads();
    }
}

__device__ __forceinline__ float rstd_of(const float* ssq, int token) {
    const f32x4* s4 = (const f32x4*)(ssq + (size_t)token * 16);
    const f32x4 a = s4[0], b = s4[1], c = s4[2], d = s4[3];
    const float s = ((a[0] + a[1]) + (a[2] + a[3])) + ((b[0] + b[1]) + (b[2] + b[3])) + ((c[0] + c[1]) + (c[2] + c[3])) + ((d[0] + d[1]) + (d[2] + d[3]));
    return rsqrtf(s * (1.f / D) + RMS_EPS);
}

template <int CTRL> __device__ __forceinline__ float dppx(float v) { return __uint_as_float((unsigned)__builtin_amdgcn_update_dpp(0, (int)__float_as_uint(v), CTRL, 0xf, 0xf, true)); }
struct EpiU {
    struct Pre {};
    struct Col { f32x4 sc; };
    bf16_t* ug; const float* cs;
    __device__ __forceinline__ Col col(int nbase, int c4, int) const { return Col{*(const f32x4*)(cs + nbase + 4 * c4)}; }
    __device__ __forceinline__ Pre pre(int, int, int, int) const { return Pre{}; }
    __device__ __forceinline__ void row(int token, int nbase, int c4, f32x4 v, int b, int, const Pre&, const Col& cc) const {
        const int n = nbase + 4 * c4, g = n >> 4, s = token - b * SEQ;
        const f32x4 sc = cc.sc;
        u32x2 o; o[0] = pack2(v[0] * sc[0], v[1] * sc[1]); o[1] = pack2(v[2] * sc[2], v[3] * sc[3]);
        *(u32x2*)(ug + (((size_t)(g * 4 + b) * SEQ + s) * 16 + (n & 15))) = o;
    }
};
struct EpiQ {
    struct Pre { float sq; };
    struct Col { f32x4 bv, csv; };
    const float* ssq; const float* bias; int boff; bf16_t* out; const float* cs;
    __device__ __forceinline__ Col col(int nbase, int c4, int b) const { const int n = nbase + 4 * c4; return Col{*(const f32x4*)(bias + (size_t)b * 2048 + boff + n), *(const f32x4*)(cs + n)}; }
    __device__ __forceinline__ Pre pre(int token, int, int c4, int) const { return Pre{ssq[(size_t)token * 16 + c4]}; }
    __device__ __forceinline__ void row(int token, int nbase, int c4, f32x4 v, int b, int, const Pre& pr, const Col& cc) const {
        const int n = nbase + 4 * c4;
        float s = pr.sq; s += dppx<0xB1>(s); s += dppx<0x4E>(s); s += dppx<0x141>(s); s += dppx<0x140>(s);
        const float rstd = rsqrtf(s * (1.f / D) + RMS_EPS);
        const f32x4 bv = cc.bv, csv = cc.csv;
        u32x2 o; o[0] = pack2(rstd * csv[0] * v[0] + bv[0], rstd * csv[1] * v[1] + bv[1]); o[1] = pack2(rstd * csv[2] * v[2] + bv[2], rstd * csv[3] * v[3] + bv[3]);
        *(u32x2*)(out + (size_t)token * D + n) = o;
    }
};
struct EpiGlu {
    struct Pre { int yw; };
    struct Col { f32x4 bv, sc; };
    const unsigned char* y; const float* bglu; const float* cs; unsigned char* out;
    __device__ __forceinline__ Col col(int nbase, int c4, int) const { const int n = nbase + 4 * c4; return Col{*(const f32x4*)(bglu + n), *(const f32x4*)(cs + n)}; }
    __device__ __forceinline__ Pre pre(int token, int nbase, int c4, int) const { return Pre{*(const int*)(y + (size_t)token * D + nbase + 4 * c4)}; }
    __device__ __forceinline__ void row(int token, int nbase, int c4, f32x4 v, int, int, const Pre& pr, const Col& cc) const {
        const int n = nbase + 4 * c4;
        const f32x4 bv = cc.bv, sc = cc.sc;
        const f32x2 ylo = __builtin_amdgcn_cvt_pk_f32_fp8(pr.yw, false), yhi = __builtin_amdgcn_cvt_pk_f32_fp8(pr.yw, true);
        const float o0 = ylo[0] / (1.f + __expf(-(v[0] * sc[0] + bv[0]))), o1 = ylo[1] / (1.f + __expf(-(v[1] * sc[1] + bv[1])));
        const float o2 = yhi[0] / (1.f + __expf(-(v[2] * sc[2] + bv[2]))), o3 = yhi[1] / (1.f + __expf(-(v[3] * sc[3] + bv[3])));
        *(unsigned*)(out + (size_t)token * D + n) = pack4_fp8(o0, o1, o2, o3);
    }
};
template <bool XB16>
struct EpiRes {
    struct Pre { f32x4 xo; };
    struct Col { f32x4 gc  , gs  ; };
    const void* xold; const float* gate  ; const float* gnorm; const float* scale  ; bf16_t* xout; bf16_t* xbout; float* ssq; const float* cs;
    __device__ __forceinline__ Pre pre(int token, int nbase, int c4, int) const {
        if (XB16) { const u32x2 w = *(const u32x2*)((const bf16_t*)xold + (size_t)token * D + nbase + 4 * c4); return Pre{(f32x4){bflo(w[0]), bfhi(w[0]), bflo(w[1]), bfhi(w[1])}}; }
        return Pre{*(const f32x4*)((const float*)xold + (size_t)token * D + nbase + 4 * c4)};
    }
    __device__ __forceinline__ Col col(int nbase, int c4, int b) const {
        const int n = nbase + 4 * c4;
        const f32x4 gv = *(const f32x4*)(gate + (size_t)b * (NCOND * D) + n), gn = *(const f32x4*)(gnorm + n), sc = *(const f32x4*)(scale + (size_t)b * (NCOND * D) + n);
        const f32x4 csv = *(const f32x4*)(cs + n);
        Col cc;
#pragma unroll
        for (int r = 0; r < 4; ++r) { cc.gc[r] = gv[r] * csv[r]; cc.gs[r] = gn[r] * (1.f + sc[r]); }
        return cc;
    }
    __device__ __forceinline__ void row(int token, int nbase, int c4, f32x4 v, int b, int slot, const Pre& pr, const Col& cc) const {
        const int n = nbase + 4 * c4;
        f32x4 xn; float hs[4]; float ss = 0.f;
#pragma unroll
        for (int r = 0; r < 4; ++r) { xn[r] = pr.xo[r] + cc.gc[r] * v[r]; ss += xn[r] * xn[r]; hs[r] = xn[r] * cc.gs[r]; }
        { u32x2 xo2; xo2[0] = pack2(xn[0], xn[1]); xo2[1] = pack2(xn[2], xn[3]); *(u32x2*)(xout + (size_t)token * D + n) = xo2; }
        *(unsigned*)((unsigned char*)xbout + (size_t)token * D + n) = pack4_fp8(hs[0], hs[1], hs[2], hs[3]);
        ss += dppx<0xB1>(ss); ss += dppx<0x4E>(ss); ss += dppx<0x141>(ss); ss += dppx<0x140>(ss);
        if (c4 == 0) ssq[(size_t)token * 16 + slot] = ss;
    }
};
template <int MODE  >
struct EpiRope {
    struct Pre { f32x4 cs4, sn4; };
    struct Col { f32x4 csv; };
    const float* ropec; const float* ropes; bf16_t* o0; bf16_t* o1; const float* cs;
    __device__ __forceinline__ Col col(int nbase, int c4, int) const { return Col{*(const f32x4*)(cs + nbase + 4 * c4)}; }
    __device__ __forceinline__ Pre pre(int token, int nbase, int c4, int) const {
        Pre pr; pr.cs4 = (f32x4){0.f, 0.f, 0.f, 0.f}; pr.sn4 = pr.cs4;
        if (MODE == 1 || nbase < 256) { const int d = (c4 & 7) * 4; pr.cs4 = *(const f32x4*)(ropec + (size_t)token * 32 + d); pr.sn4 = *(const f32x4*)(ropes + (size_t)token * 32 + d); }
        return pr;
    }
    __device__ __forceinline__ void row(int token, int nbase, int c4, f32x4 v, int, int, const Pre& pr, const Col& cc) const {
        v = v * cc.csv;
        const bool rope = MODE == 1 || nbase < 256;
        if (rope) {
            f32x4 pv;
#pragma unroll
            for (int r = 0; r < 4; ++r) pv[r] = dppx<0x128>(v[r]);
            if (c4 < 8) {
#pragma unroll
                for (int r = 0; r < 4; ++r) v[r] = v[r] * pr.cs4[r] - pv[r] * pr.sn4[r];
            } else {
#pragma unroll
                for (int r = 0; r < 4; ++r) v[r] = v[r] * pr.cs4[r] + pv[r] * pr.sn4[r];
            }
        }
        const int n = nbase + 4 * c4;
        bf16_t* dst = MODE == 1 ? o0 + (size_t)token * D + n : (nbase < 256 ? o0 + (size_t)token * 256 + n : o1 + (size_t)token * 256 + (n - 256));
        u32x2 o; o[0] = pack2(v[0], v[1]); o[1] = pack2(v[2], v[3]);
        *(u32x2*)dst = o;
    }
};

__device__ void s5_phase(const Params& p, unsigned char* smem) {
    bf16_t* Xl = (bf16_t*)smem;
    float* Sl = (float*)(smem + 16384);
    bf16_t* ktl = (bf16_t*)(smem + 16384);
    const int tid = opaque_tid(), lane = tid & 63, w = __builtin_amdgcn_readfirstlane(tid >> 6), cb = w & 3, hh = w >> 2, tk = lane & 15, q = lane >> 4;
    for (int task = blockIdx.x; task < G5 * NB; task += gridDim.x) {
        const int g = (task & 7) * 8 + ((task >> 3) >> 2), b = (task >> 3) & 3;
        const bf16_t* U = p.s1 + (size_t)(g * 4 + b) * SEQ * 16;
        const bf16_t* sm = p.smat + (size_t)g * 128 * 1024;
        const bf16_t* cm = p.cmat + (size_t)g * 1024 * 128;
        bf16x8 ufr[32];
#pragma unroll
        for (int ks = 0; ks < 32; ++ks) ufr[ks] = *(const bf16x8*)((const unsigned char*)U + (unsigned)(((cb * 16 + tk) * 1024 + ks * 32 + 8 * q) * 2));
        {
            unsigned char* stg = smem + 49664;
            auto stageA = [&](int buf, int kc) {
#pragma unroll
                for (int j = 0; j < 4; ++j) {
                    const int piece = w * 4 + j, P = piece * 1024 + lane * 16, row = P >> 8, lc = ((P >> 4) & 15) ^ (row & 15);
                    __builtin_amdgcn_global_load_lds((const __attribute__((address_space(1))) void*)((const unsigned char*)sm + (unsigned)(row * 2048 + kc * 256 + lc * 16)),
                                                     (__attribute__((address_space(3))) void*)(stg + buf * 32768 + piece * 1024), 16, 0, 0);
                }
            };
            f32x4 acc[4];
#pragma unroll
            for (int mf = 0; mf < 4; ++mf) acc[mf] = (f32x4){0.f, 0.f, 0.f, 0.f};
            stageA(0, 0);
#pragma unroll
            for (int kc = 0; kc < 8; ++kc) {
                asm volatile("s_waitcnt vmcnt(0)" ::: "memory");
                __syncthreads();
                if (kc + 1 < 8) stageA((kc + 1) & 1, kc + 1);
                const unsigned char* sb = stg + (kc & 1) * 32768 + (hh * 64 + tk) * 256;
#pragma unroll
                for (int mf = 0; mf < 4; ++mf)
#pragma unroll
                    for (int j = 0; j < 4; ++j) {
                        const bf16x8 af = *(const bf16x8*)(sb + mf * 4096 + (((j * 4 + q) ^ tk) << 4));
                        acc[mf] = __builtin_amdgcn_mfma_f32_16x16x32_bf16(af, ufr[kc * 4 + j], acc[mf], 0, 0, 0);
                    }
            }
#pragma unroll
            for (int mf = 0; mf < 4; ++mf)
#pragma unroll
                for (int r = 0; r < 4; ++r) Sl[((hh * 4 + mf) * 16 + 4 * q + r) * 65 + cb * 16 + tk] = acc[mf][r];
        }
        __syncthreads();
        if (w == 0) {
            const float lr = p.lamL[(g * P5 + lane) * 2], li = p.lamL[(g * P5 + lane) * 2 + 1];
            float xr = 0.f, xi = 0.f;
#pragma unroll 1
            for (int k0 = 0; k0 < NCH; k0 += 8) {
                float sr[8], si[8];
#pragma unroll
                for (int j = 0; j < 8; ++j) { sr[j] = Sl[lane * 65 + k0 + j]; si[j] = Sl[(64 + lane) * 65 + k0 + j]; }
#pragma unroll
                for (int j = 0; j < 8; ++j) {
                    Xl[(k0 + j) * 128 + lane] = f2bf(xr); Xl[(k0 + j) * 128 + 64 + lane] = f2bf(xi);
                    const float nr = lr * xr - li * xi + sr[j], ni = lr * xi + li * xr + si[j];
                    xr = nr; xi = ni;
                }
            }
        }
        __syncthreads();
        {
            const unsigned char* ktg = (const unsigned char*)(p.ktab + (size_t)g * KTR * 256);
#pragma unroll
            for (int j = 0; j < 5; ++j) {
                const int piece = w * 5 + j;
                __builtin_amdgcn_global_load_lds((const __attribute__((address_space(1))) void*)(ktg + piece * 1024 + lane * 16),
                                                 (__attribute__((address_space(3))) void*)((unsigned char*)ktl + piece * 1024), 16, 0, 0);
            }
        }
        const f32x4 dv = *(const f32x4*)(p.s5d + g * 16 + 4 * q);
        unsigned char* ybase = (unsigned char*)p.s0 + (size_t)b * SEQ * D + g * 16;
        const int jl = q >> 1, cih = q & 1;
        const bf16_t* kbase = ktl + (16 - jl) * 256 + tk * 16 + cih * 8;
        unsigned char* stg = smem + 57344;
        auto win_i0 = [&](int hs, int wd) { return 8 * wd + hs; };
        auto stageC = [&](int buf, int wd) {
#pragma unroll
            for (int j = 0; j < 4; ++j) {
                const int piece = w * 4 + j, P = piece * 1024 + lane * 16, rb = P >> 8, c = (P >> 4) & 15, co = rb & 15, il = (rb >> 4) & 3, hs = rb >> 6;
                const int ipos = win_i0(hs, wd) + 2 * il;
                __builtin_amdgcn_global_load_lds((const __attribute__((address_space(1))) void*)((const unsigned char*)cm + (unsigned)((ipos * 16 + co) * 256 + ((c ^ co) << 4))),
                                                 (__attribute__((address_space(3))) void*)(stg + buf * 32768 + piece * 1024), 16, 0, 0);
            }
        };
        stageC(0, 0);
        bf16x8 xfr[4];
#pragma unroll
        for (int ks = 0; ks < 4; ++ks) xfr[ks] = *(const bf16x8*)(Xl + (cb * 16 + tk) * 128 + ks * 32 + 8 * q);
#pragma unroll 1
        for (int wd = 0; wd < 8; ++wd) {
            asm volatile("s_waitcnt vmcnt(0)" ::: "memory");
            __syncthreads();
            if (wd + 1 < 8) stageC((wd + 1) & 1, wd + 1);
            const unsigned char* cbuf = stg + (wd & 1) * 32768 + (hh * 64 + tk) * 256;
            const int i0 = win_i0(hh, wd);
            const int s0 = (cb * 16 + tk) * 64 + i0;
            u32x2 uv[4];
#pragma unroll
            for (int e = 0; e < 4; ++e) uv[e] = *(const u32x2*)((const unsigned char*)U + (unsigned)((s0 + 2 * e) * 32 + 8 * q));
            f32x4 acc[4];
#pragma unroll
            for (int e = 0; e < 4; ++e) {
                acc[e] = (f32x4){0.f, 0.f, 0.f, 0.f};
#pragma unroll
                for (int ks = 0; ks < 4; ++ks) acc[e] = __builtin_amdgcn_mfma_f32_16x16x32_bf16(*(const bf16x8*)(cbuf + e * 4096 + (((ks * 4 + q) ^ tk) << 4)), xfr[ks], acc[e], 0, 0, 0);
                __builtin_amdgcn_sched_barrier(0);
            }
            const int mmaxw = (i0 + 6) >> 1;
            const bf16_t* kbw = kbase + i0 * 256;
            bf16x8 ring[4];
            ring[1] = *(const bf16x8*)(kbw + 3 * 512); ring[2] = *(const bf16x8*)(kbw + 2 * 512); ring[3] = *(const bf16x8*)(kbw + 1 * 512); ring[0] = *(const bf16x8*)(kbw);
#pragma unroll
            for (int mg = 0; mg < 8; ++mg) {
                if (4 * mg <= mmaxw) {
#pragma unroll
                    for (int j = 0; j < 4; ++j) {
                        const int m = 4 * mg + j;
                        acc[3] = __builtin_amdgcn_mfma_f32_16x16x32_bf16(ring[(j + 1) & 3], ufr[m], acc[3], 0, 0, 0);
                        ring[(j + 1) & 3] = *(const bf16x8*)(kbw - (m + 1) * 512);
                        acc[2] = __builtin_amdgcn_mfma_f32_16x16x32_bf16(ring[(j + 2) & 3], ufr[m], acc[2], 0, 0, 0);
                        acc[1] = __builtin_amdgcn_mfma_f32_16x16x32_bf16(ring[(j + 3) & 3], ufr[m], acc[1], 0, 0, 0);
                        acc[0] = __builtin_amdgcn_mfma_f32_16x16x32_bf16(ring[j], ufr[m], acc[0], 0, 0, 0);
                    }
                }
            }
#pragma unroll
            for (int e = 0; e < 4; ++e) {
                const float y0 = gelu_tanh(acc[e][0] + dv[0] * bflo(uv[e][0])), y1 = gelu_tanh(acc[e][1] + dv[1] * bfhi(uv[e][0]));
                const float y2 = gelu_tanh(acc[e][2] + dv[2] * bflo(uv[e][1])), y3 = gelu_tanh(acc[e][3] + dv[3] * bfhi(uv[e][1]));
                *(unsigned*)(ybase + (unsigned)((s0 + 2 * e) * D + 4 * q)) = pack4_fp8(y0, y1, y2, y3);
            }
        }
        __syncthreads();
    }
}

__device__ __forceinline__ float med3f(float a, float b, float c) { return __builtin_amdgcn_fmed3f(a, b, c); }
__device__ __forceinline__ void ins16(float (&a)[16], float v) {
#pragma unroll
    for (int i = 15; i >= 1; --i) a[i] = med3f(a[i - 1], a[i], v);
    a[0] = med3f(__builtin_inff(), a[0], v);
}
__device__ void route_phase(const Params& p, int layer, const bf16_t* qp, unsigned char* smem) {
    float* sc = (float*)smem;
    float* tl = (float*)(smem + 2 * 128 * 132 * 4);
    const int tid_hw = opaque_tid(), lane = tid_hw & 63, tk = lane & 15, q = lane >> 4;
    int w;
    {
        volatile LAS int* rc = (volatile LAS int*)(smem + 2 * 128 * 132 * 4 + 2 * 128 * 16 * 4);
        if (tid_hw < 4) rc[tid_hw] = 0;
        __syncthreads();
        const int simd = (int)((__builtin_amdgcn_s_getreg((1 << 11) | (4 << 6) | 4)) & 3u);
        int slot = 0;
        if (lane == 0) slot = __hip_atomic_fetch_add((LAS int*)&rc[simd], 1, __ATOMIC_RELAXED, __HIP_MEMORY_SCOPE_WORKGROUP);
        slot = __builtin_amdgcn_readfirstlane(slot);
        __syncthreads();
        const bool balanced = rc[0] == 2 && rc[1] == 2 && rc[2] == 2 && rc[3] == 2;
        w = balanced ? slot * 4 + simd : (tid_hw >> 6);
        w = __builtin_amdgcn_readfirstlane(w);
        __syncthreads();
    }
    const int tid = w * 64 + lane;
    const int gsel = (int)(gridDim.x & ~7u);
    if ((int)blockIdx.x >= gsel) return;
    const int tt_first = (int)(blockIdx.x >> 3), tt_step = gsel >> 3;
    auto pk = [](float v, unsigned idx) -> float { return __uint_as_float((__float_as_uint(v) & ~0x7Fu) | idx); };
    {
        const int h = (int)(blockIdx.x & 7);
        int tt = tt_first;
        if (tt >= T / 128) return;
        if (w < 4) {
            bf16x8 kf[2][8][2];
#pragma unroll
            for (int pp = 0; pp < 2; ++pp)
#pragma unroll
                for (int nf = 0; nf < 8; ++nf) {
                    const bf16_t* kb = p.skeys + ((size_t)((layer * 8 + h) * 2 + pp) * 128 + nf * 16 + tk) * 64 + 8 * q;
                    kf[pp][nf][0] = *(const bf16x8*)(kb); kf[pp][nf][1] = *(const bf16x8*)(kb + 32);
                }
            bf16x8 qa[2][4];
            auto load_q = [&](int t0_) {
#pragma unroll
                for (int g = 0; g < 2; ++g) {
                    const bf16_t* qrow = qp + (size_t)(t0_ + 32 * w + 16 * g + tk) * D + h * 128 + 8 * q;
#pragma unroll
                    for (int c_ = 0; c_ < 4; ++c_) qa[g][c_] = *(const bf16x8*)(qrow + 32 * c_);
                }
            };
            auto scores = [&]() {
#pragma unroll
                for (int g = 0; g < 2; ++g)
#pragma unroll
                    for (int pp = 0; pp < 2; ++pp)
#pragma unroll
                        for (int nf = 0; nf < 8; ++nf) {
                            f32x4 acc = {0.f, 0.f, 0.f, 0.f};
                            acc = __builtin_amdgcn_mfma_f32_16x16x32_bf16(kf[pp][nf][0], qa[g][pp * 2], acc, 0, 0, 0);
                            acc = __builtin_amdgcn_mfma_f32_16x16x32_bf16(kf[pp][nf][1], qa[g][pp * 2 + 1], acc, 0, 0, 0);
                            *(f32x4*)(sc + (pp * 128 + 32 * w + 16 * g + tk) * 132 + nf * 16 + 4 * q) = acc;
                        }
            };
            load_q(tt * 128);
            scores();
            __syncthreads();
            for (;;) {
                const int ntt = tt + tt_step;
                const bool hn = ntt < T / 128;
                if (hn) load_q(ntt * 128);
                float a[16];
                const float* row = sc + tid * 132;
#pragma unroll
                for (int i = 0; i < 16; ++i) a[i] = -3.0e38f;
#pragma unroll 4
                for (int m = 0; m < 32; ++m) {
                    const f32x4 v = *(const f32x4*)(row + 4 * m);
                    const float x0 = pk(v[0], 4 * m), x1 = pk(v[1], 4 * m + 1), x2 = pk(v[2], 4 * m + 2), x3 = pk(v[3], 4 * m + 3);
                    ins16(a, fmaxf(fmaxf(x0, x1), fmaxf(x2, x3)));
                }
                {
                    float sn[16];
#pragma unroll
                    for (int i = 0; i < 16; ++i) sn[i] = a[i];
#pragma unroll
                    for (int i = 0; i < 16; ++i) {
                        const unsigned j = __float_as_uint(sn[i]) & 0x7Fu, op = (j & ~3u) + ((j & 2u) ^ 2u);
                        const f32x2 pr = *(const f32x2*)(row + op);
                        ins16(a, fmaxf(pk(pr[0], op), pk(pr[1], op + 1u)));
                    }
                }
                {
                    float sn[16];
#pragma unroll
                    for (int i = 0; i < 16; ++i) sn[i] = a[i];
#pragma unroll
                    for (int i = 0; i < 16; ++i) {
                        const unsigned j = (__float_as_uint(sn[i]) & 0x7Fu) ^ 1u;
                        ins16(a, pk(row[j], j));
                    }
                }
                __syncthreads();
#pragma unroll
                for (int k4 = 0; k4 < 4; ++k4) *(f32x4*)(tl + tid * 16 + k4 * 4) = (f32x4){a[k4 * 4], a[k4 * 4 + 1], a[k4 * 4 + 2], a[k4 * 4 + 3]};
                if (!hn) break;
                tt = ntt;
                scores();
                __syncthreads();
            }
            __syncthreads();
            __syncthreads();
        } else {
    float pe[16], psu[16], psv[16]; int pid[16];
    auto combine_a = [&](int tok) {
        float s[16], r[16], c[16];
#pragma unroll
        for (int i = 0; i < 16; ++i) { s[i] = tl[tok * 16 + i]; r[i] = tl[(128 + tok) * 16 + i]; c[i] = -3.0e38f; }
#pragma unroll
        for (int i = 0; i < 16; ++i)
#pragma unroll
            for (int j = 0; j < 16; ++j)
                if ((i + 1) * (j + 1) <= 16) {
                    const float v = __uint_as_float((__float_as_uint(s[i] + r[j]) & ~0xFFu) | (unsigned)(i * 16 + j));
                    ins16(c, v);
                }
        float sum = 0.f;
#pragma unroll
        for (int k = 0; k < 16; ++k) { pe[k] = __expf(c[k] - c[0]); sum += pe[k]; }
        const float inv = 1.f / sum;
#pragma unroll
        for (int k = 0; k < 16; ++k) pe[k] *= inv;
#pragma unroll
        for (int k = 0; k < 16; ++k) {
            const unsigned bits = __float_as_uint(c[k]), i = (bits >> 4) & 15u, j = bits & 15u;
            const unsigned ki = __float_as_uint(tl[tok * 16 + i]) & 0x7Fu, kj = __float_as_uint(tl[(128 + tok) * 16 + j]) & 0x7Fu;
            pid[k] = (int)(ki * 128u + kj);
        }
        const float* sut = p.su + (size_t)layer * NEXP; const float* svt = p.sv + (size_t)layer * NEXP;
#pragma unroll
        for (int k = 0; k < 16; ++k) { psu[k] = sut[pid[k]]; psv[k] = svt[pid[k]]; }
    };
    auto combine_b = [&](int tok, int h_, int t0_) {
        int* ido = p.ids + (size_t)(t0_ + tok) * 128 + h_ * 16; float* go = p.gates + (size_t)(t0_ + tok) * 128 + h_ * 16; float* so = p.sus + (size_t)(t0_ + tok) * 128 + h_ * 16;
#pragma unroll
        for (int k4 = 0; k4 < 4; ++k4) {
            *(int4*)(ido + k4 * 4) = make_int4(pid[k4 * 4], pid[k4 * 4 + 1], pid[k4 * 4 + 2], pid[k4 * 4 + 3]);
            *(f32x4*)(go + k4 * 4) = (f32x4){pe[k4 * 4] * psv[k4 * 4], pe[k4 * 4 + 1] * psv[k4 * 4 + 1], pe[k4 * 4 + 2] * psv[k4 * 4 + 2], pe[k4 * 4 + 3] * psv[k4 * 4 + 3]};
            *(f32x4*)(so + k4 * 4) = (f32x4){psu[k4 * 4], psu[k4 * 4 + 1], psu[k4 * 4 + 2], psu[k4 * 4 + 3]};
        }
    };
            __syncthreads();
            int pt0 = -1, ft0 = -1;
            for (;;) {
                const int ntt = tt + tt_step;
                const bool hn = ntt < T / 128;
                if (w < 6) {
                    if (ft0 >= 0) combine_b(tid - 256, h, ft0);
                    if (pt0 >= 0) combine_a(tid - 256);
                    ft0 = pt0;
                }
                __syncthreads();
                pt0 = tt * 128;
                if (!hn) break;
                tt = ntt;
                __syncthreads();
            }
            __syncthreads();
            if (w < 6) {
                if (ft0 >= 0) combine_b(tid - 256, h, ft0);
                combine_a(tid - 256);
                combine_b(tid - 256, h, pt0);
            }
            __syncthreads();
        }
    }
}

typedef _Float16 h16x2 __attribute__((ext_vector_type(2)));
typedef int i32x8 __attribute__((ext_vector_type(8)));
#ifndef NVR
#define NVR 16
#endif
template <bool FINAL>
__device__ void gather_phase(const Params& p, int layer, const bf16_t* xin, bf16_t* xout, bf16_t* hkv_out, bf16_t* hq_out, unsigned char* smem) {
    const int tid_ = opaque_tid(), lane = tid_ & 63, wv = __builtin_amdgcn_readfirstlane(tid_ >> 6), tk = lane & 15, q = lane >> 4;
    const int nw = gridDim.x * (NT / 64);
    const unsigned char* utab = p.ub + (size_t)layer * NEXP * 512;
    const unsigned char* vtab = p.vb + (size_t)layer * NEXP * 512;
    const float* sutab = p.su + (size_t)layer * NEXP;
    const float* svtab = p.sv + (size_t)layer * NEXP;
    unsigned char* hl = smem + wv * 17664;
    unsigned char* a8l = hl + 1024;
    unsigned char* vbuf = hl + 1280;
    const unsigned vbuf_lds = (unsigned)__builtin_amdgcn_readfirstlane((int)(unsigned)(size_t)(LAS unsigned char*)vbuf);
    u32x4 nx[2]; int nidA = 0, nidB = 0; float ngA = 0.f, ngB = 0.f, nsA = 0.f, nsB = 0.f;
    auto preload = [&](int tt) {
        const bf16_t* xr_ = xin + (size_t)tt * D + lane * 16;
#pragma unroll
        for (int j = 0; j < 2; ++j) nx[j] = *(const u32x4*)(xr_ + j * 8);
        nidA = p.ids[(size_t)tt * 128 + lane]; nidB = p.ids[(size_t)tt * 128 + 64 + lane];
        ngA = p.gates[(size_t)tt * 128 + lane]; ngB = p.gates[(size_t)tt * 128 + 64 + lane];
        nsA = p.sus[(size_t)tt * 128 + lane]; nsB = p.sus[(size_t)tt * 128 + 64 + lane];
    };
    const int t_first = blockIdx.x * (NT / 64) + wv;
    if (t_first < T) preload(t_first);
    for (int t = t_first; t < T; t += nw) {
        const int b = t / SEQ;
        const bf16_t* cv = p.cvec + (size_t)b * 12 * 1024 + (layer ? 7 * 1024 : 0);
        const int e0 = lane * 16;
        u32x4 xv[2];
#pragma unroll
        for (int j = 0; j < 2; ++j) xv[j] = nx[j];
        const int idA = nidA, idB = nidB; const float gA = ngA, gB = ngB, suA = nsA, suB = nsB;
        {
            float ss = 0.f;
#pragma unroll
            for (int j = 0; j < 2; ++j)
#pragma unroll
                for (int e_ = 0; e_ < 4; ++e_) { const float lo_ = bflo(xv[j][e_]), hi_ = bfhi(xv[j][e_]); ss += lo_ * lo_ + hi_ * hi_; }
            ss = wave_sum(ss);
            const float rstd = rsqrtf(ss * (1.f / D) + RMS_EPS);
            u32x4 hw;
#pragma unroll
            for (int j2 = 0; j2 < 2; ++j2) {
                const u32x4 gs8 = *(const u32x4*)(cv + e0 + j2 * 8), sh8 = *(const u32x4*)(cv + 1024 + e0 + j2 * 8);
#pragma unroll
                for (int jj = 0; jj < 2; ++jj) {
                    const int j = j2 * 2 + jj;
                    const unsigned xw0 = xv[j2][jj * 2], xw1 = xv[j2][jj * 2 + 1];
                    const float h0 = bflo(xw0) * rstd * bflo(gs8[jj * 2]) + bflo(sh8[jj * 2]), h1 = bfhi(xw0) * rstd * bfhi(gs8[jj * 2]) + bfhi(sh8[jj * 2]);
                    const float h2 = bflo(xw1) * rstd * bflo(gs8[jj * 2 + 1]) + bflo(sh8[jj * 2 + 1]), h3 = bfhi(xw1) * rstd * bfhi(gs8[jj * 2 + 1]) + bfhi(sh8[jj * 2 + 1]);
                    int r = 0;
                    r = __builtin_amdgcn_cvt_pk_fp8_f32(h0, h1, r, false);
                    r = __builtin_amdgcn_cvt_pk_fp8_f32(h2, h3, r, true);
                    hw[j] = (unsigned)r;
                }
            }
            *(u32x4*)(hl + lane * 16) = hw;
        }
        asm volatile("s_waitcnt lgkmcnt(0)" ::: "memory");
        i32x8 hb[8];
#pragma unroll
        for (int kk = 0; kk < 8; ++kk) {
            const u32x4 lo = *(const u32x4*)(hl + kk * 128 + q * 16), hi = *(const u32x4*)(hl + kk * 128 + 64 + q * 16);
            hb[kk] = (i32x8){(int)lo[0], (int)lo[1], (int)lo[2], (int)lo[3], (int)hi[0], (int)hi[1], (int)hi[2], (int)hi[3]};
        }
        float dA = 0.f, dB = 0.f;
        auto dma16 = [&](const unsigned char* gsrc, unsigned dst) {
            unsigned keep;
            asm volatile("s_mov_b32 %0, m0\n\ts_mov_b32 m0, %2\n\ts_nop 0\n\tglobal_load_lds_dwordx4 %1, off\n\ts_mov_b32 m0, %0" : "=&s"(keep) : "v"(gsrc), "s"(dst) : "memory");
        };
        auto dma_ubatch = [&](int bt, int bsel) {
#pragma unroll
            for (int i_ = 0; i_ < 8; ++i_) {
                const int r_ = 2 * i_ + (lane >> 5);
                const int k0_ = (bt * 16 + 2 * i_) & 63;
                const int id0_ = __builtin_amdgcn_readlane(bt < 4 ? idA : idB, k0_), id1_ = __builtin_amdgcn_readlane(bt < 4 ? idA : idB, k0_ + 1);
                const int id_ = (lane >> 5) ? id1_ : id0_;
                dma16(utab + (size_t)((unsigned)id_ * 512u + (unsigned)(((lane & 31) ^ (r_ & 15)) * 16)), vbuf_lds + (unsigned)bsel * 8192u + (unsigned)i_ * 1024u);
            }
        };
        auto mma_ubatch = [&](int bt, int bsel) {
            const unsigned char* rowp = vbuf + bsel * 8192 + tk * 512;
            f32x4 acc = {0.f, 0.f, 0.f, 0.f};
#pragma unroll
            for (int kk = 0; kk < 8; ++kk) {
                const u32x4 a4 = *(const u32x4*)(rowp + (((kk * 4 + q) ^ tk) * 16));
                const i32x8 av = {(int)a4[0], (int)a4[1], (int)a4[2], (int)a4[3], 0, 0, 0, 0};
                acc = __builtin_amdgcn_mfma_scale_f32_16x16x128_f8f6f4(av, hb[kk], acc, 4  , 0  , 0, 0x7f7f7f7f, 0, 0x7f7f7f7f);
            }
            const int r = lane & 3;
            const float mine = r == 0 ? acc[0] : (r == 1 ? acc[1] : (r == 2 ? acc[2] : acc[3]));
            const float got = bperm_f(mine, ((lane & 15) >> 2) * 16 + (lane & 15));
            if (q == (bt & 3)) { if (bt < 4) dA = got; else dB = got; }
        };
        asm volatile("s_waitcnt vmcnt(0) lgkmcnt(0)" ::: "memory");
        dma_ubatch(0, 0);
        if (t + nw < T) preload(t + nw);
#pragma unroll
        for (int bt = 0; bt < 8; ++bt) {
            if (bt + 1 < 8) { dma_ubatch(bt + 1, (bt + 1) & 1); asm volatile("s_waitcnt vmcnt(8)" ::: "memory"); }
            else asm volatile("s_waitcnt vmcnt(0)" ::: "memory");
            mma_ubatch(bt, bt & 1);
            asm volatile("s_waitcnt lgkmcnt(0)" ::: "memory");
        }
        const float apA = gelu_tanh(dA * suA) * gA, apB = gelu_tanh(dB * suB) * gB;
        const bf16_t* cv0 = p.cvec + (size_t)b * 12 * 1024;
        u32x4 pv_gate[2], pv_a[2], pv_b[2], pv_c[2], pv_d[2];
#pragma unroll
        for (int j2 = 0; j2 < 2; ++j2) {
            pv_gate[j2] = *(const u32x4*)(cv + 2 * 1024 + e0 + j2 * 8);
            pv_a[j2] = *(const u32x4*)(cv0 + (FINAL ? 10 : 3) * 1024 + e0 + j2 * 8); pv_b[j2] = *(const u32x4*)(cv0 + (FINAL ? 11 : 4) * 1024 + e0 + j2 * 8);
            if (!FINAL) { pv_c[j2] = *(const u32x4*)(cv0 + 5 * 1024 + e0 + j2 * 8); pv_d[j2] = *(const u32x4*)(cv0 + 6 * 1024 + e0 + j2 * 8); }
        }
        float of[16];
        {
            const float amax = wave_max(fmaxf(fabsf(apA), fabsf(apB)));
            const float asc = amax > 0.f ? 224.f / amax : 0.f, iasc = amax * (1.f / 224.f);
            const int pk = __builtin_amdgcn_cvt_pk_fp8_f32(apA * asc, apB * asc, 0, false);
            a8l[lane] = (unsigned char)(pk & 0xff); a8l[64 + lane] = (unsigned char)((pk >> 8) & 0xff);
            unsigned rowoff[16];
#pragma unroll
            for (int i_ = 0; i_ < 16; ++i_) {
                const int r_ = 8 * (i_ & 7) + (lane >> 3);
                const int id_ = __builtin_amdgcn_ds_bpermute(r_ << 2, i_ < 8 ? idA : idB);
                rowoff[i_] = (unsigned)id_ * 512u + (unsigned)(((lane & 7) ^ (r_ & 7)) * 16);
            }
            asm volatile("s_waitcnt lgkmcnt(0)" ::: "memory");
            const u32x4 alo = *(const u32x4*)(a8l + 16 * q), ahi = *(const u32x4*)(a8l + 64 + 16 * q);
            const i32x8 av0 = {(int)alo[0], (int)alo[1], (int)alo[2], (int)alo[3], 0, 0, 0, 0}, av1 = {0, 0, 0, 0, (int)ahi[0], (int)ahi[1], (int)ahi[2], (int)ahi[3]};
            auto dma_slice = [&](int sidx, int bsel) {
#pragma unroll
                for (int i_ = 0; i_ < 8; ++i_)
                    dma16(vtab + (size_t)(rowoff[(sidx & 1) * 8 + i_] + (unsigned)(sidx >> 1) * 128u), vbuf_lds + (unsigned)bsel * 8192u + (unsigned)i_ * 1024u);
            };
            float ov[16];
#pragma unroll
            for (int e = 0; e < 16; ++e) ov[e] = 0.f;
            const int rl = 32 * (q & 1) + tk;
            asm volatile("s_waitcnt vmcnt(0) lgkmcnt(0)" ::: "memory");
            dma_slice(0, 0);
#pragma unroll
            for (int ln = 0; ln < 4; ++ln) {
#pragma unroll
                for (int rh = 0; rh < 2; ++rh) {
                    const int sidx = ln * 2 + rh;
                    if (sidx + 1 < 8) { dma_slice(sidx + 1, (sidx + 1) & 1); asm volatile("s_waitcnt vmcnt(8)" ::: "memory"); }
                    else asm volatile("s_waitcnt vmcnt(0)" ::: "memory");
                    const unsigned char* vb0 = vbuf + (sidx & 1) * 8192 + rl * 128, *vb1 = vb0 + 16 * 128;
                    typedef int i32x2 __attribute__((ext_vector_type(2)));
                    i32x2 ta[4][2], tb[4][2];
                    auto ldg = [&](i32x2 (&tt)[4][2], int g4) {
#pragma unroll
                        for (int e_ = 0; e_ < 4; ++e_) {
                            const int eg = g4 * 4 + e_;
                            const int co = (((eg >> 1) ^ (tk & 7)) * 16) + (eg & 1) * 8;
                            tt[e_][0] = __builtin_amdgcn_ds_read_tr4_b64_v2i32((LAS i32x2*)(vb0 + co));
                            tt[e_][1] = __builtin_amdgcn_ds_read_tr4_b64_v2i32((LAS i32x2*)(vb1 + co));
                        }
                    };
                    auto mmg = [&](const i32x2 (&tt)[4][2], int g4) {
#pragma unroll
                        for (int e_ = 0; e_ < 4; ++e_) {
                            const i32x8 bv = {tt[e_][0][0], tt[e_][0][1], tt[e_][1][0], tt[e_][1][1], 0, 0, 0, 0};
                            f32x4 z = {0.f, 0.f, 0.f, 0.f};
                            const f32x4 d = __builtin_amdgcn_mfma_scale_f32_16x16x128_f8f6f4(rh ? av1 : av0, bv, z, 0  , 4  , 0, 0x7f7f7f7f, 0, 0x7f7f7f7f);
                            if (g4 == q) ov[ln * 4 + e_] += d[0];
                        }
                    };
                    ldg(ta, 0);
#pragma unroll
                    for (int g4 = 0; g4 < 4; g4 += 2) {
                        ldg(tb, g4 + 1);
                        __builtin_amdgcn_sched_barrier(0);
                        mmg(ta, g4);
                        if (g4 + 2 < 4) ldg(ta, g4 + 2);
                        __builtin_amdgcn_sched_barrier(0);
                        mmg(tb, g4 + 1);
                    }
                    asm volatile("s_waitcnt lgkmcnt(0)" ::: "memory");
                }
            }
#pragma unroll
            for (int e = 0; e < 16; ++e) ov[e] *= iasc;
            float* outl = (float*)vbuf;
#pragma unroll
            for (int ln = 0; ln < 4; ++ln)
#pragma unroll
                for (int t_ = 0; t_ < 4; ++t_) outl[ln * 256 + (4 * q + t_) * 16 + tk] = ov[ln * 4 + t_];
            asm volatile("s_waitcnt lgkmcnt(0)" ::: "memory");
#pragma unroll
            for (int j4 = 0; j4 < 4; ++j4) { const f32x4 v4 = *(const f32x4*)(outl + lane * 16 + j4 * 4); of[j4 * 4] = v4[0]; of[j4 * 4 + 1] = v4[1]; of[j4 * 4 + 2] = v4[2]; of[j4 * 4 + 3] = v4[3]; }
            asm volatile("s_waitcnt lgkmcnt(0)" ::: "memory");
        }
        float xn[16]; float ss = 0.f;
        auto unp = [&](const u32x4 (&w)[2], float (&o)[16]) {
#pragma unroll
            for (int j2 = 0; j2 < 2; ++j2)
#pragma unroll
                for (int jj = 0; jj < 4; ++jj) { o[j2 * 8 + jj * 2] = bflo(w[j2][jj]); o[j2 * 8 + jj * 2 + 1] = bfhi(w[j2][jj]); }
        };
        {
            float gt[16]; unp(pv_gate, gt);
#pragma unroll
            for (int k = 0; k < 16; ++k) { const unsigned xw = xv[k >> 3][(k >> 1) & 3]; const float v = ((k & 1) ? bfhi(xw) : bflo(xw)) + gt[k] * of[k]; xn[k] = v; ss += v * v; }
        }
        ss = wave_sum(ss);
        const float rstd = rsqrtf(ss * (1.f / D) + RMS_EPS);
        if (!FINAL) {
#pragma unroll
            for (int j = 0; j < 2; ++j) *(u32x4*)(xout + (size_t)t * D + e0 + j * 8) = (u32x4){pack2(xn[j * 8], xn[j * 8 + 1]), pack2(xn[j * 8 + 2], xn[j * 8 + 3]), pack2(xn[j * 8 + 4], xn[j * 8 + 5]), pack2(xn[j * 8 + 6], xn[j * 8 + 7])};
            float gsv[16], shv[16], hk[16], hq[16];
            unp(pv_a, gsv); unp(pv_b, shv);
#pragma unroll
            for (int k = 0; k < 16; ++k) hk[k] = xn[k] * rstd * gsv[k] + shv[k];
            unp(pv_c, gsv); unp(pv_d, shv);
#pragma unroll
            for (int k = 0; k < 16; ++k) hq[k] = xn[k] * rstd * gsv[k] + shv[k];
            {
                u32x4 ob, oc;
#pragma unroll
                for (int j = 0; j < 4; ++j) { ob[j] = pack4_fp8(hk[j * 4], hk[j * 4 + 1], hk[j * 4 + 2], hk[j * 4 + 3]); oc[j] = pack4_fp8(hq[j * 4], hq[j * 4 + 1], hq[j * 4 + 2], hq[j * 4 + 3]); }
                *(u32x4*)((unsigned char*)hkv_out + (size_t)t * D + e0) = ob;
                *(u32x4*)((unsigned char*)hq_out + (size_t)t * D + e0) = oc;
            }
        } else {
            float gsv[16], shv[16];
            unp(pv_a, gsv); unp(pv_b, shv);
#pragma unroll
            for (int j = 0; j < 4; ++j) {
                f32x4 ov;
#pragma unroll
                for (int e = 0; e < 4; ++e) ov[e] = xn[j * 4 + e] * rstd * gsv[j * 4 + e] + shv[j * 4 + e];
                *(f32x4*)(p.out + (size_t)t * D + e0 + j * 4) = ov;
            }
        }
        asm volatile("s_waitcnt lgkmcnt(0)" ::: "memory");
    }
}

__device__ void attn_phase(const Params& p, const bf16_t* Q, const bf16_t* K, const bf16_t* V, bf16_t* O, unsigned char* smem) {
    unsigned char* Kl = smem;
    unsigned char* Vt = smem + 32768;
    unsigned char* Pl = smem + 32768 + 35840;
    const int tid = opaque_tid(), lane = tid & 63, w = __builtin_amdgcn_readfirstlane(tid >> 6), tk = lane & 15, q = lane >> 4;
    unsigned char* Pw = Pl + w * 5376;
    for (int task = blockIdx.x; task < NB * 32 * 4; task += gridDim.x) {
        const int kvh = task & 3, qblk = (task >> 2) & 31, b = task >> 7;
        const int kpos0 = (qblk - 1) * 128;
#pragma unroll
        for (int i = 0; i < 4; ++i) {
            const int id = tid + NT * i, j = id >> 3, c = id & 7, kp = kpos0 + j;
            u32x4 v = {0u, 0u, 0u, 0u};
            if (kp >= 0) v = *(const u32x4*)(K + ((size_t)b * SEQ + kp) * 256 + kvh * 64 + c * 8);
            *(u32x4*)(Kl + lds_off(j, c)) = v;
        }
#pragma unroll
        for (int i = 0; i < 4; ++i) {
            const int id = tid + NT * i, j = id & 255, dc = id >> 8, kp = kpos0 + j;
            u32x4 v = {0u, 0u, 0u, 0u};
            if (kp >= 0) v = *(const u32x4*)(V + ((size_t)b * SEQ + kp) * 256 + kvh * 64 + dc * 8);
#pragma unroll
            for (int e = 0; e < 4; ++e) {
                *(bf16_t*)(Vt + (dc * 8 + 2 * e) * 560 + j * 2) = (bf16_t)(v[e] & 0xffffu);
                *(bf16_t*)(Vt + (dc * 8 + 2 * e + 1) * 560 + j * 2) = (bf16_t)(v[e] >> 16);
            }
        }
        if (tid < 128) *(u32x4*)(Vt + (tid >> 1) * 560 + 512 + (tid & 1) * 16) = (u32x4){0u, 0u, 0u, 0u};
        *(u32x2*)(Pw + tk * 336 + (144 + 4 * q) * 2) = (u32x2){0u, 0u};
        __syncthreads();
        const int qt = w, i_q = qt * 16 + tk;
        const size_t trow = (size_t)b * SEQ + qblk * 128 + i_q;
        const unsigned char* kb0 = Kl + lds_off(qt * 16 + tk, q);
        const unsigned char* kb1 = Kl + lds_off(qt * 16 + tk, 4 + q);
        const unsigned char* vb0 = Vt + tk * 560 + (qt * 16 + 8 * q) * 2;
        unsigned char* pwr = Pw + tk * 336 + 8 * q;
        const unsigned char* prd = Pw + tk * 336 + 16 * q;
#pragma unroll 1
        for (int hq = 0; hq < 4; ++hq) {
            const int head = kvh * 4 + hq;
            const bf16x8 qf0 = *(const bf16x8*)(Q + trow * D + head * 64 + 8 * q), qf1 = *(const bf16x8*)(Q + trow * D + head * 64 + 32 + 8 * q);
            f32x4 sacc[9];
#pragma unroll
            for (int kk = 0; kk < 9; ++kk) {
                const bf16x8 k0 = *(const bf16x8*)(kb0 + kk * 2048), k1 = *(const bf16x8*)(kb1 + kk * 2048);
                f32x4 a = {0.f, 0.f, 0.f, 0.f};
                a = __builtin_amdgcn_mfma_f32_16x16x32_bf16(k0, qf0, a, 0, 0, 0);
                a = __builtin_amdgcn_mfma_f32_16x16x32_bf16(k1, qf1, a, 0, 0, 0);
                sacc[kk] = a;
                if (kk & 1) __builtin_amdgcn_sched_barrier(0);
            }
            const float sink = p.sinks[head];
            float mx = -1e30f;
#pragma unroll
            for (int kk = 0; kk < 9; ++kk)
#pragma unroll
                for (int r = 0; r < 4; ++r) {
                    const int j = (qt + kk) * 16 + 4 * q + r;
                    const bool valid = (j > i_q) && (j <= i_q + 128) && (qblk > 0 || j >= 128);
                    const float s = valid ? sacc[kk][r] * 0.125f : -1e30f;
                    sacc[kk][r] = s; mx = fmaxf(mx, s);
                }
            mx = fmaxf(mx, bperm_f(mx, lane ^ 16)); mx = fmaxf(mx, bperm_f(mx, lane ^ 32));
            mx = fmaxf(mx, sink);
            float sum = 0.f;
#pragma unroll
            for (int kk = 0; kk < 9; ++kk)
#pragma unroll
                for (int r = 0; r < 4; ++r) { const float e = __expf(sacc[kk][r] - mx); sacc[kk][r] = e; sum += e; }
            sum += bperm_f(sum, lane ^ 16); sum += bperm_f(sum, lane ^ 32);
            const float inv = 1.f / (sum + __expf(sink - mx));
#pragma unroll
            for (int kk = 0; kk < 9; ++kk) {
                u32x2 o; o[0] = pack2(sacc[kk][0] * inv, sacc[kk][1] * inv); o[1] = pack2(sacc[kk][2] * inv, sacc[kk][3] * inv);
                *(u32x2*)(pwr + kk * 32) = o;
            }
            asm volatile("s_waitcnt lgkmcnt(0)" ::: "memory");
            bf16x8 pf[5];
#pragma unroll
            for (int ks = 0; ks < 5; ++ks) pf[ks] = *(const bf16x8*)(prd + ks * 64);
#pragma unroll
            for (int dt = 0; dt < 4; ++dt) {
                f32x4 oa = {0.f, 0.f, 0.f, 0.f};
#pragma unroll
                for (int ks = 0; ks < 5; ++ks) {
                    const bf16x8 vf = *(const bf16x8*)(vb0 + dt * 8960 + ks * 64);
                    oa = __builtin_amdgcn_mfma_f32_16x16x32_bf16(vf, pf[ks], oa, 0, 0, 0);
                }
                *(unsigned*)((unsigned char*)O + trow * D + head * 64 + dt * 16 + 4 * q) = pack4_fp8(oa[0], oa[1], oa[2], oa[3]);
                __builtin_amdgcn_sched_barrier(0);
            }
            asm volatile("s_waitcnt lgkmcnt(0)" ::: "memory");
        }
        __syncthreads();
    }
}

constexpr int SMEM_BYTES = 152 * 1024;
__global__ void __launch_bounds__(NT) yoco_fwd(Params p) {
    __shared__ __attribute__((aligned(16))) unsigned char smem[SMEM_BYTES];
    volatile LAS unsigned* st = (volatile LAS unsigned*)(smem + SMEM_BYTES - 16);
    if (threadIdx.x == 0) { st[0] = 0u; st[1] = 0u; }
    __syncthreads();
    const XcdBarrier xb = xcd_barrier_post(p.bar, st);
    p0_cond(p, smem);
    xcd_barrier3(xb, 1u);
    p05_prep(p, smem);
    p0_tables(p);
    p0_w8(p, smem);
    p0_s5(p, smem);
    xcd_barrier3(xb, 2u);
    bias_finalize(p);
    { EpiU e{p.s1, p.cs_in}; gemm_phase<256, EpiU, true>(p.s0, p.w8_in, 0, 1024, e, smem); }
    xcd_barrier3(xb, 3u);
    s5_phase(p, smem);
    xcd_barrier3(xb, 4u);
    { EpiGlu e{(const unsigned char*)p.s0, p.b_glu, p.cs_glu, (unsigned char*)p.s1}; gemm_phase<256, EpiGlu, true>(p.s0, p.w8_glu, 0, 1024, e, smem); }
    xcd_barrier3(xb, 5u);
    { EpiRes<false> e{p.x, p.cond + 2 * D, p.norm_ffn, p.cond + 4 * D, p.f0, p.s2, p.ssq1, p.cs_out}; gemm_phase<256, EpiRes<false>, true>(p.s1, p.w8_out, 0, 1024, e, smem); }
    xcd_barrier3(xb, 6u);
    { EpiQ e{p.ssq1, p.bias, 0, p.s1, p.cs_pq0}; gemm_phase<256, EpiQ, true>(p.s2, p.w8_pq0, 0, 1024, e, smem); }
    xcd_barrier3(xb, 7u);
    route_phase(p, 0, p.s1, smem);
    xcd_barrier3(xb, 8u);
    gather_phase<false>(p, 0, p.f0, p.f1, p.s0, p.s2, smem);
    xcd_barrier3(xb, 9u);
    { EpiRope<0> e{p.ropec, p.ropes, p.s1, p.s1 + (size_t)T * 256, p.cs_kv}; gemm_phase<128, EpiRope<0>, true>(p.s0, p.w8_kv, 0, 512, e, smem); }
    { EpiRope<1> e{p.ropec, p.ropes, p.s3, nullptr, p.cs_q}; gemm_phase<256, EpiRope<1>, true>(p.s2, p.w8_q, 0, 1024, e, smem); }
    xcd_barrier3(xb, 10u);
    attn_phase(p, p.s3, p.s1, p.s1 + (size_t)T * 256, p.s0, smem);
    xcd_barrier3(xb, 11u);
    { EpiRes<true> e{p.f1, p.cond + 8 * D, p.norm_ffn + D, p.cond + 10 * D, p.f0, p.s2, p.ssq3, p.cs_o}; gemm_phase<256, EpiRes<true>, true>(p.s0, p.w8_o, 0, 1024, e, smem); }
    xcd_barrier3(xb, 12u);
    { EpiQ e{p.ssq3, p.bias, 1024, p.s1, p.cs_pq1}; gemm_phase<256, EpiQ, true>(p.s2, p.w8_pq1, 0, 1024, e, smem); }
    xcd_barrier3(xb, 13u);
    route_phase(p, 1, p.s1, smem);
    xcd_barrier3(xb, 14u);
    gather_phase<true>(p, 1, p.f0, nullptr, nullptr, nullptr, smem);
}

static inline size_t align_up(size_t v, size_t a) { return (v + a - 1) / a * a; }

extern "C" void kernel_launch(void* const* d_in, const int* in_sizes, int n_in, void* d_out, int out_size, void* d_ws, size_t ws_size, hipStream_t stream) {
    (void)in_sizes; (void)n_in; (void)out_size;
    Params p{};
    p.x = (const float*)d_in[0]; p.c = (const float*)d_in[1]; p.pos = (const int*)d_in[2]; p.w_cond = (const float*)d_in[3]; p.b_cond = (const float*)d_in[4];
    p.norm_mix = (const float*)d_in[5]; p.norm_ffn = (const float*)d_in[6]; p.w_in = (const float*)d_in[7]; p.a_re = (const float*)d_in[8]; p.a_im = (const float*)d_in[9];
    p.log_dt = (const float*)d_in[10]; p.b_re = (const float*)d_in[11]; p.b_im = (const float*)d_in[12]; p.c_re = (const float*)d_in[13]; p.c_im = (const float*)d_in[14];
    p.s5d = (const float*)d_in[15]; p.w_glu = (const float*)d_in[16]; p.b_glu = (const float*)d_in[17]; p.w_out = (const float*)d_in[18]; p.kv_norm = (const float*)d_in[19];
    p.w_kv = (const float*)d_in[20]; p.w_q = (const float*)d_in[21]; p.sinks = (const float*)d_in[22]; p.w_o = (const float*)d_in[23]; p.peer_wq = (const float*)d_in[24];
    p.subkeys = (const float*)d_in[25]; p.peer_u = (const float*)d_in[26]; p.peer_v = (const float*)d_in[27]; p.final_norm = (const float*)d_in[28];
    p.out = (float*)d_out;
    unsigned char* w = (unsigned char*)d_ws; size_t off = 65536;
    p.bar = (unsigned*)d_ws;
    auto take = [&](size_t bytes) { void* r = w + off; off = align_up(off + bytes, 4096); return r; };
    p.cond = (float*)take((size_t)NB * NCOND * D * 4);
    p.ropec = (float*)take((size_t)T * 32 * 4); p.ropes = (float*)take((size_t)T * 32 * 4);
    p.ssq1 = (float*)take((size_t)T * 16 * 4); p.ssq3 = (float*)take((size_t)T * 16 * 4);
    p.wt_in = (bf16_t*)take((size_t)D * D * 2); p.wt_glu = (bf16_t*)take((size_t)D * D * 2); p.wt_out = (bf16_t*)take((size_t)D * D * 2); p.wt_kv = (bf16_t*)take((size_t)512 * D * 2);
    p.wt_q = (bf16_t*)take((size_t)D * D * 2); p.wt_o = (bf16_t*)take((size_t)D * D * 2); p.wt_pq0 = (bf16_t*)take((size_t)D * D * 2); p.wt_pq1 = (bf16_t*)take((size_t)D * D * 2);
    p.w8_in = (unsigned char*)take((size_t)D * D); p.w8_glu = (unsigned char*)take((size_t)D * D); p.w8_out = (unsigned char*)take((size_t)D * D); p.w8_kv = (unsigned char*)take((size_t)512 * D);
    p.w8_q = (unsigned char*)take((size_t)D * D); p.w8_o = (unsigned char*)take((size_t)D * D); p.w8_pq0 = (unsigned char*)take((size_t)D * D); p.w8_pq1 = (unsigned char*)take((size_t)D * D);
    p.cs_in = (float*)take(4096); p.cs_glu = (float*)take(4096); p.cs_out = (float*)take(4096); p.cs_kv = (float*)take(4096); p.cs_q = (float*)take(4096); p.cs_o = (float*)take(4096); p.cs_pq0 = (float*)take(4096); p.cs_pq1 = (float*)take(4096);
    p.biasp = (float*)take((size_t)8 * 4 * 2048 * 4); p.bias = (float*)take((size_t)4 * 2048 * 4);
    p.skeys = (bf16_t*)take((size_t)2 * 8 * 2 * 128 * 64 * 2);
    p.lamL = (float*)take((size_t)G5 * P5 * 2 * 4); p.ktab = (bf16_t*)take((size_t)G5 * KTR * 256 * 2);
    p.smat = (bf16_t*)take((size_t)G5 * 128 * 1024 * 2); p.cmat = (bf16_t*)take((size_t)G5 * 1024 * 128 * 2);
    p.ub = (unsigned char*)take((size_t)2 * NEXP * D); p.vb = (unsigned char*)take((size_t)2 * NEXP * D);
    p.su = (float*)take((size_t)2 * NEXP * 4); p.sv = (float*)take((size_t)2 * NEXP * 4);
    p.s0 = (bf16_t*)take((size_t)T * D * 2); p.s1 = (bf16_t*)take((size_t)T * D * 2); p.s2 = (bf16_t*)take((size_t)T * D * 2); p.s3 = (bf16_t*)take((size_t)T * D * 2);
    p.f0 = (bf16_t*)take((size_t)T * D * 2); p.f1 = (bf16_t*)take((size_t)T * D * 2);
    p.ids = (int*)take((size_t)T * 128 * 4); p.gates = (float*)take((size_t)T * 128 * 4); p.sus = (float*)take((size_t)T * 128 * 4);
    p.cvec = (bf16_t*)take((size_t)4 * 12 * 1024 * 2);
    if (off > ws_size) { fprintf(stderr, "workspace too small: need %zu have %zu\n", off, ws_size); return; }

    static int grid_blocks = 0;
    if (!grid_blocks) {
        int dev = 0, cus = 0, per_cu = 0;
        (void)hipGetDevice(&dev);
        (void)hipDeviceGetAttribute(&cus, hipDeviceAttributeMultiprocessorCount, dev);
        (void)hipOccupancyMaxActiveBlocksPerMultiprocessor(&per_cu, yoco_fwd, NT, 0);
        if (per_cu > 1) per_cu = 1;
        grid_blocks = cus * per_cu;
        if (grid_blocks <= 0) grid_blocks = 256;
    }
    (void)hipMemsetAsync(d_ws, 0, XCD_BAR_WORDS * 4, stream);
    void* args[] = {&p};
    hipError_t e = hipLaunchCooperativeKernel((const void*)yoco_fwd, dim3(grid_blocks), dim3(NT), args, 0, stream);
    if (e != hipSuccess) fprintf(stderr, "cooperative launch failed: %s (grid %d)\n", hipGetErrorString(e), grid_blocks);
}
```
